# Optimizing an MI355X kernel written in HIP

```python
import math
import jax, jax.numpy as jnp
from jax import lax
import numpy as np

D_MODEL = 2048
BATCH = 2
SEQ = 4096
DEPTH = 1

MIX_WIDTH = D_MODEL
ATTN_WIDTH = MIX_WIDTH // 2
RWKV_WIDTH = MIX_WIDTH - ATTN_WIDTH
HEAD_DIM = 64
ATTN_HEADS = ATTN_WIDTH // HEAD_DIM
ATTN_KV_HEADS = max(1, ATTN_HEADS // 8)
ATTN_GROUP = ATTN_HEADS // ATTN_KV_HEADS
WINDOW = 128
BLOCK = WINDOW
ROPE_THETA = 10000.0
RWKV_HEAD = 64
RWKV_HEADS = RWKV_WIDTH // RWKV_HEAD
DECAY_LORA = 64
A_LORA = 64
GATE_LORA = 160
RWKV_LN_EPS = 64e-5
Q_COLS = ATTN_HEADS * HEAD_DIM
KV_COLS = ATTN_KV_HEADS * HEAD_DIM
ATTN_COLS = Q_COLS + 2 * KV_COLS
RWKV_COLS = 3 * RWKV_WIDTH + DECAY_LORA + A_LORA + GATE_LORA
IN_COLS = ATTN_COLS + RWKV_COLS
N_GROUPS = 8
EXPERTS_PER_GROUP = 8
N_EXPERTS = N_GROUPS * EXPERTS_PER_GROUP
TOP_K = 2
EXPERT_FF = 512
MOE_BLOCK = 128
NORM_EPS = 1e-6

kernel_name = "hymba_swa_rwkv7_hmoe_adaln"

F32 = jnp.float32


def rms_norm(x, g):
    x32 = x.astype(F32)
    y = x32 * lax.rsqrt(jnp.mean(x32 * x32, axis=-1, keepdims=True) + NORM_EPS)
    return (y * g.astype(F32)).astype(x.dtype)


def modulate(h, shift, scale):
    return h * (1 + scale[:, None, :]) + shift[:, None, :]


def rope_tables(seq_len):
    inv_freq = ROPE_THETA ** (-jnp.arange(0, HEAD_DIM, 2, dtype=F32) / HEAD_DIM)
    ang = jnp.arange(seq_len, dtype=F32)[:, None] * inv_freq[None, :]
    return jnp.cos(ang), jnp.sin(ang)


def apply_rope(t, cos, sin):
    t32 = t.astype(F32)
    t1, t2 = jnp.split(t32, 2, axis=-1)
    cs, sn = cos[None, :, None, :], sin[None, :, None, :]
    return jnp.concatenate([t1 * cs - t2 * sn, t2 * cs + t1 * sn], axis=-1).astype(t.dtype)


def sliding_window_attention(q, k, v, sinks):
    B, T, H, Dh = q.shape
    nb = T // BLOCK
    qb = q.reshape(B, nb, BLOCK, ATTN_KV_HEADS, ATTN_GROUP, Dh)
    pad = ((0, 0), (BLOCK, 0), (0, 0), (0, 0))
    kp = jnp.pad(k, pad).reshape(B, nb + 1, BLOCK, ATTN_KV_HEADS, Dh)
    vp = jnp.pad(v, pad).reshape(B, nb + 1, BLOCK, ATTN_KV_HEADS, Dh)
    kb = jnp.concatenate([kp[:, :-1], kp[:, 1:]], axis=2)
    vb = jnp.concatenate([vp[:, :-1], vp[:, 1:]], axis=2)
    s = jnp.einsum('bnqhgd,bnkhd->bnhgqk', qb, kb, preferred_element_type=F32) * (1.0 / math.sqrt(Dh))
    qpos = jnp.arange(BLOCK)[:, None]
    kpos = jnp.arange(2 * BLOCK)[None, :] - BLOCK
    diff = qpos - kpos
    band = (diff >= 0) & (diff < WINDOW)
    in_seq = (jnp.arange(nb)[:, None, None] * BLOCK + kpos[None]) >= 0
    valid = band[None] & in_seq
    s = jnp.where(valid[None, :, None, None], s, -jnp.inf)
    sink = sinks.astype(F32).reshape(1, 1, ATTN_KV_HEADS, ATTN_GROUP, 1, 1)
    m = jnp.maximum(jnp.max(s, axis=-1, keepdims=True), sink)
    p = jnp.exp(s - m)
    denom = jnp.sum(p, axis=-1, keepdims=True) + jnp.exp(sink - m)
    o = jnp.einsum('bnhgqk,bnkhd->bnqhgd', p / denom, vb.astype(F32))
    return o.reshape(B, T, H * Dh).astype(q.dtype)


def token_shift(z, mu):
    z_prev = jnp.pad(z, ((0, 0), (1, 0), (0, 0)))[:, :-1]
    return z + (z_prev - z) * mu


def rwkv7_time_mix(z, w0, w_decay_up, a0, w_a_up, w_g_up, k_k, k_a, r_k, ln_w, ln_b):
    B, T, _ = z.shape
    W, H, N = RWKV_WIDTH, RWKV_HEADS, RWKV_HEAD
    r, k, v, wd, ad, gd = jnp.split(
        z, [W, 2 * W, 3 * W, 3 * W + DECAY_LORA, 3 * W + DECAY_LORA + A_LORA], axis=-1)
    w = -jax.nn.softplus(-(w0 + jnp.tanh(wd) @ w_decay_up)) - 0.5
    decay = jnp.exp(-jnp.exp(w.astype(F32)))
    a = jax.nn.sigmoid(a0 + ad @ w_a_up)
    g = jax.nn.sigmoid(gd) @ w_g_up
    kk = (k * k_k).astype(F32).reshape(B, T, H, N)
    kk = kk / jnp.maximum(jnp.sqrt(jnp.sum(kk * kk, axis=-1, keepdims=True)), 1e-12)
    k = k * (1 + (a - 1) * k_a)

    def heads(t):
        return t.astype(F32).reshape(B, T, H, N)

    r_h, k_h, v_h, a_h = heads(r), heads(k), heads(v), heads(a)
    xs = tuple(jnp.moveaxis(t, 1, 0) for t in
               (r_h, decay.reshape(B, T, H, N), k_h, v_h, -kk, kk * a_h))

    def step(S, inp):
        r_t, w_t, k_t, v_t, aa_t, bb_t = inp
        sa = jnp.einsum('bhvk,bhk->bhv', S, aa_t)
        S = S * w_t[:, :, None, :] + sa[..., None] * bb_t[:, :, None, :] + v_t[..., None] * k_t[:, :, None, :]
        return S, jnp.einsum('bhvk,bhk->bhv', S, r_t)

    S0 = jnp.zeros((B, H, N, N), F32)
    _, ys = lax.scan(step, S0, xs)
    y = jnp.moveaxis(ys, 0, 1)
    mean = jnp.mean(y, axis=-1, keepdims=True)
    var = jnp.mean(jnp.square(y - mean), axis=-1, keepdims=True)
    y = (y - mean) * lax.rsqrt(var + RWKV_LN_EPS)
    y = y.reshape(B, T, W) * ln_w.astype(F32) + ln_b.astype(F32)
    bonus = jnp.sum(r_h * k_h * r_k.astype(F32), axis=-1, keepdims=True) * v_h
    y = (y + bonus.reshape(B, T, W)) * g.astype(F32)
    return y.astype(z.dtype)


def hierarchical_moe(h, w_rg, b_rg, w_re, b_re, w1, w3, w2):
    B, T, D = h.shape
    xt = h.reshape(-1, D)
    N = xt.shape[0]
    g_prob = jax.nn.softmax((xt @ w_rg).astype(F32) + b_rg.astype(F32), axis=-1)
    g_gate, g_idx = lax.top_k(g_prob, 1)
    e_logits = ((xt @ w_re).astype(F32) + b_re.astype(F32)).reshape(N, N_GROUPS, EXPERTS_PER_GROUP)
    e_logits = jnp.take_along_axis(e_logits, g_idx[:, :, None], axis=1)[:, 0]
    e_top, e_idx = lax.top_k(jax.nn.softmax(e_logits, axis=-1), TOP_K)
    e_top = e_top / jnp.sum(e_top, axis=-1, keepdims=True)
    weights = g_gate * e_top
    expert = g_idx * EXPERTS_PER_GROUP + e_idx

    A = N * TOP_K
    flat_e = expert.reshape(-1)
    flat_w = weights.reshape(-1)
    flat_tok = jnp.arange(A) // TOP_K
    order = jnp.argsort(flat_e)
    se, stok, sw = flat_e[order], flat_tok[order], flat_w[order]
    counts = jnp.bincount(flat_e, length=N_EXPERTS)
    starts = jnp.cumsum(counts) - counts
    pcounts = (counts + MOE_BLOCK - 1) // MOE_BLOCK * MOE_BLOCK
    pends = jnp.cumsum(pcounts)
    pstarts = pends - pcounts
    dest = pstarts[se] + jnp.arange(A) - starts[se]
    n_blocks = -(-A // MOE_BLOCK) + N_EXPERTS
    P = n_blocks * MOE_BLOCK
    buf_tok = jnp.zeros((P,), jnp.int32).at[dest].set(stok.astype(jnp.int32))
    buf_w = jnp.zeros((P,), F32).at[dest].set(sw)
    block_expert = jnp.minimum(
        jnp.searchsorted(pends, jnp.arange(n_blocks) * MOE_BLOCK, side='right'), N_EXPERTS - 1)
    xb = xt[buf_tok].reshape(n_blocks, MOE_BLOCK, D)

    def expert_block(args):
        xblk, e = args
        hid = jax.nn.silu(xblk @ w1[e]) * (xblk @ w3[e])
        return hid @ w2[e]

    yb = lax.map(expert_block, (xb, block_expert)).reshape(P, D)
    yb = yb * buf_w[:, None].astype(yb.dtype)
    out = jnp.zeros_like(xt).at[buf_tok].add(yb)
    return out.reshape(B, T, D)


def setup_inputs(seed: int = 0) -> dict:
    key = jax.random.key(seed)
    ks = jax.random.split(key, 32)
    L, D = DEPTH, D_MODEL

    def nrm(k, shape, scale):
        return jax.random.normal(k, shape, F32) * scale

    return {
        "x": nrm(ks[0], (BATCH, SEQ, D), 1.0),
        "c": nrm(ks[1], (BATCH, D), 1.0),
        "w_ada": nrm(ks[2], (L, D, 6 * D), 0.02),
        "b_ada": nrm(ks[3], (L, 6 * D), 0.02),
        "norm1_g": 1.0 + nrm(ks[4], (L, D), 0.02),
        "w_in": nrm(ks[5], (L, D, IN_COLS), D ** -0.5),
        "mu_shift": jax.random.uniform(ks[6], (L, RWKV_COLS), F32),
        "sinks": nrm(ks[7], (L, ATTN_HEADS), 0.5),
        "w0": nrm(ks[8], (L, RWKV_WIDTH), 0.5) - 0.5,
        "w_decay_up": nrm(ks[9], (L, DECAY_LORA, RWKV_WIDTH), 0.1),
        "a0": nrm(ks[10], (L, RWKV_WIDTH), 0.5),
        "w_a_up": nrm(ks[11], (L, A_LORA, RWKV_WIDTH), 0.5 * A_LORA ** -0.5),
        "w_g_up": nrm(ks[12], (L, GATE_LORA, RWKV_WIDTH), GATE_LORA ** -0.5),
        "k_k": 1.0 + nrm(ks[13], (L, RWKV_WIDTH), 0.1),
        "k_a": 1.0 + nrm(ks[14], (L, RWKV_WIDTH), 0.1),
        "r_k": nrm(ks[15], (L, RWKV_HEADS, RWKV_HEAD), 0.1),
        "ln_x_w": 1.0 + nrm(ks[16], (L, RWKV_WIDTH), 0.02),
        "ln_x_b": nrm(ks[17], (L, RWKV_WIDTH), 0.02),
        "w_o": nrm(ks[18], (L, MIX_WIDTH, D), MIX_WIDTH ** -0.5),
        "norm2_g": 1.0 + nrm(ks[19], (L, D), 0.02),
        "w_router_group": nrm(ks[20], (L, D, N_GROUPS), D ** -0.5),
        "b_router_group": nrm(ks[21], (L, N_GROUPS), 0.01),
        "w_router_expert": nrm(ks[22], (L, D, N_EXPERTS), D ** -0.5),
        "b_router_expert": nrm(ks[23], (L, N_EXPERTS), 0.01),
        "w1": nrm(ks[24], (L, N_EXPERTS, D, EXPERT_FF), D ** -0.5),
        "w3": nrm(ks[25], (L, N_EXPERTS, D, EXPERT_FF), D ** -0.5),
        "w2": nrm(ks[26], (L, N_EXPERTS, EXPERT_FF, D), EXPERT_FF ** -0.5),
        "final_g": 1.0 + nrm(ks[27], (D,), 0.02),
    }


def reference(x, c, w_ada, b_ada, norm1_g, w_in, mu_shift, sinks, w0, w_decay_up, a0, w_a_up,
              w_g_up, k_k, k_a, r_k, ln_x_w, ln_x_b, w_o, norm2_g, w_router_group, b_router_group,
              w_router_expert, b_router_expert, w1, w3, w2, final_g):
    B, T, _ = x.shape
    cos, sin = rope_tables(T)
    for l in range(DEPTH):
        mod = jax.nn.silu(c) @ w_ada[l] + b_ada[l]
        sh1, sc1, gt1, sh2, sc2, gt2 = jnp.split(mod, 6, axis=-1)

        h = modulate(rms_norm(x, norm1_g[l]), sh1, sc1)
        z = h @ w_in[l]
        z_attn, z_rwkv = z[..., :ATTN_COLS], z[..., ATTN_COLS:]
        q, k, v = jnp.split(z_attn, [Q_COLS, Q_COLS + KV_COLS], axis=-1)
        q = apply_rope(q.reshape(B, T, ATTN_HEADS, HEAD_DIM), cos, sin)
        k = apply_rope(k.reshape(B, T, ATTN_KV_HEADS, HEAD_DIM), cos, sin)
        v = v.reshape(B, T, ATTN_KV_HEADS, HEAD_DIM)
        o_attn = sliding_window_attention(q, k, v, sinks[l])
        o_rwkv = rwkv7_time_mix(token_shift(z_rwkv, mu_shift[l]), w0[l], w_decay_up[l], a0[l],
                                w_a_up[l], w_g_up[l], k_k[l], k_a[l], r_k[l],
                                ln_x_w[l], ln_x_b[l])
        mixed = jnp.concatenate([o_attn, o_rwkv], axis=-1) @ w_o[l]
        x = x + gt1[:, None, :] * mixed

        h = modulate(rms_norm(x, norm2_g[l]), sh2, sc2)
        x = x + gt2[:, None, :] * hierarchical_moe(h, w_router_group[l], b_router_group[l],
                                                   w_router_expert[l], b_router_expert[l],
                                                   w1[l], w3[l], w2[l])
    return rms_norm(x, final_g)
```

```cpp
#include <hip/hip_runtime.h>
#include <stdint.h>

#define DEVI __device__ __forceinline__
typedef unsigned short bf16_t;
typedef short bf16x8 __attribute__((ext_vector_type(8)));
typedef float f32x4 __attribute__((ext_vector_type(4)));
typedef float f32x2_t __attribute__((ext_vector_type(2)));
typedef __bf16 bf16x2_t __attribute__((ext_vector_type(2)));

constexpr int NTOK = 8192, DM = 2048, SEQ = 4096, INC = 4640, RW = 1024;
constexpr int ZC_K = 1024, ZC_V = 1152, ZC_RW = 1280;
constexpr int NEXP = 64, FF = 512, LCAP = 8192;
constexpr int NKS = 16;

constexpr size_t MiB = 1u << 20;
constexpr size_t WS_CTL = 0, CTL_BYTES = 1 * MiB;
constexpr size_t WS_PART = 1 * MiB;
constexpr size_t WS_MODF = 3 * MiB;
constexpr size_t WS_ROPE = 4 * MiB;
constexpr size_t WS_H = 8 * MiB;
constexpr size_t WS_Z = 40 * MiB;
constexpr size_t WS_MIX = 116 * MiB;
constexpr size_t WS_X1 = 148 * MiB;
constexpr size_t WS_R = 212 * MiB, WS_DEC = 244 * MiB, WS_K2 = 276 * MiB, WS_V = 308 * MiB, WS_AA = 340 * MiB, WS_BB = 372 * MiB, WS_G = 404 * MiB, WS_Y = 436 * MiB;
constexpr size_t WS_RKS = 468 * MiB;
constexpr size_t WS_LIST = 469 * MiB;
constexpr size_t WS_LW = 471 * MiB;
constexpr size_t WS_HID = 473 * MiB;
constexpr size_t WS_YB = 490 * MiB;

constexpr int LDS_BYTES = 114688;

struct Params {
    const float *x, *c, *w_ada, *b_ada, *norm1_g, *w_in, *mu, *sinks, *w0, *wd_up, *a0, *wa_up, *wg_up, *k_k, *k_a, *r_k, *ln_w, *ln_b, *w_o, *norm2_g,
        *w_rg, *b_rg, *w_re, *b_re, *w1, *w3, *w2, *final_g;
    float* out;
    unsigned char* ws;
};

DEVI unsigned cvtpk(float lo, float hi) { f32x2_t v = {lo, hi}; bf16x2_t b = __builtin_convertvector(v, bf16x2_t); return __builtin_bit_cast(unsigned, b); }
DEVI float bf2f(unsigned h) { return __builtin_bit_cast(float, h << 16); }
DEVI float bflo(unsigned u) { return __builtin_bit_cast(float, u << 16); }
DEVI float bfhi(unsigned u) { return __builtin_bit_cast(float, u & 0xffff0000u); }
DEVI float wave_sum(float v) {
#pragma unroll
    for (int o = 32; o > 0; o >>= 1) v += __shfl_xor(v, o, 64);
    return v;
}
DEVI float sigmoidf_(float x) { return 1.f / (1.f + __expf(-x)); }

template <int PF, int R, class Epi>
DEVI void gemm_tile(char* smem, int nk, long ldb, const float* bp0, const float* bp1, const bf16_t* ap0, const bf16_t* ap1, Epi&& epi) {
    static_assert(R > PF && (R % 2) == 0, "ring");
    const int tid = threadIdx.x, lane = tid & 63, li = lane & 15, lg = lane >> 4;
    const int sr = tid >> 2, scn = tid & 3;
    const unsigned aw0 = sr * 64 + ((scn ^ ((0 - (sr >> 2)) & 3)) << 4), aw1 = aw0 + 128 * 64;
    const unsigned ar = li * 64 + ((lg ^ ((0 - (li >> 2)) & 3)) << 4);
    float breg[R][2][8];
    f32x4 acc[16][2];
#pragma unroll
    for (int m = 0; m < 16; ++m) { acc[m][0] = f32x4{0.f, 0.f, 0.f, 0.f}; acc[m][1] = f32x4{0.f, 0.f, 0.f, 0.f}; }
    uint4 areg0 = *(const uint4*)ap0, areg1 = *(const uint4*)ap1;
#pragma unroll
    for (int s = 0; s < PF; ++s) {
        if (s < nk) {
#pragma unroll
            for (int j = 0; j < 8; ++j) { breg[s][0][j] = bp0[(long)(s * 32 + j) * ldb]; breg[s][1][j] = bp1[(long)(s * 32 + j) * ldb]; }
        }
    }
    *(uint4*)(smem + aw0) = areg0; *(uint4*)(smem + aw1) = areg1;
    __syncthreads();
    for (int kt0 = 0; kt0 < nk; kt0 += R) {
#pragma unroll
        for (int u = 0; u < R; ++u) {
            const int kt = kt0 + u;
            if (kt + 1 < nk) { areg0 = *(const uint4*)(ap0 + (kt + 1) * 32); areg1 = *(const uint4*)(ap1 + (kt + 1) * 32); }
            if (kt + PF < nk) {
                const float* q0 = bp0 + (long)(kt + PF) * 32 * ldb; const float* q1 = bp1 + (long)(kt + PF) * 32 * ldb;
#pragma unroll
                for (int j = 0; j < 8; ++j) { breg[(u + PF) % R][0][j] = q0[(long)j * ldb]; breg[(u + PF) % R][1][j] = q1[(long)j * ldb]; }
            }
            uint4 b0, b1;
            b0.x = cvtpk(breg[u][0][0], breg[u][0][1]); b0.y = cvtpk(breg[u][0][2], breg[u][0][3]); b0.z = cvtpk(breg[u][0][4], breg[u][0][5]); b0.w = cvtpk(breg[u][0][6], breg[u][0][7]);
            b1.x = cvtpk(breg[u][1][0], breg[u][1][1]); b1.y = cvtpk(breg[u][1][2], breg[u][1][3]); b1.z = cvtpk(breg[u][1][4], breg[u][1][5]); b1.w = cvtpk(breg[u][1][6], breg[u][1][7]);
            const bf16x8 bf0 = __builtin_bit_cast(bf16x8, b0), bf1 = __builtin_bit_cast(bf16x8, b1);
            const char* As = smem + (u & 1) * 16384 + ar;
#pragma unroll
            for (int m = 0; m < 16; ++m) {
                const bf16x8 af = *(const bf16x8*)(As + m * 1024);
                acc[m][0] = __builtin_amdgcn_mfma_f32_16x16x32_bf16(bf0, af, acc[m][0], 0, 0, 0);
                acc[m][1] = __builtin_amdgcn_mfma_f32_16x16x32_bf16(bf1, af, acc[m][1], 0, 0, 0);
            }
            if (kt + 1 < nk) { char* Aw = smem + ((u + 1) & 1) * 16384; *(uint4*)(Aw + aw0) = areg0; *(uint4*)(Aw + aw1) = areg1; }
            __syncthreads();
        }
    }
    epi(acc);
}

DEVI void phase0(const Params& p, char* smem) {
    float* sl = (float*)smem;
    float* part = (float*)(p.ws + WS_PART);
    float* rope = (float*)(p.ws + WS_ROPE);
    const int tid = threadIdx.x;
    constexpr int N_ADA = 24 * NKS, N_ROPE = 256;
    for (int u = blockIdx.x; u < N_ADA + N_ROPE; u += gridDim.x) {
        if (u < N_ADA) {
            const int cb = u % 24, ks = u / 24;
            __syncthreads();
            if (tid < 256) { const int b = tid >> 7, kk = tid & 127; const float cv = p.c[b * DM + ks * 128 + kk]; sl[b * 128 + kk] = cv / (1.f + expf(-cv)); }
            __syncthreads();
            const int j = cb * 512 + tid;
            const float* w = p.w_ada + (size_t)(ks * 128) * 12288 + j;
            float a0 = 0.f, a1 = 0.f;
#pragma unroll 8
            for (int kk = 0; kk < 128; ++kk) { const float wv = w[(size_t)kk * 12288]; a0 += sl[kk] * wv; a1 += sl[128 + kk] * wv; }
            part[(ks * 2 + 0) * 12288 + j] = a0; part[(ks * 2 + 1) * 12288 + j] = a1;
        } else {
            const int idx = (u - N_ADA) * 512 + tid;
            const int t = idx >> 5, i = idx & 31;
            const double invf = exp(-(double)(2 * i) / 64.0 * 9.210340371976184);
            const double ang = (double)t * invf;
            rope[idx] = (float)cos(ang); rope[SEQ * 32 + idx] = (float)sin(ang);
        }
    }
}

DEVI float mod_from_part(const Params& p, int b, int j) {
    const float* part = (const float*)(p.ws + WS_PART);
    float s = p.b_ada[j];
#pragma unroll
    for (int ks = 0; ks < NKS; ++ks) s += part[(ks * 2 + b) * 12288 + j];
    return s;
}

DEVI void phase1(const Params& p, char* smem) {
    float* A1 = (float*)smem;
    float* S1 = A1 + 2 * DM;
    float* modf = (float*)(p.ws + WS_MODF);
    bf16_t* h = (bf16_t*)(p.ws + WS_H);
    const int tid = threadIdx.x, lane = tid & 63, wave = tid >> 6;
    for (int idx = tid; idx < 2 * DM; idx += 512) {
        const int b = idx >> 11, k = idx & 2047;
        const float sh = mod_from_part(p, b, k), sc = mod_from_part(p, b, DM + k);
        A1[idx] = p.norm1_g[k] * (1.f + sc); S1[idx] = sh;
    }
    __syncthreads();
    constexpr int N_MODF = 48, N_ROWS = NTOK / 8;
    for (int u = blockIdx.x; u < N_MODF + N_ROWS; u += gridDim.x) {
        if (u < N_MODF) {
            const int idx = u * 512 + tid; const int b = idx / 12288, j = idx % 12288;
            modf[idx] = mod_from_part(p, b, j);
        } else {
            const int row = (u - N_MODF) * 8 + wave, b = row >> 12;
            const float* xr = p.x + (size_t)row * DM;
            float4 v[8]; float ss = 0.f;
#pragma unroll
            for (int i = 0; i < 8; ++i) { v[i] = *(const float4*)(xr + i * 256 + lane * 4); ss += v[i].x * v[i].x + v[i].y * v[i].y + v[i].z * v[i].z + v[i].w * v[i].w; }
            ss = wave_sum(ss);
            const float rstd = rsqrtf(ss * (1.f / DM) + 1e-6f);
#pragma unroll
            for (int i = 0; i < 8; ++i) {
                const int k = i * 256 + lane * 4;
                const float4 a = *(const float4*)(A1 + b * DM + k), s = *(const float4*)(S1 + b * DM + k);
                uint2 o; o.x = cvtpk(v[i].x * rstd * a.x + s.x, v[i].y * rstd * a.y + s.y); o.y = cvtpk(v[i].z * rstd * a.z + s.z, v[i].w * rstd * a.w + s.w);
                *(uint2*)(h + (size_t)row * DM + k) = o;
            }
        }
    }
}

DEVI void phase2(const Params& p, char* smem) {
    const bf16_t* h = (const bf16_t*)(p.ws + WS_H);
    bf16_t* z = (bf16_t*)(p.ws + WS_Z);
    const int tid = threadIdx.x, lane = tid & 63, wave = tid >> 6, li = lane & 15, lg = lane >> 4;
    constexpr int NMT = NTOK / 256, NNT = (INC + 255) / 256;
    for (int u = blockIdx.x; u < NMT * NNT; u += gridDim.x) {
        const int mt = u % NMT, nt = u / NMT;
        const int row0 = mt * 256, col0 = nt * 256 + wave * 32;
        int c0 = col0 + li, c1 = col0 + 16 + li; c0 = c0 < INC ? c0 : INC - 1; c1 = c1 < INC ? c1 : INC - 1;
        const float* bp0 = p.w_in + (size_t)(8 * lg) * INC + c0; const float* bp1 = p.w_in + (size_t)(8 * lg) * INC + c1;
        const bf16_t* ap0 = h + (size_t)(row0 + (tid >> 2)) * DM + (tid & 3) * 8; const bf16_t* ap1 = ap0 + (size_t)128 * DM;
        __syncthreads();
        gemm_tile<1, 2>(smem, DM / 32, INC, bp0, bp1, ap0, ap1, [&](f32x4 (&acc)[16][2]) {
#pragma unroll
            for (int m = 0; m < 16; ++m)
#pragma unroll
                for (int nf = 0; nf < 2; ++nf) {
                    const int col = col0 + nf * 16 + 4 * lg;
                    if (col < INC) {
                        uint2 o; o.x = cvtpk(acc[m][nf][0], acc[m][nf][1]); o.y = cvtpk(acc[m][nf][2], acc[m][nf][3]);
                        *(uint2*)(z + (size_t)(row0 + 16 * m + li) * INC + col) = o;
                    }
                }
        });
    }
}

DEVI float tokshift(const bf16_t* z, const float* mu, int tok, int c) {
    const float zc = bf2f(z[(size_t)tok * INC + ZC_RW + c]);
    const float zp = (tok & (SEQ - 1)) ? bf2f(z[(size_t)(tok - 1) * INC + ZC_RW + c]) : 0.f;
    return zc + (zp - zc) * mu[c];
}

DEVI void phase3(const Params& p, char* smem) {
    const bf16_t* z = (const bf16_t*)(p.ws + WS_Z);
    bf16_t* mix = (bf16_t*)(p.ws + WS_MIX);
    const float* rope = (const float*)(p.ws + WS_ROPE);
    const int tid = threadIdx.x, lane = tid & 63, wave = tid >> 6;
    constexpr int N_ATT = 256, N_PREP = NTOK / 16;
    for (int u = blockIdx.x; u < N_ATT + N_PREP; u += gridDim.x) {
        __syncthreads();
        if (u < N_ATT) {
            float* Ks = (float*)smem;
            float* Vs = Ks + 192 * 65;
            const int b = u >> 7, kvh = (u >> 6) & 1, qb = u & 63, t0 = qb * 64;
            for (int idx = tid; idx < 192 * 32; idx += 512) {
                const int j = idx >> 5, d = idx & 31, t = t0 - 127 + j;
                float k1 = 0.f, k2 = 0.f, v1 = 0.f, v2 = 0.f;
                if (t >= 0 && j < 191) {
                    const bf16_t* zr = z + (size_t)(b * SEQ + t) * INC;
                    const float ka = bf2f(zr[ZC_K + kvh * 64 + d]), kb = bf2f(zr[ZC_K + kvh * 64 + 32 + d]);
                    const float cs = rope[t * 32 + d], sn = rope[SEQ * 32 + t * 32 + d];
                    k1 = ka * cs - kb * sn; k2 = kb * cs + ka * sn;
                    v1 = bf2f(zr[ZC_V + kvh * 64 + d]); v2 = bf2f(zr[ZC_V + kvh * 64 + 32 + d]);
                }
                Ks[j * 65 + d] = k1; Ks[j * 65 + 32 + d] = k2; Vs[j * 65 + d] = v1; Vs[j * 65 + 32 + d] = v2;
            }
            __syncthreads();
            const int h = kvh * 8 + wave, t = t0 + lane;
            float q[64], o[64];
            {
                const bf16_t* zr = z + (size_t)(b * SEQ + t) * INC + h * 64;
                float raw[64];
#pragma unroll
                for (int i = 0; i < 8; ++i) {
                    const uint4 w = *(const uint4*)(zr + i * 8);
                    raw[i * 8 + 0] = bflo(w.x); raw[i * 8 + 1] = bfhi(w.x); raw[i * 8 + 2] = bflo(w.y); raw[i * 8 + 3] = bfhi(w.y);
                    raw[i * 8 + 4] = bflo(w.z); raw[i * 8 + 5] = bfhi(w.z); raw[i * 8 + 6] = bflo(w.w); raw[i * 8 + 7] = bfhi(w.w);
                }
#pragma unroll
                for (int d = 0; d < 32; ++d) {
                    const float cs = rope[t * 32 + d], sn = rope[SEQ * 32 + t * 32 + d];
                    q[d] = (raw[d] * cs - raw[d + 32] * sn) * 0.125f; q[d + 32] = (raw[d + 32] * cs + raw[d] * sn) * 0.125f;
                }
            }
#pragma unroll
            for (int d = 0; d < 64; ++d) o[d] = 0.f;
            float mx = p.sinks[h], l = 1.f;
            for (int i0 = 0; i0 < 128; i0 += 8) {
                float s[8];
#pragma unroll
                for (int ii = 0; ii < 8; ++ii) {
                    const float* kr = Ks + (lane + i0 + ii) * 65;
                    float a = 0.f;
#pragma unroll
                    for (int d = 0; d < 64; ++d) a += q[d] * kr[d];
                    s[ii] = (t - 127 + i0 + ii >= 0) ? a : -1e30f;
                }
                float mb = s[0];
#pragma unroll
                for (int ii = 1; ii < 8; ++ii) mb = fmaxf(mb, s[ii]);
                const float mn = fmaxf(mx, mb), corr = __expf(mx - mn);
                mx = mn; l *= corr;
#pragma unroll
                for (int d = 0; d < 64; ++d) o[d] *= corr;
#pragma unroll
                for (int ii = 0; ii < 8; ++ii) {
                    const float pe = __expf(s[ii] - mn);
                    l += pe;
                    const float* vr = Vs + (lane + i0 + ii) * 65;
#pragma unroll
                    for (int d = 0; d < 64; ++d) o[d] += pe * vr[d];
                }
            }
            const float inv = 1.f / l;
            bf16_t* orow = mix + (size_t)(b * SEQ + t) * DM + h * 64;
#pragma unroll
            for (int i = 0; i < 8; ++i) {
                uint4 w;
                w.x = cvtpk(o[i * 8 + 0] * inv, o[i * 8 + 1] * inv); w.y = cvtpk(o[i * 8 + 2] * inv, o[i * 8 + 3] * inv);
                w.z = cvtpk(o[i * 8 + 4] * inv, o[i * 8 + 5] * inv); w.w = cvtpk(o[i * 8 + 6] * inv, o[i * 8 + 7] * inv);
                *(uint4*)(orow + i * 8) = w;
            }
        } else {
            float* lin = (float*)smem;
            const int tok0 = (u - N_ATT) * 16;
            for (int idx = tid; idx < 16 * 288; idx += 512) {
                const int tk = idx / 288, i = idx % 288;
                const float zs = tokshift(z, p.mu, tok0 + tk, 3072 + i);
                lin[idx] = i < 64 ? tanhf(zs) : (i < 128 ? zs : sigmoidf_(zs));
            }
            __syncthreads();
            float* Rb = (float*)(p.ws + WS_R); float* DECb = (float*)(p.ws + WS_DEC); float* K2b = (float*)(p.ws + WS_K2); float* Vb = (float*)(p.ws + WS_V);
            float* AAb = (float*)(p.ws + WS_AA); float* BBb = (float*)(p.ws + WS_BB); float* Gb = (float*)(p.ws + WS_G); float* RKSb = (float*)(p.ws + WS_RKS);
            for (int chs = 0; chs < 2; ++chs) {
                const int ch = tid + 512 * chs, head = ch >> 6;
                float dl[16], al[16], gl[16];
#pragma unroll
                for (int tk = 0; tk < 16; ++tk) { dl[tk] = 0.f; al[tk] = 0.f; gl[tk] = 0.f; }
                for (int i = 0; i < 64; i += 4) {
                    const float w0_ = p.wd_up[(i + 0) * RW + ch], w1_ = p.wd_up[(i + 1) * RW + ch], w2_ = p.wd_up[(i + 2) * RW + ch], w3_ = p.wd_up[(i + 3) * RW + ch];
#pragma unroll
                    for (int tk = 0; tk < 16; ++tk) { const float4 lv = *(const float4*)(lin + tk * 288 + i); dl[tk] += lv.x * w0_ + lv.y * w1_ + lv.z * w2_ + lv.w * w3_; }
                }
                for (int i = 0; i < 64; i += 4) {
                    const float w0_ = p.wa_up[(i + 0) * RW + ch], w1_ = p.wa_up[(i + 1) * RW + ch], w2_ = p.wa_up[(i + 2) * RW + ch], w3_ = p.wa_up[(i + 3) * RW + ch];
#pragma unroll
                    for (int tk = 0; tk < 16; ++tk) { const float4 lv = *(const float4*)(lin + tk * 288 + 64 + i); al[tk] += lv.x * w0_ + lv.y * w1_ + lv.z * w2_ + lv.w * w3_; }
                }
                for (int i = 0; i < 160; i += 4) {
                    const float w0_ = p.wg_up[(i + 0) * RW + ch], w1_ = p.wg_up[(i + 1) * RW + ch], w2_ = p.wg_up[(i + 2) * RW + ch], w3_ = p.wg_up[(i + 3) * RW + ch];
#pragma unroll
                    for (int tk = 0; tk < 16; ++tk) { const float4 lv = *(const float4*)(lin + tk * 288 + 128 + i); gl[tk] += lv.x * w0_ + lv.y * w1_ + lv.z * w2_ + lv.w * w3_; }
                }
                const float w0c = p.w0[ch], a0c = p.a0[ch], kkc = p.k_k[ch], kac = p.k_a[ch], rkc = p.r_k[ch];
#pragma unroll
                for (int tk = 0; tk < 16; ++tk) {
                    const int tok = tok0 + tk;
                    const float r = tokshift(z, p.mu, tok, ch), k = tokshift(z, p.mu, tok, 1024 + ch), v = tokshift(z, p.mu, tok, 2048 + ch);
                    const float wl = w0c + dl[tk];
                    const float nx = -wl;
                    const float sp = nx > 20.f ? nx : log1pf(expf(nx));
                    const float w = -sp - 0.5f;
                    const float dec = expf(-expf(w));
                    const float a = sigmoidf_(a0c + al[tk]);
                    const float kk = k * kkc;
                    const float ssq = wave_sum(kk * kk);
                    const float kkn = kk / fmaxf(sqrtf(ssq), 1e-12f);
                    const float k2 = k * (1.f + (a - 1.f) * kac);
                    const float rk = wave_sum(r * k2 * rkc);
                    const size_t o = (size_t)tok * RW + ch;
                    Rb[o] = r; DECb[o] = dec; K2b[o] = k2; Vb[o] = v; AAb[o] = -kkn; BBb[o] = kkn * a; Gb[o] = gl[tk];
                    if (lane == 0) RKSb[tok * 16 + head] = rk;
                }
            }
        }
    }
}

DEVI void phase4(const Params& p, char* smem) {
    const int tid = threadIdx.x, lane = tid & 63, wave = tid >> 6;
    const float* const pAA = (const float*)(p.ws + WS_AA); const float* const pDE = (const float*)(p.ws + WS_DEC); const float* const pBB = (const float*)(p.ws + WS_BB);
    const float* const pK2 = (const float*)(p.ws + WS_K2); const float* const pR = (const float*)(p.ws + WS_R); const float* const pV = (const float*)(p.ws + WS_V);
    float* Y = (float*)(p.ws + WS_Y);
    constexpr int CH = 32;
    float* bufs = (float*)smem;
    for (int u = blockIdx.x; u < 32; u += gridDim.x) {
        const int b = u >> 4, h = u & 15;
        const int vr = lane >> 2, kq = lane & 3;
        float s[16];
#pragma unroll
        for (int j = 0; j < 16; ++j) s[j] = 0.f;
        __syncthreads();
        const int lst = tid >> 4, lc4 = tid & 15;
        const size_t goff = (size_t)(b * SEQ + lst) * RW + h * 64 + lc4 * 4;
        const int loff = lst * 64 + lc4 * 4;
        {
            *(float4*)(bufs + 0 * CH * 64 + loff) = *(const float4*)(pAA + goff); *(float4*)(bufs + 1 * CH * 64 + loff) = *(const float4*)(pDE + goff);
            *(float4*)(bufs + 2 * CH * 64 + loff) = *(const float4*)(pBB + goff); *(float4*)(bufs + 3 * CH * 64 + loff) = *(const float4*)(pK2 + goff);
            *(float4*)(bufs + 4 * CH * 64 + loff) = *(const float4*)(pR + goff); *(float4*)(bufs + 5 * CH * 64 + loff) = *(const float4*)(pV + goff);
        }
        __syncthreads();
        for (int c = 0; c < SEQ / CH; ++c) {
            float* cur = bufs + (c & 1) * (6 * CH * 64);
            float* nxt = bufs + ((c + 1) & 1) * (6 * CH * 64);
            float4 pre0, pre1, pre2, pre3, pre4, pre5;
            if (c + 1 < SEQ / CH) {
                const size_t g2 = goff + (size_t)(c + 1) * CH * RW;
                pre0 = *(const float4*)(pAA + g2); pre1 = *(const float4*)(pDE + g2); pre2 = *(const float4*)(pBB + g2);
                pre3 = *(const float4*)(pK2 + g2); pre4 = *(const float4*)(pR + g2); pre5 = *(const float4*)(pV + g2);
            }
            if (wave < 4) {
                for (int st = 0; st < CH; ++st) {
                    const float* aa = cur + (0 * CH + st) * 64 + kq * 16;
                    const float* de = cur + (1 * CH + st) * 64 + kq * 16;
                    const float* bb = cur + (2 * CH + st) * 64 + kq * 16;
                    const float* k2 = cur + (3 * CH + st) * 64 + kq * 16;
                    const float* rr = cur + (4 * CH + st) * 64 + kq * 16;
                    const float v = cur[(5 * CH + st) * 64 + wave * 16 + vr];
                    float sa = 0.f;
#pragma unroll
                    for (int j = 0; j < 16; ++j) sa += s[j] * aa[j];
                    sa += __shfl_xor(sa, 1, 64); sa += __shfl_xor(sa, 2, 64);
                    float y = 0.f;
#pragma unroll
                    for (int j = 0; j < 16; ++j) { s[j] = s[j] * de[j] + sa * bb[j] + v * k2[j]; y += s[j] * rr[j]; }
                    y += __shfl_xor(y, 1, 64); y += __shfl_xor(y, 2, 64);
                    if (kq == 0) Y[(size_t)(b * SEQ + c * CH + st) * RW + h * 64 + wave * 16 + vr] = y;
                }
            }
            if (c + 1 < SEQ / CH) {
                *(float4*)(nxt + 0 * CH * 64 + loff) = pre0; *(float4*)(nxt + 1 * CH * 64 + loff) = pre1; *(float4*)(nxt + 2 * CH * 64 + loff) = pre2;
                *(float4*)(nxt + 3 * CH * 64 + loff) = pre3; *(float4*)(nxt + 4 * CH * 64 + loff) = pre4; *(float4*)(nxt + 5 * CH * 64 + loff) = pre5;
            }
            __syncthreads();
        }
    }
}

DEVI void phase5(const Params& p, char* smem) {
    const int tid = threadIdx.x, lane = tid & 63, wave = tid >> 6;
    const float* Y = (const float*)(p.ws + WS_Y); const float* Vb = (const float*)(p.ws + WS_V); const float* Gb = (const float*)(p.ws + WS_G); const float* RKSb = (const float*)(p.ws + WS_RKS);
    bf16_t* mix = (bf16_t*)(p.ws + WS_MIX);
    for (int u = blockIdx.x; u < NTOK * 16 / 8; u += gridDim.x) {
        const int pi = u * 8 + wave, tok = pi >> 4, head = pi & 15, ch = head * 64 + lane;
        const float y = Y[(size_t)tok * RW + ch];
        const float mean = wave_sum(y) * (1.f / 64.f);
        const float d = y - mean;
        const float var = wave_sum(d * d) * (1.f / 64.f);
        const float yn = d * rsqrtf(var + 64e-5f) * p.ln_w[ch] + p.ln_b[ch];
        const float o = (yn + RKSb[tok * 16 + head] * Vb[(size_t)tok * RW + ch]) * Gb[(size_t)tok * RW + ch];
        mix[(size_t)tok * DM + 1024 + ch] = (bf16_t)(cvtpk(o, 0.f) & 0xffffu);
    }
}

DEVI void phase6(const Params& p, char* smem) {
    const bf16_t* mix = (const bf16_t*)(p.ws + WS_MIX);
    const float* modf = (const float*)(p.ws + WS_MODF);
    float* x1 = (float*)(p.ws + WS_X1);
    const int tid = threadIdx.x, lane = tid & 63, wave = tid >> 6, li = lane & 15, lg = lane >> 4;
    for (int u = blockIdx.x; u < 32 * 8; u += gridDim.x) {
        const int mt = u % 32, nt = u / 32;
        const int row0 = mt * 256, col0 = nt * 256 + wave * 32, b = row0 >> 12;
        const float* bp0 = p.w_o + (size_t)(8 * lg) * DM + col0 + li; const float* bp1 = bp0 + 16;
        const bf16_t* ap0 = mix + (size_t)(row0 + (tid >> 2)) * DM + (tid & 3) * 8; const bf16_t* ap1 = ap0 + (size_t)128 * DM;
        __syncthreads();
        gemm_tile<1, 2>(smem, DM / 32, DM, bp0, bp1, ap0, ap1, [&](f32x4 (&acc)[16][2]) {
#pragma unroll
            for (int nf = 0; nf < 2; ++nf) {
                const int col = col0 + nf * 16 + 4 * lg;
                const float4 gt = *(const float4*)(modf + b * 12288 + 2 * DM + col);
#pragma unroll
                for (int m = 0; m < 16; ++m) {
                    const size_t o = (size_t)(row0 + 16 * m + li) * DM + col;
                    const float4 xv = *(const float4*)(p.x + o);
                    float4 r; r.x = xv.x + gt.x * acc[m][nf][0]; r.y = xv.y + gt.y * acc[m][nf][1]; r.z = xv.z + gt.z * acc[m][nf][2]; r.w = xv.w + gt.w * acc[m][nf][3];
                    *(float4*)(x1 + o) = r;
                }
            }
        });
    }
}

DEVI void phase7(const Params& p, char* smem) {
    float* A2 = (float*)smem;
    float* S2 = A2 + 2 * DM;
    float* hs = S2 + 2 * DM;
    float* lg_ = hs + 8 * DM;
    const float* modf = (const float*)(p.ws + WS_MODF);
    const float* x1 = (const float*)(p.ws + WS_X1);
    bf16_t* h = (bf16_t*)(p.ws + WS_H);
    int* cnt = (int*)(p.ws + WS_CTL);
    int* list = (int*)(p.ws + WS_LIST); float* lw = (float*)(p.ws + WS_LW);
    const int tid = threadIdx.x, lane = tid & 63, wave = tid >> 6;
    __syncthreads();
    for (int idx = tid; idx < 2 * DM; idx += 512) {
        const int b = idx >> 11, k = idx & 2047;
        A2[idx] = p.norm2_g[k] * (1.f + modf[b * 12288 + 4 * DM + k]); S2[idx] = modf[b * 12288 + 3 * DM + k];
    }
    __syncthreads();
    for (int u = blockIdx.x; u < NTOK / 8; u += gridDim.x) {
        const int tok = u * 8 + wave, b = tok >> 12;
        const float* xr = x1 + (size_t)tok * DM;
        float4 v[8]; float ss = 0.f;
#pragma unroll
        for (int i = 0; i < 8; ++i) { v[i] = *(const float4*)(xr + i * 256 + lane * 4); ss += v[i].x * v[i].x + v[i].y * v[i].y + v[i].z * v[i].z + v[i].w * v[i].w; }
        ss = wave_sum(ss);
        const float rstd = rsqrtf(ss * (1.f / DM) + 1e-6f);
        float* hw = hs + wave * DM;
#pragma unroll
        for (int i = 0; i < 8; ++i) {
            const int k = i * 256 + lane * 4;
            const float4 a = *(const float4*)(A2 + b * DM + k), s = *(const float4*)(S2 + b * DM + k);
            float4 hv; hv.x = v[i].x * rstd * a.x + s.x; hv.y = v[i].y * rstd * a.y + s.y; hv.z = v[i].z * rstd * a.z + s.z; hv.w = v[i].w * rstd * a.w + s.w;
            *(float4*)(hw + k) = hv;
            uint2 o; o.x = cvtpk(hv.x, hv.y); o.y = cvtpk(hv.z, hv.w);
            *(uint2*)(h + (size_t)tok * DM + k) = o;
        }
        __syncthreads();
        float ae = 0.f, ag = 0.f;
        const float* wre = p.w_re + lane; const float* wrg = p.w_rg + (lane & 7);
        for (int k = 0; k < DM; k += 4) {
            const float4 hv = *(const float4*)(hw + k);
            ae += hv.x * wre[(k + 0) * 64] + hv.y * wre[(k + 1) * 64] + hv.z * wre[(k + 2) * 64] + hv.w * wre[(k + 3) * 64];
            ag += hv.x * wrg[(k + 0) * 8] + hv.y * wrg[(k + 1) * 8] + hv.z * wrg[(k + 2) * 8] + hv.w * wrg[(k + 3) * 8];
        }
        lg_[wave * 80 + lane] = ae + p.b_re[lane];
        if (lane < 8) lg_[wave * 80 + 64 + lane] = ag + p.b_rg[lane];
        __syncthreads();
        if (lane == 0) {
            const float* L = lg_ + wave * 80;
            int gi = 0; float gm = L[64];
            for (int j = 1; j < 8; ++j) if (L[64 + j] > gm) { gm = L[64 + j]; gi = j; }
            float den = 0.f;
            for (int j = 0; j < 8; ++j) den += expf(L[64 + j] - gm);
            const float ggate = 1.f / den;
            const float* E = L + gi * 8;
            int i1 = 0; float m1 = E[0];
            for (int j = 1; j < 8; ++j) if (E[j] > m1) { m1 = E[j]; i1 = j; }
            int i2 = -1; float m2 = -3.0e38f;
            for (int j = 0; j < 8; ++j) if (j != i1 && E[j] > m2) { m2 = E[j]; i2 = j; }
            const float e2 = expf(m2 - m1);
            const float p1 = 1.f / (1.f + e2), p2 = e2 / (1.f + e2);
            const int ex1 = gi * 8 + i1, ex2 = gi * 8 + i2;
            const int pos1 = atomicAdd(&cnt[ex1], 1); list[ex1 * LCAP + pos1] = tok * 2; lw[ex1 * LCAP + pos1] = ggate * p1;
            const int pos2 = atomicAdd(&cnt[ex2], 1); list[ex2 * LCAP + pos2] = tok * 2 + 1; lw[ex2 * LCAP + pos2] = ggate * p2;
        }
        __syncthreads();
    }
}

struct MoeTab { int cnt[64]; int ub[65]; int sb[65]; };
DEVI void moe_tables(const Params& p, MoeTab* tb, int units_per_pass) {
    const int* cnt = (const int*)(p.ws + WS_CTL);
    const int tid = threadIdx.x;
    __syncthreads();
    if (tid < 64) tb->cnt[tid] = cnt[tid];
    __syncthreads();
    if (tid == 0) {
        int ub = 0, sb = 0;
        for (int e = 0; e < 64; ++e) { tb->ub[e] = ub; tb->sb[e] = sb; ub += ((tb->cnt[e] + 255) >> 8) * units_per_pass; sb += tb->cnt[e]; }
        tb->ub[64] = ub; tb->sb[64] = sb;
    }
    __syncthreads();
}

DEVI void phase8(const Params& p, char* smem) {
    MoeTab* tb = (MoeTab*)(smem + 32768);
    const bf16_t* h = (const bf16_t*)(p.ws + WS_H);
    bf16_t* hid = (bf16_t*)(p.ws + WS_HID);
    const int* list = (const int*)(p.ws + WS_LIST);
    const int tid = threadIdx.x, lane = tid & 63, wave = tid >> 6, li = lane & 15, lg = lane >> 4;
    moe_tables(p, tb, 4);
    const int total = tb->ub[64];
    for (int u = blockIdx.x; u < total; u += gridDim.x) {
        int e = 0;
        while (tb->ub[e + 1] <= u) ++e;
        const int rem = u - tb->ub[e], s = rem & 3, ps = rem >> 2;
        const int ce = tb->cnt[e], sbase = tb->sb[e];
        const int fcol = s * 128 + wave * 16;
        const float* bp0 = p.w1 + (size_t)e * DM * FF + (size_t)(8 * lg) * FF + fcol + li;
        const float* bp1 = p.w3 + (size_t)e * DM * FF + (size_t)(8 * lg) * FF + fcol + li;
        int r0 = ps * 256 + (tid >> 2), r1 = r0 + 128; r0 = r0 < ce ? r0 : ce - 1; r1 = r1 < ce ? r1 : ce - 1;
        const bf16_t* ap0 = h + (size_t)(list[e * LCAP + r0] >> 1) * DM + (tid & 3) * 8;
        const bf16_t* ap1 = h + (size_t)(list[e * LCAP + r1] >> 1) * DM + (tid & 3) * 8;
        __syncthreads();
        gemm_tile<1, 2>(smem, DM / 32, FF, bp0, bp1, ap0, ap1, [&](f32x4 (&acc)[16][2]) {
#pragma unroll
            for (int m = 0; m < 16; ++m) {
                const int r = ps * 256 + 16 * m + li;
                if (r < ce) {
                    float hv[4];
#pragma unroll
                    for (int q = 0; q < 4; ++q) { const float a = acc[m][0][q]; hv[q] = a / (1.f + __expf(-a)) * acc[m][1][q]; }
                    uint2 o; o.x = cvtpk(hv[0], hv[1]); o.y = cvtpk(hv[2], hv[3]);
                    *(uint2*)(hid + (size_t)(sbase + r) * FF + fcol + 4 * lg) = o;
                }
            }
        });
    }
}

DEVI void phase9(const Params& p, char* smem) {
    MoeTab* tb = (MoeTab*)(smem + 32768);
    const bf16_t* hid = (const bf16_t*)(p.ws + WS_HID);
    bf16_t* yb = (bf16_t*)(p.ws + WS_YB);
    const int* list = (const int*)(p.ws + WS_LIST); const float* lw = (const float*)(p.ws + WS_LW);
    const int tid = threadIdx.x, lane = tid & 63, wave = tid >> 6, li = lane & 15, lg = lane >> 4;
    moe_tables(p, tb, 8);
    const int total = tb->ub[64];
    for (int u = blockIdx.x; u < total; u += gridDim.x) {
        int e = 0;
        while (tb->ub[e + 1] <= u) ++e;
        const int rem = u - tb->ub[e], s = rem & 7, ps = rem >> 3;
        const int ce = tb->cnt[e], sbase = tb->sb[e];
        const int col0 = s * 256 + wave * 32;
        const float* bp0 = p.w2 + (size_t)e * FF * DM + (size_t)(8 * lg) * DM + col0 + li; const float* bp1 = bp0 + 16;
        const bf16_t* ap0 = hid + (size_t)(sbase + ps * 256 + (tid >> 2)) * FF + (tid & 3) * 8; const bf16_t* ap1 = ap0 + (size_t)128 * FF;
        __syncthreads();
        gemm_tile<1, 2>(smem, FF / 32, DM, bp0, bp1, ap0, ap1, [&](f32x4 (&acc)[16][2]) {
#pragma unroll
            for (int m = 0; m < 16; ++m) {
                const int r = ps * 256 + 16 * m + li;
                if (r < ce) {
                    const int a = list[e * LCAP + r]; const float wgt = lw[e * LCAP + r];
#pragma unroll
                    for (int nf = 0; nf < 2; ++nf) {
                        uint2 o; o.x = cvtpk(acc[m][nf][0] * wgt, acc[m][nf][1] * wgt); o.y = cvtpk(acc[m][nf][2] * wgt, acc[m][nf][3] * wgt);
                        *(uint2*)(yb + (size_t)a * DM + col0 + nf * 16 + 4 * lg) = o;
                    }
                }
            }
        });
    }
}

DEVI void phase10(const Params& p, char* smem) {
    const float* modf = (const float*)(p.ws + WS_MODF);
    const float* x1 = (const float*)(p.ws + WS_X1);
    const bf16_t* yb = (const bf16_t*)(p.ws + WS_YB);
    const int tid = threadIdx.x, lane = tid & 63, wave = tid >> 6;
    for (int u = blockIdx.x; u < NTOK / 8; u += gridDim.x) {
        const int tok = u * 8 + wave, b = tok >> 12;
        float4 v[8]; float ss = 0.f;
#pragma unroll
        for (int i = 0; i < 8; ++i) {
            const int k = i * 256 + lane * 4;
            const float4 xv = *(const float4*)(x1 + (size_t)tok * DM + k);
            const float4 gt = *(const float4*)(modf + b * 12288 + 5 * DM + k);
            const uint2 ya = *(const uint2*)(yb + (size_t)(tok * 2) * DM + k), yc = *(const uint2*)(yb + (size_t)(tok * 2 + 1) * DM + k);
            v[i].x = xv.x + gt.x * (bflo(ya.x) + bflo(yc.x)); v[i].y = xv.y + gt.y * (bfhi(ya.x) + bfhi(yc.x));
            v[i].z = xv.z + gt.z * (bflo(ya.y) + bflo(yc.y)); v[i].w = xv.w + gt.w * (bfhi(ya.y) + bfhi(yc.y));
            ss += v[i].x * v[i].x + v[i].y * v[i].y + v[i].z * v[i].z + v[i].w * v[i].w;
        }
        ss = wave_sum(ss);
        const float rstd = rsqrtf(ss * (1.f / DM) + 1e-6f);
#pragma unroll
        for (int i = 0; i < 8; ++i) {
            const int k = i * 256 + lane * 4;
            const float4 g = *(const float4*)(p.final_g + k);
            float4 o; o.x = v[i].x * rstd * g.x; o.y = v[i].y * rstd * g.y; o.z = v[i].z * rstd * g.z; o.w = v[i].w * rstd * g.w;
            *(float4*)(p.out + (size_t)tok * DM + k) = o;
        }
    }
}

template <int PH>
__global__ void __launch_bounds__(512) phase_kernel(Params p) {
    extern __shared__ __attribute__((aligned(16))) char smem[];
    if constexpr (PH == 0) phase0(p, smem);
    if constexpr (PH == 1) phase1(p, smem);
    if constexpr (PH == 2) phase2(p, smem);
    if constexpr (PH == 3) phase3(p, smem);
    if constexpr (PH == 4) phase4(p, smem);
    if constexpr (PH == 5) phase5(p, smem);
    if constexpr (PH == 6) phase6(p, smem);
    if constexpr (PH == 7) phase7(p, smem);
    if constexpr (PH == 8) phase8(p, smem);
    if constexpr (PH == 9) phase9(p, smem);
    if constexpr (PH == 10) phase10(p, smem);
}

template <int PH>
static void launch_phase(const Params& p, int grid, hipStream_t stream) {
    static bool attr_done = false;
    if (!attr_done) { (void)hipFuncSetAttribute((const void*)phase_kernel<PH>, hipFuncAttributeMaxDynamicSharedMemorySize, LDS_BYTES); attr_done = true; }
    hipLaunchKernelGGL(phase_kernel<PH>, dim3(grid), dim3(512), LDS_BYTES, stream, p);
}

extern "C" void kernel_launch(void* const* d_in, const int* in_sizes, int n_in, void* d_out, int out_size, void* d_ws, size_t ws_size, hipStream_t stream) {
    Params p{};
    const float* const* in = (const float* const*)d_in;
    p.x = in[0]; p.c = in[1]; p.w_ada = in[2]; p.b_ada = in[3]; p.norm1_g = in[4]; p.w_in = in[5]; p.mu = in[6]; p.sinks = in[7]; p.w0 = in[8]; p.wd_up = in[9];
    p.a0 = in[10]; p.wa_up = in[11]; p.wg_up = in[12]; p.k_k = in[13]; p.k_a = in[14]; p.r_k = in[15]; p.ln_w = in[16]; p.ln_b = in[17]; p.w_o = in[18]; p.norm2_g = in[19];
    p.w_rg = in[20]; p.b_rg = in[21]; p.w_re = in[22]; p.b_re = in[23]; p.w1 = in[24]; p.w3 = in[25]; p.w2 = in[26]; p.final_g = in[27];
    p.out = (float*)d_out; p.ws = (unsigned char*)d_ws;
    (void)hipMemsetAsync((char*)d_ws + WS_CTL, 0, CTL_BYTES, stream);
    launch_phase<0>(p, 256, stream);
    launch_phase<1>(p, 256, stream);
    launch_phase<2>(p, 256, stream);
    launch_phase<3>(p, 256, stream);
    launch_phase<4>(p, 32, stream);
    launch_phase<5>(p, 256, stream);
    launch_phase<6>(p, 256, stream);
    launch_phase<7>(p, 256, stream);
    launch_phase<8>(p, 256, stream);
    launch_phase<9>(p, 256, stream);
    launch_phase<10>(p, 256, stream);
}
```

```cpp
#include <hip/hip_runtime.h>
#include <stdint.h>

#define DEVI __device__ __forceinline__
typedef unsigned short bf16_t;
typedef short bf16x8 __attribute__((ext_vector_type(8)));
typedef float f32x4 __attribute__((ext_vector_type(4)));
typedef float f32x16 __attribute__((ext_vector_type(16)));
typedef float f32x2_t __attribute__((ext_vector_type(2)));
typedef __bf16 bf16x2_t __attribute__((ext_vector_type(2)));

constexpr int NTOK = 8192, DM = 2048, SEQ = 4096, INC = 4640, RW = 1024;
constexpr int ZC_K = 1024, ZC_V = 1152, ZC_RW = 1280;
constexpr int NEXP = 64, FF = 512, LCAP = 8192;
constexpr int NKS = 16;

constexpr size_t MiB = 1u << 20;
constexpr size_t WS_CTL = 0, CTL_BYTES = 20480;
constexpr size_t WS_PART = 1 * MiB;
constexpr size_t WS_MODF = 3 * MiB;
constexpr size_t WS_ROPE = 4 * MiB;
constexpr size_t WS_WRF = 5 * MiB;
constexpr size_t WS_CB = 7 * MiB;
constexpr size_t WS_AS2 = 7 * MiB + 4096;
constexpr size_t WS_H = 8 * MiB;
constexpr size_t WS_Z = 40 * MiB;
constexpr size_t WS_MIX = 116 * MiB;
constexpr size_t WS_X1 = 148 * MiB;
constexpr size_t WS_R = 212 * MiB, WS_DEC = 244 * MiB, WS_K2 = 276 * MiB, WS_V = 308 * MiB, WS_AA = 340 * MiB, WS_BB = 372 * MiB, WS_G = 404 * MiB, WS_Y = 436 * MiB;
constexpr size_t WS_LW = 212 * MiB;
constexpr size_t WS_AV = 244 * MiB;
constexpr size_t WS_GV = 260 * MiB;
constexpr size_t WS_RKS = 468 * MiB;
constexpr size_t WS_LIST = 469 * MiB;
constexpr size_t WS_LWT = 471 * MiB;
constexpr size_t WS_HID = 473 * MiB;
constexpr size_t WS_YB = 490 * MiB;

constexpr size_t WS_WTI = 672 * MiB;
constexpr size_t WS_WTO = 692 * MiB;
constexpr size_t WS_GB = 556 * MiB;
constexpr size_t WS_HB = 572 * MiB;
constexpr size_t WS_Q2 = 604 * MiB;
constexpr size_t WS_Q1 = 636 * MiB;
constexpr size_t WS_S0 = 652 * MiB;

constexpr int LDS_BYTES = 147456;

struct Params {
    const float *x, *c, *w_ada, *b_ada, *norm1_g, *w_in, *mu, *sinks, *w0, *wd_up, *a0, *wa_up, *wg_up, *k_k, *k_a, *r_k, *ln_w, *ln_b, *w_o, *norm2_g,
        *w_rg, *b_rg, *w_re, *b_re, *w1, *w3, *w2, *final_g;
    float* out;
    unsigned char* ws;
};

DEVI unsigned cvtpk(float lo, float hi) { f32x2_t v = {lo, hi}; bf16x2_t b = __builtin_convertvector(v, bf16x2_t); return __builtin_bit_cast(unsigned, b); }
DEVI float bf2f(unsigned h) { return __builtin_bit_cast(float, h << 16); }
DEVI float bflo(unsigned u) { return __builtin_bit_cast(float, u << 16); }
DEVI float bfhi(unsigned u) { return __builtin_bit_cast(float, u & 0xffff0000u); }
DEVI float wave_sum(float v) {
#pragma unroll
    for (int o = 32; o > 0; o >>= 1) v += __shfl_xor(v, o, 64);
    return v;
}
DEVI float sigmoidf_(float x) { return 1.f / (1.f + __expf(-x)); }

#define XB_TMO      128
#define XB_XCNT(j)  (256  + 64 * (j))
#define XB_XSUB(j)  (1280 + 64 * (j))
#define XB_XGEN(j)  (2304 + 64 * (j))
#define XB_TOP      3328
#define XB_TOPGEN   3392
#define XCD_BAR_WORDS 3456
#define XB_SPIN_CAP (1u << 18)
#define LAS __attribute__((address_space(3)))

__device__ __forceinline__ unsigned xb_ld(unsigned* p)              { return __hip_atomic_load(p, __ATOMIC_RELAXED, __HIP_MEMORY_SCOPE_AGENT); }
__device__ __forceinline__ unsigned xb_add(unsigned* p, unsigned v) { return __hip_atomic_fetch_add(p, v, __ATOMIC_RELAXED, __HIP_MEMORY_SCOPE_AGENT); }
__device__ __forceinline__ unsigned xb_xcc_id() { return (unsigned)__builtin_amdgcn_s_getreg((3 << 11) | 20) & 0xFu; }
#define XB_SPIN(cond, bar) do { unsigned _sp = 0; while (cond) { __builtin_amdgcn_s_sleep(1); \
    if ((++_sp & 255u) == 0u) { if (xb_ld(&(bar)[XB_TMO])) break; if (_sp > XB_SPIN_CAP) { atomicAdd(&(bar)[XB_TMO], 1u); break; } } } } while (0)

struct XcdBarrier {
    unsigned* bar; unsigned x;
    volatile LAS unsigned* st;
};

__device__ __forceinline__ XcdBarrier xcd_barrier_post(unsigned* bar, volatile LAS unsigned* st) {
    XcdBarrier b; b.bar = bar; b.x = xb_xcc_id(); b.st = st;
    if (threadIdx.x == 0) (void)xb_add(&bar[XB_XCNT(b.x)], 1u);
    return b;
}
__device__ __forceinline__ void xcd_barrier_complete(unsigned* bar, unsigned x, unsigned& nloc, unsigned& nx) {
    const unsigned G = gridDim.x * gridDim.y * gridDim.z;
    unsigned sum, cnt, mine, sp = 0u;
    for (;;) {
        sum = 0u; cnt = 0u; mine = 0u;
#pragma unroll
        for (unsigned j = 0; j < 16; ++j) { const unsigned c = xb_ld(&bar[XB_XCNT(j)]); sum += c; cnt += (c > 0u) ? 1u : 0u; mine = (j == x) ? c : mine; }
        if (sum == G) break;
        __builtin_amdgcn_s_sleep(1);
        if ((++sp & 255u) == 0u) { if (xb_ld(&bar[XB_TMO])) break; if (sp > XB_SPIN_CAP) { atomicAdd(&bar[XB_TMO], 1u); break; } }
    }
    nloc = mine > 0u ? mine : 1u; nx = cnt > 0u ? cnt : 1u;
}

__device__ __forceinline__ void xcd_barrier(const XcdBarrier& b) {
    asm volatile("s_waitcnt vmcnt(0)" ::: "memory");
    __syncthreads();
    if (threadIdx.x == 0) {
        unsigned* bar = b.bar;
        __builtin_amdgcn_s_waitcnt(0);
        unsigned nloc = b.st[0], nx = b.st[1];
        if (nloc == 0u) { xcd_barrier_complete(bar, b.x, nloc, nx); b.st[0] = nloc; b.st[1] = nx; }
        const unsigned old = xb_add(&bar[XB_XSUB(b.x)], 1u);
        const unsigned gen = old / nloc;
        if (old + 1u == (gen + 1u) * nloc) {
            __builtin_amdgcn_fence(__ATOMIC_RELEASE, "agent");
            asm volatile("s_waitcnt vmcnt(0)" ::: "memory");
            const unsigned og = xb_add(&bar[XB_TOP], 1u);
            const unsigned tg = og / nx;
            if (og + 1u == (tg + 1u) * nx) xb_add(&bar[XB_TOPGEN], 1u);
            else XB_SPIN(xb_ld(&bar[XB_TOPGEN]) == tg, bar);
            __builtin_amdgcn_fence(__ATOMIC_ACQUIRE, "agent");
            xb_add(&bar[XB_XGEN(b.x)], 1u);
            asm volatile("s_waitcnt vmcnt(0)" ::: "memory");
        } else {
            XB_SPIN(xb_ld(&bar[XB_XGEN(b.x)]) == gen, bar);
            __builtin_amdgcn_fence(__ATOMIC_ACQUIRE, "agent");
            asm volatile("s_waitcnt vmcnt(0)" ::: "memory");
        }
    }
    __syncthreads();
}

template <int PF, int R, class ALoad, class Epi>
DEVI void gemm_tile_f(char* smem, int nk, long ldb, const float* bp0, const float* bp1, ALoad&& aload, Epi&& epi) {
    static_assert(R > PF && (R % 2) == 0, "ring");
    const int tid = threadIdx.x, lane = tid & 63, li = lane & 15, lg = lane >> 4;
    const int sr = tid >> 2, scn = tid & 3;
    const unsigned aw0 = sr * 64 + ((scn ^ ((0 - (sr >> 2)) & 3)) << 4), aw1 = aw0 + 128 * 64;
    const unsigned ar = li * 64 + ((lg ^ ((0 - (li >> 2)) & 3)) << 4);
    float breg[R][2][8];
    f32x4 acc[16][2];
#pragma unroll
    for (int m = 0; m < 16; ++m) { acc[m][0] = f32x4{0.f, 0.f, 0.f, 0.f}; acc[m][1] = f32x4{0.f, 0.f, 0.f, 0.f}; }
    uint4 areg0 = aload(0, 0), areg1 = aload(1, 0);
#pragma unroll
    for (int s = 0; s < PF; ++s) {
        if (s < nk) {
#pragma unroll
            for (int j = 0; j < 8; ++j) { breg[s][0][j] = bp0[(long)(s * 32 + j) * ldb]; breg[s][1][j] = bp1[(long)(s * 32 + j) * ldb]; }
        }
    }
    *(uint4*)(smem + aw0) = areg0; *(uint4*)(smem + aw1) = areg1;
    __syncthreads();
    for (int kt0 = 0; kt0 < nk; kt0 += R) {
#pragma unroll
        for (int u = 0; u < R; ++u) {
            const int kt = kt0 + u;
            if (kt < nk) {
                if (kt + 1 < nk) { areg0 = aload(0, kt + 1); areg1 = aload(1, kt + 1); }
                if (kt + PF < nk) {
                    const float* q0 = bp0 + (long)(kt + PF) * 32 * ldb; const float* q1 = bp1 + (long)(kt + PF) * 32 * ldb;
#pragma unroll
                    for (int j = 0; j < 8; ++j) { breg[(u + PF) % R][0][j] = q0[(long)j * ldb]; breg[(u + PF) % R][1][j] = q1[(long)j * ldb]; }
                }
                __builtin_amdgcn_sched_barrier(0);
                uint4 b0, b1;
                b0.x = cvtpk(breg[u][0][0], breg[u][0][1]); b0.y = cvtpk(breg[u][0][2], breg[u][0][3]); b0.z = cvtpk(breg[u][0][4], breg[u][0][5]); b0.w = cvtpk(breg[u][0][6], breg[u][0][7]);
                b1.x = cvtpk(breg[u][1][0], breg[u][1][1]); b1.y = cvtpk(breg[u][1][2], breg[u][1][3]); b1.z = cvtpk(breg[u][1][4], breg[u][1][5]); b1.w = cvtpk(breg[u][1][6], breg[u][1][7]);
                const bf16x8 bf0 = __builtin_bit_cast(bf16x8, b0), bf1 = __builtin_bit_cast(bf16x8, b1);
                const char* As = smem + (u & 1) * 16384 + ar;
#pragma unroll
                for (int mb = 0; mb < 16; mb += 4) {
                    bf16x8 af[4];
#pragma unroll
                    for (int m = 0; m < 4; ++m) af[m] = *(const bf16x8*)(As + (mb + m) * 1024);
                    __builtin_amdgcn_sched_barrier(0);
#pragma unroll
                    for (int m = 0; m < 4; ++m) {
                        acc[mb + m][0] = __builtin_amdgcn_mfma_f32_16x16x32_bf16(bf0, af[m], acc[mb + m][0], 0, 0, 0);
                        acc[mb + m][1] = __builtin_amdgcn_mfma_f32_16x16x32_bf16(bf1, af[m], acc[mb + m][1], 0, 0, 0);
                    }
                    __builtin_amdgcn_sched_barrier(0);
                }
                if (kt + 1 < nk) { char* Aw = smem + ((u + 1) & 1) * 16384; *(uint4*)(Aw + aw0) = areg0; *(uint4*)(Aw + aw1) = areg1; }
                __syncthreads();
            }
        }
    }
    epi(acc);
}
template <int PF, int R, class Epi>
DEVI void gemm_tile(char* smem, int nk, long ldb, const float* bp0, const float* bp1, const bf16_t* ap0, const bf16_t* ap1, Epi&& epi) {
    gemm_tile_f<PF, R>(smem, nk, ldb, bp0, bp1, [&](int i, int kt) { return *(const uint4*)((i ? ap1 : ap0) + kt * 32); }, epi);
}

namespace pg8 {
#define PG8_LAS __attribute__((address_space(3)))
typedef unsigned short bf16_t;
typedef short bf16x8 __attribute__((ext_vector_type(8)));
typedef float f32x4 __attribute__((ext_vector_type(4)));
typedef unsigned u32x4 __attribute__((ext_vector_type(4)));
constexpr int BM = 256, BK = 64, HALF = 128, HTB = HALF * BK * 2  , STAGE_BYTES = 8 * HTB, NXCD = 8, WGM = 8;

__host__ __device__ __forceinline__ int lds_byte(int r, int c) { const int st = (r >> 4) * 2 + (c >> 5), rr = r & 15, cc = c & 31, ob = rr * 64 + cc * 2; return st * 1024 + (ob ^ (((ob >> 9) & 1) << 5)); }
__host__ __device__ __forceinline__ void stage_rc(int b, int& R, int& C) { const int st = b / 1024, sb = b % 1024, swz = sb ^ (((sb >> 9) & 1) << 5); R = (st >> 1) * 16 + swz / 64; C = (st & 1) * 32 + (swz % 64) / 2; }
__host__ __device__ __forceinline__ int perm32(int rho) { const int n = rho >> 4, i = rho & 15; return 8 * (i >> 2) + 4 * n + (i & 3); }

struct Unit { int pm, pn; };
struct Gemm { const bf16_t* A; const bf16_t* Bt; int M, N, K; };

struct StaticOrder {
    int nM, nN, nwg, G, c;
    __host__ __device__ void init(int M, int N, int G_, int c_) { nM = M / BM; nN = N / BM; nwg = nM * nN; G = G_; c = c_; }
    __host__ __device__ bool next(int i, Unit& u) const {
        const long L = (long)i * G + c; if (L >= nwg) return false;
        int wgid = (int)L; { const int q = nwg / NXCD, r = nwg % NXCD, xcd = wgid % NXCD, off = wgid / NXCD; wgid = (xcd < r ? xcd * (q + 1) : r * (q + 1) + (xcd - r) * q) + off; }
        const int nig = WGM * nN, gid = wgid / nig, fm = gid * WGM, gsz = (nM - fm) < WGM ? (nM - fm) : WGM;
        u.pm = fm + ((wgid % nig) % gsz); u.pn = (wgid % nig) / gsz; return true;
    }
    __device__ __forceinline__ void a_ready(const Unit&) const {}
    __device__ __forceinline__ void done(const Unit&) const {}
};


__device__ __forceinline__ unsigned cvt_pk_bf16(float lo, float hi) { unsigned r; asm volatile("v_cvt_pk_bf16_f32 %0, %1, %2" : "=v"(r) : "v"(lo), "v"(hi)); return r; }
struct EpiZ {
    static constexpr bool PERM = true, AFTER_DRAIN = false;
    bf16_t* O; int ldc; int ncols;
    __device__ __forceinline__ void operator()(const f32x4 (&acc)[2][2][4][2], const Unit& u, int wr, int wc, int fr, int fq) const {
        const int row0 = u.pm * BM + wr * 64 + fr, col0 = u.pn * BM + wc * 32 + 8 * fq;
#pragma unroll
        for (int ai = 0; ai < 2; ++ai)
#pragma unroll
            for (int m = 0; m < 4; ++m) { bf16_t* rowp = O + (size_t)(row0 + ai * HALF + m * 16) * ldc;
#pragma unroll
                for (int bj = 0; bj < 2; ++bj) { const int col = col0 + bj * HALF;
                    if (col < ncols) { const f32x4 v0 = acc[ai][bj][m][0], v1 = acc[ai][bj][m][1];
                        u32x4 w; w.x = cvt_pk_bf16(v0[0], v0[1]); w.y = cvt_pk_bf16(v0[2], v0[3]); w.z = cvt_pk_bf16(v1[0], v1[1]); w.w = cvt_pk_bf16(v1[2], v1[3]);
                        *(u32x4*)(rowp + col) = w; } } }
    }
};
struct EpiX1 {
    static constexpr bool PERM = true, AFTER_DRAIN = false;
    float* O; const float* res; const float* gate; int ldc; int gate_stride; int rows_per_batch;
    __device__ __forceinline__ void operator()(const f32x4 (&acc)[2][2][4][2], const Unit& u, int wr, int wc, int fr, int fq) const {
        const int row0 = u.pm * BM + wr * 64 + fr, col0 = u.pn * BM + wc * 32 + 8 * fq;
        const float* gp = gate + (size_t)((u.pm * BM) / rows_per_batch) * gate_stride;
#pragma unroll
        for (int bj = 0; bj < 2; ++bj) { const int col = col0 + bj * HALF;
            const f32x4 g0 = *(const f32x4*)(gp + col), g1 = *(const f32x4*)(gp + col + 4);
#pragma unroll
            for (int ai = 0; ai < 2; ++ai)
#pragma unroll
                for (int m = 0; m < 4; ++m) { const size_t o = (size_t)(row0 + ai * HALF + m * 16) * ldc + col;
                    const f32x4 x0 = *(const f32x4*)(res + o), x1 = *(const f32x4*)(res + o + 4);
                    *(f32x4*)(O + o) = x0 + g0 * acc[ai][bj][m][0]; *(f32x4*)(O + o + 4) = x1 + g1 * acc[ai][bj][m][1]; } }
    }
};
template <class Epi, class Sched, bool ALIGN_EPI = false, bool SP2 = false>
__device__ __forceinline__ void gemm_phase(PG8_LAS unsigned char* lds, const Gemm g, const Sched& S, const Epi& E) {
    const int tid = threadIdx.x, wid = __builtin_amdgcn_readfirstlane(tid >> 6), lane = tid & 63, wr = wid >> 2, wc = wid & 3, fr = lane & 15, fq = lane >> 4;
    const int K = g.K, nt = K / BK;
    unsigned voffA[2], voffB[2];
#pragma unroll
    for (int i = 0; i < 2; ++i) { int R, C; stage_rc(tid * 16 + i * 8192, R, C); const int Rb = Epi::PERM ? ((R & ~31) + perm32(R & 31)) : R;
        voffA[i] = (unsigned)(R * K + C) * 2u; voffB[i] = (unsigned)(Rb * K + C) * 2u; }
    const size_t kstep = (size_t)(BK * 2);
    const size_t hstep = (size_t)HALF * K * 2;
    const size_t tstep = 2 * hstep;
    const unsigned ldsw = (unsigned)wid * 1024u;
    const int aoff = lds_byte(wr * 64 + fr, fq * 8), boff = lds_byte(wc * 32 + fr, fq * 8);
#define PG8_SA(b, h) (((b) * 2 + (h)) * HTB)
#define PG8_SB(b, h) ((4 + (b) * 2 + (h)) * HTB)
#define PG8_STAGE(bufoff, gbase, voff) do { _Pragma("unroll") for (int _i = 0; _i < 2; ++_i) \
        __builtin_amdgcn_global_load_lds((const unsigned*)((const char*)(gbase) + (voff)[_i]), (PG8_LAS unsigned*)(lds + (bufoff) + ldsw + _i * 8192), 16, 0, 0); } while (0)
#define PG8_LDA(dst, b, h) do { _Pragma("unroll") for (int m = 0; m < 4; ++m) _Pragma("unroll") for (int k = 0; k < 2; ++k) dst[m][k] = *(const PG8_LAS bf16x8*)(lds + PG8_SA(b, h) + aoff + m * 2048 + k * 1024); } while (0)
#define PG8_LDB(dst, b, h) do { _Pragma("unroll") for (int n = 0; n < 2; ++n) _Pragma("unroll") for (int k = 0; k < 2; ++k) dst[n][k] = *(const PG8_LAS bf16x8*)(lds + PG8_SB(b, h) + boff + n * 2048 + k * 1024); } while (0)
#define PG8_MMA(ai, bj, At, Bt) do { __builtin_amdgcn_s_setprio(1); _Pragma("unroll") for (int m = 0; m < 4; ++m) _Pragma("unroll") for (int n = 0; n < 2; ++n) _Pragma("unroll") for (int k = 0; k < 2; ++k) \
        acc[ai][bj][m][n] = __builtin_amdgcn_mfma_f32_16x16x32_bf16(Bt[n][k], At[m][k], acc[ai][bj][m][n], 0, 0, 0); __builtin_amdgcn_s_setprio(0); } while (0)
#define PG8_WAIT_V(n) asm volatile("s_waitcnt vmcnt(" #n ")" ::: "memory")
#define PG8_WAIT_L(n) asm volatile("s_waitcnt lgkmcnt(" #n ")" ::: "memory")
#define PG8_BAR __builtin_amdgcn_s_barrier()
#define PG8_SCHED __builtin_amdgcn_sched_barrier(0)
    Unit cur, nxt; int ui = 0;
    if (!S.next(0, cur)) return;
    f32x4 acc[2][2][4][2];
#pragma unroll
    for (int a = 0; a < 2; ++a)
#pragma unroll
        for (int b = 0; b < 2; ++b)
#pragma unroll
            for (int m = 0; m < 4; ++m)
#pragma unroll
                for (int n = 0; n < 2; ++n) acc[a][b][m][n] = (f32x4){0.f, 0.f, 0.f, 0.f};
    bf16x8 At[4][2], B0[2][2], B1[2][2];
    const char* cA = (const char*)g.A + (size_t)cur.pm * tstep; const char* cB = (const char*)g.Bt + (size_t)cur.pn * tstep;
    S.a_ready(cur);
    if constexpr (SP2) {
        PG8_STAGE(PG8_SB(0, 0), cB, voffB); PG8_STAGE(PG8_SB(0, 1), cB + hstep, voffB); PG8_STAGE(PG8_SA(0, 0), cA, voffA); PG8_STAGE(PG8_SA(0, 1), cA + hstep, voffA);
        if (wr == 1) PG8_BAR;
        PG8_WAIT_V(2); PG8_BAR;
        PG8_STAGE(PG8_SB(1, 0), cB + kstep, voffB); PG8_STAGE(PG8_SA(1, 0), cA + kstep, voffA); PG8_STAGE(PG8_SB(1, 1), cB + hstep + kstep, voffB);
        PG8_WAIT_V(6); PG8_BAR;
    } else {
        PG8_STAGE(PG8_SB(0, 0), cB, voffB); PG8_STAGE(PG8_SA(0, 0), cA, voffA); PG8_STAGE(PG8_SB(0, 1), cB + hstep, voffB); PG8_STAGE(PG8_SA(0, 1), cA + hstep, voffA);
        if (wr == 1) PG8_BAR;
        PG8_WAIT_V(4); PG8_BAR;
        PG8_STAGE(PG8_SB(1, 0), cB + kstep, voffB); PG8_STAGE(PG8_SA(1, 0), cA + kstep, voffA); PG8_STAGE(PG8_SB(1, 1), cB + hstep + kstep, voffB);
        PG8_WAIT_V(6); PG8_BAR;
    }
    for (;;) {
        const bool has_next = S.next(ui + 1, nxt);
        const char* nA = has_next ? (const char*)g.A + (size_t)nxt.pm * tstep : cA; const char* nB = has_next ? (const char*)g.Bt + (size_t)nxt.pn * tstep : cB;
        for (int t = 0; t < nt; t += 2) {
            const bool last = (t == nt - 2);
            const char* a1 = cA + (size_t)(t + 1) * kstep;
            const char* a2 = last ? nA : cA + (size_t)(t + 2) * kstep; const char* b2 = last ? nB : cB + (size_t)(t + 2) * kstep;
            const char* a3 = a2 + kstep; const char* b3 = b2 + kstep;
            if (last && has_next) S.a_ready(nxt);
            if constexpr (SP2) {
            PG8_LDB(B0, 0, 0); PG8_LDB(B1, 0, 1); PG8_SCHED; PG8_LDA(At, 0, 0); PG8_STAGE(PG8_SA(1, 1), a1 + hstep, voffA);
            PG8_WAIT_V(8); PG8_WAIT_L(0); PG8_BAR; PG8_MMA(0, 0, At, B0); PG8_MMA(0, 1, At, B1); PG8_BAR; PG8_SCHED;
            PG8_LDA(At, 0, 1); PG8_STAGE(PG8_SB(0, 0), b2, voffB); PG8_STAGE(PG8_SB(0, 1), b2 + hstep, voffB); PG8_STAGE(PG8_SA(0, 0), a2, voffA);
            PG8_WAIT_V(8); PG8_WAIT_L(0); PG8_BAR; PG8_MMA(1, 0, At, B0); PG8_MMA(1, 1, At, B1); PG8_BAR; PG8_SCHED;
            PG8_LDB(B0, 1, 0); PG8_LDB(B1, 1, 1); PG8_SCHED; PG8_LDA(At, 1, 0); PG8_STAGE(PG8_SA(0, 1), a2 + hstep, voffA);
            PG8_WAIT_V(8); PG8_WAIT_L(0); PG8_BAR; PG8_MMA(0, 0, At, B0); PG8_MMA(0, 1, At, B1); PG8_BAR; PG8_SCHED;
            PG8_LDA(At, 1, 1); PG8_STAGE(PG8_SB(1, 0), b3, voffB); PG8_STAGE(PG8_SB(1, 1), b3 + hstep, voffB); PG8_STAGE(PG8_SA(1, 0), a3, voffA);
            PG8_WAIT_V(8); PG8_WAIT_L(0); PG8_BAR; PG8_MMA(1, 0, At, B0); PG8_MMA(1, 1, At, B1); PG8_BAR; PG8_SCHED;
            } else {
            PG8_LDB(B0, 0, 0); PG8_SCHED; PG8_LDA(At, 0, 0); PG8_STAGE(PG8_SA(1, 1), a1 + hstep, voffA);
            PG8_WAIT_L(8); PG8_BAR; PG8_WAIT_L(0); PG8_MMA(0, 0, At, B0); PG8_BAR; PG8_SCHED;
            PG8_LDB(B1, 0, 1); PG8_STAGE(PG8_SB(0, 0), b2, voffB);
            PG8_BAR; PG8_WAIT_L(0); PG8_MMA(0, 1, At, B1); PG8_BAR;
            PG8_LDA(At, 0, 1); PG8_STAGE(PG8_SA(0, 0), a2, voffA);
            PG8_BAR; PG8_WAIT_L(0); PG8_MMA(1, 0, At, B0); PG8_BAR; PG8_SCHED;
            PG8_STAGE(PG8_SB(0, 1), b2 + hstep, voffB);
            PG8_WAIT_V(6); PG8_BAR; PG8_MMA(1, 1, At, B1); PG8_BAR;
            PG8_LDB(B0, 1, 0); PG8_SCHED; PG8_LDA(At, 1, 0); PG8_STAGE(PG8_SA(0, 1), a2 + hstep, voffA);
            PG8_WAIT_L(8); PG8_BAR; PG8_WAIT_L(0); PG8_MMA(0, 0, At, B0); PG8_BAR; PG8_SCHED;
            PG8_LDB(B1, 1, 1); PG8_STAGE(PG8_SB(1, 0), b3, voffB);
            PG8_BAR; PG8_WAIT_L(0); PG8_MMA(0, 1, At, B1); PG8_BAR;
            PG8_LDA(At, 1, 1); PG8_STAGE(PG8_SA(1, 0), a3, voffA);
            PG8_BAR; PG8_WAIT_L(0); PG8_MMA(1, 0, At, B0); PG8_BAR; PG8_SCHED;
            PG8_STAGE(PG8_SB(1, 1), b3 + hstep, voffB);
            PG8_WAIT_V(6); PG8_BAR; PG8_MMA(1, 1, At, B1); PG8_BAR;
            }
        }
        if constexpr (ALIGN_EPI) { if (wr == 0) PG8_BAR; }
        if constexpr (!Epi::AFTER_DRAIN) { E(acc, cur, wr, wc, fr, fq); S.done(cur); }
        if (!has_next) break;
#pragma unroll
        for (int a = 0; a < 2; ++a)
#pragma unroll
            for (int b = 0; b < 2; ++b)
#pragma unroll
                for (int m = 0; m < 4; ++m)
#pragma unroll
                    for (int n = 0; n < 2; ++n) acc[a][b][m][n] = (f32x4){0.f, 0.f, 0.f, 0.f};
        cur = nxt; cA = nA; cB = nB; ++ui;
        if constexpr (ALIGN_EPI) { if (wr == 1) PG8_BAR; }
    }
    PG8_WAIT_V(0);
    if constexpr (!ALIGN_EPI) { if (wr == 0) PG8_BAR; }
    PG8_BAR;
    if constexpr (Epi::AFTER_DRAIN) { E.fused(acc, cur, wr, wc, fr, fq, lds, wid, lane); S.done(cur); }
#undef PG8_SA
#undef PG8_SB
#undef PG8_STAGE
#undef PG8_LDA
#undef PG8_LDB
#undef PG8_MMA
#undef PG8_WAIT_V
#undef PG8_WAIT_L
#undef PG8_BAR
#undef PG8_SCHED
}
}

DEVI void ada_unit(const Params& p, char* smem, int cb, int ks) {
    float* sl = (float*)smem;
    float* part = (float*)(p.ws + WS_PART);
    const int tid = threadIdx.x;
    __syncthreads();
    if (tid < 256) { const int b = tid >> 7, kk = tid & 127; const float cv = p.c[b * DM + ks * 128 + kk]; sl[b * 128 + kk] = cv / (1.f + expf(-cv)); }
    __syncthreads();
    const int j = cb * 512 + tid;
    const float* w = p.w_ada + (size_t)(ks * 128) * 12288 + j;
    float a0 = 0.f, a1 = 0.f;
#pragma unroll 16
    for (int kk = 0; kk < 128; ++kk) { const float wv = w[(size_t)kk * 12288]; a0 += sl[kk] * wv; a1 += sl[128 + kk] * wv; }
    part[(ks * 2 + 0) * 12288 + j] = a0; part[(ks * 2 + 1) * 12288 + j] = a1;
}
DEVI void transpose_item(const float* W, int N, bf16_t* WT, int r, char* smem) {
    const int lane = threadIdx.x & 63, wave = threadIdx.x >> 6;
    float* scr = (float*)(smem + 4096) + wave * (64 * 33);
    const int nblk = N / 32, kb = r / nblk, nb = r % nblk, k0 = 64 * kb, n0 = 32 * nb;
#pragma unroll 16
    for (int i = 0; i < 32; ++i) { const int kk = 2 * i + (lane >> 5); scr[kk * 33 + (lane & 31)] = W[(size_t)(k0 + kk) * N + n0 + (lane & 31)]; }
    const int c = lane & 7;
#pragma unroll
    for (int j = 0; j < 4; ++j) { const int n = (lane >> 3) + 8 * j; const float* sp = scr + (8 * c) * 33 + n;
        uint4 o; o.x = cvtpk(sp[0 * 33], sp[1 * 33]); o.y = cvtpk(sp[2 * 33], sp[3 * 33]); o.z = cvtpk(sp[4 * 33], sp[5 * 33]); o.w = cvtpk(sp[6 * 33], sp[7 * 33]);
        *(uint4*)(WT + (size_t)(n0 + n) * DM + k0 + 8 * c) = o; }
}
DEVI void phase0(const Params& p, char* smem) {
    float* rope = (float*)(p.ws + WS_ROPE);
    const int tid = threadIdx.x, lane = tid & 63, wave = tid >> 6;
    constexpr int N_ADA = 8 * NKS, N_ROPE = 256;
    for (int u = blockIdx.x; u < N_ADA + N_ROPE; u += gridDim.x) {
        if (u < N_ADA) {
            ada_unit(p, smem, u & 7, u >> 3);
        } else {
            const int idx = (u - N_ADA) * 512 + tid;
            const int t = idx >> 5, i = idx & 31;
            const double invf = exp(-(double)(2 * i) / 64.0 * 9.210340371976184);
            const double ang = (double)t * invf;
            rope[idx] = (float)cos(ang); rope[SEQ * 32 + idx] = (float)sin(ang);
        }
    }
    __syncthreads();
    {
        bf16_t* wti = (bf16_t*)(p.ws + WS_WTI);
        constexpr int I_IN = 32 * (INC / 32), I_Z = (4864 - INC) * DM / 8 / 64;
        for (int it = blockIdx.x * 8 + wave; it < I_IN + I_Z; it += gridDim.x * 8) {
            if (it >= I_IN) { const size_t o = (size_t)INC * DM + ((size_t)(it - I_IN) * 64 + lane) * 8; *(uint4*)(wti + o) = make_uint4(0u, 0u, 0u, 0u); continue; }
            transpose_item(p.w_in, INC, wti, it, smem);
        }
    }
}

DEVI float mod_from_part(const Params& p, int b, int j) {
    const float* part = (const float*)(p.ws + WS_PART);
    float s = p.b_ada[j];
#pragma unroll
    for (int ks = 0; ks < NKS; ++ks) s += part[(ks * 2 + b) * 12288 + j];
    return s;
}

constexpr int N_MODF = 48, N_WRF = 128, N_CB = 2, N_AS2 = 8, N_SPEC = N_WRF + N_CB + N_AS2 + N_MODF;
DEVI void spec_unit(const Params& p, char* smem, int v) {
    float* A1 = (float*)smem;
    const int tid = threadIdx.x, lane = tid & 63, wave = tid >> 6;
    if (v >= N_CB + N_WRF + N_AS2) {
        const int idx = (v - (N_CB + N_WRF + N_AS2)) * 512 + tid; const int b = idx / 12288, j = idx % 12288;
        ((float*)(p.ws + WS_MODF))[idx] = mod_from_part(p, b, j);
    } else {
            if (v < N_CB) {
                const int b = v;
                float* sh2 = A1 + 4 * DM;
                float* red = sh2 + DM;
                __syncthreads();
                for (int k = tid; k < DM; k += 512) sh2[k] = mod_from_part(p, b, 3 * DM + k);
                __syncthreads();
                float ae = 0.f, ag = 0.f;
#pragma unroll 16
                for (int kk = 0; kk < 256; ++kk) { const int k = wave * 256 + kk; const float sv = sh2[k]; ae += sv * p.w_re[k * 64 + lane]; ag += sv * p.w_rg[k * 8 + (lane & 7)]; }
                red[wave * 80 + lane] = ae; if (lane < 8) red[wave * 80 + 64 + lane] = ag;
                __syncthreads();
                if (tid < 80) {
                    float r = 0.f;
                    if (tid < 72) {
#pragma unroll
                        for (int w = 0; w < 8; ++w) r += red[w * 80 + tid];
                        r += (tid < 64 ? p.b_re[tid] : p.b_rg[tid - 64]);
                    }
                    ((float*)(p.ws + WS_CB))[b * 80 + tid] = r;
                }
            } else if (v < N_CB + N_WRF) {
                const int vv = v - N_CB, b = vv >> 6, ks = vv & 63, ln = tid & 63, e = tid >> 6;
                const int k = ks * 32 + 8 * (ln >> 4) + e;
                const float a2 = p.norm2_g[k] * (1.f + mod_from_part(p, b, 4 * DM + k));
                bf16_t* wrf = (bf16_t*)(p.ws + WS_WRF);
#pragma unroll
                for (int nf = 0; nf < 5; ++nf) {
                    const int j = nf * 16 + (ln & 15);
                    const float wv = j < 64 ? p.w_re[k * 64 + j] : (j < 72 ? p.w_rg[k * 8 + (j - 64)] : 0.f);
                    const float val = a2 * wv;
                    const unsigned hi = cvtpk(val, 0.f) & 0xffffu;
                    const unsigned lo = cvtpk(val - bf2f(hi), 0.f) & 0xffffu;
                    const size_t base = ((((size_t)(b * 64 + ks) * 5 + nf) * 2) * 64 + ln) * 8 + e;
                    wrf[base] = (bf16_t)hi; wrf[base + 512] = (bf16_t)lo;
                }
            } else {
                const int idx = (v - N_WRF - N_CB) * 512 + tid, b = idx >> 11, k = idx & 2047;
                float* as2 = (float*)(p.ws + WS_AS2);
                as2[idx] = p.norm2_g[k] * (1.f + mod_from_part(p, b, 4 * DM + k));
                as2[2 * DM + idx] = mod_from_part(p, b, 3 * DM + k);
            }
    }
}

DEVI void phase1(const Params& p, char* smem) {
    float* A1 = (float*)smem;
    float* S1 = A1 + 2 * DM;
    float* modf = (float*)(p.ws + WS_MODF);
    bf16_t* h = (bf16_t*)(p.ws + WS_H);
    const int tid = threadIdx.x, lane = tid & 63, wave = tid >> 6;
    constexpr int N_ROWS = NTOK / 8;
    const int upw = (N_ROWS + (int)gridDim.x - 1) / (int)gridDim.x, u_lo = (int)blockIdx.x * upw, u_hi = (u_lo + upw < N_ROWS) ? u_lo + upw : N_ROWS;
    const int b_lo = (u_lo * 8) >> 12, b_hi = u_hi > u_lo ? ((u_hi * 8 - 1) >> 12) : b_lo;
    for (int idx = tid; idx < 2 * DM; idx += 512) {
        const int b = idx >> 11, k = idx & 2047;
        if (b >= b_lo && b <= b_hi) {
            const float sh = mod_from_part(p, b, k), sc = mod_from_part(p, b, DM + k);
            A1[idx] = p.norm1_g[k] * (1.f + sc); S1[idx] = sh;
        }
    }
    __syncthreads();
    for (int u = u_lo; u < u_hi; ++u) {
        {
            const int row = u * 8 + wave, b = row >> 12;
            const float* xr = p.x + (size_t)row * DM;
            float4 v[8]; float ss = 0.f;
#pragma unroll
            for (int i = 0; i < 8; ++i) { v[i] = *(const float4*)(xr + i * 256 + lane * 4); ss += v[i].x * v[i].x + v[i].y * v[i].y + v[i].z * v[i].z + v[i].w * v[i].w; }
            ss = wave_sum(ss);
            const float rstd = rsqrtf(ss * (1.f / DM) + 1e-6f);
#pragma unroll
            for (int i = 0; i < 8; ++i) {
                const int k = i * 256 + lane * 4;
                const float4 a = *(const float4*)(A1 + b * DM + k), s = *(const float4*)(S1 + b * DM + k);
                uint2 o; o.x = cvtpk(v[i].x * rstd * a.x + s.x, v[i].y * rstd * a.y + s.y); o.y = cvtpk(v[i].z * rstd * a.z + s.z, v[i].w * rstd * a.w + s.w);
                *(uint2*)(h + (size_t)row * DM + k) = o;
            }
        }
    }
}

DEVI void phase2(const Params& p, char* smem) {
    pg8::Gemm g{(const pg8::bf16_t*)(p.ws + WS_H), (const pg8::bf16_t*)(p.ws + WS_WTI), NTOK, 4864, DM};
    pg8::StaticOrder S; S.init(NTOK, 4864, (int)gridDim.x, (int)blockIdx.x);
    pg8::EpiZ E{(pg8::bf16_t*)(p.ws + WS_Z), INC, INC};
    pg8::gemm_phase<pg8::EpiZ, pg8::StaticOrder, true, true>((PG8_LAS unsigned char*)smem, g, S, E);
    const int nthird = 608 - 2 * (int)gridDim.x;
    if (gridDim.x == 256 ? (int)blockIdx.x >= nthird : true) {
        const int nw = gridDim.x == 256 ? 256 - nthird : (int)gridDim.x, wi = gridDim.x == 256 ? (int)blockIdx.x - nthird : (int)blockIdx.x;
        __syncthreads();
        for (int u = wi; u < 512; u += nw) {
            if (u < 256) ada_unit(p, smem, 8 + (u & 15), u >> 4);
            else { __syncthreads(); transpose_item(p.w_o, DM, (bf16_t*)(p.ws + WS_WTO), (u - 256) * 8 + (int)(threadIdx.x >> 6), smem); }
        }
    }
}

DEVI float dpp_xor1(float x) { return __builtin_bit_cast(float, __builtin_amdgcn_update_dpp(0, __builtin_bit_cast(int, x), 0xB1, 0xF, 0xF, true)); }
DEVI float dpp_xor2(float x) { return __builtin_bit_cast(float, __builtin_amdgcn_update_dpp(0, __builtin_bit_cast(int, x), 0x4E, 0xF, 0xF, true)); }
DEVI float xor32_sum(float x) {
    float a = x, b = x;
    asm volatile("s_nop 1\n\tv_permlane32_swap_b32 %0, %1\n\ts_nop 1" : "+v"(a), "+v"(b));
    return a + b;
}
DEVI unsigned m64_off(int row, int chunk) { return row * 128 + ((chunk ^ ((row >> 1) & 7)) << 4); }
DEVI void mm_tile(f32x16& acc, const char* X, int xr0, const char* Y, int yr0, int l31, int hh) {
#pragma unroll
    for (int s4 = 0; s4 < 4; ++s4) {
        const bf16x8 a = *(const bf16x8*)(X + m64_off(xr0 + l31, 2 * s4 + hh));
        const bf16x8 b = *(const bf16x8*)(Y + m64_off(yr0 + l31, 2 * s4 + hh));
        acc = __builtin_amdgcn_mfma_f32_32x32x16_bf16(a, b, acc, 0, 0, 0);
    }
}
DEVI f32x16 zero16() { f32x16 z;
#pragma unroll
    for (int i = 0; i < 16; ++i) z[i] = 0.f;
    return z; }


DEVI float tokshift(const bf16_t* z, const float* mu, int tok, int c) {
    const float zc = bf2f(z[(size_t)tok * INC + ZC_RW + c]);
    const float zp = (tok & (SEQ - 1)) ? bf2f(z[(size_t)(tok - 1) * INC + ZC_RW + c]) : 0.f;
    return zc + (zp - zc) * mu[c];
}

DEVI void p3_unit(const Params& p, char* smem, int u) {
    const bf16_t* z = (const bf16_t*)(p.ws + WS_Z);
    bf16_t* mix = (bf16_t*)(p.ws + WS_MIX);
    const float* rope = (const float*)(p.ws + WS_ROPE);
    const int tid = threadIdx.x, lane = tid & 63, wave = tid >> 6;
    constexpr int N_ATT = 256;
    {
        __syncthreads();
        if (u < N_ATT) {
            constexpr int VTS = 392;
            char* Ks = smem;
            char* Vt = smem + 192 * 128;
            const int b = u >> 7, kvh = (u >> 6) & 1, qb = u & 63, t0 = qb * 64, kbase = t0 - 128;
            for (int idx = tid; idx < 192 * 4; idx += 512) {
                const int j = idx >> 2, c = idx & 3, t = kbase + j;
                uint4 o1 = make_uint4(0u, 0u, 0u, 0u), o2 = o1;
                if (t >= 0) {
                    const bf16_t* zr = z + (size_t)(b * SEQ + t) * INC + ZC_K + kvh * 64 + 8 * c;
                    const uint4 ka = *(const uint4*)zr, kb = *(const uint4*)(zr + 32);
                    const float4 c0 = *(const float4*)(rope + t * 32 + 8 * c), c1 = *(const float4*)(rope + t * 32 + 8 * c + 4);
                    const float4 s0 = *(const float4*)(rope + SEQ * 32 + t * 32 + 8 * c), s1 = *(const float4*)(rope + SEQ * 32 + t * 32 + 8 * c + 4);
                    const float a[8] = {bflo(ka.x), bfhi(ka.x), bflo(ka.y), bfhi(ka.y), bflo(ka.z), bfhi(ka.z), bflo(ka.w), bfhi(ka.w)};
                    const float bq[8] = {bflo(kb.x), bfhi(kb.x), bflo(kb.y), bfhi(kb.y), bflo(kb.z), bfhi(kb.z), bflo(kb.w), bfhi(kb.w)};
                    const float cs[8] = {c0.x, c0.y, c0.z, c0.w, c1.x, c1.y, c1.z, c1.w}, sn[8] = {s0.x, s0.y, s0.z, s0.w, s1.x, s1.y, s1.z, s1.w};
                    float r1[8], r2[8];
#pragma unroll
                    for (int e = 0; e < 8; ++e) { r1[e] = a[e] * cs[e] - bq[e] * sn[e]; r2[e] = bq[e] * cs[e] + a[e] * sn[e]; }
                    o1 = make_uint4(cvtpk(r1[0], r1[1]), cvtpk(r1[2], r1[3]), cvtpk(r1[4], r1[5]), cvtpk(r1[6], r1[7]));
                    o2 = make_uint4(cvtpk(r2[0], r2[1]), cvtpk(r2[2], r2[3]), cvtpk(r2[4], r2[5]), cvtpk(r2[6], r2[7]));
                }
                *(uint4*)(Ks + m64_off(j, c)) = o1; *(uint4*)(Ks + m64_off(j, c + 4)) = o2;
            }
            for (int idx = tid; idx < 192 * 8; idx += 512) {
                const int j = idx >> 3, c = idx & 7, t = kbase + j;
                uint4 vv = make_uint4(0u, 0u, 0u, 0u);
                if (t >= 0) vv = *(const uint4*)(z + (size_t)(b * SEQ + t) * INC + ZC_V + kvh * 64 + 8 * c);
                char* vp = Vt + (8 * c) * VTS + j * 2;
                *(bf16_t*)(vp + 0 * VTS) = (bf16_t)(vv.x & 0xffffu); *(bf16_t*)(vp + 1 * VTS) = (bf16_t)(vv.x >> 16);
                *(bf16_t*)(vp + 2 * VTS) = (bf16_t)(vv.y & 0xffffu); *(bf16_t*)(vp + 3 * VTS) = (bf16_t)(vv.y >> 16);
                *(bf16_t*)(vp + 4 * VTS) = (bf16_t)(vv.z & 0xffffu); *(bf16_t*)(vp + 5 * VTS) = (bf16_t)(vv.z >> 16);
                *(bf16_t*)(vp + 6 * VTS) = (bf16_t)(vv.w & 0xffffu); *(bf16_t*)(vp + 7 * VTS) = (bf16_t)(vv.w >> 16);
            }
            __syncthreads();
            const int h = kvh * 8 + wave, l31 = lane & 31, hh = lane >> 5;
            const float sink = p.sinks[h];
#pragma unroll 1
            for (int qt = 0; qt < 2; ++qt) {
                const int T0 = t0 + qt * 32, tq = T0 + l31;
                bf16x8 qf[4];
                {
                    const bf16_t* zr = z + (size_t)(b * SEQ + tq) * INC + h * 64 + 8 * hh;
                    uint4 raw[4];
#pragma unroll
                    for (int s4 = 0; s4 < 4; ++s4) raw[s4] = *(const uint4*)(zr + 16 * s4);
#pragma unroll
                    for (int s2 = 0; s2 < 2; ++s2) {
                        const int d0 = 16 * s2 + 8 * hh;
                        const float4 c0 = *(const float4*)(rope + tq * 32 + d0), c1 = *(const float4*)(rope + tq * 32 + d0 + 4);
                        const float4 s0 = *(const float4*)(rope + SEQ * 32 + tq * 32 + d0), s1 = *(const float4*)(rope + SEQ * 32 + tq * 32 + d0 + 4);
                        const uint4 ua = raw[s2], ub = raw[s2 + 2];
                        const float a[8] = {bflo(ua.x), bfhi(ua.x), bflo(ua.y), bfhi(ua.y), bflo(ua.z), bfhi(ua.z), bflo(ua.w), bfhi(ua.w)};
                        const float bq[8] = {bflo(ub.x), bfhi(ub.x), bflo(ub.y), bfhi(ub.y), bflo(ub.z), bfhi(ub.z), bflo(ub.w), bfhi(ub.w)};
                        const float cs[8] = {c0.x, c0.y, c0.z, c0.w, c1.x, c1.y, c1.z, c1.w}, sn[8] = {s0.x, s0.y, s0.z, s0.w, s1.x, s1.y, s1.z, s1.w};
                        float r1[8], r2[8];
#pragma unroll
                        for (int e = 0; e < 8; ++e) { r1[e] = (a[e] * cs[e] - bq[e] * sn[e]) * 0.125f; r2[e] = (bq[e] * cs[e] + a[e] * sn[e]) * 0.125f; }
                        qf[s2] = __builtin_bit_cast(bf16x8, make_uint4(cvtpk(r1[0], r1[1]), cvtpk(r1[2], r1[3]), cvtpk(r1[4], r1[5]), cvtpk(r1[6], r1[7])));
                        qf[s2 + 2] = __builtin_bit_cast(bf16x8, make_uint4(cvtpk(r2[0], r2[1]), cvtpk(r2[2], r2[3]), cvtpk(r2[4], r2[5]), cvtpk(r2[6], r2[7])));
                    }
                }
                f32x16 sc[5];
#pragma unroll
                for (int kt = 0; kt < 5; ++kt) {
                    sc[kt] = zero16();
                    const int krow = 32 * qt + 32 * kt + l31;
#pragma unroll
                    for (int s4 = 0; s4 < 4; ++s4) {
                        const bf16x8 kf = *(const bf16x8*)(Ks + m64_off(krow, 2 * s4 + hh));
                        sc[kt] = __builtin_amdgcn_mfma_f32_32x32x16_bf16(kf, qf[s4], sc[kt], 0, 0, 0);
                    }
                }
                float mx = -1e30f;
#pragma unroll
                for (int kt = 0; kt < 5; ++kt)
#pragma unroll
                    for (int i = 0; i < 16; ++i) {
                        const int r = (i & 3) + 8 * (i >> 2) + 4 * hh;
                        bool ok = (T0 - 128 + 32 * kt + r) >= 0;
                        if (kt == 0) ok = ok && (r > l31);
                        if (kt == 4) ok = ok && (r <= l31);
                        sc[kt][i] = ok ? sc[kt][i] : -1e30f;
                        mx = fmaxf(mx, sc[kt][i]);
                    }
                {
                    float a = mx, bq = mx;
                    asm volatile("s_nop 1\n\tv_permlane32_swap_b32 %0, %1\n\ts_nop 1" : "+v"(a), "+v"(bq));
                    mx = fmaxf(fmaxf(a, bq), sink);
                }
                float lsum = 0.f;
#pragma unroll
                for (int kt = 0; kt < 5; ++kt)
#pragma unroll
                    for (int i = 0; i < 16; ++i) { const float pe = __expf(sc[kt][i] - mx); sc[kt][i] = pe; lsum += pe; }
                lsum = xor32_sum(lsum) + __expf(sink - mx);
                const float inv = 1.f / lsum;
                f32x16 oacc[2];
                oacc[0] = zero16(); oacc[1] = zero16();
#pragma unroll
                for (int kt = 0; kt < 5; ++kt)
#pragma unroll
                    for (int s2 = 0; s2 < 2; ++s2) {
                        uint4 pb;
                        pb.x = cvtpk(sc[kt][8 * s2 + 0], sc[kt][8 * s2 + 1]); pb.y = cvtpk(sc[kt][8 * s2 + 2], sc[kt][8 * s2 + 3]);
                        pb.z = cvtpk(sc[kt][8 * s2 + 4], sc[kt][8 * s2 + 5]); pb.w = cvtpk(sc[kt][8 * s2 + 6], sc[kt][8 * s2 + 7]);
                        const int kloc = 32 * qt + 32 * kt + 16 * s2 + 4 * hh;
#pragma unroll
                        for (int dt = 0; dt < 2; ++dt) {
                            const char* vp = Vt + (dt * 32 + l31) * VTS + kloc * 2;
                            const uint2 v0 = *(const uint2*)vp, v1 = *(const uint2*)(vp + 16);
                            const bf16x8 vf = __builtin_bit_cast(bf16x8, make_uint4(v0.x, v0.y, v1.x, v1.y));
                            oacc[dt] = __builtin_amdgcn_mfma_f32_32x32x16_bf16(vf, __builtin_bit_cast(bf16x8, pb), oacc[dt], 0, 0, 0);
                        }
                    }
                bf16_t* orow = mix + (size_t)(b * SEQ + tq) * DM + h * 64;
#pragma unroll
                for (int dt = 0; dt < 2; ++dt)
#pragma unroll
                    for (int q = 0; q < 4; ++q) {
                        uint2 o; o.x = cvtpk(oacc[dt][4 * q] * inv, oacc[dt][4 * q + 1] * inv); o.y = cvtpk(oacc[dt][4 * q + 2] * inv, oacc[dt][4 * q + 3] * inv);
                        *(uint2*)(orow + dt * 32 + 8 * q + 4 * hh) = o;
                    }
            }
        } else {
            const int v = u - N_ATT, prod = 2 - (v >> 7), mt = v & 31, nt = (v >> 5) & 3;
            const int row0 = mt * 256, col0 = nt * 256 + wave * 32, li = lane & 15, lg = lane >> 4;
            const int koff = prod == 0 ? 3072 : (prod == 1 ? 3136 : 3200), nk = prod == 2 ? 5 : 2;
            const float* W = prod == 0 ? p.wd_up : (prod == 1 ? p.wa_up : p.wg_up);
            const float* bp0 = W + (size_t)(8 * lg) * RW + col0 + li; const float* bp1 = bp0 + 16;
            const int srow = row0 + (tid >> 2), scol = koff + (tid & 3) * 8;
            auto aload = [&](int i, int kt) -> uint4 {
                const int tok = srow + 128 * i, c = scol + kt * 32;
                const uint4 zc = *(const uint4*)(z + (size_t)tok * INC + ZC_RW + c);
                uint4 zp = make_uint4(0u, 0u, 0u, 0u);
                if (tok & (SEQ - 1)) zp = *(const uint4*)(z + (size_t)(tok - 1) * INC + ZC_RW + c);
                const float4 m0 = *(const float4*)(p.mu + c), m1 = *(const float4*)(p.mu + c + 4);
                const float a[8] = {bflo(zc.x), bfhi(zc.x), bflo(zc.y), bfhi(zc.y), bflo(zc.z), bfhi(zc.z), bflo(zc.w), bfhi(zc.w)};
                const float q[8] = {bflo(zp.x), bfhi(zp.x), bflo(zp.y), bfhi(zp.y), bflo(zp.z), bfhi(zp.z), bflo(zp.w), bfhi(zp.w)};
                const float mm[8] = {m0.x, m0.y, m0.z, m0.w, m1.x, m1.y, m1.z, m1.w};
                float o[8];
#pragma unroll
                for (int e = 0; e < 8; ++e) {
                    const float zs = a[e] + (q[e] - a[e]) * mm[e];
                    o[e] = prod == 0 ? (1.f - 2.f / (1.f + __expf(2.f * zs))) : (prod == 1 ? zs : sigmoidf_(zs));
                }
                return make_uint4(cvtpk(o[0], o[1]), cvtpk(o[2], o[3]), cvtpk(o[4], o[5]), cvtpk(o[6], o[7]));
            };
            float* LWb = (float*)(p.ws + WS_LW); bf16_t* AVb = (bf16_t*)(p.ws + WS_AV); bf16_t* GVb = (bf16_t*)(p.ws + WS_GV);
            gemm_tile_f<1, 2>(smem, nk, RW, bp0, bp1, aload, [&](f32x4 (&acc)[16][2]) {
#pragma unroll
                for (int nf = 0; nf < 2; ++nf) {
                    const int col = col0 + nf * 16 + 4 * lg;
                    const float4 w0c = *(const float4*)(p.w0 + col), a0c = *(const float4*)(p.a0 + col);
                    const float wc[4] = {w0c.x, w0c.y, w0c.z, w0c.w}, ac[4] = {a0c.x, a0c.y, a0c.z, a0c.w};
#pragma unroll
                    for (int m = 0; m < 16; ++m) {
                        const size_t o = (size_t)(row0 + 16 * m + li) * RW + col;
                        if (prod == 0) {
                            float r[4];
#pragma unroll
                            for (int e = 0; e < 4; ++e) r[e] = -0.60653065971f * sigmoidf_(wc[e] + acc[m][nf][e]);
                            *(float4*)(LWb + o) = make_float4(r[0], r[1], r[2], r[3]);
                        } else if (prod == 1) {
                            uint2 ob; ob.x = cvtpk(sigmoidf_(ac[0] + acc[m][nf][0]), sigmoidf_(ac[1] + acc[m][nf][1])); ob.y = cvtpk(sigmoidf_(ac[2] + acc[m][nf][2]), sigmoidf_(ac[3] + acc[m][nf][3]));
                            *(uint2*)(AVb + o) = ob;
                        } else {
                            uint2 ob; ob.x = cvtpk(acc[m][nf][0], acc[m][nf][1]); ob.y = cvtpk(acc[m][nf][2], acc[m][nf][3]);
                            *(uint2*)(GVb + o) = ob;
                        }
                    }
                }
            });
        }
    }
}
DEVI void phase3(const Params& p, char* smem) {
    for (int v = blockIdx.x; v < 384; v += gridDim.x) p3_unit(p, smem, 256 + v);
}

DEVI void phase4(const Params& p, char* smem) {
    const int tid = threadIdx.x, lane = tid & 63, wave = tid >> 6;
    const float* const pAA = (const float*)(p.ws + WS_AA); const float* const pDE = (const float*)(p.ws + WS_DEC); const float* const pBB = (const float*)(p.ws + WS_BB);
    const float* const pK2 = (const float*)(p.ws + WS_K2); const float* const pR = (const float*)(p.ws + WS_R); const float* const pV = (const float*)(p.ws + WS_V);
    float* Y = (float*)(p.ws + WS_Y);
    constexpr int CH = 32;
    float* bufs = (float*)smem;
    for (int u = blockIdx.x; u < 32; u += gridDim.x) {
        const int b = u >> 4, h = u & 15;
        const int vr = lane >> 2, kq = lane & 3;
        float s[16];
#pragma unroll
        for (int j = 0; j < 16; ++j) s[j] = 0.f;
        __syncthreads();
        const int lst = tid >> 4, lc4 = tid & 15;
        const size_t goff = (size_t)(b * SEQ + lst) * RW + h * 64 + lc4 * 4;
        const int loff = lst * 64 + lc4 * 4;
        {
            *(float4*)(bufs + 0 * CH * 64 + loff) = *(const float4*)(pAA + goff); *(float4*)(bufs + 1 * CH * 64 + loff) = *(const float4*)(pDE + goff);
            *(float4*)(bufs + 2 * CH * 64 + loff) = *(const float4*)(pBB + goff); *(float4*)(bufs + 3 * CH * 64 + loff) = *(const float4*)(pK2 + goff);
            *(float4*)(bufs + 4 * CH * 64 + loff) = *(const float4*)(pR + goff); *(float4*)(bufs + 5 * CH * 64 + loff) = *(const float4*)(pV + goff);
        }
        __syncthreads();
        for (int c = 0; c < SEQ / CH; ++c) {
            float* cur = bufs + (c & 1) * (6 * CH * 64);
            float* nxt = bufs + ((c + 1) & 1) * (6 * CH * 64);
            float4 pre0, pre1, pre2, pre3, pre4, pre5;
            if (c + 1 < SEQ / CH) {
                const size_t g2 = goff + (size_t)(c + 1) * CH * RW;
                pre0 = *(const float4*)(pAA + g2); pre1 = *(const float4*)(pDE + g2); pre2 = *(const float4*)(pBB + g2);
                pre3 = *(const float4*)(pK2 + g2); pre4 = *(const float4*)(pR + g2); pre5 = *(const float4*)(pV + g2);
            }
            if (wave < 4) {
                for (int st = 0; st < CH; ++st) {
                    const float* aa = cur + (0 * CH + st) * 64 + kq * 16;
                    const float* de = cur + (1 * CH + st) * 64 + kq * 16;
                    const float* bb = cur + (2 * CH + st) * 64 + kq * 16;
                    const float* k2 = cur + (3 * CH + st) * 64 + kq * 16;
                    const float* rr = cur + (4 * CH + st) * 64 + kq * 16;
                    const float v = cur[(5 * CH + st) * 64 + wave * 16 + vr];
                    float sa = 0.f;
#pragma unroll
                    for (int j = 0; j < 16; ++j) sa += s[j] * aa[j];
                    sa += __shfl_xor(sa, 1, 64); sa += __shfl_xor(sa, 2, 64);
                    float y = 0.f;
#pragma unroll
                    for (int j = 0; j < 16; ++j) { s[j] = s[j] * de[j] + sa * bb[j] + v * k2[j]; y += s[j] * rr[j]; }
                    y += __shfl_xor(y, 1, 64); y += __shfl_xor(y, 2, 64);
                    if (kq == 0) Y[(size_t)(b * SEQ + c * CH + st) * RW + h * 64 + wave * 16 + vr] = y;
                }
            }
            if (c + 1 < SEQ / CH) {
                *(float4*)(nxt + 0 * CH * 64 + loff) = pre0; *(float4*)(nxt + 1 * CH * 64 + loff) = pre1; *(float4*)(nxt + 2 * CH * 64 + loff) = pre2;
                *(float4*)(nxt + 3 * CH * 64 + loff) = pre3; *(float4*)(nxt + 4 * CH * 64 + loff) = pre4; *(float4*)(nxt + 5 * CH * 64 + loff) = pre5;
            }
            __syncthreads();
        }
    }
}

DEVI void phase5(const Params& p, char* smem) {
    const int tid = threadIdx.x, lane = tid & 63, wave = tid >> 6;
    const float* Y = (const float*)(p.ws + WS_Y); const float* Vb = (const float*)(p.ws + WS_V); const float* Gb = (const float*)(p.ws + WS_G); const float* RKSb = (const float*)(p.ws + WS_RKS);
    bf16_t* mix = (bf16_t*)(p.ws + WS_MIX);
    for (int u = blockIdx.x; u < NTOK * 16 / 8; u += gridDim.x) {
        const int pi = u * 8 + wave, tok = pi >> 4, head = pi & 15, ch = head * 64 + lane;
        const float y = Y[(size_t)tok * RW + ch];
        const float mean = wave_sum(y) * (1.f / 64.f);
        const float d = y - mean;
        const float var = wave_sum(d * d) * (1.f / 64.f);
        const float yn = d * rsqrtf(var + 64e-5f) * p.ln_w[ch] + p.ln_b[ch];
        const float o = (yn + RKSb[tok * 16 + head] * Vb[(size_t)tok * RW + ch]) * Gb[(size_t)tok * RW + ch];
        mix[(size_t)tok * DM + 1024 + ch] = (bf16_t)(cvtpk(o, 0.f) & 0xffffu);
    }
}


constexpr int RA_AT = 0, RA_BT = 8192, RA_KT = 16384, RA_RT = 24576, RA_BPT = 32768, RA_KPT = 40960, RA_VT = 49152, RA_AAK = 57344, RA_ARB = 65536, RA_ARK = 73728,
              RA_AABP = 81920, RA_RHS = 98304, RA_WL = 131072, RA_SEG = 131328, RA_P1T = RA_BT, RA_P2T = RA_KT, RA_CUM = RA_AABP;

DEVI void phaseRA(const Params& p, char* smem) {
    const int tid = threadIdx.x, lane = tid & 63, wave = tid >> 6, l31 = lane & 31, hh = lane >> 5;
    const bf16_t* z = (const bf16_t*)(p.ws + WS_Z);
    float* cumb = (float*)(smem + RA_CUM); float* segs = (float*)(smem + RA_SEG); float* wl = (float*)(smem + RA_WL);
    float* rhs = (float*)(smem + RA_RHS); float* aabp = (float*)(smem + RA_AABP);
    uint4 n_cr, n_ck, n_cv, n_pr, n_pk, n_pv, n_au; float4 n_lw0, n_lw1;
    auto load_raw = [&](int unit_) {
        const int bh_ = unit_ >> 6, c_ = unit_ & 63, b_ = bh_ >> 4, h_ = bh_ & 15;
        const int tok = b_ * SEQ + c_ * 64 + (tid >> 3), ch0 = h_ * 64 + (tid & 7) * 8;
        const bf16_t* zr = z + (size_t)tok * INC + ZC_RW + ch0;
        const bool hasp = (tok & (SEQ - 1)) != 0;
        const uint4 zero4 = make_uint4(0u, 0u, 0u, 0u);
        n_cr = *(const uint4*)zr; n_ck = *(const uint4*)(zr + 1024); n_cv = *(const uint4*)(zr + 2048);
        n_pr = hasp ? *(const uint4*)(zr - INC) : zero4; n_pk = hasp ? *(const uint4*)(zr - INC + 1024) : zero4; n_pv = hasp ? *(const uint4*)(zr - INC + 2048) : zero4;
        n_au = *(const uint4*)((const bf16_t*)(p.ws + WS_AV) + (size_t)tok * RW + ch0);
        const float* lwp = (const float*)(p.ws + WS_LW) + (size_t)tok * RW + ch0;
        n_lw0 = *(const float4*)lwp; n_lw1 = *(const float4*)(lwp + 4);
    };
    if (((int)blockIdx.x >> 3) < 256) load_raw((((int)blockIdx.x & 7) + 8 * (((int)blockIdx.x >> 3) >> 6)) * 64 + (((int)blockIdx.x >> 3) & 63));
    const int ra_x = (int)blockIdx.x & 7, ra_slot = (int)blockIdx.x >> 3, ra_nslot = ((int)gridDim.x - ra_x + 7) >> 3;
    for (int uu = ra_slot; uu < 256; uu += ra_nslot) {
        const int bh = ra_x + 8 * (uu >> 6), c = uu & 63, b = bh >> 4, h = bh & 15;
        const int unit = bh * 64 + c;
        const int tokbase = b * SEQ + c * 64;
        __syncthreads();
        const int t = tid >> 3, c8 = tid & 7;
        float r_[8], k2[8], v_[8], aa[8], bb[8], lw[8];
        {
            const int tok = tokbase + t, ch0 = h * 64 + c8 * 8;
            const uint4 cr = n_cr, ck = n_ck, cv = n_cv, pr = n_pr, pk_ = n_pk, pv = n_pv, au = n_au;
            float fr[8], fk[8], fpr[8], fpk[8], fpv[8], mur[8], muk[8], muv[8], av[8], kkc[8], kac[8], rkc[8];
#define UNPK8(dst, u) { dst[0] = bflo(u.x); dst[1] = bfhi(u.x); dst[2] = bflo(u.y); dst[3] = bfhi(u.y); dst[4] = bflo(u.z); dst[5] = bfhi(u.z); dst[6] = bflo(u.w); dst[7] = bfhi(u.w); }
#define LDF8(dst, ptr) { const float4 q0_ = *(const float4*)(ptr), q1_ = *(const float4*)((ptr) + 4); dst[0] = q0_.x; dst[1] = q0_.y; dst[2] = q0_.z; dst[3] = q0_.w; dst[4] = q1_.x; dst[5] = q1_.y; dst[6] = q1_.z; dst[7] = q1_.w; }
            UNPK8(fr, cr) UNPK8(fk, ck) UNPK8(v_, cv) UNPK8(fpr, pr) UNPK8(fpk, pk_) UNPK8(fpv, pv) UNPK8(av, au)
            LDF8(mur, p.mu + ch0) LDF8(muk, p.mu + 1024 + ch0) LDF8(muv, p.mu + 2048 + ch0)
            LDF8(kkc, p.k_k + ch0) LDF8(kac, p.k_a + ch0) LDF8(rkc, p.r_k + ch0)
            lw[0] = n_lw0.x; lw[1] = n_lw0.y; lw[2] = n_lw0.z; lw[3] = n_lw0.w; lw[4] = n_lw1.x; lw[5] = n_lw1.y; lw[6] = n_lw1.z; lw[7] = n_lw1.w;
            float ssq = 0.f, rk = 0.f, kk[8];
#pragma unroll
            for (int i = 0; i < 8; ++i) {
                r_[i] = fr[i] + (fpr[i] - fr[i]) * mur[i];
                const float kx = fk[i] + (fpk[i] - fk[i]) * muk[i];
                v_[i] = v_[i] + (fpv[i] - v_[i]) * muv[i];
                kk[i] = kx * kkc[i]; ssq += kk[i] * kk[i];
                k2[i] = kx * (1.f + (av[i] - 1.f) * kac[i]);
                rk += r_[i] * k2[i] * rkc[i];
            }
            ssq += dpp_xor1(ssq); ssq += dpp_xor2(ssq); ssq += __shfl_xor(ssq, 4, 64);
            rk += dpp_xor1(rk); rk += dpp_xor2(rk); rk += __shfl_xor(rk, 4, 64);
            const float invn = 1.f / fmaxf(sqrtf(ssq), 1e-12f);
#pragma unroll
            for (int i = 0; i < 8; ++i) { const float kn = kk[i] * invn; aa[i] = -kn; bb[i] = kn * av[i]; }
            if (c8 == 0) ((float*)(p.ws + WS_RKS))[tok * 16 + h] = rk;
        }
#pragma unroll
        for (int i = 0; i < 8; ++i) cumb[t * 64 + c8 * 8 + i] = lw[i];
        __syncthreads();
        if (uu + ra_nslot < 256) { const int u2 = uu + ra_nslot; load_raw((ra_x + 8 * (u2 >> 6)) * 64 + (u2 & 63)); }
        {
            const int ch = tid & 63, seg = tid >> 6;
            float loc[8]; float run = 0.f;
#pragma unroll
            for (int j = 0; j < 8; ++j) { run += cumb[(seg * 8 + j) * 64 + ch]; loc[j] = run; }
            segs[seg * 64 + ch] = run;
            __syncthreads();
            float off = 0.f;
#pragma unroll
            for (int s2 = 0; s2 < 8; ++s2) off += (s2 < seg) ? segs[s2 * 64 + ch] : 0.f;
#pragma unroll
            for (int j = 0; j < 8; ++j) cumb[(seg * 8 + j) * 64 + ch] = off + loc[j];
        }
        __syncthreads();
        {
            unsigned pk[7][4];
            float atf[8];
#pragma unroll
            for (int i = 0; i < 8; i += 2) {
                float o[7][2];
#pragma unroll
                for (int e = 0; e < 2; ++e) {
                    const float cu = cumb[t * 64 + c8 * 8 + i + e], cl = cumb[63 * 64 + c8 * 8 + i + e];
                    const float e1 = __expf(cu), e2 = 1.f / e1, ex = __expf(cu - lw[i + e]), ew = __expf(cl - cu);
                    o[0][e] = aa[i + e] * ex; o[1][e] = bb[i + e] * e2; o[2][e] = k2[i + e] * e2; o[3][e] = r_[i + e] * e1;
                    o[4][e] = bb[i + e] * ew; o[5][e] = k2[i + e] * ew; o[6][e] = v_[i + e];
                    atf[i + e] = o[0][e];
                    if (t == 63) wl[c8 * 8 + i + e] = e1;
                }
#pragma unroll
                for (int m = 0; m < 7; ++m) pk[m][i >> 1] = cvtpk(o[m][0], o[m][1]);
            }
            const unsigned ro = m64_off(t, c8);
            *(uint4*)(smem + RA_AT + ro) = make_uint4(pk[0][0], pk[0][1], pk[0][2], pk[0][3]);
            *(uint4*)(smem + RA_BT + ro) = make_uint4(pk[1][0], pk[1][1], pk[1][2], pk[1][3]);
            *(uint4*)(smem + RA_KT + ro) = make_uint4(pk[2][0], pk[2][1], pk[2][2], pk[2][3]);
            *(uint4*)(smem + RA_RT + ro) = make_uint4(pk[3][0], pk[3][1], pk[3][2], pk[3][3]);
            *(float4*)(rhs + t * 128 + c8 * 8) = make_float4(atf[0], atf[1], atf[2], atf[3]);
            *(float4*)(rhs + t * 128 + c8 * 8 + 4) = make_float4(atf[4], atf[5], atf[6], atf[7]);
#pragma unroll
            for (int i = 0; i < 8; ++i) {
                const int ch = c8 * 8 + i;
                const unsigned to = m64_off(ch, t >> 3) + (t & 7) * 2;
                const unsigned w4 = pk[4][i >> 1], w5 = pk[5][i >> 1], w6 = pk[6][i >> 1];
                *(bf16_t*)(smem + RA_BPT + to) = (bf16_t)((i & 1) ? (w4 >> 16) : (w4 & 0xffffu));
                *(bf16_t*)(smem + RA_KPT + to) = (bf16_t)((i & 1) ? (w5 >> 16) : (w5 & 0xffffu));
                *(bf16_t*)(smem + RA_VT + to) = (bf16_t)((i & 1) ? (w6 >> 16) : (w6 & 0xffffu));
            }
        }
        __syncthreads();
        {
            const int pr = wave >> 1, sub = wave & 1;
            const char* X = smem + ((pr & 1) ? RA_KT : RA_BT);
            const char* Y = smem + ((pr & 2) ? RA_RT : RA_AT);
            const int incl = (pr & 2) ? 1 : 0;
            char* dst = smem + (pr == 1 ? RA_AAK : pr == 2 ? RA_ARB : RA_ARK);
#pragma unroll
            for (int tt = 0; tt < 2; ++tt) {
                const int i0 = sub ? (tt ? 32 : 0) : (tt ? 32 : 0);
                const int t0 = sub ? (tt ? 0 : 32) : (tt ? 32 : 0);
                const bool zero_tile = sub && tt;
                f32x16 acc = zero16();
                if (!zero_tile) mm_tile(acc, X, i0, Y, t0, l31, hh);
                const int tq = t0 + l31;
#pragma unroll
                for (int q = 0; q < 4; ++q) {
                    float vv[4];
#pragma unroll
                    for (int e = 0; e < 4; ++e) { const int ii = i0 + 8 * q + 4 * hh + e; vv[e] = (ii < tq + incl) ? acc[4 * q + e] : 0.f; }
                    if (pr == 0) {
                        if (!zero_tile) {
#pragma unroll
                            for (int e = 0; e < 4; ++e) aabp[tq * 64 + e * 16 + (i0 >> 2) + 2 * q + hh] = vv[e];
                        }
                    } else {
                        uint2 o; o.x = cvtpk(vv[0], vv[1]); o.y = cvtpk(vv[2], vv[3]);
                        *(uint2*)(dst + m64_off(tq, (i0 >> 3) + q) + 8 * hh) = o;
                    }
                }
            }
        }
        __syncthreads();
        f32x16 accA = zero16();
        const int w4 = wave & 3, ta = w4 & 1, tb2 = w4 >> 1;
        if (wave < 4) {
            f32x16 x2 = zero16();
            mm_tile(x2, smem + RA_VT, ta * 32, smem + RA_AAK, tb2 * 32, l31, hh);
            const int tq = tb2 * 32 + l31;
#pragma unroll
            for (int q = 0; q < 4; ++q) *(float4*)(rhs + tq * 128 + 64 + ta * 32 + 8 * q + 4 * hh) = make_float4(x2[4 * q], x2[4 * q + 1], x2[4 * q + 2], x2[4 * q + 3]);
            mm_tile(accA, smem + RA_VT, ta * 32, smem + RA_ARK, tb2 * 32, l31, hh);
        } else {
            mm_tile(accA, smem + RA_KPT, ta * 32, smem + RA_VT, tb2 * 32, l31, hh);
        }
        __syncthreads();
        {
            const int g = lane & 3, col = wave * 16 + (lane >> 2);
            float P[16];
#pragma unroll
            for (int q = 0; q < 16; ++q) P[q] = 0.f;
            float last[4];
            char* pt = smem + (col < 64 ? RA_P1T : RA_P2T);
            const int prow = col & 63;
            float4 acur[4]; float rcur = rhs[col];
#pragma unroll
            for (int q4 = 0; q4 < 4; ++q4) acur[q4] = make_float4(0.f, 0.f, 0.f, 0.f);
#pragma unroll
            for (int ts = 0; ts < 64; ++ts) {
                float4 anxt[4]; float rnxt = 0.f;
#pragma unroll
                for (int q4 = 0; q4 < 4; ++q4) anxt[q4] = make_float4(0.f, 0.f, 0.f, 0.f);
                if (ts + 1 < 64) {
                    const int nq4n = (((ts + 4) >> 2) + 3) >> 2;
#pragma unroll
                    for (int q4 = 0; q4 < nq4n; ++q4) anxt[q4] = *(const float4*)(aabp + (ts + 1) * 64 + g * 16 + q4 * 4);
                    rnxt = rhs[(ts + 1) * 128 + col];
                }
                float part = 0.f;
                const int nq4 = (((ts + 3) >> 2) + 3) >> 2;
#pragma unroll
                for (int q4 = 0; q4 < nq4; ++q4) {
                    const float4 a = acur[q4];
                    part += a.x * P[4 * q4] + a.y * P[4 * q4 + 1] + a.z * P[4 * q4 + 2] + a.w * P[4 * q4 + 3];
                }
                part += dpp_xor1(part); part += dpp_xor2(part);
                const float val = rcur + part;
#pragma unroll
                for (int q4 = 0; q4 < 4; ++q4) acur[q4] = anxt[q4];
                rcur = rnxt;
                if (g == (ts & 3)) P[ts >> 2] = val;
                last[ts & 3] = val;
                if ((ts & 3) == 3 && g == 0) {
                    uint2 o; o.x = cvtpk(last[0], last[1]); o.y = cvtpk(last[2], last[3]);
                    *(uint2*)(pt + m64_off(prow, ts >> 3) + ((ts >> 2) & 1) * 8) = o;
                }
            }
        }
        __syncthreads();
        if (wave < 4) {
            mm_tile(accA, smem + RA_P2T, ta * 32, smem + RA_ARB, tb2 * 32, l31, hh);
            float* q2 = (float*)(p.ws + WS_Q2) + ((size_t)unit * 4 + (ta * 2 + tb2)) * 1024;
#pragma unroll
            for (int i = 0; i < 16; ++i) q2[i * 64 + lane] = accA[i];
            f32x16 q1 = zero16();
            mm_tile(q1, smem + RA_P1T, ta * 32, smem + RA_ARB, tb2 * 32, l31, hh);
            const int tq = tb2 * 32 + l31;
            bf16_t* q1g = (bf16_t*)(p.ws + WS_Q1) + (size_t)unit * 4096 + tq * 64;
#pragma unroll
            for (int q = 0; q < 4; ++q) {
                const int k0 = ta * 32 + 8 * q + 4 * hh;
                const uint2 rr = *(const uint2*)(smem + RA_RT + m64_off(tq, k0 >> 3) + (k0 & 7) * 2);
                uint2 o; o.x = cvtpk(q1[4 * q] + bflo(rr.x), q1[4 * q + 1] + bfhi(rr.x)); o.y = cvtpk(q1[4 * q + 2] + bflo(rr.y), q1[4 * q + 3] + bfhi(rr.y));
                *(uint2*)(q1g + k0) = o;
            }
        } else {
            mm_tile(accA, smem + RA_BPT, ta * 32, smem + RA_P2T, tb2 * 32, l31, hh);
            unsigned* hb = (unsigned*)(p.ws + WS_HB) + ((size_t)unit * 4 + (ta * 2 + tb2)) * 512;
#pragma unroll
            for (int j = 0; j < 8; ++j) hb[j * 64 + lane] = cvtpk(accA[2 * j], accA[2 * j + 1]);
            f32x16 gg = zero16();
            mm_tile(gg, smem + RA_P1T, ta * 32, smem + RA_BPT, tb2 * 32, l31, hh);
            if (ta == tb2) {
#pragma unroll
                for (int i = 0; i < 16; ++i) { const int kk = (i & 3) + 8 * (i >> 2) + 4 * hh; if (kk == l31) gg[i] += wl[ta * 32 + kk]; }
            }
            unsigned* gb = (unsigned*)(p.ws + WS_GB) + ((size_t)unit * 4 + (ta * 2 + tb2)) * 512 + lane * 8;
            uint4 o0, o1;
            o0.x = cvtpk(gg[0], gg[1]); o0.y = cvtpk(gg[2], gg[3]); o0.z = cvtpk(gg[4], gg[5]); o0.w = cvtpk(gg[6], gg[7]);
            o1.x = cvtpk(gg[8], gg[9]); o1.y = cvtpk(gg[10], gg[11]); o1.z = cvtpk(gg[12], gg[13]); o1.w = cvtpk(gg[14], gg[15]);
            *(uint4*)(gb) = o0; *(uint4*)(gb + 4) = o1;
        }
    }
}

struct RbH { unsigned w[2][8]; };
DEVI void rb_load(const Params& p, int unit, int vh, int lane, uint4 (&g)[8], RbH& hq) {
    const unsigned* gb = (const unsigned*)(p.ws + WS_GB) + (size_t)unit * 2048 + lane * 8;
    const unsigned* hb = (const unsigned*)(p.ws + WS_HB) + (size_t)unit * 2048 + lane;
#pragma unroll
    for (int t4 = 0; t4 < 4; ++t4) { g[2 * t4] = *(const uint4*)(gb + t4 * 512); g[2 * t4 + 1] = *(const uint4*)(gb + t4 * 512 + 4); }
#pragma unroll
    for (int j = 0; j < 8; ++j) { hq.w[0][j] = hb[(0 * 2 + vh) * 512 + j * 64]; hq.w[1][j] = hb[(1 * 2 + vh) * 512 + j * 64]; }
}
DEVI void rb_store(const Params& p, int unit, int vh, int l31, int hh, const f32x16& X0, const f32x16& X1) {
    bf16_t* s0 = (bf16_t*)(p.ws + WS_S0) + (size_t)unit * 4096 + (vh * 32 + l31) * 64;
#pragma unroll
    for (int q = 0; q < 4; ++q) {
        uint2 o; o.x = cvtpk(X0[4 * q], X0[4 * q + 1]); o.y = cvtpk(X0[4 * q + 2], X0[4 * q + 3]);
        *(uint2*)(s0 + 8 * q + 4 * hh) = o;
        uint2 o2; o2.x = cvtpk(X1[4 * q], X1[4 * q + 1]); o2.y = cvtpk(X1[4 * q + 2], X1[4 * q + 3]);
        *(uint2*)(s0 + 32 + 8 * q + 4 * hh) = o2;
    }
}
#define BF8(u) __builtin_bit_cast(bf16x8, u)
DEVI void rb_step(f32x16& X0, f32x16& X1, const uint4 (&g)[8], const RbH& hq) {
    uint4 xa, xb, xc, xd;
    xa.x = cvtpk(X0[0], X0[1]); xa.y = cvtpk(X0[2], X0[3]); xa.z = cvtpk(X0[4], X0[5]); xa.w = cvtpk(X0[6], X0[7]);
    xb.x = cvtpk(X0[8], X0[9]); xb.y = cvtpk(X0[10], X0[11]); xb.z = cvtpk(X0[12], X0[13]); xb.w = cvtpk(X0[14], X0[15]);
    xc.x = cvtpk(X1[0], X1[1]); xc.y = cvtpk(X1[2], X1[3]); xc.z = cvtpk(X1[4], X1[5]); xc.w = cvtpk(X1[6], X1[7]);
    xd.x = cvtpk(X1[8], X1[9]); xd.y = cvtpk(X1[10], X1[11]); xd.z = cvtpk(X1[12], X1[13]); xd.w = cvtpk(X1[14], X1[15]);
    f32x16 N0, N1;
#pragma unroll
    for (int j = 0; j < 8; ++j) { N0[2 * j] = bflo(hq.w[0][j]); N0[2 * j + 1] = bfhi(hq.w[0][j]); N1[2 * j] = bflo(hq.w[1][j]); N1[2 * j + 1] = bfhi(hq.w[1][j]); }
    N0 = __builtin_amdgcn_mfma_f32_32x32x16_bf16(BF8(g[0]), BF8(xa), N0, 0, 0, 0);
    N1 = __builtin_amdgcn_mfma_f32_32x32x16_bf16(BF8(g[2]), BF8(xa), N1, 0, 0, 0);
    N0 = __builtin_amdgcn_mfma_f32_32x32x16_bf16(BF8(g[1]), BF8(xb), N0, 0, 0, 0);
    N1 = __builtin_amdgcn_mfma_f32_32x32x16_bf16(BF8(g[3]), BF8(xb), N1, 0, 0, 0);
    N0 = __builtin_amdgcn_mfma_f32_32x32x16_bf16(BF8(g[4]), BF8(xc), N0, 0, 0, 0);
    N1 = __builtin_amdgcn_mfma_f32_32x32x16_bf16(BF8(g[6]), BF8(xc), N1, 0, 0, 0);
    N0 = __builtin_amdgcn_mfma_f32_32x32x16_bf16(BF8(g[5]), BF8(xd), N0, 0, 0, 0);
    N1 = __builtin_amdgcn_mfma_f32_32x32x16_bf16(BF8(g[7]), BF8(xd), N1, 0, 0, 0);
    X0 = N0; X1 = N1;
}
DEVI void phaseRB_core(const Params& p, char* smem) {
    const int tid = threadIdx.x, lane = tid & 63, wave = tid >> 6, l31 = lane & 31, hh = lane >> 5;
    if (wave != 0) return;
    for (int wu = blockIdx.x; wu < 64; wu += gridDim.x) {
        const int bh = (wu & 7) | ((wu >> 4) << 3), vh = (wu >> 3) & 1;
        f32x16 X0 = zero16(), X1 = zero16();
        uint4 gA[8], gB[8], gC[8]; RbH hA, hB, hC;
        rb_load(p, bh * 64, vh, lane, gA, hA);
        rb_load(p, bh * 64 + 1, vh, lane, gB, hB);
        for (int c = 0; c < 63; c += 3) {
            rb_load(p, bh * 64 + (c + 2 < 64 ? c + 2 : 63), vh, lane, gC, hC);
            rb_store(p, bh * 64 + c, vh, l31, hh, X0, X1);
            rb_step(X0, X1, gA, hA);
            rb_load(p, bh * 64 + (c + 3 < 64 ? c + 3 : 63), vh, lane, gA, hA);
            rb_store(p, bh * 64 + c + 1, vh, l31, hh, X0, X1);
            rb_step(X0, X1, gB, hB);
            rb_load(p, bh * 64 + (c + 4 < 64 ? c + 4 : 63), vh, lane, gB, hB);
            rb_store(p, bh * 64 + c + 2, vh, l31, hh, X0, X1);
            rb_step(X0, X1, gC, hC);
        }
        rb_store(p, bh * 64 + 63, vh, l31, hh, X0, X1);
    }
}

DEVI void phaseRB(const Params& p, char* smem) {
    const bool split = gridDim.x >= 128;
    if (split && blockIdx.x < 64) { phaseRB_core(p, smem); return; }
    const int nw = split ? (int)gridDim.x - 64 : (int)gridDim.x, wi = split ? (int)blockIdx.x - 64 : (int)blockIdx.x;
    for (int u = wi; u < 256; u += nw) p3_unit(p, smem, u);
    if (!split) { __syncthreads(); phaseRB_core(p, smem); }
}

DEVI void phaseRC(const Params& p, char* smem) {
    const int tid = threadIdx.x, lane = tid & 63, wave = tid >> 6, l31 = lane & 31, hh = lane >> 5;
    const bf16_t* z = (const bf16_t*)(p.ws + WS_Z); const bf16_t* GVb = (const bf16_t*)(p.ws + WS_GV); const float* RKSb = (const float*)(p.ws + WS_RKS);
    bf16_t* mix = (bf16_t*)(p.ws + WS_MIX);
    for (int it0 = blockIdx.x; it0 < 512 + N_SPEC; it0 += gridDim.x) {
        if (it0 < N_SPEC) { spec_unit(p, smem, it0); continue; }
        const int it = it0 - N_SPEC;
        const int unit = it * 4 + (wave >> 1), tb = wave & 1;
        const int bh = unit >> 6, c = unit & 63, b = bh >> 4, h = bh & 15;
        const int tq = tb * 32 + l31, tok = b * SEQ + c * 64 + tq;
        const float* q2 = (const float*)(p.ws + WS_Q2) + (size_t)unit * 4096 + lane;
        f32x16 a0, a1;
#pragma unroll
        for (int i = 0; i < 16; ++i) { a0[i] = q2[(0 * 2 + tb) * 1024 + i * 64]; a1[i] = q2[(1 * 2 + tb) * 1024 + i * 64]; }
        const bf16_t* s0 = (const bf16_t*)(p.ws + WS_S0) + (size_t)unit * 4096;
        const bf16_t* q1 = (const bf16_t*)(p.ws + WS_Q1) + (size_t)unit * 4096 + tq * 64;
#pragma unroll
        for (int s4 = 0; s4 < 4; ++s4) {
            const bf16x8 fa0 = *(const bf16x8*)(s0 + (l31) * 64 + 16 * s4 + 8 * hh);
            const bf16x8 fa1 = *(const bf16x8*)(s0 + (32 + l31) * 64 + 16 * s4 + 8 * hh);
            const bf16x8 fb = *(const bf16x8*)(q1 + 16 * s4 + 8 * hh);
            a0 = __builtin_amdgcn_mfma_f32_32x32x16_bf16(fa0, fb, a0, 0, 0, 0);
            a1 = __builtin_amdgcn_mfma_f32_32x32x16_bf16(fa1, fb, a1, 0, 0, 0);
        }
        float sm = 0.f;
#pragma unroll
        for (int i = 0; i < 16; ++i) sm += a0[i] + a1[i];
        sm = xor32_sum(sm);
        const float mean = sm * (1.f / 64.f);
        float sq = 0.f;
#pragma unroll
        for (int i = 0; i < 16; ++i) { const float d0 = a0[i] - mean, d1 = a1[i] - mean; sq += d0 * d0 + d1 * d1; }
        sq = xor32_sum(sq);
        const float rstd = rsqrtf(sq * (1.f / 64.f) + 64e-5f);
        const float rk = RKSb[tok * 16 + h];
#pragma unroll
        for (int vb = 0; vb < 2; ++vb)
#pragma unroll
            for (int q = 0; q < 4; ++q) {
                const int ch = h * 64 + vb * 32 + 8 * q + 4 * hh;
                const int hc = ch;
                const uint2 zc2 = *(const uint2*)(z + (size_t)tok * INC + ZC_RW + 2048 + hc);
                uint2 zp2 = make_uint2(0u, 0u);
                if (tok & (SEQ - 1)) zp2 = *(const uint2*)(z + (size_t)(tok - 1) * INC + ZC_RW + 2048 + hc);
                const float4 muv = *(const float4*)(p.mu + 2048 + hc);
                const uint2 g2 = *(const uint2*)(GVb + (size_t)tok * RW + hc);
                float4 vv, gv;
                vv.x = bflo(zc2.x) + (bflo(zp2.x) - bflo(zc2.x)) * muv.x; vv.y = bfhi(zc2.x) + (bfhi(zp2.x) - bfhi(zc2.x)) * muv.y;
                vv.z = bflo(zc2.y) + (bflo(zp2.y) - bflo(zc2.y)) * muv.z; vv.w = bfhi(zc2.y) + (bfhi(zp2.y) - bfhi(zc2.y)) * muv.w;
                gv.x = bflo(g2.x); gv.y = bfhi(g2.x); gv.z = bflo(g2.y); gv.w = bfhi(g2.y);
                const float4 lnw = *(const float4*)(p.ln_w + ch), lnb = *(const float4*)(p.ln_b + ch);
                float y[4];
#pragma unroll
                for (int e = 0; e < 4; ++e) y[e] = ((vb ? a1[4 * q + e] : a0[4 * q + e]) - mean) * rstd;
                uint2 o;
                o.x = cvtpk((y[0] * lnw.x + lnb.x + rk * vv.x) * gv.x, (y[1] * lnw.y + lnb.y + rk * vv.y) * gv.y);
                o.y = cvtpk((y[2] * lnw.z + lnb.z + rk * vv.z) * gv.z, (y[3] * lnw.w + lnb.w + rk * vv.w) * gv.w);
                *(uint2*)(mix + (size_t)tok * DM + 1024 + ch) = o;
            }
    }
}

DEVI void phase6(const Params& p, char* smem) {
    pg8::Gemm g{(const pg8::bf16_t*)(p.ws + WS_MIX), (const pg8::bf16_t*)(p.ws + WS_WTO), NTOK, DM, DM};
    pg8::StaticOrder S; S.init(NTOK, DM, (int)gridDim.x, (int)blockIdx.x);
    pg8::EpiX1 E{(float*)(p.ws + WS_X1), p.x, (const float*)(p.ws + WS_MODF) + 2 * DM, DM, 12288, SEQ};
    pg8::gemm_phase<pg8::EpiX1, pg8::StaticOrder, true, true>((PG8_LAS unsigned char*)smem, g, S, E);
}

DEVI void phase7(const Params& p, char* smem) {
    float* part = (float*)smem;
    float* ssq = part + 8 * 32 * 80;
    float* rstd_s = ssq + 8 * 128;
    float* lg_ = rstd_s + 32;
    const float* x1 = (const float*)(p.ws + WS_X1);
    const uint4* wrf = (const uint4*)(p.ws + WS_WRF);
    const float* cb = (const float*)(p.ws + WS_CB);
    const float* as2 = (const float*)(p.ws + WS_AS2);
    bf16_t* h = (bf16_t*)(p.ws + WS_H);
    int* cnt = (int*)(p.ws + WS_CTL);
    int* list = (int*)(p.ws + WS_LIST); float* lw = (float*)(p.ws + WS_LWT);
    const int tid = threadIdx.x, lane = tid & 63, wave = tid >> 6, li = lane & 15, lg = lane >> 4;
    for (int u = blockIdx.x; u < NTOK / 32; u += gridDim.x) {
        const int tok0 = u * 32, b = tok0 >> 12;
        __syncthreads();
        f32x4 acc[2][5];
#pragma unroll
        for (int tg = 0; tg < 2; ++tg)
#pragma unroll
            for (int nf = 0; nf < 5; ++nf) acc[tg][nf] = f32x4{0.f, 0.f, 0.f, 0.f};
        float sq[2] = {0.f, 0.f};
        const float* xr = x1 + (size_t)(tok0 + li) * DM + wave * 256 + 8 * lg;
#pragma unroll 2
        for (int s4 = 0; s4 < 8; ++s4) {
            bf16x8 ah[2], al[2];
#pragma unroll
            for (int tg = 0; tg < 2; ++tg) {
                const float4 xa = *(const float4*)(xr + (size_t)tg * 16 * DM + s4 * 32), xb = *(const float4*)(xr + (size_t)tg * 16 * DM + s4 * 32 + 4);
                sq[tg] += xa.x * xa.x + xa.y * xa.y + xa.z * xa.z + xa.w * xa.w + xb.x * xb.x + xb.y * xb.y + xb.z * xb.z + xb.w * xb.w;
                uint4 hi, lo;
                hi.x = cvtpk(xa.x, xa.y); hi.y = cvtpk(xa.z, xa.w); hi.z = cvtpk(xb.x, xb.y); hi.w = cvtpk(xb.z, xb.w);
                lo.x = cvtpk(xa.x - bflo(hi.x), xa.y - bfhi(hi.x)); lo.y = cvtpk(xa.z - bflo(hi.y), xa.w - bfhi(hi.y));
                lo.z = cvtpk(xb.x - bflo(hi.z), xb.y - bfhi(hi.z)); lo.w = cvtpk(xb.z - bflo(hi.w), xb.w - bfhi(hi.w));
                ah[tg] = __builtin_bit_cast(bf16x8, hi); al[tg] = __builtin_bit_cast(bf16x8, lo);
            }
            const uint4* wf = wrf + ((size_t)(b * 64 + wave * 8 + s4) * 5) * 128 + lane;
#pragma unroll
            for (int nf = 0; nf < 5; ++nf) {
                const bf16x8 bh = __builtin_bit_cast(bf16x8, wf[nf * 128]), bl = __builtin_bit_cast(bf16x8, wf[nf * 128 + 64]);
#pragma unroll
                for (int tg = 0; tg < 2; ++tg) {
                    acc[tg][nf] = __builtin_amdgcn_mfma_f32_16x16x32_bf16(al[tg], bh, acc[tg][nf], 0, 0, 0);
                    acc[tg][nf] = __builtin_amdgcn_mfma_f32_16x16x32_bf16(ah[tg], bl, acc[tg][nf], 0, 0, 0);
                    acc[tg][nf] = __builtin_amdgcn_mfma_f32_16x16x32_bf16(ah[tg], bh, acc[tg][nf], 0, 0, 0);
                }
            }
        }
#pragma unroll
        for (int tg = 0; tg < 2; ++tg) {
#pragma unroll
            for (int nf = 0; nf < 5; ++nf)
#pragma unroll
                for (int r = 0; r < 4; ++r) part[(wave * 32 + 16 * tg + 4 * lg + r) * 80 + nf * 16 + li] = acc[tg][nf][r];
            ssq[(wave * 4 + lg) * 32 + 16 * tg + li] = sq[tg];
        }
        __syncthreads();
        if (tid < 32) {
            float t = 0.f;
#pragma unroll
            for (int q = 0; q < 32; ++q) t += ssq[q * 32 + tid];
            rstd_s[tid] = rsqrtf(t * (1.f / DM) + 1e-6f);
        }
        __syncthreads();
        for (int idx = tid; idx < 32 * 80; idx += 512) {
            const int tk = idx / 80, j = idx % 80;
            float t = 0.f;
#pragma unroll
            for (int w = 0; w < 8; ++w) t += part[(w * 32 + tk) * 80 + j];
            lg_[idx] = rstd_s[tk] * t + cb[b * 80 + j];
        }
        __syncthreads();
        if (tid < 32) {
            const int tok = tok0 + tid;
            const float* L = lg_ + tid * 80;
            int gi = 0; float gm = L[64];
            for (int j = 1; j < 8; ++j) if (L[64 + j] > gm) { gm = L[64 + j]; gi = j; }
            float den = 0.f;
            for (int j = 0; j < 8; ++j) den += expf(L[64 + j] - gm);
            const float ggate = 1.f / den;
            const float* E = L + gi * 8;
            int i1 = 0; float m1 = E[0];
            for (int j = 1; j < 8; ++j) if (E[j] > m1) { m1 = E[j]; i1 = j; }
            int i2 = -1; float m2 = -3.0e38f;
            for (int j = 0; j < 8; ++j) if (j != i1 && E[j] > m2) { m2 = E[j]; i2 = j; }
            const float e2 = expf(m2 - m1);
            const float p1 = 1.f / (1.f + e2), p2 = e2 / (1.f + e2);
            const int ex1 = gi * 8 + i1, ex2 = gi * 8 + i2;
            const int pos1 = atomicAdd(&cnt[ex1], 1); list[ex1 * LCAP + pos1] = tok * 2; lw[ex1 * LCAP + pos1] = ggate * p1;
            const int pos2 = atomicAdd(&cnt[ex2], 1); list[ex2 * LCAP + pos2] = tok * 2 + 1; lw[ex2 * LCAP + pos2] = ggate * p2;
        }
#pragma unroll 2
        for (int tt = 0; tt < 4; ++tt) {
            const int tk = wave * 4 + tt, tok = tok0 + tk;
            const float rs = rstd_s[tk];
            const float* xrow = x1 + (size_t)tok * DM;
#pragma unroll
            for (int i = 0; i < 8; ++i) {
                const int k = i * 256 + lane * 4;
                const float4 xv = *(const float4*)(xrow + k);
                const float4 a = *(const float4*)(as2 + b * DM + k), sft = *(const float4*)(as2 + 2 * DM + b * DM + k);
                uint2 o; o.x = cvtpk(xv.x * rs * a.x + sft.x, xv.y * rs * a.y + sft.y); o.y = cvtpk(xv.z * rs * a.z + sft.z, xv.w * rs * a.w + sft.w);
                *(uint2*)(h + (size_t)tok * DM + k) = o;
            }
        }
    }
}

struct MoeTab { int cnt[64]; int sb[65]; int ubx[9]; int np[8]; };
DEVI void moe_tables(const Params& p, MoeTab* tb, int slabs) {
    const int* cnt = (const int*)(p.ws + WS_CTL);
    const int tid = threadIdx.x, x = blockIdx.x & 7;
    __syncthreads();
    if (tid < 64) tb->cnt[tid] = cnt[tid];
    __syncthreads();
    if (tid == 0) {
        int sb = 0;
        for (int e = 0; e < 64; ++e) { tb->sb[e] = sb; sb += tb->cnt[e]; }
        tb->sb[64] = sb;
        int ub = 0;
        for (int i = 0; i < 8; ++i) { const int np = (tb->cnt[x + 8 * i] + 255) >> 8; tb->np[i] = np; tb->ubx[i] = ub; ub += np * slabs; }
        tb->ubx[8] = ub;
    }
    __syncthreads();
}
struct MoeUnit { int e, s, ce, sbase, rbeg, rend; };
DEVI MoeUnit moe_unit(const MoeTab* tb, int u) {
    int i = 0;
    while (tb->ubx[i + 1] <= u) ++i;
    const int rem = u - tb->ubx[i], np = tb->np[i], ps = rem % np;
    MoeUnit m; m.e = (blockIdx.x & 7) + 8 * i; m.s = rem / np; m.ce = tb->cnt[m.e]; m.sbase = tb->sb[m.e];
    const int rp = (((m.ce + np - 1) / np) + 15) & ~15;
    m.rbeg = ps * rp; m.rend = m.rbeg + rp < m.ce ? m.rbeg + rp : m.ce;
    return m;
}

DEVI void phase8(const Params& p, char* smem) {
    MoeTab* tb = (MoeTab*)(smem + 32768);
    const bf16_t* h = (const bf16_t*)(p.ws + WS_H);
    bf16_t* hid = (bf16_t*)(p.ws + WS_HID);
    const int* list = (const int*)(p.ws + WS_LIST);
    const int tid = threadIdx.x, lane = tid & 63, wave = tid >> 6, li = lane & 15, lg = lane >> 4;
    moe_tables(p, tb, 4);
    const int total = tb->ubx[8], nslot = ((int)gridDim.x - (int)(blockIdx.x & 7) + 7) >> 3;
    for (int u = blockIdx.x >> 3; u < total; u += nslot) {
        const MoeUnit mu = moe_unit(tb, u);
        const int e = mu.e, s = mu.s;
        const int fcol = s * 128 + wave * 16;
        const float* bp0 = p.w1 + (size_t)e * DM * FF + (size_t)(8 * lg) * FF + fcol + li;
        const float* bp1 = p.w3 + (size_t)e * DM * FF + (size_t)(8 * lg) * FF + fcol + li;
        int r0 = mu.rbeg + (tid >> 2), r1 = r0 + 128; r0 = r0 < mu.rend ? r0 : mu.rend - 1; r1 = r1 < mu.rend ? r1 : mu.rend - 1;
        const bf16_t* ap0 = h + (size_t)(list[e * LCAP + r0] >> 1) * DM + (tid & 3) * 8;
        const bf16_t* ap1 = h + (size_t)(list[e * LCAP + r1] >> 1) * DM + (tid & 3) * 8;
        __syncthreads();
        gemm_tile<1, 2>(smem, DM / 32, FF, bp0, bp1, ap0, ap1, [&](f32x4 (&acc)[16][2]) {
#pragma unroll
            for (int m = 0; m < 16; ++m) {
                const int r = mu.rbeg + 16 * m + li;
                if (r < mu.rend) {
                    float hv[4];
#pragma unroll
                    for (int q = 0; q < 4; ++q) { const float a = acc[m][0][q]; hv[q] = a / (1.f + __expf(-a)) * acc[m][1][q]; }
                    uint2 o; o.x = cvtpk(hv[0], hv[1]); o.y = cvtpk(hv[2], hv[3]);
                    *(uint2*)(hid + (size_t)(mu.sbase + r) * FF + fcol + 4 * lg) = o;
                }
            }
        });
    }
}

DEVI void phase9(const Params& p, char* smem) {
    MoeTab* tb = (MoeTab*)(smem + 32768);
    const bf16_t* hid = (const bf16_t*)(p.ws + WS_HID);
    bf16_t* yb = (bf16_t*)(p.ws + WS_YB);
    const int* list = (const int*)(p.ws + WS_LIST); const float* lw = (const float*)(p.ws + WS_LWT);
    const int tid = threadIdx.x, lane = tid & 63, wave = tid >> 6, li = lane & 15, lg = lane >> 4;
    moe_tables(p, tb, 8);
    const int total = tb->ubx[8], nslot = ((int)gridDim.x - (int)(blockIdx.x & 7) + 7) >> 3;
    for (int u = blockIdx.x >> 3; u < total; u += nslot) {
        const MoeUnit mu = moe_unit(tb, u);
        const int e = mu.e, s = mu.s;
        const int col0 = s * 256 + wave * 32;
        const float* bp0 = p.w2 + (size_t)e * FF * DM + (size_t)(8 * lg) * DM + col0 + li; const float* bp1 = bp0 + 16;
        int r0 = mu.rbeg + (tid >> 2), r1 = r0 + 128; r0 = r0 < mu.rend ? r0 : mu.rend - 1; r1 = r1 < mu.rend ? r1 : mu.rend - 1;
        const bf16_t* ap0 = hid + (size_t)(mu.sbase + r0) * FF + (tid & 3) * 8; const bf16_t* ap1 = hid + (size_t)(mu.sbase + r1) * FF + (tid & 3) * 8;
        __syncthreads();
        gemm_tile<1, 2>(smem, FF / 32, DM, bp0, bp1, ap0, ap1, [&](f32x4 (&acc)[16][2]) {
#pragma unroll
            for (int m = 0; m < 16; ++m) {
                const int r = mu.rbeg + 16 * m + li;
                if (r < mu.rend) {
                    const int a = list[e * LCAP + r]; const float wgt = lw[e * LCAP + r];
#pragma unroll
                    for (int nf = 0; nf < 2; ++nf) {
                        uint2 o; o.x = cvtpk(acc[m][nf][0] * wgt, acc[m][nf][1] * wgt); o.y = cvtpk(acc[m][nf][2] * wgt, acc[m][nf][3] * wgt);
                        *(uint2*)(yb + (size_t)a * DM + col0 + nf * 16 + 4 * lg) = o;
                    }
                }
            }
        });
    }
}

DEVI void phase10(const Params& p, char* smem) {
    const float* modf = (const float*)(p.ws + WS_MODF);
    const float* x1 = (const float*)(p.ws + WS_X1);
    const bf16_t* yb = (const bf16_t*)(p.ws + WS_YB);
    const int tid = threadIdx.x, lane = tid & 63, wave = tid >> 6;
    for (int u = blockIdx.x; u < NTOK / 8; u += gridDim.x) {
        const int tok = u * 8 + wave, b = tok >> 12;
        float4 v[8]; float ss = 0.f;
#pragma unroll
        for (int i = 0; i < 8; ++i) {
            const int k = i * 256 + lane * 4;
            const float4 xv = *(const float4*)(x1 + (size_t)tok * DM + k);
            const float4 gt = *(const float4*)(modf + b * 12288 + 5 * DM + k);
            const uint2 ya = *(const uint2*)(yb + (size_t)(tok * 2) * DM + k), yc = *(const uint2*)(yb + (size_t)(tok * 2 + 1) * DM + k);
            v[i].x = xv.x + gt.x * (bflo(ya.x) + bflo(yc.x)); v[i].y = xv.y + gt.y * (bfhi(ya.x) + bfhi(yc.x));
            v[i].z = xv.z + gt.z * (bflo(ya.y) + bflo(yc.y)); v[i].w = xv.w + gt.w * (bfhi(ya.y) + bfhi(yc.y));
            ss += v[i].x * v[i].x + v[i].y * v[i].y + v[i].z * v[i].z + v[i].w * v[i].w;
        }
        ss = wave_sum(ss);
        const float rstd = rsqrtf(ss * (1.f / DM) + 1e-6f);
#pragma unroll
        for (int i = 0; i < 8; ++i) {
            const int k = i * 256 + lane * 4;
            const float4 g = *(const float4*)(p.final_g + k);
            float4 o; o.x = v[i].x * rstd * g.x; o.y = v[i].y * rstd * g.y; o.z = v[i].z * rstd * g.z; o.w = v[i].w * rstd * g.w;
            *(float4*)(p.out + (size_t)tok * DM + k) = o;
        }
    }
}

constexpr size_t WS_BAR = 4096;
constexpr int N_PHASES = 12;
#ifndef MK_N_LAUNCHES
#define MK_N_LAUNCHES 1
#endif

__global__ void __launch_bounds__(512) mega_kernel(Params p, int lo, int hi) {
    extern __shared__ __attribute__((aligned(16))) char smem[];
    volatile LAS unsigned* xb_words = (volatile LAS unsigned*)(smem + LDS_BYTES - 16);
    if (threadIdx.x == 0) { xb_words[0] = 0u; xb_words[1] = 0u; xb_words[2] = 0u; xb_words[3] = 0u; }
    __syncthreads();
    XcdBarrier bar;
    if (hi - lo > 1) bar = xcd_barrier_post((unsigned*)(p.ws + WS_BAR), xb_words);
#define IN(k) (lo <= (k) && (k) < hi)
#define SEAM(k) do { if (IN(k) && IN((k) + 1)) xcd_barrier(bar); } while (0)
#ifndef PROBE_MASK
#define PROBE_MASK 0
#endif
#define REP(k) (((PROBE_MASK >> (k)) & 1) ? 2 : 1)
    if (IN(0)) for (int rp = 0; rp < REP(0); ++rp) phase0(p, smem);
    SEAM(0);
    if (IN(1)) for (int rp = 0; rp < REP(1); ++rp) phase1(p, smem);
    SEAM(1);
    if (IN(2)) for (int rp = 0; rp < REP(2); ++rp) phase2(p, smem);
    SEAM(2);
    if (IN(3)) for (int rp = 0; rp < REP(3); ++rp) phase3(p, smem);
    SEAM(3);
    if (IN(4)) for (int rp = 0; rp < REP(4); ++rp) phaseRA(p, smem);
    SEAM(4);
    if (IN(5)) for (int rp = 0; rp < REP(5); ++rp) phaseRB(p, smem);
    SEAM(5);
    if (IN(6)) for (int rp = 0; rp < REP(6); ++rp) phaseRC(p, smem);
    SEAM(6);
    if (IN(7)) for (int rp = 0; rp < REP(7); ++rp) phase6(p, smem);
    SEAM(7);
    if (IN(8)) phase7(p, smem);
    SEAM(8);
    if (IN(9)) for (int rp = 0; rp < REP(9); ++rp) phase8(p, smem);
    SEAM(9);
    if (IN(10)) for (int rp = 0; rp < REP(10); ++rp) phase9(p, smem);
    SEAM(10);
    if (IN(11)) for (int rp = 0; rp < REP(11); ++rp) phase10(p, smem);
#undef IN
#undef SEAM
}

extern "C" void kernel_launch(void* const* d_in, const int* in_sizes, int n_in, void* d_out, int out_size, void* d_ws, size_t ws_size, hipStream_t stream) {
    static int grid = 0;
    if (!grid) {
        int dev = 0, cus = 0, per_cu = 0;
        (void)hipGetDevice(&dev);
        (void)hipDeviceGetAttribute(&cus, hipDeviceAttributeMultiprocessorCount, dev);
        if (hipFuncSetAttribute((const void*)mega_kernel, hipFuncAttributeMaxDynamicSharedMemorySize, LDS_BYTES) != hipSuccess) { grid = -1; return; }
        if (hipOccupancyMaxActiveBlocksPerMultiprocessor(&per_cu, (const void*)mega_kernel, 512, LDS_BYTES) != hipSuccess || per_cu < 1) { grid = -1; return; }
        grid = cus;
        if (grid > 256) grid = 256;
    }
    if (grid < 0) return;
    Params p{};
    const float* const* in = (const float* const*)d_in;
    p.x = in[0]; p.c = in[1]; p.w_ada = in[2]; p.b_ada = in[3]; p.norm1_g = in[4]; p.w_in = in[5]; p.mu = in[6]; p.sinks = in[7]; p.w0 = in[8]; p.wd_up = in[9];
    p.a0 = in[10]; p.wa_up = in[11]; p.wg_up = in[12]; p.k_k = in[13]; p.k_a = in[14]; p.r_k = in[15]; p.ln_w = in[16]; p.ln_b = in[17]; p.w_o = in[18]; p.norm2_g = in[19];
    p.w_rg = in[20]; p.b_rg = in[21]; p.w_re = in[22]; p.b_re = in[23]; p.w1 = in[24]; p.w3 = in[25]; p.w2 = in[26]; p.final_g = in[27];
    p.out = (float*)d_out; p.ws = (unsigned char*)d_ws;
    (void)hipMemsetAsync((char*)d_ws + WS_CTL, 0, CTL_BYTES, stream);
#if MK_N_LAUNCHES == 1
    hipLaunchKernelGGL(mega_kernel, dim3(grid), dim3(512), LDS_BYTES, stream, p, 0, N_PHASES);
#else
    for (int k = 0; k < N_PHASES; ++k) hipLaunchKernelGGL(mega_kernel, dim3(grid), dim3(512), LDS_BYTES, stream, p, k, k + 1);
#endif
}
```

```cpp
#include <hip/hip_runtime.h>
#include <stdint.h>

#define DEVI __device__ __forceinline__
typedef unsigned short bf16_t;
typedef short bf16x8 __attribute__((ext_vector_type(8)));
typedef float f32x4 __attribute__((ext_vector_type(4)));
typedef float f32x16 __attribute__((ext_vector_type(16)));
typedef float f32x2_t __attribute__((ext_vector_type(2)));
typedef __bf16 bf16x2_t __attribute__((ext_vector_type(2)));

constexpr int NTOK = 8192, DM = 2048, SEQ = 4096, INC = 4640, RW = 1024;
constexpr int ZC_K = 1024, ZC_V = 1152, ZC_RW = 1280;
constexpr int NEXP = 64, FF = 512, LCAP = 8192;
constexpr int NKS = 16;

constexpr size_t MiB = 1u << 20;
constexpr size_t WS_CTL = 0, CTL_BYTES = 20480;
constexpr size_t WS_PART = 1 * MiB;
constexpr size_t WS_MODF = 3 * MiB;
constexpr size_t WS_ROPE = 4 * MiB;
constexpr size_t WS_WRF = 5 * MiB;
constexpr size_t WS_CB = 7 * MiB;
constexpr size_t WS_AS2 = 7 * MiB + 4096;
constexpr size_t WS_H = 8 * MiB;
constexpr size_t WS_Z = 40 * MiB;
constexpr size_t WS_MIX = 116 * MiB;
constexpr size_t WS_X1 = 148 * MiB;
constexpr size_t WS_R = 212 * MiB, WS_DEC = 244 * MiB, WS_K2 = 276 * MiB, WS_V = 308 * MiB, WS_AA = 340 * MiB, WS_BB = 372 * MiB, WS_G = 404 * MiB, WS_Y = 436 * MiB;
constexpr size_t WS_LW = 212 * MiB;
constexpr size_t WS_AV = 244 * MiB;
constexpr size_t WS_GV = 260 * MiB;
constexpr size_t WS_RKS = 468 * MiB;
constexpr size_t WS_LIST = 469 * MiB;
constexpr size_t WS_LWT = 471 * MiB;
constexpr size_t WS_HID = 473 * MiB;
constexpr size_t WS_YB = 490 * MiB;

constexpr size_t WS_WTI = 672 * MiB;
constexpr size_t WS_WTO = 692 * MiB;
constexpr size_t WS_GB = 556 * MiB;
constexpr size_t WS_HB = 572 * MiB;
constexpr size_t WS_Q2 = 604 * MiB;
constexpr size_t WS_Q1 = 636 * MiB;
constexpr size_t WS_S0 = 652 * MiB;

constexpr int LDS_BYTES = 147456;

struct Params {
    const float *x, *c, *w_ada, *b_ada, *norm1_g, *w_in, *mu, *sinks, *w0, *wd_up, *a0, *wa_up, *wg_up, *k_k, *k_a, *r_k, *ln_w, *ln_b, *w_o, *norm2_g,
        *w_rg, *b_rg, *w_re, *b_re, *w1, *w3, *w2, *final_g;
    float* out;
    unsigned char* ws;
};

DEVI unsigned cvtpk(float lo, float hi) { f32x2_t v = {lo, hi}; bf16x2_t b = __builtin_convertvector(v, bf16x2_t); return __builtin_bit_cast(unsigned, b); }
DEVI float bf2f(unsigned h) { return __builtin_bit_cast(float, h << 16); }
DEVI float bflo(unsigned u) { return __builtin_bit_cast(float, u << 16); }
DEVI float bfhi(unsigned u) { return __builtin_bit_cast(float, u & 0xffff0000u); }
DEVI float wave_sum(float v) {
#pragma unroll
    for (int o = 32; o > 0; o >>= 1) v += __shfl_xor(v, o, 64);
    return v;
}
DEVI float sigmoidf_(float x) { return 1.f / (1.f + __expf(-x)); }

#define XB_TMO      128
#define XB_XCNT(j)  (256  + 64 * (j))
#define XB_XSUB(j)  (1280 + 64 * (j))
#define XB_XGEN(j)  (2304 + 64 * (j))
#define XB_TOP      3328
#define XB_TOPGEN   3392
#define XCD_BAR_WORDS 3456
#define XB_SPIN_CAP (1u << 18)
#define LAS __attribute__((address_space(3)))

__device__ __forceinline__ unsigned xb_ld(unsigned* p)              { return __hip_atomic_load(p, __ATOMIC_RELAXED, __HIP_MEMORY_SCOPE_AGENT); }
__device__ __forceinline__ unsigned xb_add(unsigned* p, unsigned v) { return __hip_atomic_fetch_add(p, v, __ATOMIC_RELAXED, __HIP_MEMORY_SCOPE_AGENT); }
__device__ __forceinline__ unsigned xb_xcc_id() { return (unsigned)__builtin_amdgcn_s_getreg((3 << 11) | 20) & 0xFu; }
#define XB_SPIN(cond, bar) do { unsigned _sp = 0; while (cond) { __builtin_amdgcn_s_sleep(1); \
    if ((++_sp & 255u) == 0u) { if (xb_ld(&(bar)[XB_TMO])) break; if (_sp > XB_SPIN_CAP) { atomicAdd(&(bar)[XB_TMO], 1u); break; } } } } while (0)

struct XcdBarrier {
    unsigned* bar; unsigned x;
    volatile LAS unsigned* st;
};

__device__ __forceinline__ XcdBarrier xcd_barrier_post(unsigned* bar, volatile LAS unsigned* st) {
    XcdBarrier b; b.bar = bar; b.x = xb_xcc_id(); b.st = st;
    if (threadIdx.x == 0) (void)xb_add(&bar[XB_XCNT(b.x)], 1u);
    return b;
}
__device__ __forceinline__ void xcd_barrier_complete(unsigned* bar, unsigned x, unsigned& nloc, unsigned& nx) {
    const unsigned G = gridDim.x * gridDim.y * gridDim.z;
    unsigned sum, cnt, mine, sp = 0u;
    for (;;) {
        sum = 0u; cnt = 0u; mine = 0u;
#pragma unroll
        for (unsigned j = 0; j < 16; ++j) { const unsigned c = xb_ld(&bar[XB_XCNT(j)]); sum += c; cnt += (c > 0u) ? 1u : 0u; mine = (j == x) ? c : mine; }
        if (sum == G) break;
        __builtin_amdgcn_s_sleep(1);
        if ((++sp & 255u) == 0u) { if (xb_ld(&bar[XB_TMO])) break; if (sp > XB_SPIN_CAP) { atomicAdd(&bar[XB_TMO], 1u); break; } }
    }
    nloc = mine > 0u ? mine : 1u; nx = cnt > 0u ? cnt : 1u;
}

__device__ __forceinline__ void xcd_barrier(const XcdBarrier& b) {
    asm volatile("s_waitcnt vmcnt(0)" ::: "memory");
    __syncthreads();
    if (threadIdx.x == 0) {
        unsigned* bar = b.bar;
        __builtin_amdgcn_s_waitcnt(0);
        unsigned nloc = b.st[0], nx = b.st[1];
        if (nloc == 0u) { xcd_barrier_complete(bar, b.x, nloc, nx); b.st[0] = nloc; b.st[1] = nx; }
        const unsigned old = xb_add(&bar[XB_XSUB(b.x)], 1u);
        const unsigned gen = old / nloc;
        if (old + 1u == (gen + 1u) * nloc) {
            __builtin_amdgcn_fence(__ATOMIC_RELEASE, "agent");
            asm volatile("s_waitcnt vmcnt(0)" ::: "memory");
            const unsigned og = xb_add(&bar[XB_TOP], 1u);
            const unsigned tg = og / nx;
            if (og + 1u == (tg + 1u) * nx) xb_add(&bar[XB_TOPGEN], 1u);
            else XB_SPIN(xb_ld(&bar[XB_TOPGEN]) == tg, bar);
            __builtin_amdgcn_fence(__ATOMIC_ACQUIRE, "agent");
            xb_add(&bar[XB_XGEN(b.x)], 1u);
            asm volatile("s_waitcnt vmcnt(0)" ::: "memory");
        } else {
            XB_SPIN(xb_ld(&bar[XB_XGEN(b.x)]) == gen, bar);
            __builtin_amdgcn_fence(__ATOMIC_ACQUIRE, "agent");
            asm volatile("s_waitcnt vmcnt(0)" ::: "memory");
        }
    }
    __syncthreads();
}

template <int PF, int R, class ALoad, class Epi>
DEVI void gemm_tile_f(char* smem, int nk, long ldb, const float* bp0, const float* bp1, ALoad&& aload, Epi&& epi) {
    static_assert(R > PF && (R % 2) == 0, "ring");
    const int tid = threadIdx.x, lane = tid & 63, li = lane & 15, lg = lane >> 4;
    const int sr = tid >> 2, scn = tid & 3;
    const unsigned aw0 = sr * 64 + ((scn ^ ((0 - (sr >> 2)) & 3)) << 4), aw1 = aw0 + 128 * 64;
    const unsigned ar = li * 64 + ((lg ^ ((0 - (li >> 2)) & 3)) << 4);
    float breg[R][2][8];
    f32x4 acc[16][2];
#pragma unroll
    for (int m = 0; m < 16; ++m) { acc[m][0] = f32x4{0.f, 0.f, 0.f, 0.f}; acc[m][1] = f32x4{0.f, 0.f, 0.f, 0.f}; }
    uint4 areg0 = aload(0, 0), areg1 = aload(1, 0);
#pragma unroll
    for (int s = 0; s < PF; ++s) {
        if (s < nk) {
#pragma unroll
            for (int j = 0; j < 8; ++j) { breg[s][0][j] = bp0[(long)(s * 32 + j) * ldb]; breg[s][1][j] = bp1[(long)(s * 32 + j) * ldb]; }
        }
    }
    *(uint4*)(smem + aw0) = areg0; *(uint4*)(smem + aw1) = areg1;
    __syncthreads();
    for (int kt0 = 0; kt0 < nk; kt0 += R) {
#pragma unroll
        for (int u = 0; u < R; ++u) {
            const int kt = kt0 + u;
            if (kt < nk) {
                if (kt + 1 < nk) { areg0 = aload(0, kt + 1); areg1 = aload(1, kt + 1); }
                if (kt + PF < nk) {
                    const float* q0 = bp0 + (long)(kt + PF) * 32 * ldb; const float* q1 = bp1 + (long)(kt + PF) * 32 * ldb;
#pragma unroll
                    for (int j = 0; j < 8; ++j) { breg[(u + PF) % R][0][j] = q0[(long)j * ldb]; breg[(u + PF) % R][1][j] = q1[(long)j * ldb]; }
                }
                __builtin_amdgcn_sched_barrier(0);
                uint4 b0, b1;
                b0.x = cvtpk(breg[u][0][0], breg[u][0][1]); b0.y = cvtpk(breg[u][0][2], breg[u][0][3]); b0.z = cvtpk(breg[u][0][4], breg[u][0][5]); b0.w = cvtpk(breg[u][0][6], breg[u][0][7]);
                b1.x = cvtpk(breg[u][1][0], breg[u][1][1]); b1.y = cvtpk(breg[u][1][2], breg[u][1][3]); b1.z = cvtpk(breg[u][1][4], breg[u][1][5]); b1.w = cvtpk(breg[u][1][6], breg[u][1][7]);
                const bf16x8 bf0 = __builtin_bit_cast(bf16x8, b0), bf1 = __builtin_bit_cast(bf16x8, b1);
                const char* As = smem + (u & 1) * 16384 + ar;
#pragma unroll
                for (int mb = 0; mb < 16; mb += 4) {
                    bf16x8 af[4];
#pragma unroll
                    for (int m = 0; m < 4; ++m) af[m] = *(const bf16x8*)(As + (mb + m) * 1024);
                    __builtin_amdgcn_sched_barrier(0);
#pragma unroll
                    for (int m = 0; m < 4; ++m) {
                        acc[mb + m][0] = __builtin_amdgcn_mfma_f32_16x16x32_bf16(bf0, af[m], acc[mb + m][0], 0, 0, 0);
                        acc[mb + m][1] = __builtin_amdgcn_mfma_f32_16x16x32_bf16(bf1, af[m], acc[mb + m][1], 0, 0, 0);
                    }
                    __builtin_amdgcn_sched_barrier(0);
                }
                if (kt + 1 < nk) { char* Aw = smem + ((u + 1) & 1) * 16384; *(uint4*)(Aw + aw0) = areg0; *(uint4*)(Aw + aw1) = areg1; }
                __syncthreads();
            }
        }
    }
    epi(acc);
}
template <int PF, int R, class Epi>
DEVI void gemm_tile(char* smem, int nk, long ldb, const float* bp0, const float* bp1, const bf16_t* ap0, const bf16_t* ap1, Epi&& epi) {
    gemm_tile_f<PF, R>(smem, nk, ldb, bp0, bp1, [&](int i, int kt) { return *(const uint4*)((i ? ap1 : ap0) + kt * 32); }, epi);
}

namespace pg8 {
#define PG8_LAS __attribute__((address_space(3)))
typedef unsigned short bf16_t;
typedef short bf16x8 __attribute__((ext_vector_type(8)));
typedef float f32x4 __attribute__((ext_vector_type(4)));
typedef unsigned u32x4 __attribute__((ext_vector_type(4)));
constexpr int BM = 256, BK = 64, HALF = 128, HTB = HALF * BK * 2  , STAGE_BYTES = 8 * HTB, NXCD = 8, WGM = 8;

__host__ __device__ __forceinline__ int lds_byte(int r, int c) { const int st = (r >> 4) * 2 + (c >> 5), rr = r & 15, cc = c & 31, ob = rr * 64 + cc * 2; return st * 1024 + (ob ^ (((ob >> 9) & 1) << 5)); }
__host__ __device__ __forceinline__ void stage_rc(int b, int& R, int& C) { const int st = b / 1024, sb = b % 1024, swz = sb ^ (((sb >> 9) & 1) << 5); R = (st >> 1) * 16 + swz / 64; C = (st & 1) * 32 + (swz % 64) / 2; }
__host__ __device__ __forceinline__ int perm32(int rho) { const int n = rho >> 4, i = rho & 15; return 8 * (i >> 2) + 4 * n + (i & 3); }

struct Unit { int pm, pn; };
struct Gemm { const bf16_t* A; const bf16_t* Bt; int M, N, K; };

struct StaticOrder {
    int nM, nN, nwg, G, c;
    __host__ __device__ void init(int M, int N, int G_, int c_) { nM = M / BM; nN = N / BM; nwg = nM * nN; G = G_; c = c_; }
    __host__ __device__ bool next(int i, Unit& u) const {
        const long L = (long)i * G + c; if (L >= nwg) return false;
        int wgid = (int)L; { const int q = nwg / NXCD, r = nwg % NXCD, xcd = wgid % NXCD, off = wgid / NXCD; wgid = (xcd < r ? xcd * (q + 1) : r * (q + 1) + (xcd - r) * q) + off; }
        const int nig = WGM * nN, gid = wgid / nig, fm = gid * WGM, gsz = (nM - fm) < WGM ? (nM - fm) : WGM;
        u.pm = fm + ((wgid % nig) % gsz); u.pn = (wgid % nig) / gsz; return true;
    }
    __device__ __forceinline__ void a_ready(const Unit&) const {}
    __device__ __forceinline__ void done(const Unit&) const {}
};


__device__ __forceinline__ unsigned cvt_pk_bf16(float lo, float hi) { unsigned r; asm volatile("v_cvt_pk_bf16_f32 %0, %1, %2" : "=v"(r) : "v"(lo), "v"(hi)); return r; }
struct EpiZ {
    static constexpr bool PERM = true, AFTER_DRAIN = false;
    bf16_t* O; int ldc; int ncols;
    __device__ __forceinline__ void operator()(const f32x4 (&acc)[2][2][4][2], const Unit& u, int wr, int wc, int fr, int fq) const {
        const int row0 = u.pm * BM + wr * 64 + fr, col0 = u.pn * BM + wc * 32 + 8 * fq;
#pragma unroll
        for (int ai = 0; ai < 2; ++ai)
#pragma unroll
            for (int m = 0; m < 4; ++m) { bf16_t* rowp = O + (size_t)(row0 + ai * HALF + m * 16) * ldc;
#pragma unroll
                for (int bj = 0; bj < 2; ++bj) { const int col = col0 + bj * HALF;
                    if (col < ncols) { const f32x4 v0 = acc[ai][bj][m][0], v1 = acc[ai][bj][m][1];
                        u32x4 w; w.x = cvt_pk_bf16(v0[0], v0[1]); w.y = cvt_pk_bf16(v0[2], v0[3]); w.z = cvt_pk_bf16(v1[0], v1[1]); w.w = cvt_pk_bf16(v1[2], v1[3]);
                        *(u32x4*)(rowp + col) = w; } } }
    }
};
struct EpiX1 {
    static constexpr bool PERM = true, AFTER_DRAIN = false;
    float* O; const float* res; const float* gate; int ldc; int gate_stride; int rows_per_batch;
    __device__ __forceinline__ void operator()(const f32x4 (&acc)[2][2][4][2], const Unit& u, int wr, int wc, int fr, int fq) const {
        const int row0 = u.pm * BM + wr * 64 + fr, col0 = u.pn * BM + wc * 32 + 8 * fq;
        const float* gp = gate + (size_t)((u.pm * BM) / rows_per_batch) * gate_stride;
#pragma unroll
        for (int bj = 0; bj < 2; ++bj) { const int col = col0 + bj * HALF;
            const f32x4 g0 = *(const f32x4*)(gp + col), g1 = *(const f32x4*)(gp + col + 4);
#pragma unroll
            for (int ai = 0; ai < 2; ++ai)
#pragma unroll
                for (int m = 0; m < 4; ++m) { const size_t o = (size_t)(row0 + ai * HALF + m * 16) * ldc + col;
                    const f32x4 x0 = *(const f32x4*)(res + o), x1 = *(const f32x4*)(res + o + 4);
                    *(f32x4*)(O + o) = x0 + g0 * acc[ai][bj][m][0]; *(f32x4*)(O + o + 4) = x1 + g1 * acc[ai][bj][m][1]; } }
    }
};
template <class Epi, class Sched, bool ALIGN_EPI = false, bool SP2 = false>
__device__ __forceinline__ void gemm_phase(PG8_LAS unsigned char* lds, const Gemm g, const Sched& S, const Epi& E) {
    const int tid = threadIdx.x, wid = __builtin_amdgcn_readfirstlane(tid >> 6), lane = tid & 63, wr = wid >> 2, wc = wid & 3, fr = lane & 15, fq = lane >> 4;
    const int K = g.K, nt = K / BK;
    unsigned voffA[2], voffB[2];
#pragma unroll
    for (int i = 0; i < 2; ++i) { int R, C; stage_rc(tid * 16 + i * 8192, R, C); const int Rb = Epi::PERM ? ((R & ~31) + perm32(R & 31)) : R;
        voffA[i] = (unsigned)(R * K + C) * 2u; voffB[i] = (unsigned)(Rb * K + C) * 2u; }
    const size_t kstep = (size_t)(BK * 2);
    const size_t hstep = (size_t)HALF * K * 2;
    const size_t tstep = 2 * hstep;
    const unsigned ldsw = (unsigned)wid * 1024u;
    const int aoff = lds_byte(wr * 64 + fr, fq * 8), boff = lds_byte(wc * 32 + fr, fq * 8);
#define PG8_SA(b, h) (((b) * 2 + (h)) * HTB)
#define PG8_SB(b, h) ((4 + (b) * 2 + (h)) * HTB)
#define PG8_STAGE(bufoff, gbase, voff) do { _Pragma("unroll") for (int _i = 0; _i < 2; ++_i) \
        __builtin_amdgcn_global_load_lds((const unsigned*)((const char*)(gbase) + (voff)[_i]), (PG8_LAS unsigned*)(lds + (bufoff) + ldsw + _i * 8192), 16, 0, 0); } while (0)
#define PG8_LDA(dst, b, h) do { _Pragma("unroll") for (int m = 0; m < 4; ++m) _Pragma("unroll") for (int k = 0; k < 2; ++k) dst[m][k] = *(const PG8_LAS bf16x8*)(lds + PG8_SA(b, h) + aoff + m * 2048 + k * 1024); } while (0)
#define PG8_LDB(dst, b, h) do { _Pragma("unroll") for (int n = 0; n < 2; ++n) _Pragma("unroll") for (int k = 0; k < 2; ++k) dst[n][k] = *(const PG8_LAS bf16x8*)(lds + PG8_SB(b, h) + boff + n * 2048 + k * 1024); } while (0)
#define PG8_MMA(ai, bj, At, Bt) do { __builtin_amdgcn_s_setprio(1); _Pragma("unroll") for (int m = 0; m < 4; ++m) _Pragma("unroll") for (int n = 0; n < 2; ++n) _Pragma("unroll") for (int k = 0; k < 2; ++k) \
        acc[ai][bj][m][n] = __builtin_amdgcn_mfma_f32_16x16x32_bf16(Bt[n][k], At[m][k], acc[ai][bj][m][n], 0, 0, 0); __builtin_amdgcn_s_setprio(0); } while (0)
#define PG8_WAIT_V(n) asm volatile("s_waitcnt vmcnt(" #n ")" ::: "memory")
#define PG8_WAIT_L(n) asm volatile("s_waitcnt lgkmcnt(" #n ")" ::: "memory")
#define PG8_BAR __builtin_amdgcn_s_barrier()
#define PG8_SCHED __builtin_amdgcn_sched_barrier(0)
    Unit cur, nxt; int ui = 0;
    if (!S.next(0, cur)) return;
    f32x4 acc[2][2][4][2];
#pragma unroll
    for (int a = 0; a < 2; ++a)
#pragma unroll
        for (int b = 0; b < 2; ++b)
#pragma unroll
            for (int m = 0; m < 4; ++m)
#pragma unroll
                for (int n = 0; n < 2; ++n) acc[a][b][m][n] = (f32x4){0.f, 0.f, 0.f, 0.f};
    bf16x8 At[4][2], B0[2][2], B1[2][2];
    const char* cA = (const char*)g.A + (size_t)cur.pm * tstep; const char* cB = (const char*)g.Bt + (size_t)cur.pn * tstep;
    S.a_ready(cur);
    if constexpr (SP2) {
        PG8_STAGE(PG8_SB(0, 0), cB, voffB); PG8_STAGE(PG8_SB(0, 1), cB + hstep, voffB); PG8_STAGE(PG8_SA(0, 0), cA, voffA); PG8_STAGE(PG8_SA(0, 1), cA + hstep, voffA);
        if (wr == 1) PG8_BAR;
        PG8_WAIT_V(2); PG8_BAR;
        PG8_STAGE(PG8_SB(1, 0), cB + kstep, voffB); PG8_STAGE(PG8_SA(1, 0), cA + kstep, voffA); PG8_STAGE(PG8_SB(1, 1), cB + hstep + kstep, voffB);
        PG8_WAIT_V(6); PG8_BAR;
    } else {
        PG8_STAGE(PG8_SB(0, 0), cB, voffB); PG8_STAGE(PG8_SA(0, 0), cA, voffA); PG8_STAGE(PG8_SB(0, 1), cB + hstep, voffB); PG8_STAGE(PG8_SA(0, 1), cA + hstep, voffA);
        if (wr == 1) PG8_BAR;
        PG8_WAIT_V(4); PG8_BAR;
        PG8_STAGE(PG8_SB(1, 0), cB + kstep, voffB); PG8_STAGE(PG8_SA(1, 0), cA + kstep, voffA); PG8_STAGE(PG8_SB(1, 1), cB + hstep + kstep, voffB);
        PG8_WAIT_V(6); PG8_BAR;
    }
    for (;;) {
        const bool has_next = S.next(ui + 1, nxt);
        const char* nA = has_next ? (const char*)g.A + (size_t)nxt.pm * tstep : cA; const char* nB = has_next ? (const char*)g.Bt + (size_t)nxt.pn * tstep : cB;
        for (int t = 0; t < nt; t += 2) {
            const bool last = (t == nt - 2);
            const char* a1 = cA + (size_t)(t + 1) * kstep;
            const char* a2 = last ? nA : cA + (size_t)(t + 2) * kstep; const char* b2 = last ? nB : cB + (size_t)(t + 2) * kstep;
            const char* a3 = a2 + kstep; const char* b3 = b2 + kstep;
            if (last && has_next) S.a_ready(nxt);
            if constexpr (SP2) {
            PG8_LDB(B0, 0, 0); PG8_LDB(B1, 0, 1); PG8_SCHED; PG8_LDA(At, 0, 0); PG8_STAGE(PG8_SA(1, 1), a1 + hstep, voffA);
            PG8_WAIT_V(8); PG8_WAIT_L(0); PG8_BAR; PG8_MMA(0, 0, At, B0); PG8_MMA(0, 1, At, B1); PG8_BAR; PG8_SCHED;
            PG8_LDA(At, 0, 1); PG8_STAGE(PG8_SB(0, 0), b2, voffB); PG8_STAGE(PG8_SB(0, 1), b2 + hstep, voffB); PG8_STAGE(PG8_SA(0, 0), a2, voffA);
            PG8_WAIT_V(8); PG8_WAIT_L(0); PG8_BAR; PG8_MMA(1, 0, At, B0); PG8_MMA(1, 1, At, B1); PG8_BAR; PG8_SCHED;
            PG8_LDB(B0, 1, 0); PG8_LDB(B1, 1, 1); PG8_SCHED; PG8_LDA(At, 1, 0); PG8_STAGE(PG8_SA(0, 1), a2 + hstep, voffA);
            PG8_WAIT_V(8); PG8_WAIT_L(0); PG8_BAR; PG8_MMA(0, 0, At, B0); PG8_MMA(0, 1, At, B1); PG8_BAR; PG8_SCHED;
            PG8_LDA(At, 1, 1); PG8_STAGE(PG8_SB(1, 0), b3, voffB); PG8_STAGE(PG8_SB(1, 1), b3 + hstep, voffB); PG8_STAGE(PG8_SA(1, 0), a3, voffA);
            PG8_WAIT_V(8); PG8_WAIT_L(0); PG8_BAR; PG8_MMA(1, 0, At, B0); PG8_MMA(1, 1, At, B1); PG8_BAR; PG8_SCHED;
            } else {
            PG8_LDB(B0, 0, 0); PG8_SCHED; PG8_LDA(At, 0, 0); PG8_STAGE(PG8_SA(1, 1), a1 + hstep, voffA);
            PG8_WAIT_L(8); PG8_BAR; PG8_WAIT_L(0); PG8_MMA(0, 0, At, B0); PG8_BAR; PG8_SCHED;
            PG8_LDB(B1, 0, 1); PG8_STAGE(PG8_SB(0, 0), b2, voffB);
            PG8_BAR; PG8_WAIT_L(0); PG8_MMA(0, 1, At, B1); PG8_BAR;
            PG8_LDA(At, 0, 1); PG8_STAGE(PG8_SA(0, 0), a2, voffA);
            PG8_BAR; PG8_WAIT_L(0); PG8_MMA(1, 0, At, B0); PG8_BAR; PG8_SCHED;
            PG8_STAGE(PG8_SB(0, 1), b2 + hstep, voffB);
            PG8_WAIT_V(6); PG8_BAR; PG8_MMA(1, 1, At, B1); PG8_BAR;
            PG8_LDB(B0, 1, 0); PG8_SCHED; PG8_LDA(At, 1, 0); PG8_STAGE(PG8_SA(0, 1), a2 + hstep, voffA);
            PG8_WAIT_L(8); PG8_BAR; PG8_WAIT_L(0); PG8_MMA(0, 0, At, B0); PG8_BAR; PG8_SCHED;
            PG8_LDB(B1, 1, 1); PG8_STAGE(PG8_SB(1, 0), b3, voffB);
            PG8_BAR; PG8_WAIT_L(0); PG8_MMA(0, 1, At, B1); PG8_BAR;
            PG8_LDA(At, 1, 1); PG8_STAGE(PG8_SA(1, 0), a3, voffA);
            PG8_BAR; PG8_WAIT_L(0); PG8_MMA(1, 0, At, B0); PG8_BAR; PG8_SCHED;
            PG8_STAGE(PG8_SB(1, 1), b3 + hstep, voffB);
            PG8_WAIT_V(6); PG8_BAR; PG8_MMA(1, 1, At, B1); PG8_BAR;
            }
        }
        if constexpr (ALIGN_EPI) { if (wr == 0) PG8_BAR; }
        if constexpr (!Epi::AFTER_DRAIN) { E(acc, cur, wr, wc, fr, fq); S.done(cur); }
        if (!has_next) break;
#pragma unroll
        for (int a = 0; a < 2; ++a)
#pragma unroll
            for (int b = 0; b < 2; ++b)
#pragma unroll
                for (int m = 0; m < 4; ++m)
#pragma unroll
                    for (int n = 0; n < 2; ++n) acc[a][b][m][n] = (f32x4){0.f, 0.f, 0.f, 0.f};
        cur = nxt; cA = nA; cB = nB; ++ui;
        if constexpr (ALIGN_EPI) { if (wr == 1) PG8_BAR; }
    }
    PG8_WAIT_V(0);
    if constexpr (!ALIGN_EPI) { if (wr == 0) PG8_BAR; }
    PG8_BAR;
    if constexpr (Epi::AFTER_DRAIN) { E.fused(acc, cur, wr, wc, fr, fq, lds, wid, lane); S.done(cur); }
#undef PG8_SA
#undef PG8_SB
#undef PG8_STAGE
#undef PG8_LDA
#undef PG8_LDB
#undef PG8_MMA
#undef PG8_WAIT_V
#undef PG8_WAIT_L
#undef PG8_BAR
#undef PG8_SCHED
}
}

DEVI void ada_unit(const Params& p, char* smem, int cb, int ks) {
    float* sl = (float*)smem;
    float* part = (float*)(p.ws + WS_PART);
    const int tid = threadIdx.x;
    __syncthreads();
    if (tid < 256) { const int b = tid >> 7, kk = tid & 127; const float cv = p.c[b * DM + ks * 128 + kk]; sl[b * 128 + kk] = cv / (1.f + expf(-cv)); }
    __syncthreads();
    const int j = cb * 512 + tid;
    const float* w = p.w_ada + (size_t)(ks * 128) * 12288 + j;
    float a0 = 0.f, a1 = 0.f;
#pragma unroll 16
    for (int kk = 0; kk < 128; ++kk) { const float wv = w[(size_t)kk * 12288]; a0 += sl[kk] * wv; a1 += sl[128 + kk] * wv; }
    part[(ks * 2 + 0) * 12288 + j] = a0; part[(ks * 2 + 1) * 12288 + j] = a1;
}
DEVI void transpose_item(const float* W, int N, bf16_t* WT, int r, char* smem) {
    const int lane = threadIdx.x & 63, wave = threadIdx.x >> 6;
    float* scr = (float*)(smem + 4096) + wave * (64 * 33);
    const int nblk = N / 32, kb = r / nblk, nb = r % nblk, k0 = 64 * kb, n0 = 32 * nb;
    {
        float4 t[8];
#pragma unroll
        for (int i = 0; i < 8; ++i) t[i] = *(const float4*)(W + (size_t)(k0 + (lane >> 3) + 8 * i) * N + n0 + 4 * (lane & 7));
#pragma unroll
        for (int i = 0; i < 8; ++i) { float* d = scr + ((lane >> 3) + 8 * i) * 33 + 4 * (lane & 7); d[0] = t[i].x; d[1] = t[i].y; d[2] = t[i].z; d[3] = t[i].w; }
    }
    const int c = lane & 7;
#pragma unroll
    for (int j = 0; j < 4; ++j) { const int n = (lane >> 3) + 8 * j; const float* sp = scr + (8 * c) * 33 + n;
        uint4 o; o.x = cvtpk(sp[0 * 33], sp[1 * 33]); o.y = cvtpk(sp[2 * 33], sp[3 * 33]); o.z = cvtpk(sp[4 * 33], sp[5 * 33]); o.w = cvtpk(sp[6 * 33], sp[7 * 33]);
        *(uint4*)(WT + (size_t)(n0 + n) * DM + k0 + 8 * c) = o; }
}
DEVI void phase0(const Params& p, char* smem) {
    float* rope = (float*)(p.ws + WS_ROPE);
    const int tid = threadIdx.x, lane = tid & 63, wave = tid >> 6;
    constexpr int N_ADA = 8 * NKS, N_ROPE = 256;
    for (int u = blockIdx.x; u < N_ADA + N_ROPE; u += gridDim.x) {
        if (u < N_ADA) {
            ada_unit(p, smem, u & 7, u >> 3);
        } else {
            const int idx = (u - N_ADA) * 512 + tid;
            const int t = idx >> 5, i = idx & 31;
            const double invf = exp(-(double)(2 * i) / 64.0 * 9.210340371976184);
            const double ang = (double)t * invf;
            rope[idx] = (float)cos(ang); rope[SEQ * 32 + idx] = (float)sin(ang);
        }
    }
    __syncthreads();
    {
        bf16_t* wti = (bf16_t*)(p.ws + WS_WTI);
        constexpr int I_IN = 32 * (INC / 32), I_Z = (4864 - INC) * DM / 8 / 64;
        for (int it = blockIdx.x * 8 + wave; it < I_IN + I_Z; it += gridDim.x * 8) {
            if (it >= I_IN) { const size_t o = (size_t)INC * DM + ((size_t)(it - I_IN) * 64 + lane) * 8; *(uint4*)(wti + o) = make_uint4(0u, 0u, 0u, 0u); continue; }
            transpose_item(p.w_in, INC, wti, it, smem);
        }
    }
}

DEVI float mod_from_part(const Params& p, int b, int j) {
    const float* part = (const float*)(p.ws + WS_PART);
    float s = p.b_ada[j];
#pragma unroll
    for (int ks = 0; ks < NKS; ++ks) s += part[(ks * 2 + b) * 12288 + j];
    return s;
}

constexpr int N_MODF = 48, N_WRF = 128, N_CB = 2, N_AS2 = 8, N_SPEC = N_WRF + N_CB + N_AS2 + N_MODF;
DEVI void spec_unit(const Params& p, char* smem, int v) {
    float* A1 = (float*)smem;
    const int tid = threadIdx.x, lane = tid & 63, wave = tid >> 6;
    if (v >= N_CB + N_WRF + N_AS2) {
        const int idx = (v - (N_CB + N_WRF + N_AS2)) * 512 + tid; const int b = idx / 12288, j = idx % 12288;
        ((float*)(p.ws + WS_MODF))[idx] = mod_from_part(p, b, j);
    } else {
            if (v < N_CB) {
                const int b = v;
                float* sh2 = A1 + 4 * DM;
                float* red = sh2 + DM;
                __syncthreads();
                for (int k = tid; k < DM; k += 512) sh2[k] = mod_from_part(p, b, 3 * DM + k);
                __syncthreads();
                float ae = 0.f, ag = 0.f;
#pragma unroll 16
                for (int kk = 0; kk < 256; ++kk) { const int k = wave * 256 + kk; const float sv = sh2[k]; ae += sv * p.w_re[k * 64 + lane]; ag += sv * p.w_rg[k * 8 + (lane & 7)]; }
                red[wave * 80 + lane] = ae; if (lane < 8) red[wave * 80 + 64 + lane] = ag;
                __syncthreads();
                if (tid < 80) {
                    float r = 0.f;
                    if (tid < 72) {
#pragma unroll
                        for (int w = 0; w < 8; ++w) r += red[w * 80 + tid];
                        r += (tid < 64 ? p.b_re[tid] : p.b_rg[tid - 64]);
                    }
                    ((float*)(p.ws + WS_CB))[b * 80 + tid] = r;
                }
            } else if (v < N_CB + N_WRF) {
                const int vv = v - N_CB, b = vv >> 6, ks = vv & 63, ln = tid & 63, e = tid >> 6;
                const int k = ks * 32 + 8 * (ln >> 4) + e;
                const float a2 = p.norm2_g[k] * (1.f + mod_from_part(p, b, 4 * DM + k));
                bf16_t* wrf = (bf16_t*)(p.ws + WS_WRF);
#pragma unroll
                for (int nf = 0; nf < 5; ++nf) {
                    const int j = nf * 16 + (ln & 15);
                    const float wv = j < 64 ? p.w_re[k * 64 + j] : (j < 72 ? p.w_rg[k * 8 + (j - 64)] : 0.f);
                    const float val = a2 * wv;
                    const unsigned hi = cvtpk(val, 0.f) & 0xffffu;
                    const unsigned lo = cvtpk(val - bf2f(hi), 0.f) & 0xffffu;
                    const size_t base = ((((size_t)(b * 64 + ks) * 5 + nf) * 2) * 64 + ln) * 8 + e;
                    wrf[base] = (bf16_t)hi; wrf[base + 512] = (bf16_t)lo;
                }
            } else {
                const int idx = (v - N_WRF - N_CB) * 512 + tid, b = idx >> 11, k = idx & 2047;
                float* as2 = (float*)(p.ws + WS_AS2);
                as2[idx] = p.norm2_g[k] * (1.f + mod_from_part(p, b, 4 * DM + k));
                as2[2 * DM + idx] = mod_from_part(p, b, 3 * DM + k);
            }
    }
}

DEVI void phase1(const Params& p, char* smem) {
    float* A1 = (float*)smem;
    float* S1 = A1 + 2 * DM;
    float* modf = (float*)(p.ws + WS_MODF);
    bf16_t* h = (bf16_t*)(p.ws + WS_H);
    const int tid = threadIdx.x, lane = tid & 63, wave = tid >> 6;
    constexpr int N_ROWS = NTOK / 8;
    const int upw = (N_ROWS + (int)gridDim.x - 1) / (int)gridDim.x, u_lo = (int)blockIdx.x * upw, u_hi = (u_lo + upw < N_ROWS) ? u_lo + upw : N_ROWS;
    const int b_lo = (u_lo * 8) >> 12, b_hi = u_hi > u_lo ? ((u_hi * 8 - 1) >> 12) : b_lo;
    for (int idx = tid; idx < 2 * DM; idx += 512) {
        const int b = idx >> 11, k = idx & 2047;
        if (b >= b_lo && b <= b_hi) {
            const float sh = mod_from_part(p, b, k), sc = mod_from_part(p, b, DM + k);
            A1[idx] = p.norm1_g[k] * (1.f + sc); S1[idx] = sh;
        }
    }
    __syncthreads();
    for (int u = u_lo; u < u_hi; ++u) {
        {
            const int row = u * 8 + wave, b = row >> 12;
            const float* xr = p.x + (size_t)row * DM;
            float4 v[8]; float ss = 0.f;
#pragma unroll
            for (int i = 0; i < 8; ++i) { v[i] = *(const float4*)(xr + i * 256 + lane * 4); ss += v[i].x * v[i].x + v[i].y * v[i].y + v[i].z * v[i].z + v[i].w * v[i].w; }
            ss = wave_sum(ss);
            const float rstd = rsqrtf(ss * (1.f / DM) + 1e-6f);
#pragma unroll
            for (int i = 0; i < 8; ++i) {
                const int k = i * 256 + lane * 4;
                const float4 a = *(const float4*)(A1 + b * DM + k), s = *(const float4*)(S1 + b * DM + k);
                uint2 o; o.x = cvtpk(v[i].x * rstd * a.x + s.x, v[i].y * rstd * a.y + s.y); o.y = cvtpk(v[i].z * rstd * a.z + s.z, v[i].w * rstd * a.w + s.w);
                *(uint2*)(h + (size_t)row * DM + k) = o;
            }
        }
    }
}

DEVI void phase2(const Params& p, char* smem) {
    pg8::Gemm g{(const pg8::bf16_t*)(p.ws + WS_H), (const pg8::bf16_t*)(p.ws + WS_WTI), NTOK, 4864, DM};
    pg8::StaticOrder S; S.init(NTOK, 4864, (int)gridDim.x, (int)blockIdx.x);
    pg8::EpiZ E{(pg8::bf16_t*)(p.ws + WS_Z), INC, INC};
    pg8::gemm_phase<pg8::EpiZ, pg8::StaticOrder, true, true>((PG8_LAS unsigned char*)smem, g, S, E);
    const int nthird = 608 - 2 * (int)gridDim.x;
    if (gridDim.x == 256 ? (int)blockIdx.x >= nthird : true) {
        const int nw = gridDim.x == 256 ? 256 - nthird : (int)gridDim.x, wi = gridDim.x == 256 ? (int)blockIdx.x - nthird : (int)blockIdx.x;
        __syncthreads();
        for (int u = wi; u < 512; u += nw) {
            if (u < 256) ada_unit(p, smem, 8 + (u & 15), u >> 4);
            else { __syncthreads(); transpose_item(p.w_o, DM, (bf16_t*)(p.ws + WS_WTO), (u - 256) * 8 + (int)(threadIdx.x >> 6), smem); }
        }
    }
}

DEVI float dpp_xor1(float x) { return __builtin_bit_cast(float, __builtin_amdgcn_update_dpp(0, __builtin_bit_cast(int, x), 0xB1, 0xF, 0xF, true)); }
DEVI float dpp_xor2(float x) { return __builtin_bit_cast(float, __builtin_amdgcn_update_dpp(0, __builtin_bit_cast(int, x), 0x4E, 0xF, 0xF, true)); }
DEVI float xor32_sum(float x) {
    float a = x, b = x;
    asm volatile("s_nop 1\n\tv_permlane32_swap_b32 %0, %1\n\ts_nop 1" : "+v"(a), "+v"(b));
    return a + b;
}
DEVI unsigned m64_off(int row, int chunk) { return row * 128 + ((chunk ^ ((row >> 1) & 7)) << 4); }
DEVI void mm_tile(f32x16& acc, const char* X, int xr0, const char* Y, int yr0, int l31, int hh) {
#pragma unroll
    for (int s4 = 0; s4 < 4; ++s4) {
        const bf16x8 a = *(const bf16x8*)(X + m64_off(xr0 + l31, 2 * s4 + hh));
        const bf16x8 b = *(const bf16x8*)(Y + m64_off(yr0 + l31, 2 * s4 + hh));
        acc = __builtin_amdgcn_mfma_f32_32x32x16_bf16(a, b, acc, 0, 0, 0);
    }
}
DEVI f32x16 zero16() { f32x16 z;
#pragma unroll
    for (int i = 0; i < 16; ++i) z[i] = 0.f;
    return z; }


DEVI float tokshift(const bf16_t* z, const float* mu, int tok, int c) {
    const float zc = bf2f(z[(size_t)tok * INC + ZC_RW + c]);
    const float zp = (tok & (SEQ - 1)) ? bf2f(z[(size_t)(tok - 1) * INC + ZC_RW + c]) : 0.f;
    return zc + (zp - zc) * mu[c];
}

DEVI void p3_unit(const Params& p, char* smem, int u) {
    const bf16_t* z = (const bf16_t*)(p.ws + WS_Z);
    bf16_t* mix = (bf16_t*)(p.ws + WS_MIX);
    const float* rope = (const float*)(p.ws + WS_ROPE);
    const int tid = threadIdx.x, lane = tid & 63, wave = tid >> 6;
    constexpr int N_ATT = 256;
    {
        __syncthreads();
        if (u < N_ATT) {
            constexpr int VTS = 392;
            char* Ks = smem;
            char* Vt = smem + 192 * 128;
            const int b = u >> 7, kvh = (u >> 6) & 1, qb = u & 63, t0 = qb * 64, kbase = t0 - 128;
            for (int idx = tid; idx < 192 * 4; idx += 512) {
                const int j = idx >> 2, c = idx & 3, t = kbase + j;
                uint4 o1 = make_uint4(0u, 0u, 0u, 0u), o2 = o1;
                if (t >= 0) {
                    const bf16_t* zr = z + (size_t)(b * SEQ + t) * INC + ZC_K + kvh * 64 + 8 * c;
                    const uint4 ka = *(const uint4*)zr, kb = *(const uint4*)(zr + 32);
                    const float4 c0 = *(const float4*)(rope + t * 32 + 8 * c), c1 = *(const float4*)(rope + t * 32 + 8 * c + 4);
                    const float4 s0 = *(const float4*)(rope + SEQ * 32 + t * 32 + 8 * c), s1 = *(const float4*)(rope + SEQ * 32 + t * 32 + 8 * c + 4);
                    const float a[8] = {bflo(ka.x), bfhi(ka.x), bflo(ka.y), bfhi(ka.y), bflo(ka.z), bfhi(ka.z), bflo(ka.w), bfhi(ka.w)};
                    const float bq[8] = {bflo(kb.x), bfhi(kb.x), bflo(kb.y), bfhi(kb.y), bflo(kb.z), bfhi(kb.z), bflo(kb.w), bfhi(kb.w)};
                    const float cs[8] = {c0.x, c0.y, c0.z, c0.w, c1.x, c1.y, c1.z, c1.w}, sn[8] = {s0.x, s0.y, s0.z, s0.w, s1.x, s1.y, s1.z, s1.w};
                    float r1[8], r2[8];
#pragma unroll
                    for (int e = 0; e < 8; ++e) { r1[e] = a[e] * cs[e] - bq[e] * sn[e]; r2[e] = bq[e] * cs[e] + a[e] * sn[e]; }
                    o1 = make_uint4(cvtpk(r1[0], r1[1]), cvtpk(r1[2], r1[3]), cvtpk(r1[4], r1[5]), cvtpk(r1[6], r1[7]));
                    o2 = make_uint4(cvtpk(r2[0], r2[1]), cvtpk(r2[2], r2[3]), cvtpk(r2[4], r2[5]), cvtpk(r2[6], r2[7]));
                }
                *(uint4*)(Ks + m64_off(j, c)) = o1; *(uint4*)(Ks + m64_off(j, c + 4)) = o2;
            }
            for (int idx = tid; idx < 192 * 8; idx += 512) {
                const int j = idx >> 3, c = idx & 7, t = kbase + j;
                uint4 vv = make_uint4(0u, 0u, 0u, 0u);
                if (t >= 0) vv = *(const uint4*)(z + (size_t)(b * SEQ + t) * INC + ZC_V + kvh * 64 + 8 * c);
                char* vp = Vt + (8 * c) * VTS + j * 2;
                *(bf16_t*)(vp + 0 * VTS) = (bf16_t)(vv.x & 0xffffu); *(bf16_t*)(vp + 1 * VTS) = (bf16_t)(vv.x >> 16);
                *(bf16_t*)(vp + 2 * VTS) = (bf16_t)(vv.y & 0xffffu); *(bf16_t*)(vp + 3 * VTS) = (bf16_t)(vv.y >> 16);
                *(bf16_t*)(vp + 4 * VTS) = (bf16_t)(vv.z & 0xffffu); *(bf16_t*)(vp + 5 * VTS) = (bf16_t)(vv.z >> 16);
                *(bf16_t*)(vp + 6 * VTS) = (bf16_t)(vv.w & 0xffffu); *(bf16_t*)(vp + 7 * VTS) = (bf16_t)(vv.w >> 16);
            }
            __syncthreads();
            const int h = kvh * 8 + wave, l31 = lane & 31, hh = lane >> 5;
            const float sink = p.sinks[h];
#pragma unroll 1
            for (int qt = 0; qt < 2; ++qt) {
                const int T0 = t0 + qt * 32, tq = T0 + l31;
                bf16x8 qf[4];
                {
                    const bf16_t* zr = z + (size_t)(b * SEQ + tq) * INC + h * 64 + 8 * hh;
                    uint4 raw[4];
#pragma unroll
                    for (int s4 = 0; s4 < 4; ++s4) raw[s4] = *(const uint4*)(zr + 16 * s4);
#pragma unroll
                    for (int s2 = 0; s2 < 2; ++s2) {
                        const int d0 = 16 * s2 + 8 * hh;
                        const float4 c0 = *(const float4*)(rope + tq * 32 + d0), c1 = *(const float4*)(rope + tq * 32 + d0 + 4);
                        const float4 s0 = *(const float4*)(rope + SEQ * 32 + tq * 32 + d0), s1 = *(const float4*)(rope + SEQ * 32 + tq * 32 + d0 + 4);
                        const uint4 ua = raw[s2], ub = raw[s2 + 2];
                        const float a[8] = {bflo(ua.x), bfhi(ua.x), bflo(ua.y), bfhi(ua.y), bflo(ua.z), bfhi(ua.z), bflo(ua.w), bfhi(ua.w)};
                        const float bq[8] = {bflo(ub.x), bfhi(ub.x), bflo(ub.y), bfhi(ub.y), bflo(ub.z), bfhi(ub.z), bflo(ub.w), bfhi(ub.w)};
                        const float cs[8] = {c0.x, c0.y, c0.z, c0.w, c1.x, c1.y, c1.z, c1.w}, sn[8] = {s0.x, s0.y, s0.z, s0.w, s1.x, s1.y, s1.z, s1.w};
                        float r1[8], r2[8];
#pragma unroll
                        for (int e = 0; e < 8; ++e) { r1[e] = (a[e] * cs[e] - bq[e] * sn[e]) * 0.125f; r2[e] = (bq[e] * cs[e] + a[e] * sn[e]) * 0.125f; }
                        qf[s2] = __builtin_bit_cast(bf16x8, make_uint4(cvtpk(r1[0], r1[1]), cvtpk(r1[2], r1[3]), cvtpk(r1[4], r1[5]), cvtpk(r1[6], r1[7])));
                        qf[s2 + 2] = __builtin_bit_cast(bf16x8, make_uint4(cvtpk(r2[0], r2[1]), cvtpk(r2[2], r2[3]), cvtpk(r2[4], r2[5]), cvtpk(r2[6], r2[7])));
                    }
                }
                f32x16 sc[5];
#pragma unroll
                for (int kt = 0; kt < 5; ++kt) {
                    sc[kt] = zero16();
                    const int krow = 32 * qt + 32 * kt + l31;
#pragma unroll
                    for (int s4 = 0; s4 < 4; ++s4) {
                        const bf16x8 kf = *(const bf16x8*)(Ks + m64_off(krow, 2 * s4 + hh));
                        sc[kt] = __builtin_amdgcn_mfma_f32_32x32x16_bf16(kf, qf[s4], sc[kt], 0, 0, 0);
                    }
                }
                float mx = -1e30f;
#pragma unroll
                for (int kt = 0; kt < 5; ++kt)
#pragma unroll
                    for (int i = 0; i < 16; ++i) {
                        const int r = (i & 3) + 8 * (i >> 2) + 4 * hh;
                        bool ok = (T0 - 128 + 32 * kt + r) >= 0;
                        if (kt == 0) ok = ok && (r > l31);
                        if (kt == 4) ok = ok && (r <= l31);
                        sc[kt][i] = ok ? sc[kt][i] : -1e30f;
                        mx = fmaxf(mx, sc[kt][i]);
                    }
                {
                    float a = mx, bq = mx;
                    asm volatile("s_nop 1\n\tv_permlane32_swap_b32 %0, %1\n\ts_nop 1" : "+v"(a), "+v"(bq));
                    mx = fmaxf(fmaxf(a, bq), sink);
                }
                float lsum = 0.f;
#pragma unroll
                for (int kt = 0; kt < 5; ++kt)
#pragma unroll
                    for (int i = 0; i < 16; ++i) { const float pe = __expf(sc[kt][i] - mx); sc[kt][i] = pe; lsum += pe; }
                lsum = xor32_sum(lsum) + __expf(sink - mx);
                const float inv = 1.f / lsum;
                f32x16 oacc[2];
                oacc[0] = zero16(); oacc[1] = zero16();
#pragma unroll
                for (int kt = 0; kt < 5; ++kt)
#pragma unroll
                    for (int s2 = 0; s2 < 2; ++s2) {
                        uint4 pb;
                        pb.x = cvtpk(sc[kt][8 * s2 + 0], sc[kt][8 * s2 + 1]); pb.y = cvtpk(sc[kt][8 * s2 + 2], sc[kt][8 * s2 + 3]);
                        pb.z = cvtpk(sc[kt][8 * s2 + 4], sc[kt][8 * s2 + 5]); pb.w = cvtpk(sc[kt][8 * s2 + 6], sc[kt][8 * s2 + 7]);
                        const int kloc = 32 * qt + 32 * kt + 16 * s2 + 4 * hh;
#pragma unroll
                        for (int dt = 0; dt < 2; ++dt) {
                            const char* vp = Vt + (dt * 32 + l31) * VTS + kloc * 2;
                            const uint2 v0 = *(const uint2*)vp, v1 = *(const uint2*)(vp + 16);
                            const bf16x8 vf = __builtin_bit_cast(bf16x8, make_uint4(v0.x, v0.y, v1.x, v1.y));
                            oacc[dt] = __builtin_amdgcn_mfma_f32_32x32x16_bf16(vf, __builtin_bit_cast(bf16x8, pb), oacc[dt], 0, 0, 0);
                        }
                    }
                bf16_t* orow = mix + (size_t)(b * SEQ + tq) * DM + h * 64;
#pragma unroll
                for (int dt = 0; dt < 2; ++dt)
#pragma unroll
                    for (int q = 0; q < 4; ++q) {
                        uint2 o; o.x = cvtpk(oacc[dt][4 * q] * inv, oacc[dt][4 * q + 1] * inv); o.y = cvtpk(oacc[dt][4 * q + 2] * inv, oacc[dt][4 * q + 3] * inv);
                        *(uint2*)(orow + dt * 32 + 8 * q + 4 * hh) = o;
                    }
            }
        } else {
            const int v = u - N_ATT, prod = 2 - (v >> 7), mt = v & 31, nt = (v >> 5) & 3;
            const int row0 = mt * 256, col0 = nt * 256 + wave * 32, li = lane & 15, lg = lane >> 4;
            const int koff = prod == 0 ? 3072 : (prod == 1 ? 3136 : 3200), nk = prod == 2 ? 5 : 2;
            const float* W = prod == 0 ? p.wd_up : (prod == 1 ? p.wa_up : p.wg_up);
            const float* bp0 = W + (size_t)(8 * lg) * RW + col0 + li; const float* bp1 = bp0 + 16;
            const int srow = row0 + (tid >> 2), scol = koff + (tid & 3) * 8;
            auto aload = [&](int i, int kt) -> uint4 {
                const int tok = srow + 128 * i, c = scol + kt * 32;
                const uint4 zc = *(const uint4*)(z + (size_t)tok * INC + ZC_RW + c);
                uint4 zp = make_uint4(0u, 0u, 0u, 0u);
                if (tok & (SEQ - 1)) zp = *(const uint4*)(z + (size_t)(tok - 1) * INC + ZC_RW + c);
                const float4 m0 = *(const float4*)(p.mu + c), m1 = *(const float4*)(p.mu + c + 4);
                const float a[8] = {bflo(zc.x), bfhi(zc.x), bflo(zc.y), bfhi(zc.y), bflo(zc.z), bfhi(zc.z), bflo(zc.w), bfhi(zc.w)};
                const float q[8] = {bflo(zp.x), bfhi(zp.x), bflo(zp.y), bfhi(zp.y), bflo(zp.z), bfhi(zp.z), bflo(zp.w), bfhi(zp.w)};
                const float mm[8] = {m0.x, m0.y, m0.z, m0.w, m1.x, m1.y, m1.z, m1.w};
                float o[8];
#pragma unroll
                for (int e = 0; e < 8; ++e) {
                    const float zs = a[e] + (q[e] - a[e]) * mm[e];
                    o[e] = prod == 0 ? (1.f - 2.f / (1.f + __expf(2.f * zs))) : (prod == 1 ? zs : sigmoidf_(zs));
                }
                return make_uint4(cvtpk(o[0], o[1]), cvtpk(o[2], o[3]), cvtpk(o[4], o[5]), cvtpk(o[6], o[7]));
            };
            float* LWb = (float*)(p.ws + WS_LW); bf16_t* AVb = (bf16_t*)(p.ws + WS_AV); bf16_t* GVb = (bf16_t*)(p.ws + WS_GV);
            gemm_tile_f<1, 2>(smem, nk, RW, bp0, bp1, aload, [&](f32x4 (&acc)[16][2]) {
#pragma unroll
                for (int nf = 0; nf < 2; ++nf) {
                    const int col = col0 + nf * 16 + 4 * lg;
                    const float4 w0c = *(const float4*)(p.w0 + col), a0c = *(const float4*)(p.a0 + col);
                    const float wc[4] = {w0c.x, w0c.y, w0c.z, w0c.w}, ac[4] = {a0c.x, a0c.y, a0c.z, a0c.w};
#pragma unroll
                    for (int m = 0; m < 16; ++m) {
                        const size_t o = (size_t)(row0 + 16 * m + li) * RW + col;
                        if (prod == 0) {
                            float r[4];
#pragma unroll
                            for (int e = 0; e < 4; ++e) r[e] = -0.60653065971f * sigmoidf_(wc[e] + acc[m][nf][e]);
                            *(float4*)(LWb + o) = make_float4(r[0], r[1], r[2], r[3]);
                        } else if (prod == 1) {
                            uint2 ob; ob.x = cvtpk(sigmoidf_(ac[0] + acc[m][nf][0]), sigmoidf_(ac[1] + acc[m][nf][1])); ob.y = cvtpk(sigmoidf_(ac[2] + acc[m][nf][2]), sigmoidf_(ac[3] + acc[m][nf][3]));
                            *(uint2*)(AVb + o) = ob;
                        } else {
                            uint2 ob; ob.x = cvtpk(acc[m][nf][0], acc[m][nf][1]); ob.y = cvtpk(acc[m][nf][2], acc[m][nf][3]);
                            *(uint2*)(GVb + o) = ob;
                        }
                    }
                }
            });
        }
    }
}
DEVI void phase3(const Params& p, char* smem) {
    for (int v = blockIdx.x; v < 384; v += gridDim.x) p3_unit(p, smem, 256 + v);
}

DEVI void phase4(const Params& p, char* smem) {
    const int tid = threadIdx.x, lane = tid & 63, wave = tid >> 6;
    const float* const pAA = (const float*)(p.ws + WS_AA); const float* const pDE = (const float*)(p.ws + WS_DEC); const float* const pBB = (const float*)(p.ws + WS_BB);
    const float* const pK2 = (const float*)(p.ws + WS_K2); const float* const pR = (const float*)(p.ws + WS_R); const float* const pV = (const float*)(p.ws + WS_V);
    float* Y = (float*)(p.ws + WS_Y);
    constexpr int CH = 32;
    float* bufs = (float*)smem;
    for (int u = blockIdx.x; u < 32; u += gridDim.x) {
        const int b = u >> 4, h = u & 15;
        const int vr = lane >> 2, kq = lane & 3;
        float s[16];
#pragma unroll
        for (int j = 0; j < 16; ++j) s[j] = 0.f;
        __syncthreads();
        const int lst = tid >> 4, lc4 = tid & 15;
        const size_t goff = (size_t)(b * SEQ + lst) * RW + h * 64 + lc4 * 4;
        const int loff = lst * 64 + lc4 * 4;
        {
            *(float4*)(bufs + 0 * CH * 64 + loff) = *(const float4*)(pAA + goff); *(float4*)(bufs + 1 * CH * 64 + loff) = *(const float4*)(pDE + goff);
            *(float4*)(bufs + 2 * CH * 64 + loff) = *(const float4*)(pBB + goff); *(float4*)(bufs + 3 * CH * 64 + loff) = *(const float4*)(pK2 + goff);
            *(float4*)(bufs + 4 * CH * 64 + loff) = *(const float4*)(pR + goff); *(float4*)(bufs + 5 * CH * 64 + loff) = *(const float4*)(pV + goff);
        }
        __syncthreads();
        for (int c = 0; c < SEQ / CH; ++c) {
            float* cur = bufs + (c & 1) * (6 * CH * 64);
            float* nxt = bufs + ((c + 1) & 1) * (6 * CH * 64);
            float4 pre0, pre1, pre2, pre3, pre4, pre5;
            if (c + 1 < SEQ / CH) {
                const size_t g2 = goff + (size_t)(c + 1) * CH * RW;
                pre0 = *(const float4*)(pAA + g2); pre1 = *(const float4*)(pDE + g2); pre2 = *(const float4*)(pBB + g2);
                pre3 = *(const float4*)(pK2 + g2); pre4 = *(const float4*)(pR + g2); pre5 = *(const float4*)(pV + g2);
            }
            if (wave < 4) {
                for (int st = 0; st < CH; ++st) {
                    const float* aa = cur + (0 * CH + st) * 64 + kq * 16;
                    const float* de = cur + (1 * CH + st) * 64 + kq * 16;
                    const float* bb = cur + (2 * CH + st) * 64 + kq * 16;
                    const float* k2 = cur + (3 * CH + st) * 64 + kq * 16;
                    const float* rr = cur + (4 * CH + st) * 64 + kq * 16;
                    const float v = cur[(5 * CH + st) * 64 + wave * 16 + vr];
                    float sa = 0.f;
#pragma unroll
                    for (int j = 0; j < 16; ++j) sa += s[j] * aa[j];
                    sa += __shfl_xor(sa, 1, 64); sa += __shfl_xor(sa, 2, 64);
                    float y = 0.f;
#pragma unroll
                    for (int j = 0; j < 16; ++j) { s[j] = s[j] * de[j] + sa * bb[j] + v * k2[j]; y += s[j] * rr[j]; }
                    y += __shfl_xor(y, 1, 64); y += __shfl_xor(y, 2, 64);
                    if (kq == 0) Y[(size_t)(b * SEQ + c * CH + st) * RW + h * 64 + wave * 16 + vr] = y;
                }
            }
            if (c + 1 < SEQ / CH) {
                *(float4*)(nxt + 0 * CH * 64 + loff) = pre0; *(float4*)(nxt + 1 * CH * 64 + loff) = pre1; *(float4*)(nxt + 2 * CH * 64 + loff) = pre2;
                *(float4*)(nxt + 3 * CH * 64 + loff) = pre3; *(float4*)(nxt + 4 * CH * 64 + loff) = pre4; *(float4*)(nxt + 5 * CH * 64 + loff) = pre5;
            }
            __syncthreads();
        }
    }
}

DEVI void phase5(const Params& p, char* smem) {
    const int tid = threadIdx.x, lane = tid & 63, wave = tid >> 6;
    const float* Y = (const float*)(p.ws + WS_Y); const float* Vb = (const float*)(p.ws + WS_V); const float* Gb = (const float*)(p.ws + WS_G); const float* RKSb = (const float*)(p.ws + WS_RKS);
    bf16_t* mix = (bf16_t*)(p.ws + WS_MIX);
    for (int u = blockIdx.x; u < NTOK * 16 / 8; u += gridDim.x) {
        const int pi = u * 8 + wave, tok = pi >> 4, head = pi & 15, ch = head * 64 + lane;
        const float y = Y[(size_t)tok * RW + ch];
        const float mean = wave_sum(y) * (1.f / 64.f);
        const float d = y - mean;
        const float var = wave_sum(d * d) * (1.f / 64.f);
        const float yn = d * rsqrtf(var + 64e-5f) * p.ln_w[ch] + p.ln_b[ch];
        const float o = (yn + RKSb[tok * 16 + head] * Vb[(size_t)tok * RW + ch]) * Gb[(size_t)tok * RW + ch];
        mix[(size_t)tok * DM + 1024 + ch] = (bf16_t)(cvtpk(o, 0.f) & 0xffffu);
    }
}


constexpr int RA_AT = 0, RA_BT = 8192, RA_KT = 16384, RA_RT = 24576, RA_BPT = 32768, RA_KPT = 40960, RA_VT = 49152, RA_AAK = 57344, RA_ARB = 65536, RA_ARK = 73728,
              RA_AABP = 81920, RA_RHS = 98304, RA_WL = 131072, RA_SEG = 131328, RA_P1T = RA_BT, RA_P2T = RA_KT, RA_CUM = RA_AABP;

DEVI void phaseRA(const Params& p, char* smem) {
    const int tid = threadIdx.x, lane = tid & 63, wave = tid >> 6, l31 = lane & 31, hh = lane >> 5;
    const bf16_t* z = (const bf16_t*)(p.ws + WS_Z);
    float* cumb = (float*)(smem + RA_CUM); float* segs = (float*)(smem + RA_SEG); float* wl = (float*)(smem + RA_WL);
    float* rhs = (float*)(smem + RA_RHS); float* aabp = (float*)(smem + RA_AABP);
    uint4 n_cr, n_ck, n_cv, n_pr, n_pk, n_pv, n_au; float4 n_lw0, n_lw1;
    auto load_raw = [&](int unit_) {
        const int bh_ = unit_ >> 6, c_ = unit_ & 63, b_ = bh_ >> 4, h_ = bh_ & 15;
        const int tok = b_ * SEQ + c_ * 64 + (tid >> 3), ch0 = h_ * 64 + (tid & 7) * 8;
        const bf16_t* zr = z + (size_t)tok * INC + ZC_RW + ch0;
        const bool hasp = (tok & (SEQ - 1)) != 0;
        const uint4 zero4 = make_uint4(0u, 0u, 0u, 0u);
        n_cr = *(const uint4*)zr; n_ck = *(const uint4*)(zr + 1024); n_cv = *(const uint4*)(zr + 2048);
        n_pr = hasp ? *(const uint4*)(zr - INC) : zero4; n_pk = hasp ? *(const uint4*)(zr - INC + 1024) : zero4; n_pv = hasp ? *(const uint4*)(zr - INC + 2048) : zero4;
        n_au = *(const uint4*)((const bf16_t*)(p.ws + WS_AV) + (size_t)tok * RW + ch0);
        const float* lwp = (const float*)(p.ws + WS_LW) + (size_t)tok * RW + ch0;
        n_lw0 = *(const float4*)lwp; n_lw1 = *(const float4*)(lwp + 4);
    };
    if (((int)blockIdx.x >> 3) < 256) load_raw((((int)blockIdx.x & 7) + 8 * (((int)blockIdx.x >> 3) >> 6)) * 64 + (((int)blockIdx.x >> 3) & 63));
    const int ra_x = (int)blockIdx.x & 7, ra_slot = (int)blockIdx.x >> 3, ra_nslot = ((int)gridDim.x - ra_x + 7) >> 3;
    for (int uu = ra_slot; uu < 256; uu += ra_nslot) {
        const int bh = ra_x + 8 * (uu >> 6), c = uu & 63, b = bh >> 4, h = bh & 15;
        const int unit = bh * 64 + c;
        const int tokbase = b * SEQ + c * 64;
        __syncthreads();
        const int t = tid >> 3, c8 = tid & 7;
        float r_[8], k2[8], v_[8], aa[8], bb[8], lw[8];
        {
            const int tok = tokbase + t, ch0 = h * 64 + c8 * 8;
            const uint4 cr = n_cr, ck = n_ck, cv = n_cv, pr = n_pr, pk_ = n_pk, pv = n_pv, au = n_au;
            float fr[8], fk[8], fpr[8], fpk[8], fpv[8], mur[8], muk[8], muv[8], av[8], kkc[8], kac[8], rkc[8];
#define UNPK8(dst, u) { dst[0] = bflo(u.x); dst[1] = bfhi(u.x); dst[2] = bflo(u.y); dst[3] = bfhi(u.y); dst[4] = bflo(u.z); dst[5] = bfhi(u.z); dst[6] = bflo(u.w); dst[7] = bfhi(u.w); }
#define LDF8(dst, ptr) { const float4 q0_ = *(const float4*)(ptr), q1_ = *(const float4*)((ptr) + 4); dst[0] = q0_.x; dst[1] = q0_.y; dst[2] = q0_.z; dst[3] = q0_.w; dst[4] = q1_.x; dst[5] = q1_.y; dst[6] = q1_.z; dst[7] = q1_.w; }
            UNPK8(fr, cr) UNPK8(fk, ck) UNPK8(v_, cv) UNPK8(fpr, pr) UNPK8(fpk, pk_) UNPK8(fpv, pv) UNPK8(av, au)
            LDF8(mur, p.mu + ch0) LDF8(muk, p.mu + 1024 + ch0) LDF8(muv, p.mu + 2048 + ch0)
            LDF8(kkc, p.k_k + ch0) LDF8(kac, p.k_a + ch0) LDF8(rkc, p.r_k + ch0)
            lw[0] = n_lw0.x; lw[1] = n_lw0.y; lw[2] = n_lw0.z; lw[3] = n_lw0.w; lw[4] = n_lw1.x; lw[5] = n_lw1.y; lw[6] = n_lw1.z; lw[7] = n_lw1.w;
            float ssq = 0.f, rk = 0.f, kk[8];
#pragma unroll
            for (int i = 0; i < 8; ++i) {
                r_[i] = fr[i] + (fpr[i] - fr[i]) * mur[i];
                const float kx = fk[i] + (fpk[i] - fk[i]) * muk[i];
                v_[i] = v_[i] + (fpv[i] - v_[i]) * muv[i];
                kk[i] = kx * kkc[i]; ssq += kk[i] * kk[i];
                k2[i] = kx * (1.f + (av[i] - 1.f) * kac[i]);
                rk += r_[i] * k2[i] * rkc[i];
            }
            ssq += dpp_xor1(ssq); ssq += dpp_xor2(ssq); ssq += __shfl_xor(ssq, 4, 64);
            rk += dpp_xor1(rk); rk += dpp_xor2(rk); rk += __shfl_xor(rk, 4, 64);
            const float invn = 1.f / fmaxf(sqrtf(ssq), 1e-12f);
#pragma unroll
            for (int i = 0; i < 8; ++i) { const float kn = kk[i] * invn; aa[i] = -kn; bb[i] = kn * av[i]; }
            if (c8 == 0) ((float*)(p.ws + WS_RKS))[tok * 16 + h] = rk;
        }
#pragma unroll
        for (int i = 0; i < 8; ++i) cumb[t * 64 + c8 * 8 + i] = lw[i];
        __syncthreads();
        if (uu + ra_nslot < 256) { const int u2 = uu + ra_nslot; load_raw((ra_x + 8 * (u2 >> 6)) * 64 + (u2 & 63)); }
        {
            const int ch = tid & 63, seg = tid >> 6;
            float loc[8]; float run = 0.f;
#pragma unroll
            for (int j = 0; j < 8; ++j) { run += cumb[(seg * 8 + j) * 64 + ch]; loc[j] = run; }
            segs[seg * 64 + ch] = run;
            __syncthreads();
            float off = 0.f;
#pragma unroll
            for (int s2 = 0; s2 < 8; ++s2) off += (s2 < seg) ? segs[s2 * 64 + ch] : 0.f;
#pragma unroll
            for (int j = 0; j < 8; ++j) cumb[(seg * 8 + j) * 64 + ch] = off + loc[j];
        }
        __syncthreads();
        {
            unsigned pk[7][4];
            float atf[8];
#pragma unroll
            for (int i = 0; i < 8; i += 2) {
                float o[7][2];
#pragma unroll
                for (int e = 0; e < 2; ++e) {
                    const float cu = cumb[t * 64 + c8 * 8 + i + e], cl = cumb[63 * 64 + c8 * 8 + i + e];
                    const float e1 = __expf(cu), e2 = 1.f / e1, ex = __expf(cu - lw[i + e]), ew = __expf(cl - cu);
                    o[0][e] = aa[i + e] * ex; o[1][e] = bb[i + e] * e2; o[2][e] = k2[i + e] * e2; o[3][e] = r_[i + e] * e1;
                    o[4][e] = bb[i + e] * ew; o[5][e] = k2[i + e] * ew; o[6][e] = v_[i + e];
                    atf[i + e] = o[0][e];
                    if (t == 63) wl[c8 * 8 + i + e] = e1;
                }
#pragma unroll
                for (int m = 0; m < 7; ++m) pk[m][i >> 1] = cvtpk(o[m][0], o[m][1]);
            }
            const unsigned ro = m64_off(t, c8);
            *(uint4*)(smem + RA_AT + ro) = make_uint4(pk[0][0], pk[0][1], pk[0][2], pk[0][3]);
            *(uint4*)(smem + RA_BT + ro) = make_uint4(pk[1][0], pk[1][1], pk[1][2], pk[1][3]);
            *(uint4*)(smem + RA_KT + ro) = make_uint4(pk[2][0], pk[2][1], pk[2][2], pk[2][3]);
            *(uint4*)(smem + RA_RT + ro) = make_uint4(pk[3][0], pk[3][1], pk[3][2], pk[3][3]);
            *(float4*)(rhs + t * 128 + c8 * 8) = make_float4(atf[0], atf[1], atf[2], atf[3]);
            *(float4*)(rhs + t * 128 + c8 * 8 + 4) = make_float4(atf[4], atf[5], atf[6], atf[7]);
#pragma unroll
            for (int i = 0; i < 8; ++i) {
                const int ch = c8 * 8 + i;
                const unsigned to = m64_off(ch, t >> 3) + (t & 7) * 2;
                const unsigned w4 = pk[4][i >> 1], w5 = pk[5][i >> 1], w6 = pk[6][i >> 1];
                *(bf16_t*)(smem + RA_BPT + to) = (bf16_t)((i & 1) ? (w4 >> 16) : (w4 & 0xffffu));
                *(bf16_t*)(smem + RA_KPT + to) = (bf16_t)((i & 1) ? (w5 >> 16) : (w5 & 0xffffu));
                *(bf16_t*)(smem + RA_VT + to) = (bf16_t)((i & 1) ? (w6 >> 16) : (w6 & 0xffffu));
            }
        }
        __syncthreads();
        {
            const int pr = wave >> 1, sub = wave & 1;
            const char* X = smem + ((pr & 1) ? RA_KT : RA_BT);
            const char* Y = smem + ((pr & 2) ? RA_RT : RA_AT);
            const int incl = (pr & 2) ? 1 : 0;
            char* dst = smem + (pr == 1 ? RA_AAK : pr == 2 ? RA_ARB : RA_ARK);
#pragma unroll
            for (int tt = 0; tt < 2; ++tt) {
                const int i0 = sub ? (tt ? 32 : 0) : (tt ? 32 : 0);
                const int t0 = sub ? (tt ? 0 : 32) : (tt ? 32 : 0);
                const bool zero_tile = sub && tt;
                f32x16 acc = zero16();
                if (!zero_tile) mm_tile(acc, X, i0, Y, t0, l31, hh);
                const int tq = t0 + l31;
#pragma unroll
                for (int q = 0; q < 4; ++q) {
                    float vv[4];
#pragma unroll
                    for (int e = 0; e < 4; ++e) { const int ii = i0 + 8 * q + 4 * hh + e; vv[e] = (ii < tq + incl) ? acc[4 * q + e] : 0.f; }
                    if (pr == 0) {
                        if (!zero_tile) {
#pragma unroll
                            for (int e = 0; e < 4; ++e) aabp[tq * 64 + e * 16 + (i0 >> 2) + 2 * q + hh] = vv[e];
                        }
                    } else {
                        uint2 o; o.x = cvtpk(vv[0], vv[1]); o.y = cvtpk(vv[2], vv[3]);
                        *(uint2*)(dst + m64_off(tq, (i0 >> 3) + q) + 8 * hh) = o;
                    }
                }
            }
        }
        __syncthreads();
        f32x16 accA = zero16();
        const int w4 = wave & 3, ta = w4 & 1, tb2 = w4 >> 1;
        if (wave < 4) {
            f32x16 x2 = zero16();
            mm_tile(x2, smem + RA_VT, ta * 32, smem + RA_AAK, tb2 * 32, l31, hh);
            const int tq = tb2 * 32 + l31;
#pragma unroll
            for (int q = 0; q < 4; ++q) *(float4*)(rhs + tq * 128 + 64 + ta * 32 + 8 * q + 4 * hh) = make_float4(x2[4 * q], x2[4 * q + 1], x2[4 * q + 2], x2[4 * q + 3]);
            mm_tile(accA, smem + RA_VT, ta * 32, smem + RA_ARK, tb2 * 32, l31, hh);
        } else {
            mm_tile(accA, smem + RA_KPT, ta * 32, smem + RA_VT, tb2 * 32, l31, hh);
        }
        __syncthreads();
        {
            const int g = lane & 3, col = wave * 16 + (lane >> 2);
            float P[16];
#pragma unroll
            for (int q = 0; q < 16; ++q) P[q] = 0.f;
            float last[4];
            char* pt = smem + (col < 64 ? RA_P1T : RA_P2T);
            const int prow = col & 63;
            float4 acur[4]; float rcur = rhs[col];
#pragma unroll
            for (int q4 = 0; q4 < 4; ++q4) acur[q4] = make_float4(0.f, 0.f, 0.f, 0.f);
#pragma unroll
            for (int ts = 0; ts < 64; ++ts) {
                float4 anxt[4]; float rnxt = 0.f;
#pragma unroll
                for (int q4 = 0; q4 < 4; ++q4) anxt[q4] = make_float4(0.f, 0.f, 0.f, 0.f);
                if (ts + 1 < 64) {
                    const int nq4n = (((ts + 4) >> 2) + 3) >> 2;
#pragma unroll
                    for (int q4 = 0; q4 < nq4n; ++q4) anxt[q4] = *(const float4*)(aabp + (ts + 1) * 64 + g * 16 + q4 * 4);
                    rnxt = rhs[(ts + 1) * 128 + col];
                }
                float part = 0.f;
                const int nq4 = (((ts + 3) >> 2) + 3) >> 2;
#pragma unroll
                for (int q4 = 0; q4 < nq4; ++q4) {
                    const float4 a = acur[q4];
                    part += a.x * P[4 * q4] + a.y * P[4 * q4 + 1] + a.z * P[4 * q4 + 2] + a.w * P[4 * q4 + 3];
                }
                part += dpp_xor1(part); part += dpp_xor2(part);
                const float val = rcur + part;
#pragma unroll
                for (int q4 = 0; q4 < 4; ++q4) acur[q4] = anxt[q4];
                rcur = rnxt;
                if (g == (ts & 3)) P[ts >> 2] = val;
                last[ts & 3] = val;
                if ((ts & 3) == 3 && g == 0) {
                    uint2 o; o.x = cvtpk(last[0], last[1]); o.y = cvtpk(last[2], last[3]);
                    *(uint2*)(pt + m64_off(prow, ts >> 3) + ((ts >> 2) & 1) * 8) = o;
                }
            }
        }
        __syncthreads();
        if (wave < 4) {
            mm_tile(accA, smem + RA_P2T, ta * 32, smem + RA_ARB, tb2 * 32, l31, hh);
            float* q2 = (float*)(p.ws + WS_Q2) + ((size_t)unit * 4 + (ta * 2 + tb2)) * 1024;
#pragma unroll
            for (int i = 0; i < 16; ++i) q2[i * 64 + lane] = accA[i];
            f32x16 q1 = zero16();
            mm_tile(q1, smem + RA_P1T, ta * 32, smem + RA_ARB, tb2 * 32, l31, hh);
            const int tq = tb2 * 32 + l31;
            bf16_t* q1g = (bf16_t*)(p.ws + WS_Q1) + (size_t)unit * 4096 + tq * 64;
#pragma unroll
            for (int q = 0; q < 4; ++q) {
                const int k0 = ta * 32 + 8 * q + 4 * hh;
                const uint2 rr = *(const uint2*)(smem + RA_RT + m64_off(tq, k0 >> 3) + (k0 & 7) * 2);
                uint2 o; o.x = cvtpk(q1[4 * q] + bflo(rr.x), q1[4 * q + 1] + bfhi(rr.x)); o.y = cvtpk(q1[4 * q + 2] + bflo(rr.y), q1[4 * q + 3] + bfhi(rr.y));
                *(uint2*)(q1g + k0) = o;
            }
        } else {
            mm_tile(accA, smem + RA_BPT, ta * 32, smem + RA_P2T, tb2 * 32, l31, hh);
            unsigned* hb = (unsigned*)(p.ws + WS_HB) + ((size_t)unit * 4 + (ta * 2 + tb2)) * 512;
#pragma unroll
            for (int j = 0; j < 8; ++j) hb[j * 64 + lane] = cvtpk(accA[2 * j], accA[2 * j + 1]);
            f32x16 gg = zero16();
            mm_tile(gg, smem + RA_P1T, ta * 32, smem + RA_BPT, tb2 * 32, l31, hh);
            if (ta == tb2) {
#pragma unroll
                for (int i = 0; i < 16; ++i) { const int kk = (i & 3) + 8 * (i >> 2) + 4 * hh; if (kk == l31) gg[i] += wl[ta * 32 + kk]; }
            }
            unsigned* gb = (unsigned*)(p.ws + WS_GB) + ((size_t)unit * 4 + (ta * 2 + tb2)) * 512 + lane * 8;
            uint4 o0, o1;
            o0.x = cvtpk(gg[0], gg[1]); o0.y = cvtpk(gg[2], gg[3]); o0.z = cvtpk(gg[4], gg[5]); o0.w = cvtpk(gg[6], gg[7]);
            o1.x = cvtpk(gg[8], gg[9]); o1.y = cvtpk(gg[10], gg[11]); o1.z = cvtpk(gg[12], gg[13]); o1.w = cvtpk(gg[14], gg[15]);
            *(uint4*)(gb) = o0; *(uint4*)(gb + 4) = o1;
        }
    }
}

struct RbH { unsigned w[2][8]; };
DEVI void rb_load(const Params& p, int unit, int vh, int lane, uint4 (&g)[8], RbH& hq) {
    const unsigned* gb = (const unsigned*)(p.ws + WS_GB) + (size_t)unit * 2048 + lane * 8;
    const unsigned* hb = (const unsigned*)(p.ws + WS_HB) + (size_t)unit * 2048 + lane;
#pragma unroll
    for (int t4 = 0; t4 < 4; ++t4) { g[2 * t4] = *(const uint4*)(gb + t4 * 512); g[2 * t4 + 1] = *(const uint4*)(gb + t4 * 512 + 4); }
#pragma unroll
    for (int j = 0; j < 8; ++j) { hq.w[0][j] = hb[(0 * 2 + vh) * 512 + j * 64]; hq.w[1][j] = hb[(1 * 2 + vh) * 512 + j * 64]; }
}
DEVI void rb_store(const Params& p, int unit, int vh, int l31, int hh, const f32x16& X0, const f32x16& X1) {
    bf16_t* s0 = (bf16_t*)(p.ws + WS_S0) + (size_t)unit * 4096 + (vh * 32 + l31) * 64;
#pragma unroll
    for (int q = 0; q < 4; ++q) {
        uint2 o; o.x = cvtpk(X0[4 * q], X0[4 * q + 1]); o.y = cvtpk(X0[4 * q + 2], X0[4 * q + 3]);
        *(uint2*)(s0 + 8 * q + 4 * hh) = o;
        uint2 o2; o2.x = cvtpk(X1[4 * q], X1[4 * q + 1]); o2.y = cvtpk(X1[4 * q + 2], X1[4 * q + 3]);
        *(uint2*)(s0 + 32 + 8 * q + 4 * hh) = o2;
    }
}
#define BF8(u) __builtin_bit_cast(bf16x8, u)
DEVI void rb_step(f32x16& X0, f32x16& X1, const uint4 (&g)[8], const RbH& hq) {
    uint4 xa, xb, xc, xd;
    xa.x = cvtpk(X0[0], X0[1]); xa.y = cvtpk(X0[2], X0[3]); xa.z = cvtpk(X0[4], X0[5]); xa.w = cvtpk(X0[6], X0[7]);
    xb.x = cvtpk(X0[8], X0[9]); xb.y = cvtpk(X0[10], X0[11]); xb.z = cvtpk(X0[12], X0[13]); xb.w = cvtpk(X0[14], X0[15]);
    xc.x = cvtpk(X1[0], X1[1]); xc.y = cvtpk(X1[2], X1[3]); xc.z = cvtpk(X1[4], X1[5]); xc.w = cvtpk(X1[6], X1[7]);
    xd.x = cvtpk(X1[8], X1[9]); xd.y = cvtpk(X1[10], X1[11]); xd.z = cvtpk(X1[12], X1[13]); xd.w = cvtpk(X1[14], X1[15]);
    f32x16 N0, N1;
#pragma unroll
    for (int j = 0; j < 8; ++j) { N0[2 * j] = bflo(hq.w[0][j]); N0[2 * j + 1] = bfhi(hq.w[0][j]); N1[2 * j] = bflo(hq.w[1][j]); N1[2 * j + 1] = bfhi(hq.w[1][j]); }
    N0 = __builtin_amdgcn_mfma_f32_32x32x16_bf16(BF8(g[0]), BF8(xa), N0, 0, 0, 0);
    N1 = __builtin_amdgcn_mfma_f32_32x32x16_bf16(BF8(g[2]), BF8(xa), N1, 0, 0, 0);
    N0 = __builtin_amdgcn_mfma_f32_32x32x16_bf16(BF8(g[1]), BF8(xb), N0, 0, 0, 0);
    N1 = __builtin_amdgcn_mfma_f32_32x32x16_bf16(BF8(g[3]), BF8(xb), N1, 0, 0, 0);
    N0 = __builtin_amdgcn_mfma_f32_32x32x16_bf16(BF8(g[4]), BF8(xc), N0, 0, 0, 0);
    N1 = __builtin_amdgcn_mfma_f32_32x32x16_bf16(BF8(g[6]), BF8(xc), N1, 0, 0, 0);
    N0 = __builtin_amdgcn_mfma_f32_32x32x16_bf16(BF8(g[5]), BF8(xd), N0, 0, 0, 0);
    N1 = __builtin_amdgcn_mfma_f32_32x32x16_bf16(BF8(g[7]), BF8(xd), N1, 0, 0, 0);
    X0 = N0; X1 = N1;
}
DEVI void phaseRB_core(const Params& p, char* smem) {
    const int tid = threadIdx.x, lane = tid & 63, wave = tid >> 6, l31 = lane & 31, hh = lane >> 5;
    if (wave != 0) return;
    for (int wu = blockIdx.x; wu < 64; wu += gridDim.x) {
        const int bh = (wu & 7) | ((wu >> 4) << 3), vh = (wu >> 3) & 1;
        f32x16 X0 = zero16(), X1 = zero16();
        uint4 gA[8], gB[8], gC[8]; RbH hA, hB, hC;
        rb_load(p, bh * 64, vh, lane, gA, hA);
        rb_load(p, bh * 64 + 1, vh, lane, gB, hB);
        for (int c = 0; c < 63; c += 3) {
            rb_load(p, bh * 64 + (c + 2 < 64 ? c + 2 : 63), vh, lane, gC, hC);
            rb_store(p, bh * 64 + c, vh, l31, hh, X0, X1);
            rb_step(X0, X1, gA, hA);
            rb_load(p, bh * 64 + (c + 3 < 64 ? c + 3 : 63), vh, lane, gA, hA);
            rb_store(p, bh * 64 + c + 1, vh, l31, hh, X0, X1);
            rb_step(X0, X1, gB, hB);
            rb_load(p, bh * 64 + (c + 4 < 64 ? c + 4 : 63), vh, lane, gB, hB);
            rb_store(p, bh * 64 + c + 2, vh, l31, hh, X0, X1);
            rb_step(X0, X1, gC, hC);
        }
        rb_store(p, bh * 64 + 63, vh, l31, hh, X0, X1);
    }
}

DEVI void phaseRB(const Params& p, char* smem) {
    const bool split = gridDim.x >= 128;
    if (split && blockIdx.x < 64) { phaseRB_core(p, smem); return; }
    const int nw = split ? (int)gridDim.x - 64 : (int)gridDim.x, wi = split ? (int)blockIdx.x - 64 : (int)blockIdx.x;
    for (int u = wi; u < 256; u += nw) p3_unit(p, smem, u);
    if (!split) { __syncthreads(); phaseRB_core(p, smem); }
}

DEVI void phaseRC(const Params& p, char* smem) {
    const int tid = threadIdx.x, lane = tid & 63, wave = tid >> 6, l31 = lane & 31, hh = lane >> 5;
    const bf16_t* z = (const bf16_t*)(p.ws + WS_Z); const bf16_t* GVb = (const bf16_t*)(p.ws + WS_GV); const float* RKSb = (const float*)(p.ws + WS_RKS);
    bf16_t* mix = (bf16_t*)(p.ws + WS_MIX);
    for (int it0 = blockIdx.x; it0 < 512 + N_SPEC; it0 += gridDim.x) {
        if (it0 < N_SPEC) { spec_unit(p, smem, it0); continue; }
        const int it = it0 - N_SPEC;
        const int unit = it * 4 + (wave >> 1), tb = wave & 1;
        const int bh = unit >> 6, c = unit & 63, b = bh >> 4, h = bh & 15;
        const int tq = tb * 32 + l31, tok = b * SEQ + c * 64 + tq;
        const float* q2 = (const float*)(p.ws + WS_Q2) + (size_t)unit * 4096 + lane;
        f32x16 a0, a1;
#pragma unroll
        for (int i = 0; i < 16; ++i) { a0[i] = q2[(0 * 2 + tb) * 1024 + i * 64]; a1[i] = q2[(1 * 2 + tb) * 1024 + i * 64]; }
        const bf16_t* s0 = (const bf16_t*)(p.ws + WS_S0) + (size_t)unit * 4096;
        const bf16_t* q1 = (const bf16_t*)(p.ws + WS_Q1) + (size_t)unit * 4096 + tq * 64;
#pragma unroll
        for (int s4 = 0; s4 < 4; ++s4) {
            const bf16x8 fa0 = *(const bf16x8*)(s0 + (l31) * 64 + 16 * s4 + 8 * hh);
            const bf16x8 fa1 = *(const bf16x8*)(s0 + (32 + l31) * 64 + 16 * s4 + 8 * hh);
            const bf16x8 fb = *(const bf16x8*)(q1 + 16 * s4 + 8 * hh);
            a0 = __builtin_amdgcn_mfma_f32_32x32x16_bf16(fa0, fb, a0, 0, 0, 0);
            a1 = __builtin_amdgcn_mfma_f32_32x32x16_bf16(fa1, fb, a1, 0, 0, 0);
        }
        float sm = 0.f;
#pragma unroll
        for (int i = 0; i < 16; ++i) sm += a0[i] + a1[i];
        sm = xor32_sum(sm);
        const float mean = sm * (1.f / 64.f);
        float sq = 0.f;
#pragma unroll
        for (int i = 0; i < 16; ++i) { const float d0 = a0[i] - mean, d1 = a1[i] - mean; sq += d0 * d0 + d1 * d1; }
        sq = xor32_sum(sq);
        const float rstd = rsqrtf(sq * (1.f / 64.f) + 64e-5f);
        const float rk = RKSb[tok * 16 + h];
#pragma unroll
        for (int vb = 0; vb < 2; ++vb)
#pragma unroll
            for (int q = 0; q < 4; ++q) {
                const int ch = h * 64 + vb * 32 + 8 * q + 4 * hh;
                const int hc = ch;
                const uint2 zc2 = *(const uint2*)(z + (size_t)tok * INC + ZC_RW + 2048 + hc);
                uint2 zp2 = make_uint2(0u, 0u);
                if (tok & (SEQ - 1)) zp2 = *(const uint2*)(z + (size_t)(tok - 1) * INC + ZC_RW + 2048 + hc);
                const float4 muv = *(const float4*)(p.mu + 2048 + hc);
                const uint2 g2 = *(const uint2*)(GVb + (size_t)tok * RW + hc);
                float4 vv, gv;
                vv.x = bflo(zc2.x) + (bflo(zp2.x) - bflo(zc2.x)) * muv.x; vv.y = bfhi(zc2.x) + (bfhi(zp2.x) - bfhi(zc2.x)) * muv.y;
                vv.z = bflo(zc2.y) + (bflo(zp2.y) - bflo(zc2.y)) * muv.z; vv.w = bfhi(zc2.y) + (bfhi(zp2.y) - bfhi(zc2.y)) * muv.w;
                gv.x = bflo(g2.x); gv.y = bfhi(g2.x); gv.z = bflo(g2.y); gv.w = bfhi(g2.y);
                const float4 lnw = *(const float4*)(p.ln_w + ch), lnb = *(const float4*)(p.ln_b + ch);
                float y[4];
#pragma unroll
                for (int e = 0; e < 4; ++e) y[e] = ((vb ? a1[4 * q + e] : a0[4 * q + e]) - mean) * rstd;
                uint2 o;
                o.x = cvtpk((y[0] * lnw.x + lnb.x + rk * vv.x) * gv.x, (y[1] * lnw.y + lnb.y + rk * vv.y) * gv.y);
                o.y = cvtpk((y[2] * lnw.z + lnb.z + rk * vv.z) * gv.z, (y[3] * lnw.w + lnb.w + rk * vv.w) * gv.w);
                *(uint2*)(mix + (size_t)tok * DM + 1024 + ch) = o;
            }
    }
}

DEVI void phase6(const Params& p, char* smem) {
    pg8::Gemm g{(const pg8::bf16_t*)(p.ws + WS_MIX), (const pg8::bf16_t*)(p.ws + WS_WTO), NTOK, DM, DM};
    pg8::StaticOrder S; S.init(NTOK, DM, (int)gridDim.x, (int)blockIdx.x);
    pg8::EpiX1 E{(float*)(p.ws + WS_X1), p.x, (const float*)(p.ws + WS_MODF) + 2 * DM, DM, 12288, SEQ};
    pg8::gemm_phase<pg8::EpiX1, pg8::StaticOrder, true, true>((PG8_LAS unsigned char*)smem, g, S, E);
}

DEVI void phase7(const Params& p, char* smem) {
    float* part = (float*)smem;
    float* ssq = part + 8 * 32 * 80;
    float* rstd_s = ssq + 8 * 128;
    float* lg_ = rstd_s + 32;
    const float* x1 = (const float*)(p.ws + WS_X1);
    const uint4* wrf = (const uint4*)(p.ws + WS_WRF);
    const float* cb = (const float*)(p.ws + WS_CB);
    const float* as2 = (const float*)(p.ws + WS_AS2);
    bf16_t* h = (bf16_t*)(p.ws + WS_H);
    int* cnt = (int*)(p.ws + WS_CTL);
    int* list = (int*)(p.ws + WS_LIST); float* lw = (float*)(p.ws + WS_LWT);
    const int tid = threadIdx.x, lane = tid & 63, wave = tid >> 6, li = lane & 15, lg = lane >> 4;
    for (int u = blockIdx.x; u < NTOK / 32; u += gridDim.x) {
        const int tok0 = u * 32, b = tok0 >> 12;
        __syncthreads();
        f32x4 acc[2][5];
#pragma unroll
        for (int tg = 0; tg < 2; ++tg)
#pragma unroll
            for (int nf = 0; nf < 5; ++nf) acc[tg][nf] = f32x4{0.f, 0.f, 0.f, 0.f};
        float sq[2] = {0.f, 0.f};
        const float* xr = x1 + (size_t)(tok0 + li) * DM + wave * 256 + 8 * lg;
#pragma unroll 2
        for (int s4 = 0; s4 < 8; ++s4) {
            bf16x8 ah[2], al[2];
#pragma unroll
            for (int tg = 0; tg < 2; ++tg) {
                const float4 xa = *(const float4*)(xr + (size_t)tg * 16 * DM + s4 * 32), xb = *(const float4*)(xr + (size_t)tg * 16 * DM + s4 * 32 + 4);
                sq[tg] += xa.x * xa.x + xa.y * xa.y + xa.z * xa.z + xa.w * xa.w + xb.x * xb.x + xb.y * xb.y + xb.z * xb.z + xb.w * xb.w;
                uint4 hi, lo;
                hi.x = cvtpk(xa.x, xa.y); hi.y = cvtpk(xa.z, xa.w); hi.z = cvtpk(xb.x, xb.y); hi.w = cvtpk(xb.z, xb.w);
                lo.x = cvtpk(xa.x - bflo(hi.x), xa.y - bfhi(hi.x)); lo.y = cvtpk(xa.z - bflo(hi.y), xa.w - bfhi(hi.y));
                lo.z = cvtpk(xb.x - bflo(hi.z), xb.y - bfhi(hi.z)); lo.w = cvtpk(xb.z - bflo(hi.w), xb.w - bfhi(hi.w));
                ah[tg] = __builtin_bit_cast(bf16x8, hi); al[tg] = __builtin_bit_cast(bf16x8, lo);
            }
            const uint4* wf = wrf + ((size_t)(b * 64 + wave * 8 + s4) * 5) * 128 + lane;
#pragma unroll
            for (int nf = 0; nf < 5; ++nf) {
                const bf16x8 bh = __builtin_bit_cast(bf16x8, wf[nf * 128]), bl = __builtin_bit_cast(bf16x8, wf[nf * 128 + 64]);
#pragma unroll
                for (int tg = 0; tg < 2; ++tg) {
                    acc[tg][nf] = __builtin_amdgcn_mfma_f32_16x16x32_bf16(al[tg], bh, acc[tg][nf], 0, 0, 0);
                    acc[tg][nf] = __builtin_amdgcn_mfma_f32_16x16x32_bf16(ah[tg], bl, acc[tg][nf], 0, 0, 0);
                    acc[tg][nf] = __builtin_amdgcn_mfma_f32_16x16x32_bf16(ah[tg], bh, acc[tg][nf], 0, 0, 0);
                }
            }
        }
#pragma unroll
        for (int tg = 0; tg < 2; ++tg) {
#pragma unroll
            for (int nf = 0; nf < 5; ++nf)
#pragma unroll
                for (int r = 0; r < 4; ++r) part[(wave * 32 + 16 * tg + 4 * lg + r) * 80 + nf * 16 + li] = acc[tg][nf][r];
            ssq[(wave * 4 + lg) * 32 + 16 * tg + li] = sq[tg];
        }
        __syncthreads();
        if (tid < 32) {
            float t = 0.f;
#pragma unroll
            for (int q = 0; q < 32; ++q) t += ssq[q * 32 + tid];
            rstd_s[tid] = rsqrtf(t * (1.f / DM) + 1e-6f);
        }
        __syncthreads();
        for (int idx = tid; idx < 32 * 80; idx += 512) {
            const int tk = idx / 80, j = idx % 80;
            float t = 0.f;
#pragma unroll
            for (int w = 0; w < 8; ++w) t += part[(w * 32 + tk) * 80 + j];
            lg_[idx] = rstd_s[tk] * t + cb[b * 80 + j];
        }
        __syncthreads();
        if (tid < 32) {
            const int tok = tok0 + tid;
            const float* L = lg_ + tid * 80;
            int gi = 0; float gm = L[64];
            for (int j = 1; j < 8; ++j) if (L[64 + j] > gm) { gm = L[64 + j]; gi = j; }
            float den = 0.f;
            for (int j = 0; j < 8; ++j) den += expf(L[64 + j] - gm);
            const float ggate = 1.f / den;
            const float* E = L + gi * 8;
            int i1 = 0; float m1 = E[0];
            for (int j = 1; j < 8; ++j) if (E[j] > m1) { m1 = E[j]; i1 = j; }
            int i2 = -1; float m2 = -3.0e38f;
            for (int j = 0; j < 8; ++j) if (j != i1 && E[j] > m2) { m2 = E[j]; i2 = j; }
            const float e2 = expf(m2 - m1);
            const float p1 = 1.f / (1.f + e2), p2 = e2 / (1.f + e2);
            const int ex1 = gi * 8 + i1, ex2 = gi * 8 + i2;
            const int pos1 = atomicAdd(&cnt[ex1], 1); list[ex1 * LCAP + pos1] = tok * 2; lw[ex1 * LCAP + pos1] = ggate * p1;
            const int pos2 = atomicAdd(&cnt[ex2], 1); list[ex2 * LCAP + pos2] = tok * 2 + 1; lw[ex2 * LCAP + pos2] = ggate * p2;
        }
#pragma unroll 2
        for (int tt = 0; tt < 4; ++tt) {
            const int tk = wave * 4 + tt, tok = tok0 + tk;
            const float rs = rstd_s[tk];
            const float* xrow = x1 + (size_t)tok * DM;
#pragma unroll
            for (int i = 0; i < 8; ++i) {
                const int k = i * 256 + lane * 4;
                const float4 xv = *(const float4*)(xrow + k);
                const float4 a = *(const float4*)(as2 + b * DM + k), sft = *(const float4*)(as2 + 2 * DM + b * DM + k);
                uint2 o; o.x = cvtpk(xv.x * rs * a.x + sft.x, xv.y * rs * a.y + sft.y); o.y = cvtpk(xv.z * rs * a.z + sft.z, xv.w * rs * a.w + sft.w);
                *(uint2*)(h + (size_t)tok * DM + k) = o;
            }
        }
    }
}

struct MoeTab { int cnt[64]; int sb[65]; int ubx[9]; int np[8]; };
DEVI void moe_tables(const Params& p, MoeTab* tb, int slabs) {
    const int* cnt = (const int*)(p.ws + WS_CTL);
    const int tid = threadIdx.x, x = blockIdx.x & 7;
    __syncthreads();
    if (tid < 64) tb->cnt[tid] = cnt[tid];
    __syncthreads();
    if (tid == 0) {
        int sb = 0;
        for (int e = 0; e < 64; ++e) { tb->sb[e] = sb; sb += tb->cnt[e]; }
        tb->sb[64] = sb;
        int ub = 0;
        for (int i = 0; i < 8; ++i) { const int np = (tb->cnt[x + 8 * i] + 255) >> 8; tb->np[i] = np; tb->ubx[i] = ub; ub += np * slabs; }
        tb->ubx[8] = ub;
    }
    __syncthreads();
}
struct MoeUnit { int e, s, ce, sbase, rbeg, rend; };
DEVI MoeUnit moe_unit(const MoeTab* tb, int u) {
    int i = 0;
    while (tb->ubx[i + 1] <= u) ++i;
    const int rem = u - tb->ubx[i], np = tb->np[i], ps = rem % np;
    MoeUnit m; m.e = (blockIdx.x & 7) + 8 * i; m.s = rem / np; m.ce = tb->cnt[m.e]; m.sbase = tb->sb[m.e];
    const int rp = (((m.ce + np - 1) / np) + 15) & ~15;
    m.rbeg = ps * rp; m.rend = m.rbeg + rp < m.ce ? m.rbeg + rp : m.ce;
    return m;
}

DEVI void phase8(const Params& p, char* smem) {
    MoeTab* tb = (MoeTab*)(smem + 32768);
    const bf16_t* h = (const bf16_t*)(p.ws + WS_H);
    bf16_t* hid = (bf16_t*)(p.ws + WS_HID);
    const int* list = (const int*)(p.ws + WS_LIST);
    const int tid = threadIdx.x, lane = tid & 63, wave = tid >> 6, li = lane & 15, lg = lane >> 4;
    moe_tables(p, tb, 4);
    const int total = tb->ubx[8], nslot = ((int)gridDim.x - (int)(blockIdx.x & 7) + 7) >> 3;
    for (int u = blockIdx.x >> 3; u < total; u += nslot) {
        const MoeUnit mu = moe_unit(tb, u);
        const int e = mu.e, s = mu.s;
        const int fcol = s * 128 + wave * 16;
        const float* bp0 = p.w1 + (size_t)e * DM * FF + (size_t)(8 * lg) * FF + fcol + li;
        const float* bp1 = p.w3 + (size_t)e * DM * FF + (size_t)(8 * lg) * FF + fcol + li;
        int r0 = mu.rbeg + (tid >> 2), r1 = r0 + 128; r0 = r0 < mu.rend ? r0 : mu.rend - 1; r1 = r1 < mu.rend ? r1 : mu.rend - 1;
        const bf16_t* ap0 = h + (size_t)(list[e * LCAP + r0] >> 1) * DM + (tid & 3) * 8;
        const bf16_t* ap1 = h + (size_t)(list[e * LCAP + r1] >> 1) * DM + (tid & 3) * 8;
        __syncthreads();
        gemm_tile<1, 2>(smem, DM / 32, FF, bp0, bp1, ap0, ap1, [&](f32x4 (&acc)[16][2]) {
#pragma unroll
            for (int m = 0; m < 16; ++m) {
                const int r = mu.rbeg + 16 * m + li;
                if (r < mu.rend) {
                    float hv[4];
#pragma unroll
                    for (int q = 0; q < 4; ++q) { const float a = acc[m][0][q]; hv[q] = a / (1.f + __expf(-a)) * acc[m][1][q]; }
                    uint2 o; o.x = cvtpk(hv[0], hv[1]); o.y = cvtpk(hv[2], hv[3]);
                    *(uint2*)(hid + (size_t)(mu.sbase + r) * FF + fcol + 4 * lg) = o;
                }
            }
        });
    }
}

DEVI void phase9(const Params& p, char* smem) {
    MoeTab* tb = (MoeTab*)(smem + 32768);
    const bf16_t* hid = (const bf16_t*)(p.ws + WS_HID);
    bf16_t* yb = (bf16_t*)(p.ws + WS_YB);
    const int* list = (const int*)(p.ws + WS_LIST); const float* lw = (const float*)(p.ws + WS_LWT);
    const int tid = threadIdx.x, lane = tid & 63, wave = tid >> 6, li = lane & 15, lg = lane >> 4;
    moe_tables(p, tb, 8);
    const int total = tb->ubx[8], nslot = ((int)gridDim.x - (int)(blockIdx.x & 7) + 7) >> 3;
    for (int u = blockIdx.x >> 3; u < total; u += nslot) {
        const MoeUnit mu = moe_unit(tb, u);
        const int e = mu.e, s = mu.s;
        const int col0 = s * 256 + wave * 32;
        const float* bp0 = p.w2 + (size_t)e * FF * DM + (size_t)(8 * lg) * DM + col0 + li; const float* bp1 = bp0 + 16;
        int r0 = mu.rbeg + (tid >> 2), r1 = r0 + 128; r0 = r0 < mu.rend ? r0 : mu.rend - 1; r1 = r1 < mu.rend ? r1 : mu.rend - 1;
        const bf16_t* ap0 = hid + (size_t)(mu.sbase + r0) * FF + (tid & 3) * 8; const bf16_t* ap1 = hid + (size_t)(mu.sbase + r1) * FF + (tid & 3) * 8;
        __syncthreads();
        gemm_tile<1, 2>(smem, FF / 32, DM, bp0, bp1, ap0, ap1, [&](f32x4 (&acc)[16][2]) {
#pragma unroll
            for (int m = 0; m < 16; ++m) {
                const int r = mu.rbeg + 16 * m + li;
                if (r < mu.rend) {
                    const int a = list[e * LCAP + r]; const float wgt = lw[e * LCAP + r];
#pragma unroll
                    for (int nf = 0; nf < 2; ++nf) {
                        uint2 o; o.x = cvtpk(acc[m][nf][0] * wgt, acc[m][nf][1] * wgt); o.y = cvtpk(acc[m][nf][2] * wgt, acc[m][nf][3] * wgt);
                        *(uint2*)(yb + (size_t)a * DM + col0 + nf * 16 + 4 * lg) = o;
                    }
                }
            }
        });
    }
}

DEVI void phase10(const Params& p, char* smem) {
    const float* modf = (const float*)(p.ws + WS_MODF);
    const float* x1 = (const float*)(p.ws + WS_X1);
    const bf16_t* yb = (const bf16_t*)(p.ws + WS_YB);
    const int tid = threadIdx.x, lane = tid & 63, wave = tid >> 6;
    for (int u = blockIdx.x; u < NTOK / 8; u += gridDim.x) {
        const int tok = u * 8 + wave, b = tok >> 12;
        float4 v[8]; float ss = 0.f;
#pragma unroll
        for (int i = 0; i < 8; ++i) {
            const int k = i * 256 + lane * 4;
            const float4 xv = *(const float4*)(x1 + (size_t)tok * DM + k);
            const float4 gt = *(const float4*)(modf + b * 12288 + 5 * DM + k);
            const uint2 ya = *(const uint2*)(yb + (size_t)(tok * 2) * DM + k), yc = *(const uint2*)(yb + (size_t)(tok * 2 + 1) * DM + k);
            v[i].x = xv.x + gt.x * (bflo(ya.x) + bflo(yc.x)); v[i].y = xv.y + gt.y * (bfhi(ya.x) + bfhi(yc.x));
            v[i].z = xv.z + gt.z * (bflo(ya.y) + bflo(yc.y)); v[i].w = xv.w + gt.w * (bfhi(ya.y) + bfhi(yc.y));
            ss += v[i].x * v[i].x + v[i].y * v[i].y + v[i].z * v[i].z + v[i].w * v[i].w;
        }
        ss = wave_sum(ss);
        const float rstd = rsqrtf(ss * (1.f / DM) + 1e-6f);
#pragma unroll
        for (int i = 0; i < 8; ++i) {
            const int k = i * 256 + lane * 4;
            const float4 g = *(const float4*)(p.final_g + k);
            float4 o; o.x = v[i].x * rstd * g.x; o.y = v[i].y * rstd * g.y; o.z = v[i].z * rstd * g.z; o.w = v[i].w * rstd * g.w;
            *(float4*)(p.out + (size_t)tok * DM + k) = o;
        }
    }
}

constexpr size_t WS_BAR = 4096;
constexpr int N_PHASES = 12;
#ifndef MK_N_LAUNCHES
#define MK_N_LAUNCHES 1
#endif

__global__ void __launch_bounds__(512) mega_kernel(Params p, int lo, int hi) {
    extern __shared__ __attribute__((aligned(16))) char smem[];
    volatile LAS unsigned* xb_words = (volatile LAS unsigned*)(smem + LDS_BYTES - 16);
    if (threadIdx.x == 0) { xb_words[0] = 0u; xb_words[1] = 0u; xb_words[2] = 0u; xb_words[3] = 0u; }
    __syncthreads();
    XcdBarrier bar;
    if (hi - lo > 1) bar = xcd_barrier_post((unsigned*)(p.ws + WS_BAR), xb_words);
#define IN(k) (lo <= (k) && (k) < hi)
#define SEAM(k) do { if (IN(k) && IN((k) + 1)) xcd_barrier(bar); } while (0)
#ifndef PROBE_MASK
#define PROBE_MASK 0
#endif
#define REP(k) (((PROBE_MASK >> (k)) & 1) ? 2 : 1)
    if (IN(0)) for (int rp = 0; rp < REP(0); ++rp) phase0(p, smem);
    SEAM(0);
    if (IN(1)) for (int rp = 0; rp < REP(1); ++rp) phase1(p, smem);
    SEAM(1);
    if (IN(2)) for (int rp = 0; rp < REP(2); ++rp) phase2(p, smem);
    SEAM(2);
    if (IN(3)) for (int rp = 0; rp < REP(3); ++rp) phase3(p, smem);
    SEAM(3);
    if (IN(4)) for (int rp = 0; rp < REP(4); ++rp) phaseRA(p, smem);
    SEAM(4);
    if (IN(5)) for (int rp = 0; rp < REP(5); ++rp) phaseRB(p, smem);
    SEAM(5);
    if (IN(6)) for (int rp = 0; rp < REP(6); ++rp) phaseRC(p, smem);
    SEAM(6);
    if (IN(7)) for (int rp = 0; rp < REP(7); ++rp) phase6(p, smem);
    SEAM(7);
    if (IN(8)) phase7(p, smem);
    SEAM(8);
    if (IN(9)) for (int rp = 0; rp < REP(9); ++rp) phase8(p, smem);
    SEAM(9);
    if (IN(10)) for (int rp = 0; rp < REP(10); ++rp) phase9(p, smem);
    SEAM(10);
    if (IN(11)) for (int rp = 0; rp < REP(11); ++rp) phase10(p, smem);
#undef IN
#undef SEAM
}

extern "C" void kernel_launch(void* const* d_in, const int* in_sizes, int n_in, void* d_out, int out_size, void* d_ws, size_t ws_size, hipStream_t stream) {
    static int grid = 0;
    if (!grid) {
        int dev = 0, cus = 0, per_cu = 0;
        (void)hipGetDevice(&dev);
        (void)hipDeviceGetAttribute(&cus, hipDeviceAttributeMultiprocessorCount, dev);
        if (hipFuncSetAttribute((const void*)mega_kernel, hipFuncAttributeMaxDynamicSharedMemorySize, LDS_BYTES) != hipSuccess) { grid = -1; return; }
        if (hipOccupancyMaxActiveBlocksPerMultiprocessor(&per_cu, (const void*)mega_kernel, 512, LDS_BYTES) != hipSuccess || per_cu < 1) { grid = -1; return; }
        grid = cus;
        if (grid > 256) grid = 256;
    }
    if (grid < 0) return;
    Params p{};
    const float* const* in = (const float* const*)d_in;
    p.x = in[0]; p.c = in[1]; p.w_ada = in[2]; p.b_ada = in[3]; p.norm1_g = in[4]; p.w_in = in[5]; p.mu = in[6]; p.sinks = in[7]; p.w0 = in[8]; p.wd_up = in[9];
    p.a0 = in[10]; p.wa_up = in[11]; p.wg_up = in[12]; p.k_k = in[13]; p.k_a = in[14]; p.r_k = in[15]; p.ln_w = in[16]; p.ln_b = in[17]; p.w_o = in[18]; p.norm2_g = in[19];
    p.w_rg = in[20]; p.b_rg = in[21]; p.w_re = in[22]; p.b_re = in[23]; p.w1 = in[24]; p.w3 = in[25]; p.w2 = in[26]; p.final_g = in[27];
    p.out = (float*)d_out; p.ws = (unsigned char*)d_ws;
    (void)hipMemsetAsync((char*)d_ws + WS_CTL, 0, CTL_BYTES, stream);
#if MK_N_LAUNCHES == 1
    hipLaunchKernelGGL(mega_kernel, dim3(grid), dim3(512), LDS_BYTES, stream, p, 0, N_PHASES);
#else
    for (int k = 0; k < N_PHASES; ++k) hipLaunchKernelGGL(mega_kernel, dim3(grid), dim3(512), LDS_BYTES, stream, p, k, k + 1);
#endif
}
```

```cpp
#include <hip/hip_runtime.h>
#include <stdint.h>

#define DEVI __device__ __forceinline__
typedef unsigned short bf16_t;
typedef short bf16x8 __attribute__((ext_vector_type(8)));
typedef float f32x4 __attribute__((ext_vector_type(4)));
typedef float f32x16 __attribute__((ext_vector_type(16)));
typedef float f32x2_t __attribute__((ext_vector_type(2)));
typedef __bf16 bf16x2_t __attribute__((ext_vector_type(2)));

constexpr int NTOK = 8192, DM = 2048, SEQ = 4096, INC = 4640, RW = 1024;
constexpr int ZC_K = 1024, ZC_V = 1152, ZC_RW = 1280;
constexpr int NEXP = 64, FF = 512, LCAP = 8192;
constexpr int NKS = 16;

constexpr size_t MiB = 1u << 20;
constexpr size_t WS_CTL = 0, CTL_BYTES = 98304;
constexpr int CNT_OFF = 32768, CNT_ST = 256;
constexpr size_t WS_PART = 1 * MiB;
constexpr size_t WS_MODF = 3 * MiB;
constexpr size_t WS_ROPE = 4 * MiB;
constexpr size_t WS_WRF = 5 * MiB;
constexpr size_t WS_CB = 7 * MiB;
constexpr size_t WS_AS2 = 7 * MiB + 4096;
constexpr size_t WS_H = 8 * MiB;
constexpr size_t WS_Z = 40 * MiB;
constexpr size_t WS_MIX = 116 * MiB;
constexpr size_t WS_X1 = 148 * MiB;
constexpr size_t WS_R = 212 * MiB, WS_DEC = 244 * MiB, WS_K2 = 276 * MiB, WS_V = 308 * MiB, WS_AA = 340 * MiB, WS_BB = 372 * MiB, WS_G = 404 * MiB, WS_Y = 436 * MiB;
constexpr size_t WS_LW = 212 * MiB;
constexpr size_t WS_AV = 244 * MiB;
constexpr size_t WS_GV = 260 * MiB;
constexpr size_t WS_RKS = 468 * MiB;
constexpr size_t WS_LIST = 469 * MiB;
constexpr size_t WS_LWT = 471 * MiB;
constexpr size_t WS_HID = 473 * MiB;
constexpr size_t WS_YB = 490 * MiB;

constexpr size_t WS_WTI = 672 * MiB;
constexpr size_t WS_WTO = 692 * MiB;
constexpr size_t WS_GB = 556 * MiB;
constexpr size_t WS_HB = 572 * MiB;
constexpr size_t WS_Q2 = 604 * MiB;
constexpr size_t WS_Q1 = 636 * MiB;
constexpr size_t WS_S0 = 652 * MiB;

constexpr int LDS_BYTES = 147456;

struct Params {
    const float *x, *c, *w_ada, *b_ada, *norm1_g, *w_in, *mu, *sinks, *w0, *wd_up, *a0, *wa_up, *wg_up, *k_k, *k_a, *r_k, *ln_w, *ln_b, *w_o, *norm2_g,
        *w_rg, *b_rg, *w_re, *b_re, *w1, *w3, *w2, *final_g;
    float* out;
    unsigned char* ws;
};

DEVI unsigned cvtpk(float lo, float hi) { f32x2_t v = {lo, hi}; bf16x2_t b = __builtin_convertvector(v, bf16x2_t); return __builtin_bit_cast(unsigned, b); }
DEVI float bf2f(unsigned h) { return __builtin_bit_cast(float, h << 16); }
DEVI float bflo(unsigned u) { return __builtin_bit_cast(float, u << 16); }
DEVI float bfhi(unsigned u) { return __builtin_bit_cast(float, u & 0xffff0000u); }
DEVI float wave_sum(float v) {
#pragma unroll
    for (int o = 32; o > 0; o >>= 1) v += __shfl_xor(v, o, 64);
    return v;
}
DEVI float sigmoidf_(float x) { return 1.f / (1.f + __expf(-x)); }

#define XB_TMO      128
#define XB_XCNT(j)  (256  + 64 * (j))
#define XB_XSUB(j)  (1280 + 64 * (j))
#define XB_XGEN(j)  (2304 + 64 * (j))
#define XB_TOP      3328
#define XB_TOPGEN   3392
#define XCD_BAR_WORDS 3456
#define XB_SPIN_CAP (1u << 18)
#define LAS __attribute__((address_space(3)))

__device__ __forceinline__ unsigned xb_ld(unsigned* p)              { return __hip_atomic_load(p, __ATOMIC_RELAXED, __HIP_MEMORY_SCOPE_AGENT); }
__device__ __forceinline__ unsigned xb_add(unsigned* p, unsigned v) { return __hip_atomic_fetch_add(p, v, __ATOMIC_RELAXED, __HIP_MEMORY_SCOPE_AGENT); }
__device__ __forceinline__ unsigned xb_xcc_id() { return (unsigned)__builtin_amdgcn_s_getreg((3 << 11) | 20) & 0xFu; }
#define XB_SPIN(cond, bar) do { unsigned _sp = 0; while (cond) { __builtin_amdgcn_s_sleep(1); \
    if ((++_sp & 255u) == 0u) { if (xb_ld(&(bar)[XB_TMO])) break; if (_sp > XB_SPIN_CAP) { atomicAdd(&(bar)[XB_TMO], 1u); break; } } } } while (0)

struct XcdBarrier {
    unsigned* bar; unsigned x;
    volatile LAS unsigned* st;
};

__device__ __forceinline__ XcdBarrier xcd_barrier_post(unsigned* bar, volatile LAS unsigned* st) {
    XcdBarrier b; b.bar = bar; b.x = xb_xcc_id(); b.st = st;
    if (threadIdx.x == 0) (void)xb_add(&bar[XB_XCNT(b.x)], 1u);
    return b;
}
__device__ __forceinline__ void xcd_barrier_complete(unsigned* bar, unsigned x, unsigned& nloc, unsigned& nx) {
    const unsigned G = gridDim.x * gridDim.y * gridDim.z;
    unsigned sum, cnt, mine, sp = 0u;
    for (;;) {
        sum = 0u; cnt = 0u; mine = 0u;
#pragma unroll
        for (unsigned j = 0; j < 16; ++j) { const unsigned c = xb_ld(&bar[XB_XCNT(j)]); sum += c; cnt += (c > 0u) ? 1u : 0u; mine = (j == x) ? c : mine; }
        if (sum == G) break;
        __builtin_amdgcn_s_sleep(1);
        if ((++sp & 255u) == 0u) { if (xb_ld(&bar[XB_TMO])) break; if (sp > XB_SPIN_CAP) { atomicAdd(&bar[XB_TMO], 1u); break; } }
    }
    nloc = mine > 0u ? mine : 1u; nx = cnt > 0u ? cnt : 1u;
}

__device__ __forceinline__ void xcd_barrier(const XcdBarrier& b) {
    asm volatile("s_waitcnt vmcnt(0)" ::: "memory");
    __syncthreads();
    if (threadIdx.x == 0) {
        unsigned* bar = b.bar;
        __builtin_amdgcn_s_waitcnt(0);
        unsigned nloc = b.st[0], nx = b.st[1];
        if (nloc == 0u) { xcd_barrier_complete(bar, b.x, nloc, nx); b.st[0] = nloc; b.st[1] = nx; }
        const unsigned old = xb_add(&bar[XB_XSUB(b.x)], 1u);
        const unsigned gen = old / nloc;
        if (old + 1u == (gen + 1u) * nloc) {
            __builtin_amdgcn_fence(__ATOMIC_RELEASE, "agent");
            asm volatile("s_waitcnt vmcnt(0)" ::: "memory");
            const unsigned og = xb_add(&bar[XB_TOP], 1u);
            const unsigned tg = og / nx;
            if (og + 1u == (tg + 1u) * nx) xb_add(&bar[XB_TOPGEN], 1u);
            else XB_SPIN(xb_ld(&bar[XB_TOPGEN]) == tg, bar);
            __builtin_amdgcn_fence(__ATOMIC_ACQUIRE, "agent");
            xb_add(&bar[XB_XGEN(b.x)], 1u);
            asm volatile("s_waitcnt vmcnt(0)" ::: "memory");
        } else {
            XB_SPIN(xb_ld(&bar[XB_XGEN(b.x)]) == gen, bar);
            __builtin_amdgcn_fence(__ATOMIC_ACQUIRE, "agent");
            asm volatile("s_waitcnt vmcnt(0)" ::: "memory");
        }
    }
    __syncthreads();
}

template <int PF, int R, class ALoad, class Epi>
DEVI void gemm_tile_f(char* smem, int nk, long ldb, const float* bp0, const float* bp1, ALoad&& aload, Epi&& epi) {
    static_assert(R > PF && (R % 2) == 0, "ring");
    const int tid = threadIdx.x, lane = tid & 63, li = lane & 15, lg = lane >> 4;
    const int sr = tid >> 2, scn = tid & 3;
    const unsigned aw0 = sr * 64 + ((scn ^ ((0 - (sr >> 2)) & 3)) << 4), aw1 = aw0 + 128 * 64;
    const unsigned ar = li * 64 + ((lg ^ ((0 - (li >> 2)) & 3)) << 4);
    float breg[R][2][8];
    f32x4 acc[16][2];
#pragma unroll
    for (int m = 0; m < 16; ++m) { acc[m][0] = f32x4{0.f, 0.f, 0.f, 0.f}; acc[m][1] = f32x4{0.f, 0.f, 0.f, 0.f}; }
    uint4 areg0 = aload(0, 0), areg1 = aload(1, 0);
#pragma unroll
    for (int s = 0; s < PF; ++s) {
        if (s < nk) {
#pragma unroll
            for (int j = 0; j < 8; ++j) { breg[s][0][j] = bp0[(long)(s * 32 + j) * ldb]; breg[s][1][j] = bp1[(long)(s * 32 + j) * ldb]; }
        }
    }
    *(uint4*)(smem + aw0) = areg0; *(uint4*)(smem + aw1) = areg1;
    __syncthreads();
    for (int kt0 = 0; kt0 < nk; kt0 += R) {
#pragma unroll
        for (int u = 0; u < R; ++u) {
            const int kt = kt0 + u;
            if (kt < nk) {
                if (kt + 1 < nk) { areg0 = aload(0, kt + 1); areg1 = aload(1, kt + 1); }
                if (kt + PF < nk) {
                    const float* q0 = bp0 + (long)(kt + PF) * 32 * ldb; const float* q1 = bp1 + (long)(kt + PF) * 32 * ldb;
#pragma unroll
                    for (int j = 0; j < 8; ++j) { breg[(u + PF) % R][0][j] = q0[(long)j * ldb]; breg[(u + PF) % R][1][j] = q1[(long)j * ldb]; }
                }
                __builtin_amdgcn_sched_barrier(0);
                uint4 b0, b1;
                b0.x = cvtpk(breg[u][0][0], breg[u][0][1]); b0.y = cvtpk(breg[u][0][2], breg[u][0][3]); b0.z = cvtpk(breg[u][0][4], breg[u][0][5]); b0.w = cvtpk(breg[u][0][6], breg[u][0][7]);
                b1.x = cvtpk(breg[u][1][0], breg[u][1][1]); b1.y = cvtpk(breg[u][1][2], breg[u][1][3]); b1.z = cvtpk(breg[u][1][4], breg[u][1][5]); b1.w = cvtpk(breg[u][1][6], breg[u][1][7]);
                const bf16x8 bf0 = __builtin_bit_cast(bf16x8, b0), bf1 = __builtin_bit_cast(bf16x8, b1);
                const char* As = smem + (u & 1) * 16384 + ar;
#pragma unroll
                for (int mb = 0; mb < 16; mb += 4) {
                    bf16x8 af[4];
#pragma unroll
                    for (int m = 0; m < 4; ++m) af[m] = *(const bf16x8*)(As + (mb + m) * 1024);
                    __builtin_amdgcn_sched_barrier(0);
#pragma unroll
                    for (int m = 0; m < 4; ++m) {
                        acc[mb + m][0] = __builtin_amdgcn_mfma_f32_16x16x32_bf16(bf0, af[m], acc[mb + m][0], 0, 0, 0);
                        acc[mb + m][1] = __builtin_amdgcn_mfma_f32_16x16x32_bf16(bf1, af[m], acc[mb + m][1], 0, 0, 0);
                    }
                    __builtin_amdgcn_sched_barrier(0);
                }
                if (kt + 1 < nk) { char* Aw = smem + ((u + 1) & 1) * 16384; *(uint4*)(Aw + aw0) = areg0; *(uint4*)(Aw + aw1) = areg1; }
                __syncthreads();
            }
        }
    }
    epi(acc);
}
template <int PF, int R, class Epi>
DEVI void gemm_tile(char* smem, int nk, long ldb, const float* bp0, const float* bp1, const bf16_t* ap0, const bf16_t* ap1, Epi&& epi) {
    gemm_tile_f<PF, R>(smem, nk, ldb, bp0, bp1, [&](int i, int kt) { return *(const uint4*)((i ? ap1 : ap0) + kt * 32); }, epi);
}

namespace pg8 {
#define PG8_LAS __attribute__((address_space(3)))
typedef unsigned short bf16_t;
typedef short bf16x8 __attribute__((ext_vector_type(8)));
typedef float f32x4 __attribute__((ext_vector_type(4)));
typedef unsigned u32x4 __attribute__((ext_vector_type(4)));
constexpr int BM = 256, BK = 64, HALF = 128, HTB = HALF * BK * 2  , STAGE_BYTES = 8 * HTB, NXCD = 8, WGM = 8;

__host__ __device__ __forceinline__ int lds_byte(int r, int c) { const int st = (r >> 4) * 2 + (c >> 5), rr = r & 15, cc = c & 31, ob = rr * 64 + cc * 2; return st * 1024 + (ob ^ (((ob >> 9) & 1) << 5)); }
__host__ __device__ __forceinline__ void stage_rc(int b, int& R, int& C) { const int st = b / 1024, sb = b % 1024, swz = sb ^ (((sb >> 9) & 1) << 5); R = (st >> 1) * 16 + swz / 64; C = (st & 1) * 32 + (swz % 64) / 2; }
__host__ __device__ __forceinline__ int perm32(int rho) { const int n = rho >> 4, i = rho & 15; return 8 * (i >> 2) + 4 * n + (i & 3); }

struct Unit { int pm, pn; };
struct Gemm { const bf16_t* A; const bf16_t* Bt; int M, N, K; };

struct StaticOrder {
    int nM, nN, nwg, G, c;
    __host__ __device__ void init(int M, int N, int G_, int c_) { nM = M / BM; nN = N / BM; nwg = nM * nN; G = G_; c = c_; }
    __host__ __device__ bool next(int i, Unit& u) const {
        const long L = (long)i * G + c; if (L >= nwg) return false;
        int wgid = (int)L; { const int q = nwg / NXCD, r = nwg % NXCD, xcd = wgid % NXCD, off = wgid / NXCD; wgid = (xcd < r ? xcd * (q + 1) : r * (q + 1) + (xcd - r) * q) + off; }
        const int nig = WGM * nN, gid = wgid / nig, fm = gid * WGM, gsz = (nM - fm) < WGM ? (nM - fm) : WGM;
        u.pm = fm + ((wgid % nig) % gsz); u.pn = (wgid % nig) / gsz; return true;
    }
    __device__ __forceinline__ void a_ready(const Unit&) const {}
    __device__ __forceinline__ void done(const Unit&) const {}
};


__device__ __forceinline__ unsigned cvt_pk_bf16(float lo, float hi) { unsigned r; asm volatile("v_cvt_pk_bf16_f32 %0, %1, %2" : "=v"(r) : "v"(lo), "v"(hi)); return r; }
struct EpiZ {
    static constexpr bool PERM = true, AFTER_DRAIN = false;
    bf16_t* O; int ldc; int ncols;
    __device__ __forceinline__ void operator()(const f32x4 (&acc)[2][2][4][2], const Unit& u, int wr, int wc, int fr, int fq) const {
        const int row0 = u.pm * BM + wr * 64 + fr, col0 = u.pn * BM + wc * 32 + 8 * fq;
#pragma unroll
        for (int ai = 0; ai < 2; ++ai)
#pragma unroll
            for (int m = 0; m < 4; ++m) { bf16_t* rowp = O + (size_t)(row0 + ai * HALF + m * 16) * ldc;
#pragma unroll
                for (int bj = 0; bj < 2; ++bj) { const int col = col0 + bj * HALF;
                    if (col < ncols) { const f32x4 v0 = acc[ai][bj][m][0], v1 = acc[ai][bj][m][1];
                        u32x4 w; w.x = cvt_pk_bf16(v0[0], v0[1]); w.y = cvt_pk_bf16(v0[2], v0[3]); w.z = cvt_pk_bf16(v1[0], v1[1]); w.w = cvt_pk_bf16(v1[2], v1[3]);
                        *(u32x4*)(rowp + col) = w; } } }
    }
};
struct EpiX1 {
    static constexpr bool PERM = true, AFTER_DRAIN = false;
    float* O; const float* res; const float* gate; int ldc; int gate_stride; int rows_per_batch;
    __device__ __forceinline__ void operator()(const f32x4 (&acc)[2][2][4][2], const Unit& u, int wr, int wc, int fr, int fq) const {
        const int row0 = u.pm * BM + wr * 64 + fr, col0 = u.pn * BM + wc * 32 + 8 * fq;
        const float* gp = gate + (size_t)((u.pm * BM) / rows_per_batch) * gate_stride;
#pragma unroll
        for (int bj = 0; bj < 2; ++bj) { const int col = col0 + bj * HALF;
            const f32x4 g0 = *(const f32x4*)(gp + col), g1 = *(const f32x4*)(gp + col + 4);
#pragma unroll
            for (int ai = 0; ai < 2; ++ai)
#pragma unroll
                for (int m = 0; m < 4; ++m) { const size_t o = (size_t)(row0 + ai * HALF + m * 16) * ldc + col;
                    const f32x4 x0 = *(const f32x4*)(res + o), x1 = *(const f32x4*)(res + o + 4);
                    *(f32x4*)(O + o) = x0 + g0 * acc[ai][bj][m][0]; *(f32x4*)(O + o + 4) = x1 + g1 * acc[ai][bj][m][1]; } }
    }
};
template <class Epi, class Sched, bool ALIGN_EPI = false, bool SP2 = false>
__device__ __forceinline__ void gemm_phase(PG8_LAS unsigned char* lds, const Gemm g, const Sched& S, const Epi& E) {
    const int tid = threadIdx.x, wid = __builtin_amdgcn_readfirstlane(tid >> 6), lane = tid & 63, wr = wid >> 2, wc = wid & 3, fr = lane & 15, fq = lane >> 4;
    const int K = g.K, nt = K / BK;
    unsigned voffA[2], voffB[2];
#pragma unroll
    for (int i = 0; i < 2; ++i) { int R, C; stage_rc(tid * 16 + i * 8192, R, C); const int Rb = Epi::PERM ? ((R & ~31) + perm32(R & 31)) : R;
        voffA[i] = (unsigned)(R * K + C) * 2u; voffB[i] = (unsigned)(Rb * K + C) * 2u; }
    const size_t kstep = (size_t)(BK * 2);
    const size_t hstep = (size_t)HALF * K * 2;
    const size_t tstep = 2 * hstep;
    const unsigned ldsw = (unsigned)wid * 1024u;
    const int aoff = lds_byte(wr * 64 + fr, fq * 8), boff = lds_byte(wc * 32 + fr, fq * 8);
#define PG8_SA(b, h) (((b) * 2 + (h)) * HTB)
#define PG8_SB(b, h) ((4 + (b) * 2 + (h)) * HTB)
#define PG8_STAGE(bufoff, gbase, voff) do { _Pragma("unroll") for (int _i = 0; _i < 2; ++_i) \
        __builtin_amdgcn_global_load_lds((const unsigned*)((const char*)(gbase) + (voff)[_i]), (PG8_LAS unsigned*)(lds + (bufoff) + ldsw + _i * 8192), 16, 0, 0); } while (0)
#define PG8_LDA(dst, b, h) do { _Pragma("unroll") for (int m = 0; m < 4; ++m) _Pragma("unroll") for (int k = 0; k < 2; ++k) dst[m][k] = *(const PG8_LAS bf16x8*)(lds + PG8_SA(b, h) + aoff + m * 2048 + k * 1024); } while (0)
#define PG8_LDB(dst, b, h) do { _Pragma("unroll") for (int n = 0; n < 2; ++n) _Pragma("unroll") for (int k = 0; k < 2; ++k) dst[n][k] = *(const PG8_LAS bf16x8*)(lds + PG8_SB(b, h) + boff + n * 2048 + k * 1024); } while (0)
#define PG8_MMA(ai, bj, At, Bt) do { __builtin_amdgcn_s_setprio(1); _Pragma("unroll") for (int m = 0; m < 4; ++m) _Pragma("unroll") for (int n = 0; n < 2; ++n) _Pragma("unroll") for (int k = 0; k < 2; ++k) \
        acc[ai][bj][m][n] = __builtin_amdgcn_mfma_f32_16x16x32_bf16(Bt[n][k], At[m][k], acc[ai][bj][m][n], 0, 0, 0); __builtin_amdgcn_s_setprio(0); } while (0)
#define PG8_WAIT_V(n) asm volatile("s_waitcnt vmcnt(" #n ")" ::: "memory")
#define PG8_WAIT_L(n) asm volatile("s_waitcnt lgkmcnt(" #n ")" ::: "memory")
#define PG8_BAR __builtin_amdgcn_s_barrier()
#define PG8_SCHED __builtin_amdgcn_sched_barrier(0)
    Unit cur, nxt; int ui = 0;
    if (!S.next(0, cur)) return;
    f32x4 acc[2][2][4][2];
#pragma unroll
    for (int a = 0; a < 2; ++a)
#pragma unroll
        for (int b = 0; b < 2; ++b)
#pragma unroll
            for (int m = 0; m < 4; ++m)
#pragma unroll
                for (int n = 0; n < 2; ++n) acc[a][b][m][n] = (f32x4){0.f, 0.f, 0.f, 0.f};
    bf16x8 At[4][2], B0[2][2], B1[2][2];
    const char* cA = (const char*)g.A + (size_t)cur.pm * tstep; const char* cB = (const char*)g.Bt + (size_t)cur.pn * tstep;
    S.a_ready(cur);
    if constexpr (SP2) {
        PG8_STAGE(PG8_SB(0, 0), cB, voffB); PG8_STAGE(PG8_SB(0, 1), cB + hstep, voffB); PG8_STAGE(PG8_SA(0, 0), cA, voffA); PG8_STAGE(PG8_SA(0, 1), cA + hstep, voffA);
        if (wr == 1) PG8_BAR;
        PG8_WAIT_V(2); PG8_BAR;
        PG8_STAGE(PG8_SB(1, 0), cB + kstep, voffB); PG8_STAGE(PG8_SA(1, 0), cA + kstep, voffA); PG8_STAGE(PG8_SB(1, 1), cB + hstep + kstep, voffB);
        PG8_WAIT_V(6); PG8_BAR;
    } else {
        PG8_STAGE(PG8_SB(0, 0), cB, voffB); PG8_STAGE(PG8_SA(0, 0), cA, voffA); PG8_STAGE(PG8_SB(0, 1), cB + hstep, voffB); PG8_STAGE(PG8_SA(0, 1), cA + hstep, voffA);
        if (wr == 1) PG8_BAR;
        PG8_WAIT_V(4); PG8_BAR;
        PG8_STAGE(PG8_SB(1, 0), cB + kstep, voffB); PG8_STAGE(PG8_SA(1, 0), cA + kstep, voffA); PG8_STAGE(PG8_SB(1, 1), cB + hstep + kstep, voffB);
        PG8_WAIT_V(6); PG8_BAR;
    }
    for (;;) {
        const bool has_next = S.next(ui + 1, nxt);
        const char* nA = has_next ? (const char*)g.A + (size_t)nxt.pm * tstep : cA; const char* nB = has_next ? (const char*)g.Bt + (size_t)nxt.pn * tstep : cB;
        for (int t = 0; t < nt; t += 2) {
            const bool last = (t == nt - 2);
            const char* a1 = cA + (size_t)(t + 1) * kstep;
            const char* a2 = last ? nA : cA + (size_t)(t + 2) * kstep; const char* b2 = last ? nB : cB + (size_t)(t + 2) * kstep;
            const char* a3 = a2 + kstep; const char* b3 = b2 + kstep;
            if (last && has_next) S.a_ready(nxt);
            if constexpr (SP2) {
            PG8_LDB(B0, 0, 0); PG8_LDB(B1, 0, 1); PG8_SCHED; PG8_LDA(At, 0, 0); PG8_STAGE(PG8_SA(1, 1), a1 + hstep, voffA);
            PG8_WAIT_V(8); PG8_WAIT_L(0); PG8_BAR; PG8_MMA(0, 0, At, B0); PG8_MMA(0, 1, At, B1); PG8_BAR; PG8_SCHED;
            PG8_LDA(At, 0, 1); PG8_STAGE(PG8_SB(0, 0), b2, voffB); PG8_STAGE(PG8_SB(0, 1), b2 + hstep, voffB); PG8_STAGE(PG8_SA(0, 0), a2, voffA);
            PG8_WAIT_V(8); PG8_WAIT_L(0); PG8_BAR; PG8_MMA(1, 0, At, B0); PG8_MMA(1, 1, At, B1); PG8_BAR; PG8_SCHED;
            PG8_LDB(B0, 1, 0); PG8_LDB(B1, 1, 1); PG8_SCHED; PG8_LDA(At, 1, 0); PG8_STAGE(PG8_SA(0, 1), a2 + hstep, voffA);
            PG8_WAIT_V(8); PG8_WAIT_L(0); PG8_BAR; PG8_MMA(0, 0, At, B0); PG8_MMA(0, 1, At, B1); PG8_BAR; PG8_SCHED;
            PG8_LDA(At, 1, 1); PG8_STAGE(PG8_SB(1, 0), b3, voffB); PG8_STAGE(PG8_SB(1, 1), b3 + hstep, voffB); PG8_STAGE(PG8_SA(1, 0), a3, voffA);
            PG8_WAIT_V(8); PG8_WAIT_L(0); PG8_BAR; PG8_MMA(1, 0, At, B0); PG8_MMA(1, 1, At, B1); PG8_BAR; PG8_SCHED;
            } else {
            PG8_LDB(B0, 0, 0); PG8_SCHED; PG8_LDA(At, 0, 0); PG8_STAGE(PG8_SA(1, 1), a1 + hstep, voffA);
            PG8_WAIT_L(8); PG8_BAR; PG8_WAIT_L(0); PG8_MMA(0, 0, At, B0); PG8_BAR; PG8_SCHED;
            PG8_LDB(B1, 0, 1); PG8_STAGE(PG8_SB(0, 0), b2, voffB);
            PG8_BAR; PG8_WAIT_L(0); PG8_MMA(0, 1, At, B1); PG8_BAR;
            PG8_LDA(At, 0, 1); PG8_STAGE(PG8_SA(0, 0), a2, voffA);
            PG8_BAR; PG8_WAIT_L(0); PG8_MMA(1, 0, At, B0); PG8_BAR; PG8_SCHED;
            PG8_STAGE(PG8_SB(0, 1), b2 + hstep, voffB);
            PG8_WAIT_V(6); PG8_BAR; PG8_MMA(1, 1, At, B1); PG8_BAR;
            PG8_LDB(B0, 1, 0); PG8_SCHED; PG8_LDA(At, 1, 0); PG8_STAGE(PG8_SA(0, 1), a2 + hstep, voffA);
            PG8_WAIT_L(8); PG8_BAR; PG8_WAIT_L(0); PG8_MMA(0, 0, At, B0); PG8_BAR; PG8_SCHED;
            PG8_LDB(B1, 1, 1); PG8_STAGE(PG8_SB(1, 0), b3, voffB);
            PG8_BAR; PG8_WAIT_L(0); PG8_MMA(0, 1, At, B1); PG8_BAR;
            PG8_LDA(At, 1, 1); PG8_STAGE(PG8_SA(1, 0), a3, voffA);
            PG8_BAR; PG8_WAIT_L(0); PG8_MMA(1, 0, At, B0); PG8_BAR; PG8_SCHED;
            PG8_STAGE(PG8_SB(1, 1), b3 + hstep, voffB);
            PG8_WAIT_V(6); PG8_BAR; PG8_MMA(1, 1, At, B1); PG8_BAR;
            }
        }
        if constexpr (ALIGN_EPI) { if (wr == 0) PG8_BAR; }
        if constexpr (!Epi::AFTER_DRAIN) { E(acc, cur, wr, wc, fr, fq); S.done(cur); }
        if (!has_next) break;
#pragma unroll
        for (int a = 0; a < 2; ++a)
#pragma unroll
            for (int b = 0; b < 2; ++b)
#pragma unroll
                for (int m = 0; m < 4; ++m)
#pragma unroll
                    for (int n = 0; n < 2; ++n) acc[a][b][m][n] = (f32x4){0.f, 0.f, 0.f, 0.f};
        cur = nxt; cA = nA; cB = nB; ++ui;
        if constexpr (ALIGN_EPI) { if (wr == 1) PG8_BAR; }
    }
    PG8_WAIT_V(0);
    if constexpr (!ALIGN_EPI) { if (wr == 0) PG8_BAR; }
    PG8_BAR;
    if constexpr (Epi::AFTER_DRAIN) { E.fused(acc, cur, wr, wc, fr, fq, lds, wid, lane); S.done(cur); }
#undef PG8_SA
#undef PG8_SB
#undef PG8_STAGE
#undef PG8_LDA
#undef PG8_LDB
#undef PG8_MMA
#undef PG8_WAIT_V
#undef PG8_WAIT_L
#undef PG8_BAR
#undef PG8_SCHED
}
}

DEVI void ada_unit(const Params& p, char* smem, int cb, int ks) {
    float* sl = (float*)smem;
    float* part = (float*)(p.ws + WS_PART);
    const int tid = threadIdx.x;
    __syncthreads();
    if (tid < 256) { const int b = tid >> 7, kk = tid & 127; const float cv = p.c[b * DM + ks * 128 + kk]; sl[b * 128 + kk] = cv / (1.f + expf(-cv)); }
    __syncthreads();
    const int j = cb * 512 + tid;
    const float* w = p.w_ada + (size_t)(ks * 128) * 12288 + j;
    float a0 = 0.f, a1 = 0.f;
#pragma unroll 16
    for (int kk = 0; kk < 128; ++kk) { const float wv = w[(size_t)kk * 12288]; a0 += sl[kk] * wv; a1 += sl[128 + kk] * wv; }
    part[(ks * 2 + 0) * 12288 + j] = a0; part[(ks * 2 + 1) * 12288 + j] = a1;
}
DEVI void ada_unit_h(const Params& p, char* smem, int cb, int ks) {
    float* sl = (float*)smem;
    float* part = (float*)(p.ws + WS_PART);
    const int tid = threadIdx.x, hf = tid >> 8, t = tid & 255;
    __syncthreads();
    if (tid < 256) { const int b = tid >> 7, kk = tid & 127; const float cv = p.c[b * DM + ks * 128 + kk]; sl[b * 128 + kk] = cv / (1.f + expf(-cv)); }
    __syncthreads();
    const int j = cb * 256 + t;
    const float* w = p.w_ada + (size_t)(ks * 128 + hf * 64) * 12288 + j;
    const float* s0 = sl + hf * 64;
    float a0 = 0.f, a1 = 0.f;
#pragma unroll 16
    for (int kk = 0; kk < 64; ++kk) { const float wv = w[(size_t)kk * 12288]; a0 += s0[kk] * wv; a1 += s0[128 + kk] * wv; }
    if (hf) { sl[256 + t] = a0; sl[512 + t] = a1; }
    __syncthreads();
    if (!hf) { part[(ks * 2 + 0) * 12288 + j] = a0 + sl[256 + t]; part[(ks * 2 + 1) * 12288 + j] = a1 + sl[512 + t]; }
}
DEVI void transpose_item(const float* W, int N, bf16_t* WT, int r, char* smem) {
    const int lane = threadIdx.x & 63, wave = threadIdx.x >> 6;
    float* scr = (float*)(smem + 4096) + wave * (64 * 33);
    const int nblk = N / 32, kb = r / nblk, nb = r % nblk, k0 = 64 * kb, n0 = 32 * nb;
    {
        float4 t[8];
#pragma unroll
        for (int i = 0; i < 8; ++i) t[i] = *(const float4*)(W + (size_t)(k0 + (lane >> 3) + 8 * i) * N + n0 + 4 * (lane & 7));
#pragma unroll
        for (int i = 0; i < 8; ++i) { float* d = scr + ((lane >> 3) + 8 * i) * 33 + 4 * (lane & 7); d[0] = t[i].x; d[1] = t[i].y; d[2] = t[i].z; d[3] = t[i].w; }
    }
    const int c = lane & 7;
#pragma unroll
    for (int j = 0; j < 4; ++j) { const int n = (lane >> 3) + 8 * j; const float* sp = scr + (8 * c) * 33 + n;
        uint4 o; o.x = cvtpk(sp[0 * 33], sp[1 * 33]); o.y = cvtpk(sp[2 * 33], sp[3 * 33]); o.z = cvtpk(sp[4 * 33], sp[5 * 33]); o.w = cvtpk(sp[6 * 33], sp[7 * 33]);
        *(uint4*)(WT + (size_t)(n0 + n) * DM + k0 + 8 * c) = o; }
}
DEVI void phase0(const Params& p, char* smem) {
    float* rope = (float*)(p.ws + WS_ROPE);
    const int tid = threadIdx.x, lane = tid & 63, wave = tid >> 6;
    constexpr int N_ADA = 16 * NKS, N_ROPE = 256;
    for (int u = blockIdx.x; u < N_ADA + N_ROPE; u += gridDim.x) {
        if (u < N_ADA) {
            ada_unit_h(p, smem, u & 15, u >> 4);
        } else {
            const int idx = (u - N_ADA) * 512 + tid;
            const int t = idx >> 5, i = idx & 31;
            const double invf = exp(-(double)(2 * i) / 64.0 * 9.210340371976184);
            const double ang = (double)t * invf;
            rope[idx] = (float)cos(ang); rope[SEQ * 32 + idx] = (float)sin(ang);
        }
    }
    __syncthreads();
    {
        bf16_t* wti = (bf16_t*)(p.ws + WS_WTI);
        constexpr int I_IN = 32 * (INC / 32), I_Z = (4864 - INC) * DM / 8 / 64;
        for (int it = blockIdx.x * 8 + wave; it < I_IN + I_Z; it += gridDim.x * 8) {
            if (it >= I_IN) { const size_t o = (size_t)INC * DM + ((size_t)(it - I_IN) * 64 + lane) * 8; *(uint4*)(wti + o) = make_uint4(0u, 0u, 0u, 0u); continue; }
            transpose_item(p.w_in, INC, wti, it, smem);
        }
    }
}

DEVI float mod_from_part(const Params& p, int b, int j) {
    const float* part = (const float*)(p.ws + WS_PART);
    float s = p.b_ada[j];
#pragma unroll
    for (int ks = 0; ks < NKS; ++ks) s += part[(ks * 2 + b) * 12288 + j];
    return s;
}

constexpr int N_MODF = 48, N_WRF = 128, N_CB = 2, N_AS2 = 8, N_SPEC = N_WRF + N_CB + N_AS2 + N_MODF;
DEVI void spec_unit(const Params& p, char* smem, int v) {
    float* A1 = (float*)smem;
    const int tid = threadIdx.x, lane = tid & 63, wave = tid >> 6;
    if (v >= N_CB + N_WRF + N_AS2) {
        const int idx = (v - (N_CB + N_WRF + N_AS2)) * 512 + tid; const int b = idx / 12288, j = idx % 12288;
        ((float*)(p.ws + WS_MODF))[idx] = mod_from_part(p, b, j);
    } else {
            if (v < N_CB) {
                const int b = v;
                float* sh2 = A1 + 4 * DM;
                float* red = sh2 + DM;
                __syncthreads();
                for (int k = tid; k < DM; k += 512) sh2[k] = mod_from_part(p, b, 3 * DM + k);
                __syncthreads();
                float ae = 0.f, ag = 0.f;
#pragma unroll 16
                for (int kk = 0; kk < 256; ++kk) { const int k = wave * 256 + kk; const float sv = sh2[k]; ae += sv * p.w_re[k * 64 + lane]; ag += sv * p.w_rg[k * 8 + (lane & 7)]; }
                red[wave * 80 + lane] = ae; if (lane < 8) red[wave * 80 + 64 + lane] = ag;
                __syncthreads();
                if (tid < 80) {
                    float r = 0.f;
                    if (tid < 72) {
#pragma unroll
                        for (int w = 0; w < 8; ++w) r += red[w * 80 + tid];
                        r += (tid < 64 ? p.b_re[tid] : p.b_rg[tid - 64]);
                    }
                    ((float*)(p.ws + WS_CB))[b * 80 + tid] = r;
                }
            } else if (v < N_CB + N_WRF) {
                const int vv = v - N_CB, b = vv >> 6, ks = vv & 63, ln = tid & 63, e = tid >> 6;
                const int k = ks * 32 + 8 * (ln >> 4) + e;
                const float a2 = p.norm2_g[k] * (1.f + mod_from_part(p, b, 4 * DM + k));
                bf16_t* wrf = (bf16_t*)(p.ws + WS_WRF);
#pragma unroll
                for (int nf = 0; nf < 5; ++nf) {
                    const int j = nf * 16 + (ln & 15);
                    const float wv = j < 64 ? p.w_re[k * 64 + j] : (j < 72 ? p.w_rg[k * 8 + (j - 64)] : 0.f);
                    const float val = a2 * wv;
                    const unsigned hi = cvtpk(val, 0.f) & 0xffffu;
                    const unsigned lo = cvtpk(val - bf2f(hi), 0.f) & 0xffffu;
                    const size_t base = ((((size_t)(b * 64 + ks) * 5 + nf) * 2) * 64 + ln) * 8 + e;
                    wrf[base] = (bf16_t)hi; wrf[base + 512] = (bf16_t)lo;
                }
            } else {
                const int idx = (v - N_WRF - N_CB) * 512 + tid, b = idx >> 11, k = idx & 2047;
                float* as2 = (float*)(p.ws + WS_AS2);
                as2[idx] = p.norm2_g[k] * (1.f + mod_from_part(p, b, 4 * DM + k));
                as2[2 * DM + idx] = mod_from_part(p, b, 3 * DM + k);
            }
    }
}

DEVI void phase1(const Params& p, char* smem) {
    float* A1 = (float*)smem;
    float* S1 = A1 + 2 * DM;
    float* modf = (float*)(p.ws + WS_MODF);
    bf16_t* h = (bf16_t*)(p.ws + WS_H);
    const int tid = threadIdx.x, lane = tid & 63, wave = tid >> 6;
    constexpr int N_ROWS = NTOK / 8;
    const int upw = (N_ROWS + (int)gridDim.x - 1) / (int)gridDim.x, u_lo = (int)blockIdx.x * upw, u_hi = (u_lo + upw < N_ROWS) ? u_lo + upw : N_ROWS;
    const int b_lo = (u_lo * 8) >> 12, b_hi = u_hi > u_lo ? ((u_hi * 8 - 1) >> 12) : b_lo;
    for (int idx = tid; idx < 2 * DM; idx += 512) {
        const int b = idx >> 11, k = idx & 2047;
        if (b >= b_lo && b <= b_hi) {
            const float sh = mod_from_part(p, b, k), sc = mod_from_part(p, b, DM + k);
            A1[idx] = p.norm1_g[k] * (1.f + sc); S1[idx] = sh;
        }
    }
    __syncthreads();
    for (int u = u_lo; u < u_hi; ++u) {
        {
            const int row = u * 8 + wave, b = row >> 12;
            const float* xr = p.x + (size_t)row * DM;
            float4 v[8]; float ss = 0.f;
#pragma unroll
            for (int i = 0; i < 8; ++i) { v[i] = *(const float4*)(xr + i * 256 + lane * 4); ss += v[i].x * v[i].x + v[i].y * v[i].y + v[i].z * v[i].z + v[i].w * v[i].w; }
            ss = wave_sum(ss);
            const float rstd = rsqrtf(ss * (1.f / DM) + 1e-6f);
#pragma unroll
            for (int i = 0; i < 8; ++i) {
                const int k = i * 256 + lane * 4;
                const float4 a = *(const float4*)(A1 + b * DM + k), s = *(const float4*)(S1 + b * DM + k);
                uint2 o; o.x = cvtpk(v[i].x * rstd * a.x + s.x, v[i].y * rstd * a.y + s.y); o.y = cvtpk(v[i].z * rstd * a.z + s.z, v[i].w * rstd * a.w + s.w);
                *(uint2*)(h + (size_t)row * DM + k) = o;
            }
        }
    }
}

DEVI void phase2(const Params& p, char* smem) {
    pg8::Gemm g{(const pg8::bf16_t*)(p.ws + WS_H), (const pg8::bf16_t*)(p.ws + WS_WTI), NTOK, 4864, DM};
    pg8::StaticOrder S; S.init(NTOK, 4864, (int)gridDim.x, (int)blockIdx.x);
    pg8::EpiZ E{(pg8::bf16_t*)(p.ws + WS_Z), INC, INC};
    pg8::gemm_phase<pg8::EpiZ, pg8::StaticOrder, true, true>((PG8_LAS unsigned char*)smem, g, S, E);
    const int nthird = 608 - 2 * (int)gridDim.x;
    if (gridDim.x == 256 ? (int)blockIdx.x >= nthird : true) {
        const int nw = gridDim.x == 256 ? 256 - nthird : (int)gridDim.x, wi = gridDim.x == 256 ? (int)blockIdx.x - nthird : (int)blockIdx.x;
        __syncthreads();
        for (int u = wi; u < 512; u += nw) {
            if (u < 256) ada_unit(p, smem, 8 + (u & 15), u >> 4);
            else { __syncthreads(); transpose_item(p.w_o, DM, (bf16_t*)(p.ws + WS_WTO), (u - 256) * 8 + (int)(threadIdx.x >> 6), smem); }
        }
    }
}

DEVI float dpp_xor1(float x) { return __builtin_bit_cast(float, __builtin_amdgcn_update_dpp(0, __builtin_bit_cast(int, x), 0xB1, 0xF, 0xF, true)); }
DEVI float dpp_xor2(float x) { return __builtin_bit_cast(float, __builtin_amdgcn_update_dpp(0, __builtin_bit_cast(int, x), 0x4E, 0xF, 0xF, true)); }
DEVI float xor32_sum(float x) {
    float a = x, b = x;
    asm volatile("s_nop 1\n\tv_permlane32_swap_b32 %0, %1\n\ts_nop 1" : "+v"(a), "+v"(b));
    return a + b;
}
DEVI unsigned m64_off(int row, int chunk) { return row * 128 + ((chunk ^ ((row >> 1) & 7)) << 4); }
DEVI void mm_tile(f32x16& acc, const char* X, int xr0, const char* Y, int yr0, int l31, int hh) {
#pragma unroll
    for (int s4 = 0; s4 < 4; ++s4) {
        const bf16x8 a = *(const bf16x8*)(X + m64_off(xr0 + l31, 2 * s4 + hh));
        const bf16x8 b = *(const bf16x8*)(Y + m64_off(yr0 + l31, 2 * s4 + hh));
        acc = __builtin_amdgcn_mfma_f32_32x32x16_bf16(a, b, acc, 0, 0, 0);
    }
}
DEVI f32x16 zero16() { f32x16 z;
#pragma unroll
    for (int i = 0; i < 16; ++i) z[i] = 0.f;
    return z; }


DEVI float tokshift(const bf16_t* z, const float* mu, int tok, int c) {
    const float zc = bf2f(z[(size_t)tok * INC + ZC_RW + c]);
    const float zp = (tok & (SEQ - 1)) ? bf2f(z[(size_t)(tok - 1) * INC + ZC_RW + c]) : 0.f;
    return zc + (zp - zc) * mu[c];
}

DEVI void p3_unit(const Params& p, char* smem, int u) {
    const bf16_t* z = (const bf16_t*)(p.ws + WS_Z);
    bf16_t* mix = (bf16_t*)(p.ws + WS_MIX);
    const float* rope = (const float*)(p.ws + WS_ROPE);
    const int tid = threadIdx.x, lane = tid & 63, wave = tid >> 6;
    constexpr int N_ATT = 256;
    {
        __syncthreads();
        if (u < N_ATT) {
            constexpr int VTS = 392;
            char* Ks = smem;
            char* Vt = smem + 192 * 128;
            const int b = u >> 7, kvh = (u >> 6) & 1, qb = u & 63, t0 = qb * 64, kbase = t0 - 128;
            for (int idx = tid; idx < 192 * 4; idx += 512) {
                const int j = idx >> 2, c = idx & 3, t = kbase + j;
                uint4 o1 = make_uint4(0u, 0u, 0u, 0u), o2 = o1;
                if (t >= 0) {
                    const bf16_t* zr = z + (size_t)(b * SEQ + t) * INC + ZC_K + kvh * 64 + 8 * c;
                    const uint4 ka = *(const uint4*)zr, kb = *(const uint4*)(zr + 32);
                    const float4 c0 = *(const float4*)(rope + t * 32 + 8 * c), c1 = *(const float4*)(rope + t * 32 + 8 * c + 4);
                    const float4 s0 = *(const float4*)(rope + SEQ * 32 + t * 32 + 8 * c), s1 = *(const float4*)(rope + SEQ * 32 + t * 32 + 8 * c + 4);
                    const float a[8] = {bflo(ka.x), bfhi(ka.x), bflo(ka.y), bfhi(ka.y), bflo(ka.z), bfhi(ka.z), bflo(ka.w), bfhi(ka.w)};
                    const float bq[8] = {bflo(kb.x), bfhi(kb.x), bflo(kb.y), bfhi(kb.y), bflo(kb.z), bfhi(kb.z), bflo(kb.w), bfhi(kb.w)};
                    const float cs[8] = {c0.x, c0.y, c0.z, c0.w, c1.x, c1.y, c1.z, c1.w}, sn[8] = {s0.x, s0.y, s0.z, s0.w, s1.x, s1.y, s1.z, s1.w};
                    float r1[8], r2[8];
#pragma unroll
                    for (int e = 0; e < 8; ++e) { r1[e] = a[e] * cs[e] - bq[e] * sn[e]; r2[e] = bq[e] * cs[e] + a[e] * sn[e]; }
                    o1 = make_uint4(cvtpk(r1[0], r1[1]), cvtpk(r1[2], r1[3]), cvtpk(r1[4], r1[5]), cvtpk(r1[6], r1[7]));
                    o2 = make_uint4(cvtpk(r2[0], r2[1]), cvtpk(r2[2], r2[3]), cvtpk(r2[4], r2[5]), cvtpk(r2[6], r2[7]));
                }
                *(uint4*)(Ks + m64_off(j, c)) = o1; *(uint4*)(Ks + m64_off(j, c + 4)) = o2;
            }
            for (int idx = tid; idx < 192 * 8; idx += 512) {
                const int j = idx >> 3, c = idx & 7, t = kbase + j;
                uint4 vv = make_uint4(0u, 0u, 0u, 0u);
                if (t >= 0) vv = *(const uint4*)(z + (size_t)(b * SEQ + t) * INC + ZC_V + kvh * 64 + 8 * c);
                char* vp = Vt + (8 * c) * VTS + j * 2;
                *(bf16_t*)(vp + 0 * VTS) = (bf16_t)(vv.x & 0xffffu); *(bf16_t*)(vp + 1 * VTS) = (bf16_t)(vv.x >> 16);
                *(bf16_t*)(vp + 2 * VTS) = (bf16_t)(vv.y & 0xffffu); *(bf16_t*)(vp + 3 * VTS) = (bf16_t)(vv.y >> 16);
                *(bf16_t*)(vp + 4 * VTS) = (bf16_t)(vv.z & 0xffffu); *(bf16_t*)(vp + 5 * VTS) = (bf16_t)(vv.z >> 16);
                *(bf16_t*)(vp + 6 * VTS) = (bf16_t)(vv.w & 0xffffu); *(bf16_t*)(vp + 7 * VTS) = (bf16_t)(vv.w >> 16);
            }
            __syncthreads();
            const int h = kvh * 8 + wave, l31 = lane & 31, hh = lane >> 5;
            const float sink = p.sinks[h];
#pragma unroll 1
            for (int qt = 0; qt < 2; ++qt) {
                const int T0 = t0 + qt * 32, tq = T0 + l31;
                bf16x8 qf[4];
                {
                    const bf16_t* zr = z + (size_t)(b * SEQ + tq) * INC + h * 64 + 8 * hh;
                    uint4 raw[4];
#pragma unroll
                    for (int s4 = 0; s4 < 4; ++s4) raw[s4] = *(const uint4*)(zr + 16 * s4);
#pragma unroll
                    for (int s2 = 0; s2 < 2; ++s2) {
                        const int d0 = 16 * s2 + 8 * hh;
                        const float4 c0 = *(const float4*)(rope + tq * 32 + d0), c1 = *(const float4*)(rope + tq * 32 + d0 + 4);
                        const float4 s0 = *(const float4*)(rope + SEQ * 32 + tq * 32 + d0), s1 = *(const float4*)(rope + SEQ * 32 + tq * 32 + d0 + 4);
                        const uint4 ua = raw[s2], ub = raw[s2 + 2];
                        const float a[8] = {bflo(ua.x), bfhi(ua.x), bflo(ua.y), bfhi(ua.y), bflo(ua.z), bfhi(ua.z), bflo(ua.w), bfhi(ua.w)};
                        const float bq[8] = {bflo(ub.x), bfhi(ub.x), bflo(ub.y), bfhi(ub.y), bflo(ub.z), bfhi(ub.z), bflo(ub.w), bfhi(ub.w)};
                        const float cs[8] = {c0.x, c0.y, c0.z, c0.w, c1.x, c1.y, c1.z, c1.w}, sn[8] = {s0.x, s0.y, s0.z, s0.w, s1.x, s1.y, s1.z, s1.w};
                        float r1[8], r2[8];
#pragma unroll
                        for (int e = 0; e < 8; ++e) { r1[e] = (a[e] * cs[e] - bq[e] * sn[e]) * 0.125f; r2[e] = (bq[e] * cs[e] + a[e] * sn[e]) * 0.125f; }
                        qf[s2] = __builtin_bit_cast(bf16x8, make_uint4(cvtpk(r1[0], r1[1]), cvtpk(r1[2], r1[3]), cvtpk(r1[4], r1[5]), cvtpk(r1[6], r1[7])));
                        qf[s2 + 2] = __builtin_bit_cast(bf16x8, make_uint4(cvtpk(r2[0], r2[1]), cvtpk(r2[2], r2[3]), cvtpk(r2[4], r2[5]), cvtpk(r2[6], r2[7])));
                    }
                }
                f32x16 sc[5];
#pragma unroll
                for (int kt = 0; kt < 5; ++kt) {
                    sc[kt] = zero16();
                    const int krow = 32 * qt + 32 * kt + l31;
#pragma unroll
                    for (int s4 = 0; s4 < 4; ++s4) {
                        const bf16x8 kf = *(const bf16x8*)(Ks + m64_off(krow, 2 * s4 + hh));
                        sc[kt] = __builtin_amdgcn_mfma_f32_32x32x16_bf16(kf, qf[s4], sc[kt], 0, 0, 0);
                    }
                }
                float mx = -1e30f;
#pragma unroll
                for (int kt = 0; kt < 5; ++kt)
#pragma unroll
                    for (int i = 0; i < 16; ++i) {
                        const int r = (i & 3) + 8 * (i >> 2) + 4 * hh;
                        bool ok = (T0 - 128 + 32 * kt + r) >= 0;
                        if (kt == 0) ok = ok && (r > l31);
                        if (kt == 4) ok = ok && (r <= l31);
                        sc[kt][i] = ok ? sc[kt][i] : -1e30f;
                        mx = fmaxf(mx, sc[kt][i]);
                    }
                {
                    float a = mx, bq = mx;
                    asm volatile("s_nop 1\n\tv_permlane32_swap_b32 %0, %1\n\ts_nop 1" : "+v"(a), "+v"(bq));
                    mx = fmaxf(fmaxf(a, bq), sink);
                }
                float lsum = 0.f;
#pragma unroll
                for (int kt = 0; kt < 5; ++kt)
#pragma unroll
                    for (int i = 0; i < 16; ++i) { const float pe = __expf(sc[kt][i] - mx); sc[kt][i] = pe; lsum += pe; }
                lsum = xor32_sum(lsum) + __expf(sink - mx);
                const float inv = 1.f / lsum;
                f32x16 oacc[2];
                oacc[0] = zero16(); oacc[1] = zero16();
#pragma unroll
                for (int kt = 0; kt < 5; ++kt)
#pragma unroll
                    for (int s2 = 0; s2 < 2; ++s2) {
                        uint4 pb;
                        pb.x = cvtpk(sc[kt][8 * s2 + 0], sc[kt][8 * s2 + 1]); pb.y = cvtpk(sc[kt][8 * s2 + 2], sc[kt][8 * s2 + 3]);
                        pb.z = cvtpk(sc[kt][8 * s2 + 4], sc[kt][8 * s2 + 5]); pb.w = cvtpk(sc[kt][8 * s2 + 6], sc[kt][8 * s2 + 7]);
                        const int kloc = 32 * qt + 32 * kt + 16 * s2 + 4 * hh;
#pragma unroll
                        for (int dt = 0; dt < 2; ++dt) {
                            const char* vp = Vt + (dt * 32 + l31) * VTS + kloc * 2;
                            const uint2 v0 = *(const uint2*)vp, v1 = *(const uint2*)(vp + 16);
                            const bf16x8 vf = __builtin_bit_cast(bf16x8, make_uint4(v0.x, v0.y, v1.x, v1.y));
                            oacc[dt] = __builtin_amdgcn_mfma_f32_32x32x16_bf16(vf, __builtin_bit_cast(bf16x8, pb), oacc[dt], 0, 0, 0);
                        }
                    }
                bf16_t* orow = mix + (size_t)(b * SEQ + tq) * DM + h * 64;
#pragma unroll
                for (int dt = 0; dt < 2; ++dt)
#pragma unroll
                    for (int q = 0; q < 4; ++q) {
                        uint2 o; o.x = cvtpk(oacc[dt][4 * q] * inv, oacc[dt][4 * q + 1] * inv); o.y = cvtpk(oacc[dt][4 * q + 2] * inv, oacc[dt][4 * q + 3] * inv);
                        *(uint2*)(orow + dt * 32 + 8 * q + 4 * hh) = o;
                    }
            }
        } else {
            const int v = u - N_ATT, prod = 2 - (v >> 7), mt = v & 31, nt = (v >> 5) & 3;
            const int row0 = mt * 256, col0 = nt * 256 + wave * 32, li = lane & 15, lg = lane >> 4;
            const int koff = prod == 0 ? 3072 : (prod == 1 ? 3136 : 3200), nk = prod == 2 ? 5 : 2;
            const float* W = prod == 0 ? p.wd_up : (prod == 1 ? p.wa_up : p.wg_up);
            const float* bp0 = W + (size_t)(8 * lg) * RW + col0 + li; const float* bp1 = bp0 + 16;
            const int srow = row0 + (tid >> 2), scol = koff + (tid & 3) * 8;
            auto aload = [&](int i, int kt) -> uint4 {
                const int tok = srow + 128 * i, c = scol + kt * 32;
                const uint4 zc = *(const uint4*)(z + (size_t)tok * INC + ZC_RW + c);
                uint4 zp = make_uint4(0u, 0u, 0u, 0u);
                if (tok & (SEQ - 1)) zp = *(const uint4*)(z + (size_t)(tok - 1) * INC + ZC_RW + c);
                const float4 m0 = *(const float4*)(p.mu + c), m1 = *(const float4*)(p.mu + c + 4);
                const float a[8] = {bflo(zc.x), bfhi(zc.x), bflo(zc.y), bfhi(zc.y), bflo(zc.z), bfhi(zc.z), bflo(zc.w), bfhi(zc.w)};
                const float q[8] = {bflo(zp.x), bfhi(zp.x), bflo(zp.y), bfhi(zp.y), bflo(zp.z), bfhi(zp.z), bflo(zp.w), bfhi(zp.w)};
                const float mm[8] = {m0.x, m0.y, m0.z, m0.w, m1.x, m1.y, m1.z, m1.w};
                float o[8];
#pragma unroll
                for (int e = 0; e < 8; ++e) {
                    const float zs = a[e] + (q[e] - a[e]) * mm[e];
                    o[e] = prod == 0 ? (1.f - 2.f / (1.f + __expf(2.f * zs))) : (prod == 1 ? zs : sigmoidf_(zs));
                }
                return make_uint4(cvtpk(o[0], o[1]), cvtpk(o[2], o[3]), cvtpk(o[4], o[5]), cvtpk(o[6], o[7]));
            };
            float* LWb = (float*)(p.ws + WS_LW); bf16_t* AVb = (bf16_t*)(p.ws + WS_AV); bf16_t* GVb = (bf16_t*)(p.ws + WS_GV);
            gemm_tile_f<1, 2>(smem, nk, RW, bp0, bp1, aload, [&](f32x4 (&acc)[16][2]) {
#pragma unroll
                for (int nf = 0; nf < 2; ++nf) {
                    const int col = col0 + nf * 16 + 4 * lg;
                    const float4 w0c = *(const float4*)(p.w0 + col), a0c = *(const float4*)(p.a0 + col);
                    const float wc[4] = {w0c.x, w0c.y, w0c.z, w0c.w}, ac[4] = {a0c.x, a0c.y, a0c.z, a0c.w};
#pragma unroll
                    for (int m = 0; m < 16; ++m) {
                        const size_t o = (size_t)(row0 + 16 * m + li) * RW + col;
                        if (prod == 0) {
                            float r[4];
#pragma unroll
                            for (int e = 0; e < 4; ++e) r[e] = -0.60653065971f * sigmoidf_(wc[e] + acc[m][nf][e]);
                            *(float4*)(LWb + o) = make_float4(r[0], r[1], r[2], r[3]);
                        } else if (prod == 1) {
                            uint2 ob; ob.x = cvtpk(sigmoidf_(ac[0] + acc[m][nf][0]), sigmoidf_(ac[1] + acc[m][nf][1])); ob.y = cvtpk(sigmoidf_(ac[2] + acc[m][nf][2]), sigmoidf_(ac[3] + acc[m][nf][3]));
                            *(uint2*)(AVb + o) = ob;
                        } else {
                            uint2 ob; ob.x = cvtpk(acc[m][nf][0], acc[m][nf][1]); ob.y = cvtpk(acc[m][nf][2], acc[m][nf][3]);
                            *(uint2*)(GVb + o) = ob;
                        }
                    }
                }
            });
        }
    }
}
DEVI void phase3(const Params& p, char* smem) {
    for (int v = blockIdx.x; v < 384; v += gridDim.x) p3_unit(p, smem, 256 + v);
}

DEVI void phase4(const Params& p, char* smem) {
    const int tid = threadIdx.x, lane = tid & 63, wave = tid >> 6;
    const float* const pAA = (const float*)(p.ws + WS_AA); const float* const pDE = (const float*)(p.ws + WS_DEC); const float* const pBB = (const float*)(p.ws + WS_BB);
    const float* const pK2 = (const float*)(p.ws + WS_K2); const float* const pR = (const float*)(p.ws + WS_R); const float* const pV = (const float*)(p.ws + WS_V);
    float* Y = (float*)(p.ws + WS_Y);
    constexpr int CH = 32;
    float* bufs = (float*)smem;
    for (int u = blockIdx.x; u < 32; u += gridDim.x) {
        const int b = u >> 4, h = u & 15;
        const int vr = lane >> 2, kq = lane & 3;
        float s[16];
#pragma unroll
        for (int j = 0; j < 16; ++j) s[j] = 0.f;
        __syncthreads();
        const int lst = tid >> 4, lc4 = tid & 15;
        const size_t goff = (size_t)(b * SEQ + lst) * RW + h * 64 + lc4 * 4;
        const int loff = lst * 64 + lc4 * 4;
        {
            *(float4*)(bufs + 0 * CH * 64 + loff) = *(const float4*)(pAA + goff); *(float4*)(bufs + 1 * CH * 64 + loff) = *(const float4*)(pDE + goff);
            *(float4*)(bufs + 2 * CH * 64 + loff) = *(const float4*)(pBB + goff); *(float4*)(bufs + 3 * CH * 64 + loff) = *(const float4*)(pK2 + goff);
            *(float4*)(bufs + 4 * CH * 64 + loff) = *(const float4*)(pR + goff); *(float4*)(bufs + 5 * CH * 64 + loff) = *(const float4*)(pV + goff);
        }
        __syncthreads();
        for (int c = 0; c < SEQ / CH; ++c) {
            float* cur = bufs + (c & 1) * (6 * CH * 64);
            float* nxt = bufs + ((c + 1) & 1) * (6 * CH * 64);
            float4 pre0, pre1, pre2, pre3, pre4, pre5;
            if (c + 1 < SEQ / CH) {
                const size_t g2 = goff + (size_t)(c + 1) * CH * RW;
                pre0 = *(const float4*)(pAA + g2); pre1 = *(const float4*)(pDE + g2); pre2 = *(const float4*)(pBB + g2);
                pre3 = *(const float4*)(pK2 + g2); pre4 = *(const float4*)(pR + g2); pre5 = *(const float4*)(pV + g2);
            }
            if (wave < 4) {
                for (int st = 0; st < CH; ++st) {
                    const float* aa = cur + (0 * CH + st) * 64 + kq * 16;
                    const float* de = cur + (1 * CH + st) * 64 + kq * 16;
                    const float* bb = cur + (2 * CH + st) * 64 + kq * 16;
                    const float* k2 = cur + (3 * CH + st) * 64 + kq * 16;
                    const float* rr = cur + (4 * CH + st) * 64 + kq * 16;
                    const float v = cur[(5 * CH + st) * 64 + wave * 16 + vr];
                    float sa = 0.f;
#pragma unroll
                    for (int j = 0; j < 16; ++j) sa += s[j] * aa[j];
                    sa += __shfl_xor(sa, 1, 64); sa += __shfl_xor(sa, 2, 64);
                    float y = 0.f;
#pragma unroll
                    for (int j = 0; j < 16; ++j) { s[j] = s[j] * de[j] + sa * bb[j] + v * k2[j]; y += s[j] * rr[j]; }
                    y += __shfl_xor(y, 1, 64); y += __shfl_xor(y, 2, 64);
                    if (kq == 0) Y[(size_t)(b * SEQ + c * CH + st) * RW + h * 64 + wave * 16 + vr] = y;
                }
            }
            if (c + 1 < SEQ / CH) {
                *(float4*)(nxt + 0 * CH * 64 + loff) = pre0; *(float4*)(nxt + 1 * CH * 64 + loff) = pre1; *(float4*)(nxt + 2 * CH * 64 + loff) = pre2;
                *(float4*)(nxt + 3 * CH * 64 + loff) = pre3; *(float4*)(nxt + 4 * CH * 64 + loff) = pre4; *(float4*)(nxt + 5 * CH * 64 + loff) = pre5;
            }
            __syncthreads();
        }
    }
}

DEVI void phase5(const Params& p, char* smem) {
    const int tid = threadIdx.x, lane = tid & 63, wave = tid >> 6;
    const float* Y = (const float*)(p.ws + WS_Y); const float* Vb = (const float*)(p.ws + WS_V); const float* Gb = (const float*)(p.ws + WS_G); const float* RKSb = (const float*)(p.ws + WS_RKS);
    bf16_t* mix = (bf16_t*)(p.ws + WS_MIX);
    for (int u = blockIdx.x; u < NTOK * 16 / 8; u += gridDim.x) {
        const int pi = u * 8 + wave, tok = pi >> 4, head = pi & 15, ch = head * 64 + lane;
        const float y = Y[(size_t)tok * RW + ch];
        const float mean = wave_sum(y) * (1.f / 64.f);
        const float d = y - mean;
        const float var = wave_sum(d * d) * (1.f / 64.f);
        const float yn = d * rsqrtf(var + 64e-5f) * p.ln_w[ch] + p.ln_b[ch];
        const float o = (yn + RKSb[tok * 16 + head] * Vb[(size_t)tok * RW + ch]) * Gb[(size_t)tok * RW + ch];
        mix[(size_t)tok * DM + 1024 + ch] = (bf16_t)(cvtpk(o, 0.f) & 0xffffu);
    }
}


constexpr int RA_AT = 0, RA_BT = 8192, RA_KT = 16384, RA_RT = 24576, RA_BPT = 32768, RA_KPT = 40960, RA_VT = 49152, RA_AAK = 57344, RA_ARB = 65536, RA_ARK = 73728,
              RA_AABP = 81920, RA_RHS = 98304, RA_WL = 131072, RA_SEG = 131328, RA_P1T = RA_BT, RA_P2T = RA_KT, RA_CUM = RA_AABP;

DEVI void phaseRA(const Params& p, char* smem) {
    const int tid = threadIdx.x, lane = tid & 63, wave = tid >> 6, l31 = lane & 31, hh = lane >> 5;
    const bf16_t* z = (const bf16_t*)(p.ws + WS_Z);
    float* cumb = (float*)(smem + RA_CUM); float* segs = (float*)(smem + RA_SEG); float* wl = (float*)(smem + RA_WL);
    float* rhs = (float*)(smem + RA_RHS); float* aabp = (float*)(smem + RA_AABP);
    uint4 n_cr, n_ck, n_cv, n_pr, n_pk, n_pv, n_au; float4 n_lw0, n_lw1;
    auto load_raw = [&](int unit_) {
        const int bh_ = unit_ >> 6, c_ = unit_ & 63, b_ = bh_ >> 4, h_ = bh_ & 15;
        const int tok = b_ * SEQ + c_ * 64 + (tid >> 3), ch0 = h_ * 64 + (tid & 7) * 8;
        const bf16_t* zr = z + (size_t)tok * INC + ZC_RW + ch0;
        const bool hasp = (tok & (SEQ - 1)) != 0;
        const uint4 zero4 = make_uint4(0u, 0u, 0u, 0u);
        n_cr = *(const uint4*)zr; n_ck = *(const uint4*)(zr + 1024); n_cv = *(const uint4*)(zr + 2048);
        n_pr = hasp ? *(const uint4*)(zr - INC) : zero4; n_pk = hasp ? *(const uint4*)(zr - INC + 1024) : zero4; n_pv = hasp ? *(const uint4*)(zr - INC + 2048) : zero4;
        n_au = *(const uint4*)((const bf16_t*)(p.ws + WS_AV) + (size_t)tok * RW + ch0);
        const float* lwp = (const float*)(p.ws + WS_LW) + (size_t)tok * RW + ch0;
        n_lw0 = *(const float4*)lwp; n_lw1 = *(const float4*)(lwp + 4);
    };
    if (((int)blockIdx.x >> 3) < 256) load_raw((((int)blockIdx.x & 7) + 8 * (((int)blockIdx.x >> 3) >> 6)) * 64 + (((int)blockIdx.x >> 3) & 63));
    const int ra_x = (int)blockIdx.x & 7, ra_slot = (int)blockIdx.x >> 3, ra_nslot = ((int)gridDim.x - ra_x + 7) >> 3;
    for (int uu = ra_slot; uu < 256; uu += ra_nslot) {
        const int bh = ra_x + 8 * (uu >> 6), c = uu & 63, b = bh >> 4, h = bh & 15;
        const int unit = bh * 64 + c;
        const int tokbase = b * SEQ + c * 64;
        __syncthreads();
        const int t = tid >> 3, c8 = tid & 7;
        float r_[8], k2[8], v_[8], aa[8], bb[8], lw[8];
        {
            const int tok = tokbase + t, ch0 = h * 64 + c8 * 8;
            const uint4 cr = n_cr, ck = n_ck, cv = n_cv, pr = n_pr, pk_ = n_pk, pv = n_pv, au = n_au;
            float fr[8], fk[8], fpr[8], fpk[8], fpv[8], mur[8], muk[8], muv[8], av[8], kkc[8], kac[8], rkc[8];
#define UNPK8(dst, u) { dst[0] = bflo(u.x); dst[1] = bfhi(u.x); dst[2] = bflo(u.y); dst[3] = bfhi(u.y); dst[4] = bflo(u.z); dst[5] = bfhi(u.z); dst[6] = bflo(u.w); dst[7] = bfhi(u.w); }
#define LDF8(dst, ptr) { const float4 q0_ = *(const float4*)(ptr), q1_ = *(const float4*)((ptr) + 4); dst[0] = q0_.x; dst[1] = q0_.y; dst[2] = q0_.z; dst[3] = q0_.w; dst[4] = q1_.x; dst[5] = q1_.y; dst[6] = q1_.z; dst[7] = q1_.w; }
            UNPK8(fr, cr) UNPK8(fk, ck) UNPK8(v_, cv) UNPK8(fpr, pr) UNPK8(fpk, pk_) UNPK8(fpv, pv) UNPK8(av, au)
            LDF8(mur, p.mu + ch0) LDF8(muk, p.mu + 1024 + ch0) LDF8(muv, p.mu + 2048 + ch0)
            LDF8(kkc, p.k_k + ch0) LDF8(kac, p.k_a + ch0) LDF8(rkc, p.r_k + ch0)
            lw[0] = n_lw0.x; lw[1] = n_lw0.y; lw[2] = n_lw0.z; lw[3] = n_lw0.w; lw[4] = n_lw1.x; lw[5] = n_lw1.y; lw[6] = n_lw1.z; lw[7] = n_lw1.w;
            float ssq = 0.f, rk = 0.f, kk[8];
#pragma unroll
            for (int i = 0; i < 8; ++i) {
                r_[i] = fr[i] + (fpr[i] - fr[i]) * mur[i];
                const float kx = fk[i] + (fpk[i] - fk[i]) * muk[i];
                v_[i] = v_[i] + (fpv[i] - v_[i]) * muv[i];
                kk[i] = kx * kkc[i]; ssq += kk[i] * kk[i];
                k2[i] = kx * (1.f + (av[i] - 1.f) * kac[i]);
                rk += r_[i] * k2[i] * rkc[i];
            }
            ssq += dpp_xor1(ssq); ssq += dpp_xor2(ssq); ssq += __shfl_xor(ssq, 4, 64);
            rk += dpp_xor1(rk); rk += dpp_xor2(rk); rk += __shfl_xor(rk, 4, 64);
            const float invn = 1.f / fmaxf(sqrtf(ssq), 1e-12f);
#pragma unroll
            for (int i = 0; i < 8; ++i) { const float kn = kk[i] * invn; aa[i] = -kn; bb[i] = kn * av[i]; }
            if (c8 == 0) ((float*)(p.ws + WS_RKS))[tok * 16 + h] = rk;
        }
#pragma unroll
        for (int i = 0; i < 8; ++i) cumb[t * 64 + c8 * 8 + i] = lw[i];
        __syncthreads();
        if (uu + ra_nslot < 256) { const int u2 = uu + ra_nslot; load_raw((ra_x + 8 * (u2 >> 6)) * 64 + (u2 & 63)); }
        {
            const int ch = tid & 63, seg = tid >> 6;
            float loc[8]; float run = 0.f;
#pragma unroll
            for (int j = 0; j < 8; ++j) { run += cumb[(seg * 8 + j) * 64 + ch]; loc[j] = run; }
            segs[seg * 64 + ch] = run;
            __syncthreads();
            float off = 0.f;
#pragma unroll
            for (int s2 = 0; s2 < 8; ++s2) off += (s2 < seg) ? segs[s2 * 64 + ch] : 0.f;
#pragma unroll
            for (int j = 0; j < 8; ++j) cumb[(seg * 8 + j) * 64 + ch] = off + loc[j];
        }
        __syncthreads();
        {
            unsigned pk[7][4];
            float atf[8];
#pragma unroll
            for (int i = 0; i < 8; i += 2) {
                float o[7][2];
#pragma unroll
                for (int e = 0; e < 2; ++e) {
                    const float cu = cumb[t * 64 + c8 * 8 + i + e], cl = cumb[63 * 64 + c8 * 8 + i + e];
                    const float e1 = __expf(cu), e2 = 1.f / e1, ex = __expf(cu - lw[i + e]), ew = __expf(cl - cu);
                    o[0][e] = aa[i + e] * ex; o[1][e] = bb[i + e] * e2; o[2][e] = k2[i + e] * e2; o[3][e] = r_[i + e] * e1;
                    o[4][e] = bb[i + e] * ew; o[5][e] = k2[i + e] * ew; o[6][e] = v_[i + e];
                    atf[i + e] = o[0][e];
                    if (t == 63) wl[c8 * 8 + i + e] = e1;
                }
#pragma unroll
                for (int m = 0; m < 7; ++m) pk[m][i >> 1] = cvtpk(o[m][0], o[m][1]);
            }
            const unsigned ro = m64_off(t, c8);
            *(uint4*)(smem + RA_AT + ro) = make_uint4(pk[0][0], pk[0][1], pk[0][2], pk[0][3]);
            *(uint4*)(smem + RA_BT + ro) = make_uint4(pk[1][0], pk[1][1], pk[1][2], pk[1][3]);
            *(uint4*)(smem + RA_KT + ro) = make_uint4(pk[2][0], pk[2][1], pk[2][2], pk[2][3]);
            *(uint4*)(smem + RA_RT + ro) = make_uint4(pk[3][0], pk[3][1], pk[3][2], pk[3][3]);
            *(float4*)(rhs + t * 128 + c8 * 8) = make_float4(atf[0], atf[1], atf[2], atf[3]);
            *(float4*)(rhs + t * 128 + c8 * 8 + 4) = make_float4(atf[4], atf[5], atf[6], atf[7]);
#pragma unroll
            for (int i = 0; i < 8; ++i) {
                const int ch = c8 * 8 + i;
                const unsigned to = m64_off(ch, t >> 3) + (t & 7) * 2;
                const unsigned w4 = pk[4][i >> 1], w5 = pk[5][i >> 1], w6 = pk[6][i >> 1];
                *(bf16_t*)(smem + RA_BPT + to) = (bf16_t)((i & 1) ? (w4 >> 16) : (w4 & 0xffffu));
                *(bf16_t*)(smem + RA_KPT + to) = (bf16_t)((i & 1) ? (w5 >> 16) : (w5 & 0xffffu));
                *(bf16_t*)(smem + RA_VT + to) = (bf16_t)((i & 1) ? (w6 >> 16) : (w6 & 0xffffu));
            }
        }
        __syncthreads();
        {
            const int pr = wave >> 1, sub = wave & 1;
            const char* X = smem + ((pr & 1) ? RA_KT : RA_BT);
            const char* Y = smem + ((pr & 2) ? RA_RT : RA_AT);
            const int incl = (pr & 2) ? 1 : 0;
            char* dst = smem + (pr == 1 ? RA_AAK : pr == 2 ? RA_ARB : RA_ARK);
#pragma unroll
            for (int tt = 0; tt < 2; ++tt) {
                const int i0 = sub ? (tt ? 32 : 0) : (tt ? 32 : 0);
                const int t0 = sub ? (tt ? 0 : 32) : (tt ? 32 : 0);
                const bool zero_tile = sub && tt;
                f32x16 acc = zero16();
                if (!zero_tile) mm_tile(acc, X, i0, Y, t0, l31, hh);
                const int tq = t0 + l31;
#pragma unroll
                for (int q = 0; q < 4; ++q) {
                    float vv[4];
#pragma unroll
                    for (int e = 0; e < 4; ++e) { const int ii = i0 + 8 * q + 4 * hh + e; vv[e] = (ii < tq + incl) ? acc[4 * q + e] : 0.f; }
                    if (pr == 0) {
                        if (!zero_tile) {
#pragma unroll
                            for (int e = 0; e < 4; ++e) aabp[tq * 64 + e * 16 + (i0 >> 2) + 2 * q + hh] = vv[e];
                        }
                    } else {
                        uint2 o; o.x = cvtpk(vv[0], vv[1]); o.y = cvtpk(vv[2], vv[3]);
                        *(uint2*)(dst + m64_off(tq, (i0 >> 3) + q) + 8 * hh) = o;
                    }
                }
            }
        }
        __syncthreads();
        f32x16 accA = zero16();
        const int w4 = wave & 3, ta = w4 & 1, tb2 = w4 >> 1;
        if (wave < 4) {
            f32x16 x2 = zero16();
            mm_tile(x2, smem + RA_VT, ta * 32, smem + RA_AAK, tb2 * 32, l31, hh);
            const int tq = tb2 * 32 + l31;
#pragma unroll
            for (int q = 0; q < 4; ++q) *(float4*)(rhs + tq * 128 + 64 + ta * 32 + 8 * q + 4 * hh) = make_float4(x2[4 * q], x2[4 * q + 1], x2[4 * q + 2], x2[4 * q + 3]);
            mm_tile(accA, smem + RA_VT, ta * 32, smem + RA_ARK, tb2 * 32, l31, hh);
        } else {
            mm_tile(accA, smem + RA_KPT, ta * 32, smem + RA_VT, tb2 * 32, l31, hh);
        }
        __syncthreads();
        {
            const int g = lane & 3, col = wave * 16 + (lane >> 2);
            float P[16];
#pragma unroll
            for (int q = 0; q < 16; ++q) P[q] = 0.f;
            float last[4];
            char* pt = smem + (col < 64 ? RA_P1T : RA_P2T);
            const int prow = col & 63;
            float4 acur[4]; float rcur = rhs[col];
#pragma unroll
            for (int q4 = 0; q4 < 4; ++q4) acur[q4] = make_float4(0.f, 0.f, 0.f, 0.f);
#pragma unroll
            for (int ts = 0; ts < 64; ++ts) {
                float4 anxt[4]; float rnxt = 0.f;
#pragma unroll
                for (int q4 = 0; q4 < 4; ++q4) anxt[q4] = make_float4(0.f, 0.f, 0.f, 0.f);
                if (ts + 1 < 64) {
                    const int nq4n = (((ts + 4) >> 2) + 3) >> 2;
#pragma unroll
                    for (int q4 = 0; q4 < nq4n; ++q4) anxt[q4] = *(const float4*)(aabp + (ts + 1) * 64 + g * 16 + q4 * 4);
                    rnxt = rhs[(ts + 1) * 128 + col];
                }
                float part = 0.f;
                const int nq4 = (((ts + 3) >> 2) + 3) >> 2;
#pragma unroll
                for (int q4 = 0; q4 < nq4; ++q4) {
                    const float4 a = acur[q4];
                    part += a.x * P[4 * q4] + a.y * P[4 * q4 + 1] + a.z * P[4 * q4 + 2] + a.w * P[4 * q4 + 3];
                }
                part += dpp_xor1(part); part += dpp_xor2(part);
                const float val = rcur + part;
#pragma unroll
                for (int q4 = 0; q4 < 4; ++q4) acur[q4] = anxt[q4];
                rcur = rnxt;
                if (g == (ts & 3)) P[ts >> 2] = val;
                last[ts & 3] = val;
                if ((ts & 3) == 3 && g == 0) {
                    uint2 o; o.x = cvtpk(last[0], last[1]); o.y = cvtpk(last[2], last[3]);
                    *(uint2*)(pt + m64_off(prow, ts >> 3) + ((ts >> 2) & 1) * 8) = o;
                }
            }
        }
        __syncthreads();
        if (wave < 4) {
            mm_tile(accA, smem + RA_P2T, ta * 32, smem + RA_ARB, tb2 * 32, l31, hh);
            float* q2 = (float*)(p.ws + WS_Q2) + ((size_t)unit * 4 + (ta * 2 + tb2)) * 1024;
#pragma unroll
            for (int i = 0; i < 16; ++i) q2[i * 64 + lane] = accA[i];
            f32x16 q1 = zero16();
            mm_tile(q1, smem + RA_P1T, ta * 32, smem + RA_ARB, tb2 * 32, l31, hh);
            const int tq = tb2 * 32 + l31;
            bf16_t* q1g = (bf16_t*)(p.ws + WS_Q1) + (size_t)unit * 4096 + tq * 64;
#pragma unroll
            for (int q = 0; q < 4; ++q) {
                const int k0 = ta * 32 + 8 * q + 4 * hh;
                const uint2 rr = *(const uint2*)(smem + RA_RT + m64_off(tq, k0 >> 3) + (k0 & 7) * 2);
                uint2 o; o.x = cvtpk(q1[4 * q] + bflo(rr.x), q1[4 * q + 1] + bfhi(rr.x)); o.y = cvtpk(q1[4 * q + 2] + bflo(rr.y), q1[4 * q + 3] + bfhi(rr.y));
                *(uint2*)(q1g + k0) = o;
            }
        } else {
            mm_tile(accA, smem + RA_BPT, ta * 32, smem + RA_P2T, tb2 * 32, l31, hh);
            unsigned* hb = (unsigned*)(p.ws + WS_HB) + ((size_t)unit * 4 + (ta * 2 + tb2)) * 512;
#pragma unroll
            for (int j = 0; j < 8; ++j) hb[j * 64 + lane] = cvtpk(accA[2 * j], accA[2 * j + 1]);
            f32x16 gg = zero16();
            mm_tile(gg, smem + RA_P1T, ta * 32, smem + RA_BPT, tb2 * 32, l31, hh);
            if (ta == tb2) {
#pragma unroll
                for (int i = 0; i < 16; ++i) { const int kk = (i & 3) + 8 * (i >> 2) + 4 * hh; if (kk == l31) gg[i] += wl[ta * 32 + kk]; }
            }
            unsigned* gb = (unsigned*)(p.ws + WS_GB) + ((size_t)unit * 4 + (ta * 2 + tb2)) * 512 + lane * 8;
            uint4 o0, o1;
            o0.x = cvtpk(gg[0], gg[1]); o0.y = cvtpk(gg[2], gg[3]); o0.z = cvtpk(gg[4], gg[5]); o0.w = cvtpk(gg[6], gg[7]);
            o1.x = cvtpk(gg[8], gg[9]); o1.y = cvtpk(gg[10], gg[11]); o1.z = cvtpk(gg[12], gg[13]); o1.w = cvtpk(gg[14], gg[15]);
            *(uint4*)(gb) = o0; *(uint4*)(gb + 4) = o1;
        }
    }
}

struct RbH { unsigned w[2][8]; };
DEVI void rb_load(const Params& p, int unit, int vh, int lane, uint4 (&g)[8], RbH& hq) {
    const unsigned* gb = (const unsigned*)(p.ws + WS_GB) + (size_t)unit * 2048 + lane * 8;
    const unsigned* hb = (const unsigned*)(p.ws + WS_HB) + (size_t)unit * 2048 + lane;
#pragma unroll
    for (int t4 = 0; t4 < 4; ++t4) { g[2 * t4] = *(const uint4*)(gb + t4 * 512); g[2 * t4 + 1] = *(const uint4*)(gb + t4 * 512 + 4); }
#pragma unroll
    for (int j = 0; j < 8; ++j) { hq.w[0][j] = hb[(0 * 2 + vh) * 512 + j * 64]; hq.w[1][j] = hb[(1 * 2 + vh) * 512 + j * 64]; }
}
DEVI void rb_store(const Params& p, int unit, int vh, int l31, int hh, const f32x16& X0, const f32x16& X1) {
    bf16_t* s0 = (bf16_t*)(p.ws + WS_S0) + (size_t)unit * 4096 + (vh * 32 + l31) * 64;
#pragma unroll
    for (int q = 0; q < 4; ++q) {
        uint2 o; o.x = cvtpk(X0[4 * q], X0[4 * q + 1]); o.y = cvtpk(X0[4 * q + 2], X0[4 * q + 3]);
        *(uint2*)(s0 + 8 * q + 4 * hh) = o;
        uint2 o2; o2.x = cvtpk(X1[4 * q], X1[4 * q + 1]); o2.y = cvtpk(X1[4 * q + 2], X1[4 * q + 3]);
        *(uint2*)(s0 + 32 + 8 * q + 4 * hh) = o2;
    }
}
#define BF8(u) __builtin_bit_cast(bf16x8, u)
DEVI void rb_step(f32x16& X0, f32x16& X1, const uint4 (&g)[8], const RbH& hq) {
    uint4 xa, xb, xc, xd;
    xa.x = cvtpk(X0[0], X0[1]); xa.y = cvtpk(X0[2], X0[3]); xa.z = cvtpk(X0[4], X0[5]); xa.w = cvtpk(X0[6], X0[7]);
    xb.x = cvtpk(X0[8], X0[9]); xb.y = cvtpk(X0[10], X0[11]); xb.z = cvtpk(X0[12], X0[13]); xb.w = cvtpk(X0[14], X0[15]);
    xc.x = cvtpk(X1[0], X1[1]); xc.y = cvtpk(X1[2], X1[3]); xc.z = cvtpk(X1[4], X1[5]); xc.w = cvtpk(X1[6], X1[7]);
    xd.x = cvtpk(X1[8], X1[9]); xd.y = cvtpk(X1[10], X1[11]); xd.z = cvtpk(X1[12], X1[13]); xd.w = cvtpk(X1[14], X1[15]);
    f32x16 N0, N1;
#pragma unroll
    for (int j = 0; j < 8; ++j) { N0[2 * j] = bflo(hq.w[0][j]); N0[2 * j + 1] = bfhi(hq.w[0][j]); N1[2 * j] = bflo(hq.w[1][j]); N1[2 * j + 1] = bfhi(hq.w[1][j]); }
    N0 = __builtin_amdgcn_mfma_f32_32x32x16_bf16(BF8(g[0]), BF8(xa), N0, 0, 0, 0);
    N1 = __builtin_amdgcn_mfma_f32_32x32x16_bf16(BF8(g[2]), BF8(xa), N1, 0, 0, 0);
    N0 = __builtin_amdgcn_mfma_f32_32x32x16_bf16(BF8(g[1]), BF8(xb), N0, 0, 0, 0);
    N1 = __builtin_amdgcn_mfma_f32_32x32x16_bf16(BF8(g[3]), BF8(xb), N1, 0, 0, 0);
    N0 = __builtin_amdgcn_mfma_f32_32x32x16_bf16(BF8(g[4]), BF8(xc), N0, 0, 0, 0);
    N1 = __builtin_amdgcn_mfma_f32_32x32x16_bf16(BF8(g[6]), BF8(xc), N1, 0, 0, 0);
    N0 = __builtin_amdgcn_mfma_f32_32x32x16_bf16(BF8(g[5]), BF8(xd), N0, 0, 0, 0);
    N1 = __builtin_amdgcn_mfma_f32_32x32x16_bf16(BF8(g[7]), BF8(xd), N1, 0, 0, 0);
    X0 = N0; X1 = N1;
}
DEVI void phaseRB_core(const Params& p, char* smem) {
    const int tid = threadIdx.x, lane = tid & 63, wave = tid >> 6, l31 = lane & 31, hh = lane >> 5;
    if (wave != 0) return;
    for (int wu = blockIdx.x; wu < 64; wu += gridDim.x) {
        const int bh = (wu & 7) | ((wu >> 4) << 3), vh = (wu >> 3) & 1;
        f32x16 X0 = zero16(), X1 = zero16();
        uint4 gA[8], gB[8], gC[8]; RbH hA, hB, hC;
        rb_load(p, bh * 64, vh, lane, gA, hA);
        rb_load(p, bh * 64 + 1, vh, lane, gB, hB);
        for (int c = 0; c < 63; c += 3) {
            rb_load(p, bh * 64 + (c + 2 < 64 ? c + 2 : 63), vh, lane, gC, hC);
            rb_store(p, bh * 64 + c, vh, l31, hh, X0, X1);
            rb_step(X0, X1, gA, hA);
            rb_load(p, bh * 64 + (c + 3 < 64 ? c + 3 : 63), vh, lane, gA, hA);
            rb_store(p, bh * 64 + c + 1, vh, l31, hh, X0, X1);
            rb_step(X0, X1, gB, hB);
            rb_load(p, bh * 64 + (c + 4 < 64 ? c + 4 : 63), vh, lane, gB, hB);
            rb_store(p, bh * 64 + c + 2, vh, l31, hh, X0, X1);
            rb_step(X0, X1, gC, hC);
        }
        rb_store(p, bh * 64 + 63, vh, l31, hh, X0, X1);
    }
}

DEVI void phaseRB(const Params& p, char* smem) {
    const bool split = gridDim.x >= 128;
    if (split && blockIdx.x < 64) { phaseRB_core(p, smem); return; }
    const int nw = split ? (int)gridDim.x - 64 : (int)gridDim.x, wi = split ? (int)blockIdx.x - 64 : (int)blockIdx.x;
    for (int u = wi; u < 256; u += nw) p3_unit(p, smem, u);
    if (!split) { __syncthreads(); phaseRB_core(p, smem); }
}

DEVI void phaseRC(const Params& p, char* smem) {
    const int tid = threadIdx.x, lane = tid & 63, wave = tid >> 6, l31 = lane & 31, hh = lane >> 5;
    const bf16_t* z = (const bf16_t*)(p.ws + WS_Z); const bf16_t* GVb = (const bf16_t*)(p.ws + WS_GV); const float* RKSb = (const float*)(p.ws + WS_RKS);
    bf16_t* mix = (bf16_t*)(p.ws + WS_MIX);
    for (int it0 = blockIdx.x; it0 < 512 + N_SPEC; it0 += gridDim.x) {
        if (it0 < N_SPEC) { spec_unit(p, smem, it0); continue; }
        const int it = it0 - N_SPEC;
        const int unit = it * 4 + (wave >> 1), tb = wave & 1;
        const int bh = unit >> 6, c = unit & 63, b = bh >> 4, h = bh & 15;
        const int tq = tb * 32 + l31, tok = b * SEQ + c * 64 + tq;
        const float* q2 = (const float*)(p.ws + WS_Q2) + (size_t)unit * 4096 + lane;
        f32x16 a0, a1;
#pragma unroll
        for (int i = 0; i < 16; ++i) { a0[i] = q2[(0 * 2 + tb) * 1024 + i * 64]; a1[i] = q2[(1 * 2 + tb) * 1024 + i * 64]; }
        const bf16_t* s0 = (const bf16_t*)(p.ws + WS_S0) + (size_t)unit * 4096;
        const bf16_t* q1 = (const bf16_t*)(p.ws + WS_Q1) + (size_t)unit * 4096 + tq * 64;
#pragma unroll
        for (int s4 = 0; s4 < 4; ++s4) {
            const bf16x8 fa0 = *(const bf16x8*)(s0 + (l31) * 64 + 16 * s4 + 8 * hh);
            const bf16x8 fa1 = *(const bf16x8*)(s0 + (32 + l31) * 64 + 16 * s4 + 8 * hh);
            const bf16x8 fb = *(const bf16x8*)(q1 + 16 * s4 + 8 * hh);
            a0 = __builtin_amdgcn_mfma_f32_32x32x16_bf16(fa0, fb, a0, 0, 0, 0);
            a1 = __builtin_amdgcn_mfma_f32_32x32x16_bf16(fa1, fb, a1, 0, 0, 0);
        }
        float sm = 0.f;
#pragma unroll
        for (int i = 0; i < 16; ++i) sm += a0[i] + a1[i];
        sm = xor32_sum(sm);
        const float mean = sm * (1.f / 64.f);
        float sq = 0.f;
#pragma unroll
        for (int i = 0; i < 16; ++i) { const float d0 = a0[i] - mean, d1 = a1[i] - mean; sq += d0 * d0 + d1 * d1; }
        sq = xor32_sum(sq);
        const float rstd = rsqrtf(sq * (1.f / 64.f) + 64e-5f);
        const float rk = RKSb[tok * 16 + h];
#pragma unroll
        for (int vb = 0; vb < 2; ++vb)
#pragma unroll
            for (int q = 0; q < 4; ++q) {
                const int ch = h * 64 + vb * 32 + 8 * q + 4 * hh;
                const int hc = ch;
                const uint2 zc2 = *(const uint2*)(z + (size_t)tok * INC + ZC_RW + 2048 + hc);
                uint2 zp2 = make_uint2(0u, 0u);
                if (tok & (SEQ - 1)) zp2 = *(const uint2*)(z + (size_t)(tok - 1) * INC + ZC_RW + 2048 + hc);
                const float4 muv = *(const float4*)(p.mu + 2048 + hc);
                const uint2 g2 = *(const uint2*)(GVb + (size_t)tok * RW + hc);
                float4 vv, gv;
                vv.x = bflo(zc2.x) + (bflo(zp2.x) - bflo(zc2.x)) * muv.x; vv.y = bfhi(zc2.x) + (bfhi(zp2.x) - bfhi(zc2.x)) * muv.y;
                vv.z = bflo(zc2.y) + (bflo(zp2.y) - bflo(zc2.y)) * muv.z; vv.w = bfhi(zc2.y) + (bfhi(zp2.y) - bfhi(zc2.y)) * muv.w;
                gv.x = bflo(g2.x); gv.y = bfhi(g2.x); gv.z = bflo(g2.y); gv.w = bfhi(g2.y);
                const float4 lnw = *(const float4*)(p.ln_w + ch), lnb = *(const float4*)(p.ln_b + ch);
                float y[4];
#pragma unroll
                for (int e = 0; e < 4; ++e) y[e] = ((vb ? a1[4 * q + e] : a0[4 * q + e]) - mean) * rstd;
                uint2 o;
                o.x = cvtpk((y[0] * lnw.x + lnb.x + rk * vv.x) * gv.x, (y[1] * lnw.y + lnb.y + rk * vv.y) * gv.y);
                o.y = cvtpk((y[2] * lnw.z + lnb.z + rk * vv.z) * gv.z, (y[3] * lnw.w + lnb.w + rk * vv.w) * gv.w);
                *(uint2*)(mix + (size_t)tok * DM + 1024 + ch) = o;
            }
    }
}

DEVI void phase6(const Params& p, char* smem) {
    pg8::Gemm g{(const pg8::bf16_t*)(p.ws + WS_MIX), (const pg8::bf16_t*)(p.ws + WS_WTO), NTOK, DM, DM};
    pg8::StaticOrder S; S.init(NTOK, DM, (int)gridDim.x, (int)blockIdx.x);
    pg8::EpiX1 E{(float*)(p.ws + WS_X1), p.x, (const float*)(p.ws + WS_MODF) + 2 * DM, DM, 12288, SEQ};
    pg8::gemm_phase<pg8::EpiX1, pg8::StaticOrder, true, true>((PG8_LAS unsigned char*)smem, g, S, E);
}

DEVI void phase7(const Params& p, char* smem) {
    float* part = (float*)smem;
    float* ssq = part + 8 * 32 * 80;
    float* rstd_s = ssq + 8 * 128;
    float* lg_ = rstd_s + 32;
    const float* x1 = (const float*)(p.ws + WS_X1);
    const uint4* wrf = (const uint4*)(p.ws + WS_WRF);
    const float* cb = (const float*)(p.ws + WS_CB);
    const float* as2 = (const float*)(p.ws + WS_AS2);
    bf16_t* h = (bf16_t*)(p.ws + WS_H);
    int* cnt = (int*)(p.ws + WS_CTL + CNT_OFF);
    int* list = (int*)(p.ws + WS_LIST); float* lw = (float*)(p.ws + WS_LWT);
    const int tid = threadIdx.x, lane = tid & 63, wave = tid >> 6, li = lane & 15, lg = lane >> 4;
    for (int u = blockIdx.x; u < NTOK / 32; u += gridDim.x) {
        const int tok0 = u * 32, b = tok0 >> 12;
        __syncthreads();
        f32x4 acc[2][5];
#pragma unroll
        for (int tg = 0; tg < 2; ++tg)
#pragma unroll
            for (int nf = 0; nf < 5; ++nf) acc[tg][nf] = f32x4{0.f, 0.f, 0.f, 0.f};
        float sq[2] = {0.f, 0.f};
        const float* xr = x1 + (size_t)(tok0 + li) * DM + wave * 256 + 8 * lg;
#pragma unroll 2
        for (int s4 = 0; s4 < 8; ++s4) {
            bf16x8 ah[2], al[2];
#pragma unroll
            for (int tg = 0; tg < 2; ++tg) {
                const float4 xa = *(const float4*)(xr + (size_t)tg * 16 * DM + s4 * 32), xb = *(const float4*)(xr + (size_t)tg * 16 * DM + s4 * 32 + 4);
                sq[tg] += xa.x * xa.x + xa.y * xa.y + xa.z * xa.z + xa.w * xa.w + xb.x * xb.x + xb.y * xb.y + xb.z * xb.z + xb.w * xb.w;
                uint4 hi, lo;
                hi.x = cvtpk(xa.x, xa.y); hi.y = cvtpk(xa.z, xa.w); hi.z = cvtpk(xb.x, xb.y); hi.w = cvtpk(xb.z, xb.w);
                lo.x = cvtpk(xa.x - bflo(hi.x), xa.y - bfhi(hi.x)); lo.y = cvtpk(xa.z - bflo(hi.y), xa.w - bfhi(hi.y));
                lo.z = cvtpk(xb.x - bflo(hi.z), xb.y - bfhi(hi.z)); lo.w = cvtpk(xb.z - bflo(hi.w), xb.w - bfhi(hi.w));
                ah[tg] = __builtin_bit_cast(bf16x8, hi); al[tg] = __builtin_bit_cast(bf16x8, lo);
            }
            const uint4* wf = wrf + ((size_t)(b * 64 + wave * 8 + s4) * 5) * 128 + lane;
#pragma unroll
            for (int nf = 0; nf < 5; ++nf) {
                const bf16x8 bh = __builtin_bit_cast(bf16x8, wf[nf * 128]), bl = __builtin_bit_cast(bf16x8, wf[nf * 128 + 64]);
#pragma unroll
                for (int tg = 0; tg < 2; ++tg) {
                    acc[tg][nf] = __builtin_amdgcn_mfma_f32_16x16x32_bf16(al[tg], bh, acc[tg][nf], 0, 0, 0);
                    acc[tg][nf] = __builtin_amdgcn_mfma_f32_16x16x32_bf16(ah[tg], bl, acc[tg][nf], 0, 0, 0);
                    acc[tg][nf] = __builtin_amdgcn_mfma_f32_16x16x32_bf16(ah[tg], bh, acc[tg][nf], 0, 0, 0);
                }
            }
        }
#pragma unroll
        for (int tg = 0; tg < 2; ++tg) {
#pragma unroll
            for (int nf = 0; nf < 5; ++nf)
#pragma unroll
                for (int r = 0; r < 4; ++r) part[(wave * 32 + 16 * tg + 4 * lg + r) * 80 + nf * 16 + li] = acc[tg][nf][r];
            ssq[(wave * 4 + lg) * 32 + 16 * tg + li] = sq[tg];
        }
        __syncthreads();
        if (tid < 32) {
            float t = 0.f;
#pragma unroll
            for (int q = 0; q < 32; ++q) t += ssq[q * 32 + tid];
            rstd_s[tid] = rsqrtf(t * (1.f / DM) + 1e-6f);
        }
        __syncthreads();
        for (int idx = tid; idx < 32 * 80; idx += 512) {
            const int tk = idx / 80, j = idx % 80;
            float t = 0.f;
#pragma unroll
            for (int w = 0; w < 8; ++w) t += part[(w * 32 + tk) * 80 + j];
            lg_[idx] = rstd_s[tk] * t + cb[b * 80 + j];
        }
        __syncthreads();
        if (tid < 32) {
            const int tok = tok0 + tid;
            const float* L = lg_ + tid * 80;
            int gi = 0; float gm = L[64];
            for (int j = 1; j < 8; ++j) if (L[64 + j] > gm) { gm = L[64 + j]; gi = j; }
            float den = 0.f;
            for (int j = 0; j < 8; ++j) den += expf(L[64 + j] - gm);
            const float ggate = 1.f / den;
            const float* E = L + gi * 8;
            int i1 = 0; float m1 = E[0];
            for (int j = 1; j < 8; ++j) if (E[j] > m1) { m1 = E[j]; i1 = j; }
            int i2 = -1; float m2 = -3.0e38f;
            for (int j = 0; j < 8; ++j) if (j != i1 && E[j] > m2) { m2 = E[j]; i2 = j; }
            const float e2 = expf(m2 - m1);
            const float p1 = 1.f / (1.f + e2), p2 = e2 / (1.f + e2);
            const int ex1 = gi * 8 + i1, ex2 = gi * 8 + i2;
            const int pos1 = atomicAdd(&cnt[ex1 * CNT_ST], 1); list[ex1 * LCAP + pos1] = tok * 2; lw[ex1 * LCAP + pos1] = ggate * p1;
            const int pos2 = atomicAdd(&cnt[ex2 * CNT_ST], 1); list[ex2 * LCAP + pos2] = tok * 2 + 1; lw[ex2 * LCAP + pos2] = ggate * p2;
        }
#pragma unroll 2
        for (int tt = 0; tt < 4; ++tt) {
            const int tk = wave * 4 + tt, tok = tok0 + tk;
            const float rs = rstd_s[tk];
            const float* xrow = x1 + (size_t)tok * DM;
#pragma unroll
            for (int i = 0; i < 8; ++i) {
                const int k = i * 256 + lane * 4;
                const float4 xv = *(const float4*)(xrow + k);
                const float4 a = *(const float4*)(as2 + b * DM + k), sft = *(const float4*)(as2 + 2 * DM + b * DM + k);
                uint2 o; o.x = cvtpk(xv.x * rs * a.x + sft.x, xv.y * rs * a.y + sft.y); o.y = cvtpk(xv.z * rs * a.z + sft.z, xv.w * rs * a.w + sft.w);
                *(uint2*)(h + (size_t)tok * DM + k) = o;
            }
        }
    }
}

struct MoeTab { int cnt[64]; int sb[65]; int ubx[9]; int np[8]; };
DEVI void moe_tables(const Params& p, MoeTab* tb, int slabs) {
    const int* cnt = (const int*)(p.ws + WS_CTL + CNT_OFF);
    const int tid = threadIdx.x, x = blockIdx.x & 7;
    __syncthreads();
    if (tid < 64) tb->cnt[tid] = cnt[tid * CNT_ST];
    __syncthreads();
    if (tid == 0) {
        int sb = 0;
        for (int e = 0; e < 64; ++e) { tb->sb[e] = sb; sb += tb->cnt[e]; }
        tb->sb[64] = sb;
        int ub = 0;
        for (int i = 0; i < 8; ++i) { const int np = (tb->cnt[x + 8 * i] + 255) >> 8; tb->np[i] = np; tb->ubx[i] = ub; ub += np * slabs; }
        tb->ubx[8] = ub;
    }
    __syncthreads();
}
struct MoeUnit { int e, s, ce, sbase, rbeg, rend; };
DEVI MoeUnit moe_unit(const MoeTab* tb, int u) {
    int i = 0;
    while (tb->ubx[i + 1] <= u) ++i;
    const int rem = u - tb->ubx[i], np = tb->np[i], ps = rem % np;
    MoeUnit m; m.e = (blockIdx.x & 7) + 8 * i; m.s = rem / np; m.ce = tb->cnt[m.e]; m.sbase = tb->sb[m.e];
    const int rp = (((m.ce + np - 1) / np) + 15) & ~15;
    m.rbeg = ps * rp; m.rend = m.rbeg + rp < m.ce ? m.rbeg + rp : m.ce;
    return m;
}

DEVI void phase8(const Params& p, char* smem) {
    MoeTab* tb = (MoeTab*)(smem + 32768);
    const bf16_t* h = (const bf16_t*)(p.ws + WS_H);
    bf16_t* hid = (bf16_t*)(p.ws + WS_HID);
    const int* list = (const int*)(p.ws + WS_LIST);
    const int tid = threadIdx.x, lane = tid & 63, wave = tid >> 6, li = lane & 15, lg = lane >> 4;
    moe_tables(p, tb, 4);
    const int total = tb->ubx[8], nslot = ((int)gridDim.x - (int)(blockIdx.x & 7) + 7) >> 3;
    for (int u = blockIdx.x >> 3; u < total; u += nslot) {
        const MoeUnit mu = moe_unit(tb, u);
        const int e = mu.e, s = mu.s;
        const int fcol = s * 128 + wave * 16;
        const float* bp0 = p.w1 + (size_t)e * DM * FF + (size_t)(8 * lg) * FF + fcol + li;
        const float* bp1 = p.w3 + (size_t)e * DM * FF + (size_t)(8 * lg) * FF + fcol + li;
        int r0 = mu.rbeg + (tid >> 2), r1 = r0 + 128; r0 = r0 < mu.rend ? r0 : mu.rend - 1; r1 = r1 < mu.rend ? r1 : mu.rend - 1;
        const bf16_t* ap0 = h + (size_t)(list[e * LCAP + r0] >> 1) * DM + (tid & 3) * 8;
        const bf16_t* ap1 = h + (size_t)(list[e * LCAP + r1] >> 1) * DM + (tid & 3) * 8;
        __syncthreads();
        gemm_tile<1, 2>(smem, DM / 32, FF, bp0, bp1, ap0, ap1, [&](f32x4 (&acc)[16][2]) {
#pragma unroll
            for (int m = 0; m < 16; ++m) {
                const int r = mu.rbeg + 16 * m + li;
                if (r < mu.rend) {
                    float hv[4];
#pragma unroll
                    for (int q = 0; q < 4; ++q) { const float a = acc[m][0][q]; hv[q] = a / (1.f + __expf(-a)) * acc[m][1][q]; }
                    uint2 o; o.x = cvtpk(hv[0], hv[1]); o.y = cvtpk(hv[2], hv[3]);
                    *(uint2*)(hid + (size_t)(mu.sbase + r) * FF + fcol + 4 * lg) = o;
                }
            }
        });
    }
}

DEVI void phase9(const Params& p, char* smem) {
    MoeTab* tb = (MoeTab*)(smem + 32768);
    const bf16_t* hid = (const bf16_t*)(p.ws + WS_HID);
    bf16_t* yb = (bf16_t*)(p.ws + WS_YB);
    const int* list = (const int*)(p.ws + WS_LIST); const float* lw = (const float*)(p.ws + WS_LWT);
    const int tid = threadIdx.x, lane = tid & 63, wave = tid >> 6, li = lane & 15, lg = lane >> 4;
    moe_tables(p, tb, 8);
    const int total = tb->ubx[8], nslot = ((int)gridDim.x - (int)(blockIdx.x & 7) + 7) >> 3;
    for (int u = blockIdx.x >> 3; u < total; u += nslot) {
        const MoeUnit mu = moe_unit(tb, u);
        const int e = mu.e, s = mu.s;
        const int col0 = s * 256 + wave * 32;
        const float* bp0 = p.w2 + (size_t)e * FF * DM + (size_t)(8 * lg) * DM + col0 + li; const float* bp1 = bp0 + 16;
        int r0 = mu.rbeg + (tid >> 2), r1 = r0 + 128; r0 = r0 < mu.rend ? r0 : mu.rend - 1; r1 = r1 < mu.rend ? r1 : mu.rend - 1;
        const bf16_t* ap0 = hid + (size_t)(mu.sbase + r0) * FF + (tid & 3) * 8; const bf16_t* ap1 = hid + (size_t)(mu.sbase + r1) * FF + (tid & 3) * 8;
        __syncthreads();
        gemm_tile<1, 2>(smem, FF / 32, DM, bp0, bp1, ap0, ap1, [&](f32x4 (&acc)[16][2]) {
#pragma unroll
            for (int m = 0; m < 16; ++m) {
                const int r = mu.rbeg + 16 * m + li;
                if (r < mu.rend) {
                    const int a = list[e * LCAP + r]; const float wgt = lw[e * LCAP + r];
#pragma unroll
                    for (int nf = 0; nf < 2; ++nf) {
                        uint2 o; o.x = cvtpk(acc[m][nf][0] * wgt, acc[m][nf][1] * wgt); o.y = cvtpk(acc[m][nf][2] * wgt, acc[m][nf][3] * wgt);
                        *(uint2*)(yb + (size_t)a * DM + col0 + nf * 16 + 4 * lg) = o;
                    }
                }
            }
        });
    }
}

DEVI void phase10(const Params& p, char* smem) {
    const float* modf = (const float*)(p.ws + WS_MODF);
    const float* x1 = (const float*)(p.ws + WS_X1);
    const bf16_t* yb = (const bf16_t*)(p.ws + WS_YB);
    const int tid = threadIdx.x, lane = tid & 63, wave = tid >> 6;
    for (int u = blockIdx.x; u < NTOK / 8; u += gridDim.x) {
        const int tok = u * 8 + wave, b = tok >> 12;
        float4 v[8]; float ss = 0.f;
#pragma unroll
        for (int i = 0; i < 8; ++i) {
            const int k = i * 256 + lane * 4;
            const float4 xv = *(const float4*)(x1 + (size_t)tok * DM + k);
            const float4 gt = *(const float4*)(modf + b * 12288 + 5 * DM + k);
            const uint2 ya = *(const uint2*)(yb + (size_t)(tok * 2) * DM + k), yc = *(const uint2*)(yb + (size_t)(tok * 2 + 1) * DM + k);
            v[i].x = xv.x + gt.x * (bflo(ya.x) + bflo(yc.x)); v[i].y = xv.y + gt.y * (bfhi(ya.x) + bfhi(yc.x));
            v[i].z = xv.z + gt.z * (bflo(ya.y) + bflo(yc.y)); v[i].w = xv.w + gt.w * (bfhi(ya.y) + bfhi(yc.y));
            ss += v[i].x * v[i].x + v[i].y * v[i].y + v[i].z * v[i].z + v[i].w * v[i].w;
        }
        ss = wave_sum(ss);
        const float rstd = rsqrtf(ss * (1.f / DM) + 1e-6f);
#pragma unroll
        for (int i = 0; i < 8; ++i) {
            const int k = i * 256 + lane * 4;
            const float4 g = *(const float4*)(p.final_g + k);
            float4 o; o.x = v[i].x * rstd * g.x; o.y = v[i].y * rstd * g.y; o.z = v[i].z * rstd * g.z; o.w = v[i].w * rstd * g.w;
            *(float4*)(p.out + (size_t)tok * DM + k) = o;
        }
    }
}

constexpr size_t WS_BAR = 4096;
constexpr int N_PHASES = 12;
#ifndef MK_N_LAUNCHES
#define MK_N_LAUNCHES 1
#endif

__global__ void __launch_bounds__(512) mega_kernel(Params p, int lo, int hi) {
    extern __shared__ __attribute__((aligned(16))) char smem[];
    volatile LAS unsigned* xb_words = (volatile LAS unsigned*)(smem + LDS_BYTES - 16);
    if (threadIdx.x == 0) { xb_words[0] = 0u; xb_words[1] = 0u; xb_words[2] = 0u; xb_words[3] = 0u; }
    __syncthreads();
    XcdBarrier bar;
    if (hi - lo > 1) bar = xcd_barrier_post((unsigned*)(p.ws + WS_BAR), xb_words);
#define IN(k) (lo <= (k) && (k) < hi)
#define SEAM(k) do { if (IN(k) && IN((k) + 1)) xcd_barrier(bar); } while (0)
#ifndef PROBE_MASK
#define PROBE_MASK 0
#endif
#define REP(k) (((PROBE_MASK >> (k)) & 1) ? 2 : 1)
    if (IN(0)) for (int rp = 0; rp < REP(0); ++rp) phase0(p, smem);
    SEAM(0);
    if (IN(1)) for (int rp = 0; rp < REP(1); ++rp) phase1(p, smem);
    SEAM(1);
    if (IN(2)) for (int rp = 0; rp < REP(2); ++rp) phase2(p, smem);
    SEAM(2);
    if (IN(3)) for (int rp = 0; rp < REP(3); ++rp) phase3(p, smem);
    SEAM(3);
    if (IN(4)) for (int rp = 0; rp < REP(4); ++rp) phaseRA(p, smem);
    SEAM(4);
    if (IN(5)) for (int rp = 0; rp < REP(5); ++rp) phaseRB(p, smem);
    SEAM(5);
    if (IN(6)) for (int rp = 0; rp < REP(6); ++rp) phaseRC(p, smem);
    SEAM(6);
    if (IN(7)) for (int rp = 0; rp < REP(7); ++rp) phase6(p, smem);
    SEAM(7);
    if (IN(8)) phase7(p, smem);
    SEAM(8);
    if (IN(9)) for (int rp = 0; rp < REP(9); ++rp) phase8(p, smem);
    SEAM(9);
    if (IN(10)) for (int rp = 0; rp < REP(10); ++rp) phase9(p, smem);
    SEAM(10);
    if (IN(11)) for (int rp = 0; rp < REP(11); ++rp) phase10(p, smem);
#undef IN
#undef SEAM
}

extern "C" void kernel_launch(void* const* d_in, const int* in_sizes, int n_in, void* d_out, int out_size, void* d_ws, size_t ws_size, hipStream_t stream) {
    static int grid = 0;
    if (!grid) {
        int dev = 0, cus = 0, per_cu = 0;
        (void)hipGetDevice(&dev);
        (void)hipDeviceGetAttribute(&cus, hipDeviceAttributeMultiprocessorCount, dev);
        if (hipFuncSetAttribute((const void*)mega_kernel, hipFuncAttributeMaxDynamicSharedMemorySize, LDS_BYTES) != hipSuccess) { grid = -1; return; }
        if (hipOccupancyMaxActiveBlocksPerMultiprocessor(&per_cu, (const void*)mega_kernel, 512, LDS_BYTES) != hipSuccess || per_cu < 1) { grid = -1; return; }
        grid = cus;
        if (grid > 256) grid = 256;
    }
    if (grid < 0) return;
    Params p{};
    const float* const* in = (const float* const*)d_in;
    p.x = in[0]; p.c = in[1]; p.w_ada = in[2]; p.b_ada = in[3]; p.norm1_g = in[4]; p.w_in = in[5]; p.mu = in[6]; p.sinks = in[7]; p.w0 = in[8]; p.wd_up = in[9];
    p.a0 = in[10]; p.wa_up = in[11]; p.wg_up = in[12]; p.k_k = in[13]; p.k_a = in[14]; p.r_k = in[15]; p.ln_w = in[16]; p.ln_b = in[17]; p.w_o = in[18]; p.norm2_g = in[19];
    p.w_rg = in[20]; p.b_rg = in[21]; p.w_re = in[22]; p.b_re = in[23]; p.w1 = in[24]; p.w3 = in[25]; p.w2 = in[26]; p.final_g = in[27];
    p.out = (float*)d_out; p.ws = (unsigned char*)d_ws;
    (void)hipMemsetAsync((char*)d_ws + WS_CTL, 0, CTL_BYTES, stream);
#if MK_N_LAUNCHES == 1
    hipLaunchKernelGGL(mega_kernel, dim3(grid), dim3(512), LDS_BYTES, stream, p, 0, N_PHASES);
#else
    for (int k = 0; k < N_PHASES; ++k) hipLaunchKernelGGL(mega_kernel, dim3(grid), dim3(512), LDS_BYTES, stream, p, k, k + 1);
#endif
}
```

```cpp
#ifndef PROBE_TS
#define PROBE_TS -1
#endif
#include <hip/hip_runtime.h>
#include <stdint.h>

#define DEVI __device__ __forceinline__
typedef unsigned short bf16_t;
typedef short bf16x8 __attribute__((ext_vector_type(8)));
typedef float f32x4 __attribute__((ext_vector_type(4)));
typedef float f32x16 __attribute__((ext_vector_type(16)));
typedef float f32x2_t __attribute__((ext_vector_type(2)));
typedef __bf16 bf16x2_t __attribute__((ext_vector_type(2)));

constexpr int NTOK = 8192, DM = 2048, SEQ = 4096, INC = 4640, RW = 1024;
constexpr int ZC_K = 1024, ZC_V = 1152, ZC_RW = 1280;
constexpr int NEXP = 64, FF = 512, LCAP = 8192;
constexpr int NKS = 16;

constexpr size_t MiB = 1u << 20;
constexpr size_t WS_CTL = 0, CTL_BYTES = 98304;
constexpr int CNT_OFF = 32768, CNT_ST = 256;
constexpr size_t WS_PART = 1 * MiB;
constexpr size_t WS_MODF = 3 * MiB;
constexpr size_t WS_ROPE = 4 * MiB;
constexpr size_t WS_WRF = 5 * MiB;
constexpr size_t WS_CB = 7 * MiB;
constexpr size_t WS_AS2 = 7 * MiB + 4096;
constexpr size_t WS_H = 8 * MiB;
constexpr size_t WS_Z = 40 * MiB;
constexpr size_t WS_MIX = 116 * MiB;
constexpr size_t WS_X1 = 148 * MiB;
constexpr size_t WS_R = 212 * MiB, WS_DEC = 244 * MiB, WS_K2 = 276 * MiB, WS_V = 308 * MiB, WS_AA = 340 * MiB, WS_BB = 372 * MiB, WS_G = 404 * MiB, WS_Y = 436 * MiB;
constexpr size_t WS_LW = 212 * MiB;
constexpr size_t WS_AV = 244 * MiB;
constexpr size_t WS_GV = 260 * MiB;
constexpr size_t WS_RKS = 468 * MiB;
constexpr size_t WS_LIST = 469 * MiB;
constexpr size_t WS_LWT = 471 * MiB;
constexpr size_t WS_HID = 473 * MiB;
constexpr size_t WS_YB = 490 * MiB;

constexpr size_t WS_WTI = 672 * MiB;
constexpr size_t WS_WTO = 692 * MiB;
constexpr size_t WS_GB = 556 * MiB;
constexpr size_t WS_HB = 572 * MiB;
constexpr size_t WS_Q2 = 604 * MiB;
constexpr size_t WS_Q1 = 636 * MiB;
constexpr size_t WS_S0 = 652 * MiB;

constexpr int LDS_BYTES = 147456;

struct Params {
    const float *x, *c, *w_ada, *b_ada, *norm1_g, *w_in, *mu, *sinks, *w0, *wd_up, *a0, *wa_up, *wg_up, *k_k, *k_a, *r_k, *ln_w, *ln_b, *w_o, *norm2_g,
        *w_rg, *b_rg, *w_re, *b_re, *w1, *w3, *w2, *final_g;
    float* out;
    unsigned char* ws;
};

DEVI unsigned cvtpk_v(float lo, float hi) { unsigned r; asm volatile("v_cvt_pk_bf16_f32 %0, %1, %2" : "=v"(r) : "v"(lo), "v"(hi)); return r; }
DEVI unsigned cvtpk(float lo, float hi) { f32x2_t v = {lo, hi}; bf16x2_t b = __builtin_convertvector(v, bf16x2_t); return __builtin_bit_cast(unsigned, b); }
DEVI float bf2f(unsigned h) { return __builtin_bit_cast(float, h << 16); }
DEVI float bflo(unsigned u) { return __builtin_bit_cast(float, u << 16); }
DEVI float bfhi(unsigned u) { return __builtin_bit_cast(float, u & 0xffff0000u); }
DEVI float wave_sum(float v) {
#pragma unroll
    for (int o = 32; o > 0; o >>= 1) v += __shfl_xor(v, o, 64);
    return v;
}
DEVI float sigmoidf_(float x) { return 1.f / (1.f + __expf(-x)); }

#define XB_TMO      128
#define XB_XCNT(j)  (256  + 64 * (j))
#define XB_XSUB(j)  (1280 + 64 * (j))
#define XB_XGEN(j)  (2304 + 64 * (j))
#define XB_TOP      3328
#define XB_TOPGEN   3392
#define XCD_BAR_WORDS 3456
#define XB_SPIN_CAP (1u << 18)
#define LAS __attribute__((address_space(3)))

__device__ __forceinline__ unsigned xb_ld(unsigned* p)              { return __hip_atomic_load(p, __ATOMIC_RELAXED, __HIP_MEMORY_SCOPE_AGENT); }
__device__ __forceinline__ unsigned xb_add(unsigned* p, unsigned v) { return __hip_atomic_fetch_add(p, v, __ATOMIC_RELAXED, __HIP_MEMORY_SCOPE_AGENT); }
__device__ __forceinline__ unsigned xb_xcc_id() { return (unsigned)__builtin_amdgcn_s_getreg((3 << 11) | 20) & 0xFu; }
#define XB_SPIN(cond, bar) do { unsigned _sp = 0; while (cond) { __builtin_amdgcn_s_sleep(1); \
    if ((++_sp & 255u) == 0u) { if (xb_ld(&(bar)[XB_TMO])) break; if (_sp > XB_SPIN_CAP) { atomicAdd(&(bar)[XB_TMO], 1u); break; } } } } while (0)

struct XcdBarrier {
    unsigned* bar; unsigned x;
    volatile LAS unsigned* st;
};

__device__ __forceinline__ XcdBarrier xcd_barrier_post(unsigned* bar, volatile LAS unsigned* st) {
    XcdBarrier b; b.bar = bar; b.x = xb_xcc_id(); b.st = st;
    if (threadIdx.x == 0) (void)xb_add(&bar[XB_XCNT(b.x)], 1u);
    return b;
}
__device__ __forceinline__ void xcd_barrier_complete(unsigned* bar, unsigned x, unsigned& nloc, unsigned& nx) {
    const unsigned G = gridDim.x * gridDim.y * gridDim.z;
    unsigned sum, cnt, mine, sp = 0u;
    for (;;) {
        sum = 0u; cnt = 0u; mine = 0u;
#pragma unroll
        for (unsigned j = 0; j < 16; ++j) { const unsigned c = xb_ld(&bar[XB_XCNT(j)]); sum += c; cnt += (c > 0u) ? 1u : 0u; mine = (j == x) ? c : mine; }
        if (sum == G) break;
        __builtin_amdgcn_s_sleep(1);
        if ((++sp & 255u) == 0u) { if (xb_ld(&bar[XB_TMO])) break; if (sp > XB_SPIN_CAP) { atomicAdd(&bar[XB_TMO], 1u); break; } }
    }
    nloc = mine > 0u ? mine : 1u; nx = cnt > 0u ? cnt : 1u;
}

__device__ __forceinline__ void xcd_barrier(const XcdBarrier& b) {
    asm volatile("s_waitcnt vmcnt(0)" ::: "memory");
    __syncthreads();
    if (threadIdx.x == 0) {
        unsigned* bar = b.bar;
        __builtin_amdgcn_s_waitcnt(0);
        unsigned nloc = b.st[0], nx = b.st[1];
        if (nloc == 0u) { xcd_barrier_complete(bar, b.x, nloc, nx); b.st[0] = nloc; b.st[1] = nx; }
        const unsigned old = xb_add(&bar[XB_XSUB(b.x)], 1u);
        const unsigned gen = old / nloc;
        if (old + 1u == (gen + 1u) * nloc) {
            __builtin_amdgcn_fence(__ATOMIC_RELEASE, "agent");
            asm volatile("s_waitcnt vmcnt(0)" ::: "memory");
            const unsigned og = xb_add(&bar[XB_TOP], 1u);
            const unsigned tg = og / nx;
            if (og + 1u == (tg + 1u) * nx) xb_add(&bar[XB_TOPGEN], 1u);
            else XB_SPIN(xb_ld(&bar[XB_TOPGEN]) == tg, bar);
            __builtin_amdgcn_fence(__ATOMIC_ACQUIRE, "agent");
            xb_add(&bar[XB_XGEN(b.x)], 1u);
            asm volatile("s_waitcnt vmcnt(0)" ::: "memory");
        } else {
            XB_SPIN(xb_ld(&bar[XB_XGEN(b.x)]) == gen, bar);
            __builtin_amdgcn_fence(__ATOMIC_ACQUIRE, "agent");
            asm volatile("s_waitcnt vmcnt(0)" ::: "memory");
        }
    }
    __syncthreads();
}

template <int PF, int R, class ALoad, class Epi>
DEVI void gemm_tile_f(char* smem, int nk, long ldb, const float* bp0, const float* bp1, ALoad&& aload, Epi&& epi) {
    static_assert(R > PF && (R % 2) == 0, "ring");
    const int tid = threadIdx.x, lane = tid & 63, li = lane & 15, lg = lane >> 4;
    const int sr = tid >> 2, scn = tid & 3;
    const unsigned aw0 = sr * 64 + ((scn ^ ((0 - (sr >> 2)) & 3)) << 4), aw1 = aw0 + 128 * 64;
    const unsigned ar = li * 64 + ((lg ^ ((0 - (li >> 2)) & 3)) << 4);
    float breg[R][2][8];
    f32x4 acc[16][2];
#pragma unroll
    for (int m = 0; m < 16; ++m) { acc[m][0] = f32x4{0.f, 0.f, 0.f, 0.f}; acc[m][1] = f32x4{0.f, 0.f, 0.f, 0.f}; }
    uint4 areg0 = aload(0, 0), areg1 = aload(1, 0);
#pragma unroll
    for (int s = 0; s < PF; ++s) {
        if (s < nk) {
#pragma unroll
            for (int j = 0; j < 8; ++j) { breg[s][0][j] = bp0[(long)(s * 32 + j) * ldb]; breg[s][1][j] = bp1[(long)(s * 32 + j) * ldb]; }
        }
    }
    *(uint4*)(smem + aw0) = areg0; *(uint4*)(smem + aw1) = areg1;
    __syncthreads();
    for (int kt0 = 0; kt0 < nk; kt0 += R) {
#pragma unroll
        for (int u = 0; u < R; ++u) {
            const int kt = kt0 + u;
            if (kt < nk) {
                {
                    const int ka = kt + 1 < nk ? kt + 1 : nk - 1, kb = kt + PF < nk ? kt + PF : nk - 1;
                    areg0 = aload(0, ka); areg1 = aload(1, ka);
                    __builtin_amdgcn_sched_barrier(0);
                    const float* q0 = bp0 + (long)kb * 32 * ldb; const float* q1 = bp1 + (long)kb * 32 * ldb;
#pragma unroll
                    for (int j = 0; j < 8; ++j) { breg[(u + PF) % R][0][j] = q0[(long)j * ldb]; breg[(u + PF) % R][1][j] = q1[(long)j * ldb]; }
                }
                __builtin_amdgcn_sched_barrier(0);
                uint4 b0, b1;
                b0.x = cvtpk_v(breg[u][0][0], breg[u][0][1]); b0.y = cvtpk_v(breg[u][0][2], breg[u][0][3]); b0.z = cvtpk_v(breg[u][0][4], breg[u][0][5]); b0.w = cvtpk_v(breg[u][0][6], breg[u][0][7]);
                b1.x = cvtpk_v(breg[u][1][0], breg[u][1][1]); b1.y = cvtpk_v(breg[u][1][2], breg[u][1][3]); b1.z = cvtpk_v(breg[u][1][4], breg[u][1][5]); b1.w = cvtpk_v(breg[u][1][6], breg[u][1][7]);
                const bf16x8 bf0 = __builtin_bit_cast(bf16x8, b0), bf1 = __builtin_bit_cast(bf16x8, b1);
                const char* As = smem + (u & 1) * 16384 + ar;
#pragma unroll
                for (int mb = 0; mb < 16; mb += 4) {
                    bf16x8 af[4];
#pragma unroll
                    for (int m = 0; m < 4; ++m) af[m] = *(const bf16x8*)(As + (mb + m) * 1024);
                    __builtin_amdgcn_sched_barrier(0);
#pragma unroll
                    for (int m = 0; m < 4; ++m) {
                        acc[mb + m][0] = __builtin_amdgcn_mfma_f32_16x16x32_bf16(bf0, af[m], acc[mb + m][0], 0, 0, 0);
                        acc[mb + m][1] = __builtin_amdgcn_mfma_f32_16x16x32_bf16(bf1, af[m], acc[mb + m][1], 0, 0, 0);
                    }
                    __builtin_amdgcn_sched_barrier(0);
                }
                { char* Aw = smem + ((u + 1) & 1) * 16384; *(uint4*)(Aw + aw0) = areg0; *(uint4*)(Aw + aw1) = areg1; }
                __syncthreads();
            }
        }
    }
    epi(acc);
}
template <int PF, int R, class Epi>
DEVI void gemm_tile(char* smem, int nk, long ldb, const float* bp0, const float* bp1, const bf16_t* ap0, const bf16_t* ap1, Epi&& epi) {
    gemm_tile_f<PF, R>(smem, nk, ldb, bp0, bp1, [&](int i, int kt) { return *(const uint4*)((i ? ap1 : ap0) + kt * 32); }, epi);
}

namespace pg8 {
#define PG8_LAS __attribute__((address_space(3)))
typedef unsigned short bf16_t;
typedef short bf16x8 __attribute__((ext_vector_type(8)));
typedef float f32x4 __attribute__((ext_vector_type(4)));
typedef unsigned u32x4 __attribute__((ext_vector_type(4)));
constexpr int BM = 256, BK = 64, HALF = 128, HTB = HALF * BK * 2  , STAGE_BYTES = 8 * HTB, NXCD = 8, WGM = 8;

__host__ __device__ __forceinline__ int lds_byte(int r, int c) { const int st = (r >> 4) * 2 + (c >> 5), rr = r & 15, cc = c & 31, ob = rr * 64 + cc * 2; return st * 1024 + (ob ^ (((ob >> 9) & 1) << 5)); }
__host__ __device__ __forceinline__ void stage_rc(int b, int& R, int& C) { const int st = b / 1024, sb = b % 1024, swz = sb ^ (((sb >> 9) & 1) << 5); R = (st >> 1) * 16 + swz / 64; C = (st & 1) * 32 + (swz % 64) / 2; }
__host__ __device__ __forceinline__ int perm32(int rho) { const int n = rho >> 4, i = rho & 15; return 8 * (i >> 2) + 4 * n + (i & 3); }

struct Unit { int pm, pn; };
struct Gemm { const bf16_t* A; const bf16_t* Bt; int M, N, K; };

struct StaticOrder {
    int nM, nN, nwg, G, c;
    __host__ __device__ void init(int M, int N, int G_, int c_) { nM = M / BM; nN = N / BM; nwg = nM * nN; G = G_; c = c_; }
    __host__ __device__ bool next(int i, Unit& u) const {
        const long L = (long)i * G + c; if (L >= nwg) return false;
        int wgid = (int)L; { const int q = nwg / NXCD, r = nwg % NXCD, xcd = wgid % NXCD, off = wgid / NXCD; wgid = (xcd < r ? xcd * (q + 1) : r * (q + 1) + (xcd - r) * q) + off; }
        const int nig = WGM * nN, gid = wgid / nig, fm = gid * WGM, gsz = (nM - fm) < WGM ? (nM - fm) : WGM;
        u.pm = fm + ((wgid % nig) % gsz); u.pn = (wgid % nig) / gsz; return true;
    }
    __device__ __forceinline__ void a_ready(const Unit&) const {}
    __device__ __forceinline__ void done(const Unit&) const {}
};


__device__ __forceinline__ unsigned cvt_pk_bf16(float lo, float hi) { unsigned r; asm volatile("v_cvt_pk_bf16_f32 %0, %1, %2" : "=v"(r) : "v"(lo), "v"(hi)); return r; }
struct EpiZ {
    static constexpr bool PERM = true, AFTER_DRAIN = false;
    bf16_t* O; int ldc; int ncols;
    __device__ __forceinline__ void operator()(const f32x4 (&acc)[2][2][4][2], const Unit& u, int wr, int wc, int fr, int fq) const {
        const int row0 = u.pm * BM + wr * 64 + fr, col0 = u.pn * BM + wc * 32 + 8 * fq;
#pragma unroll
        for (int ai = 0; ai < 2; ++ai)
#pragma unroll
            for (int m = 0; m < 4; ++m) { bf16_t* rowp = O + (size_t)(row0 + ai * HALF + m * 16) * ldc;
#pragma unroll
                for (int bj = 0; bj < 2; ++bj) { const int col = col0 + bj * HALF;
                    if (col < ncols) { const f32x4 v0 = acc[ai][bj][m][0], v1 = acc[ai][bj][m][1];
                        u32x4 w; w.x = cvt_pk_bf16(v0[0], v0[1]); w.y = cvt_pk_bf16(v0[2], v0[3]); w.z = cvt_pk_bf16(v1[0], v1[1]); w.w = cvt_pk_bf16(v1[2], v1[3]);
                        *(u32x4*)(rowp + col) = w; } } }
    }
};
struct EpiX1 {
    static constexpr bool PERM = true, AFTER_DRAIN = false;
    float* O; const float* res; const float* gate; int ldc; int gate_stride; int rows_per_batch;
    __device__ __forceinline__ void operator()(const f32x4 (&acc)[2][2][4][2], const Unit& u, int wr, int wc, int fr, int fq) const {
        const int row0 = u.pm * BM + wr * 64 + fr, col0 = u.pn * BM + wc * 32 + 8 * fq;
        const float* gp = gate + (size_t)((u.pm * BM) / rows_per_batch) * gate_stride;
#pragma unroll
        for (int bj = 0; bj < 2; ++bj) { const int col = col0 + bj * HALF;
            const f32x4 g0 = *(const f32x4*)(gp + col), g1 = *(const f32x4*)(gp + col + 4);
#pragma unroll
            for (int ai = 0; ai < 2; ++ai)
#pragma unroll
                for (int m = 0; m < 4; ++m) { const size_t o = (size_t)(row0 + ai * HALF + m * 16) * ldc + col;
                    const f32x4 x0 = *(const f32x4*)(res + o), x1 = *(const f32x4*)(res + o + 4);
                    *(f32x4*)(O + o) = x0 + g0 * acc[ai][bj][m][0]; *(f32x4*)(O + o + 4) = x1 + g1 * acc[ai][bj][m][1]; } }
    }
};
template <class Epi, class Sched, bool ALIGN_EPI = false, bool SP2 = false>
__device__ __forceinline__ void gemm_phase(PG8_LAS unsigned char* lds, const Gemm g, const Sched& S, const Epi& E) {
    const int tid = threadIdx.x, wid = __builtin_amdgcn_readfirstlane(tid >> 6), lane = tid & 63, wr = wid >> 2, wc = wid & 3, fr = lane & 15, fq = lane >> 4;
    const int K = g.K, nt = K / BK;
    unsigned voffA[2], voffB[2];
#pragma unroll
    for (int i = 0; i < 2; ++i) { int R, C; stage_rc(tid * 16 + i * 8192, R, C); const int Rb = Epi::PERM ? ((R & ~31) + perm32(R & 31)) : R;
        voffA[i] = (unsigned)(R * K + C) * 2u; voffB[i] = (unsigned)(Rb * K + C) * 2u; }
    const size_t kstep = (size_t)(BK * 2);
    const size_t hstep = (size_t)HALF * K * 2;
    const size_t tstep = 2 * hstep;
    const unsigned ldsw = (unsigned)wid * 1024u;
    const int aoff = lds_byte(wr * 64 + fr, fq * 8), boff = lds_byte(wc * 32 + fr, fq * 8);
#define PG8_SA(b, h) (((b) * 2 + (h)) * HTB)
#define PG8_SB(b, h) ((4 + (b) * 2 + (h)) * HTB)
#define PG8_STAGE(bufoff, gbase, voff) do { _Pragma("unroll") for (int _i = 0; _i < 2; ++_i) \
        __builtin_amdgcn_global_load_lds((const unsigned*)((const char*)(gbase) + (voff)[_i]), (PG8_LAS unsigned*)(lds + (bufoff) + ldsw + _i * 8192), 16, 0, 0); } while (0)
#define PG8_LDA(dst, b, h) do { _Pragma("unroll") for (int m = 0; m < 4; ++m) _Pragma("unroll") for (int k = 0; k < 2; ++k) dst[m][k] = *(const PG8_LAS bf16x8*)(lds + PG8_SA(b, h) + aoff + m * 2048 + k * 1024); } while (0)
#define PG8_LDB(dst, b, h) do { _Pragma("unroll") for (int n = 0; n < 2; ++n) _Pragma("unroll") for (int k = 0; k < 2; ++k) dst[n][k] = *(const PG8_LAS bf16x8*)(lds + PG8_SB(b, h) + boff + n * 2048 + k * 1024); } while (0)
#define PG8_MMA(ai, bj, At, Bt) do { __builtin_amdgcn_s_setprio(1); _Pragma("unroll") for (int m = 0; m < 4; ++m) _Pragma("unroll") for (int n = 0; n < 2; ++n) _Pragma("unroll") for (int k = 0; k < 2; ++k) \
        acc[ai][bj][m][n] = __builtin_amdgcn_mfma_f32_16x16x32_bf16(Bt[n][k], At[m][k], acc[ai][bj][m][n], 0, 0, 0); __builtin_amdgcn_s_setprio(0); } while (0)
#define PG8_WAIT_V(n) asm volatile("s_waitcnt vmcnt(" #n ")" ::: "memory")
#define PG8_WAIT_L(n) asm volatile("s_waitcnt lgkmcnt(" #n ")" ::: "memory")
#define PG8_BAR __builtin_amdgcn_s_barrier()
#define PG8_SCHED __builtin_amdgcn_sched_barrier(0)
    Unit cur, nxt; int ui = 0;
    if (!S.next(0, cur)) return;
    f32x4 acc[2][2][4][2];
#pragma unroll
    for (int a = 0; a < 2; ++a)
#pragma unroll
        for (int b = 0; b < 2; ++b)
#pragma unroll
            for (int m = 0; m < 4; ++m)
#pragma unroll
                for (int n = 0; n < 2; ++n) acc[a][b][m][n] = (f32x4){0.f, 0.f, 0.f, 0.f};
    bf16x8 At[4][2], B0[2][2], B1[2][2];
    const char* cA = (const char*)g.A + (size_t)cur.pm * tstep; const char* cB = (const char*)g.Bt + (size_t)cur.pn * tstep;
    S.a_ready(cur);
    if constexpr (SP2) {
        PG8_STAGE(PG8_SB(0, 0), cB, voffB); PG8_STAGE(PG8_SB(0, 1), cB + hstep, voffB); PG8_STAGE(PG8_SA(0, 0), cA, voffA); PG8_STAGE(PG8_SA(0, 1), cA + hstep, voffA);
        if (wr == 1) PG8_BAR;
        PG8_WAIT_V(2); PG8_BAR;
        PG8_STAGE(PG8_SB(1, 0), cB + kstep, voffB); PG8_STAGE(PG8_SA(1, 0), cA + kstep, voffA); PG8_STAGE(PG8_SB(1, 1), cB + hstep + kstep, voffB);
        PG8_WAIT_V(6); PG8_BAR;
    } else {
        PG8_STAGE(PG8_SB(0, 0), cB, voffB); PG8_STAGE(PG8_SA(0, 0), cA, voffA); PG8_STAGE(PG8_SB(0, 1), cB + hstep, voffB); PG8_STAGE(PG8_SA(0, 1), cA + hstep, voffA);
        if (wr == 1) PG8_BAR;
        PG8_WAIT_V(4); PG8_BAR;
        PG8_STAGE(PG8_SB(1, 0), cB + kstep, voffB); PG8_STAGE(PG8_SA(1, 0), cA + kstep, voffA); PG8_STAGE(PG8_SB(1, 1), cB + hstep + kstep, voffB);
        PG8_WAIT_V(6); PG8_BAR;
    }
    for (;;) {
        const bool has_next = S.next(ui + 1, nxt);
        const char* nA = has_next ? (const char*)g.A + (size_t)nxt.pm * tstep : cA; const char* nB = has_next ? (const char*)g.Bt + (size_t)nxt.pn * tstep : cB;
        for (int t = 0; t < nt; t += 2) {
            const bool last = (t == nt - 2);
            const char* a1 = cA + (size_t)(t + 1) * kstep;
            const char* a2 = last ? nA : cA + (size_t)(t + 2) * kstep; const char* b2 = last ? nB : cB + (size_t)(t + 2) * kstep;
            const char* a3 = a2 + kstep; const char* b3 = b2 + kstep;
            if (last && has_next) S.a_ready(nxt);
            if constexpr (SP2) {
            PG8_LDB(B0, 0, 0); PG8_LDB(B1, 0, 1); PG8_SCHED; PG8_LDA(At, 0, 0); PG8_STAGE(PG8_SA(1, 1), a1 + hstep, voffA);
            PG8_WAIT_V(8); PG8_WAIT_L(0); PG8_BAR; PG8_MMA(0, 0, At, B0); PG8_MMA(0, 1, At, B1); PG8_BAR; PG8_SCHED;
            PG8_LDA(At, 0, 1); PG8_STAGE(PG8_SB(0, 0), b2, voffB); PG8_STAGE(PG8_SB(0, 1), b2 + hstep, voffB); PG8_STAGE(PG8_SA(0, 0), a2, voffA);
            PG8_WAIT_V(8); PG8_WAIT_L(0); PG8_BAR; PG8_MMA(1, 0, At, B0); PG8_MMA(1, 1, At, B1); PG8_BAR; PG8_SCHED;
            PG8_LDB(B0, 1, 0); PG8_LDB(B1, 1, 1); PG8_SCHED; PG8_LDA(At, 1, 0); PG8_STAGE(PG8_SA(0, 1), a2 + hstep, voffA);
            PG8_WAIT_V(8); PG8_WAIT_L(0); PG8_BAR; PG8_MMA(0, 0, At, B0); PG8_MMA(0, 1, At, B1); PG8_BAR; PG8_SCHED;
            PG8_LDA(At, 1, 1); PG8_STAGE(PG8_SB(1, 0), b3, voffB); PG8_STAGE(PG8_SB(1, 1), b3 + hstep, voffB); PG8_STAGE(PG8_SA(1, 0), a3, voffA);
            PG8_WAIT_V(8); PG8_WAIT_L(0); PG8_BAR; PG8_MMA(1, 0, At, B0); PG8_MMA(1, 1, At, B1); PG8_BAR; PG8_SCHED;
            } else {
            PG8_LDB(B0, 0, 0); PG8_SCHED; PG8_LDA(At, 0, 0); PG8_STAGE(PG8_SA(1, 1), a1 + hstep, voffA);
            PG8_WAIT_L(8); PG8_BAR; PG8_WAIT_L(0); PG8_MMA(0, 0, At, B0); PG8_BAR; PG8_SCHED;
            PG8_LDB(B1, 0, 1); PG8_STAGE(PG8_SB(0, 0), b2, voffB);
            PG8_BAR; PG8_WAIT_L(0); PG8_MMA(0, 1, At, B1); PG8_BAR;
            PG8_LDA(At, 0, 1); PG8_STAGE(PG8_SA(0, 0), a2, voffA);
            PG8_BAR; PG8_WAIT_L(0); PG8_MMA(1, 0, At, B0); PG8_BAR; PG8_SCHED;
            PG8_STAGE(PG8_SB(0, 1), b2 + hstep, voffB);
            PG8_WAIT_V(6); PG8_BAR; PG8_MMA(1, 1, At, B1); PG8_BAR;
            PG8_LDB(B0, 1, 0); PG8_SCHED; PG8_LDA(At, 1, 0); PG8_STAGE(PG8_SA(0, 1), a2 + hstep, voffA);
            PG8_WAIT_L(8); PG8_BAR; PG8_WAIT_L(0); PG8_MMA(0, 0, At, B0); PG8_BAR; PG8_SCHED;
            PG8_LDB(B1, 1, 1); PG8_STAGE(PG8_SB(1, 0), b3, voffB);
            PG8_BAR; PG8_WAIT_L(0); PG8_MMA(0, 1, At, B1); PG8_BAR;
            PG8_LDA(At, 1, 1); PG8_STAGE(PG8_SA(1, 0), a3, voffA);
            PG8_BAR; PG8_WAIT_L(0); PG8_MMA(1, 0, At, B0); PG8_BAR; PG8_SCHED;
            PG8_STAGE(PG8_SB(1, 1), b3 + hstep, voffB);
            PG8_WAIT_V(6); PG8_BAR; PG8_MMA(1, 1, At, B1); PG8_BAR;
            }
        }
        if constexpr (ALIGN_EPI) { if (wr == 0) PG8_BAR; }
        if constexpr (!Epi::AFTER_DRAIN) { E(acc, cur, wr, wc, fr, fq); S.done(cur); }
        if (!has_next) break;
#pragma unroll
        for (int a = 0; a < 2; ++a)
#pragma unroll
            for (int b = 0; b < 2; ++b)
#pragma unroll
                for (int m = 0; m < 4; ++m)
#pragma unroll
                    for (int n = 0; n < 2; ++n) acc[a][b][m][n] = (f32x4){0.f, 0.f, 0.f, 0.f};
        cur = nxt; cA = nA; cB = nB; ++ui;
        if constexpr (ALIGN_EPI) { if (wr == 1) PG8_BAR; }
    }
    PG8_WAIT_V(0);
    if constexpr (!ALIGN_EPI) { if (wr == 0) PG8_BAR; }
    PG8_BAR;
    if constexpr (Epi::AFTER_DRAIN) { E.fused(acc, cur, wr, wc, fr, fq, lds, wid, lane); S.done(cur); }
#undef PG8_SA
#undef PG8_SB
#undef PG8_STAGE
#undef PG8_LDA
#undef PG8_LDB
#undef PG8_MMA
#undef PG8_WAIT_V
#undef PG8_WAIT_L
#undef PG8_BAR
#undef PG8_SCHED
}
}

DEVI void ada_unit(const Params& p, char* smem, int cb, int ks) {
    float* sl = (float*)smem;
    float* part = (float*)(p.ws + WS_PART);
    const int tid = threadIdx.x;
    __syncthreads();
    if (tid < 256) { const int b = tid >> 7, kk = tid & 127; const float cv = p.c[b * DM + ks * 128 + kk]; sl[b * 128 + kk] = cv / (1.f + expf(-cv)); }
    __syncthreads();
    const int j = cb * 512 + tid;
    const float* w = p.w_ada + (size_t)(ks * 128) * 12288 + j;
    float a0 = 0.f, a1 = 0.f;
#pragma unroll 16
    for (int kk = 0; kk < 128; ++kk) { const float wv = w[(size_t)kk * 12288]; a0 += sl[kk] * wv; a1 += sl[128 + kk] * wv; }
    part[(ks * 2 + 0) * 12288 + j] = a0; part[(ks * 2 + 1) * 12288 + j] = a1;
}
DEVI void ada_unit_h(const Params& p, char* smem, int cb, int ks) {
    float* sl = (float*)smem;
    float* part = (float*)(p.ws + WS_PART);
    const int tid = threadIdx.x, hf = tid >> 8, t = tid & 255;
    __syncthreads();
    if (tid < 256) { const int b = tid >> 7, kk = tid & 127; const float cv = p.c[b * DM + ks * 128 + kk]; sl[b * 128 + kk] = cv / (1.f + expf(-cv)); }
    __syncthreads();
    const int j = cb * 256 + t;
    const float* w = p.w_ada + (size_t)(ks * 128 + hf * 64) * 12288 + j;
    const float* s0 = sl + hf * 64;
    float a0 = 0.f, a1 = 0.f;
#pragma unroll 16
    for (int kk = 0; kk < 64; ++kk) { const float wv = w[(size_t)kk * 12288]; a0 += s0[kk] * wv; a1 += s0[128 + kk] * wv; }
    if (hf) { sl[256 + t] = a0; sl[512 + t] = a1; }
    __syncthreads();
    if (!hf) { part[(ks * 2 + 0) * 12288 + j] = a0 + sl[256 + t]; part[(ks * 2 + 1) * 12288 + j] = a1 + sl[512 + t]; }
}
DEVI void transpose_item(const float* W, int N, bf16_t* WT, int r, char* smem) {
    const int lane = threadIdx.x & 63, wave = threadIdx.x >> 6;
    float* scr = (float*)(smem + 4096) + wave * (64 * 33);
    const int nblk = N / 32, kb = r / nblk, nb = r % nblk, k0 = 64 * kb, n0 = 32 * nb;
    {
        float4 t[8];
#pragma unroll
        for (int i = 0; i < 8; ++i) t[i] = *(const float4*)(W + (size_t)(k0 + (lane >> 3) + 8 * i) * N + n0 + 4 * (lane & 7));
#pragma unroll
        for (int i = 0; i < 8; ++i) { float* d = scr + ((lane >> 3) + 8 * i) * 33 + 4 * (lane & 7); d[0] = t[i].x; d[1] = t[i].y; d[2] = t[i].z; d[3] = t[i].w; }
    }
    const int c = lane & 7;
#pragma unroll
    for (int j = 0; j < 4; ++j) { const int n = (lane >> 3) + 8 * j; const float* sp = scr + (8 * c) * 33 + n;
        uint4 o; o.x = cvtpk(sp[0 * 33], sp[1 * 33]); o.y = cvtpk(sp[2 * 33], sp[3 * 33]); o.z = cvtpk(sp[4 * 33], sp[5 * 33]); o.w = cvtpk(sp[6 * 33], sp[7 * 33]);
        *(uint4*)(WT + (size_t)(n0 + n) * DM + k0 + 8 * c) = o; }
}
DEVI void phase0(const Params& p, char* smem) {
    float* rope = (float*)(p.ws + WS_ROPE);
    const int tid = threadIdx.x, lane = tid & 63, wave = tid >> 6;
    constexpr int N_ADA = 16 * NKS, N_ROPE = 256;
    for (int u = blockIdx.x; u < N_ADA + N_ROPE; u += gridDim.x) {
        if (u < N_ADA) {
            ada_unit_h(p, smem, u & 15, u >> 4);
        } else {
            const int idx = (u - N_ADA) * 512 + tid;
            const int t = idx >> 5, i = idx & 31;
            const double invf = exp(-(double)(2 * i) / 64.0 * 9.210340371976184);
            const double ang = (double)t * invf;
            rope[idx] = (float)cos(ang); rope[SEQ * 32 + idx] = (float)sin(ang);
        }
    }
    __syncthreads();
    {
        bf16_t* wti = (bf16_t*)(p.ws + WS_WTI);
        constexpr int I_IN = 32 * (INC / 32), I_Z = (4864 - INC) * DM / 8 / 64;
        for (int it = blockIdx.x * 8 + wave; it < I_IN + I_Z; it += gridDim.x * 8) {
            if (it >= I_IN) { const size_t o = (size_t)INC * DM + ((size_t)(it - I_IN) * 64 + lane) * 8; *(uint4*)(wti + o) = make_uint4(0u, 0u, 0u, 0u); continue; }
            transpose_item(p.w_in, INC, wti, it, smem);
        }
    }
}

DEVI float mod_from_part(const Params& p, int b, int j) {
    const float* part = (const float*)(p.ws + WS_PART);
    float s = p.b_ada[j];
#pragma unroll
    for (int ks = 0; ks < NKS; ++ks) s += part[(ks * 2 + b) * 12288 + j];
    return s;
}

constexpr int N_MODF = 48, N_WRF = 128, N_CB = 2, N_AS2 = 8, N_SPEC = N_WRF + N_CB + N_AS2 + N_MODF;
DEVI void spec_unit(const Params& p, char* smem, int v) {
    float* A1 = (float*)smem;
    const int tid = threadIdx.x, lane = tid & 63, wave = tid >> 6;
    if (v >= N_CB + N_WRF + N_AS2) {
        const int idx = (v - (N_CB + N_WRF + N_AS2)) * 512 + tid; const int b = idx / 12288, j = idx % 12288;
        ((float*)(p.ws + WS_MODF))[idx] = mod_from_part(p, b, j);
    } else {
            if (v < N_CB) {
                const int b = v;
                float* sh2 = A1 + 4 * DM;
                float* red = sh2 + DM;
                __syncthreads();
                for (int k = tid; k < DM; k += 512) sh2[k] = mod_from_part(p, b, 3 * DM + k);
                __syncthreads();
                float ae = 0.f, ag = 0.f;
#pragma unroll 16
                for (int kk = 0; kk < 256; ++kk) { const int k = wave * 256 + kk; const float sv = sh2[k]; ae += sv * p.w_re[k * 64 + lane]; ag += sv * p.w_rg[k * 8 + (lane & 7)]; }
                red[wave * 80 + lane] = ae; if (lane < 8) red[wave * 80 + 64 + lane] = ag;
                __syncthreads();
                if (tid < 80) {
                    float r = 0.f;
                    if (tid < 72) {
#pragma unroll
                        for (int w = 0; w < 8; ++w) r += red[w * 80 + tid];
                        r += (tid < 64 ? p.b_re[tid] : p.b_rg[tid - 64]);
                    }
                    ((float*)(p.ws + WS_CB))[b * 80 + tid] = r;
                }
            } else if (v < N_CB + N_WRF) {
                const int vv = v - N_CB, b = vv >> 6, ks = vv & 63, ln = tid & 63, e = tid >> 6;
                const int k = ks * 32 + 8 * (ln >> 4) + e;
                const float a2 = p.norm2_g[k] * (1.f + mod_from_part(p, b, 4 * DM + k));
                bf16_t* wrf = (bf16_t*)(p.ws + WS_WRF);
#pragma unroll
                for (int nf = 0; nf < 5; ++nf) {
                    const int j = nf * 16 + (ln & 15);
                    const float wv = j < 64 ? p.w_re[k * 64 + j] : (j < 72 ? p.w_rg[k * 8 + (j - 64)] : 0.f);
                    const float val = a2 * wv;
                    const unsigned hi = cvtpk(val, 0.f) & 0xffffu;
                    const unsigned lo = cvtpk(val - bf2f(hi), 0.f) & 0xffffu;
                    const size_t base = ((((size_t)(b * 64 + ks) * 5 + nf) * 2) * 64 + ln) * 8 + e;
                    wrf[base] = (bf16_t)hi; wrf[base + 512] = (bf16_t)lo;
                }
            } else {
                const int idx = (v - N_WRF - N_CB) * 512 + tid, b = idx >> 11, k = idx & 2047;
                float* as2 = (float*)(p.ws + WS_AS2);
                as2[idx] = p.norm2_g[k] * (1.f + mod_from_part(p, b, 4 * DM + k));
                as2[2 * DM + idx] = mod_from_part(p, b, 3 * DM + k);
            }
    }
}

DEVI void phase1(const Params& p, char* smem) {
    float* A1 = (float*)smem;
    float* S1 = A1 + 2 * DM;
    float* modf = (float*)(p.ws + WS_MODF);
    bf16_t* h = (bf16_t*)(p.ws + WS_H);
    const int tid = threadIdx.x, lane = tid & 63, wave = tid >> 6;
    constexpr int N_ROWS = NTOK / 8;
    const int upw = (N_ROWS + (int)gridDim.x - 1) / (int)gridDim.x, u_lo = (int)blockIdx.x * upw, u_hi = (u_lo + upw < N_ROWS) ? u_lo + upw : N_ROWS;
    const int b_lo = (u_lo * 8) >> 12, b_hi = u_hi > u_lo ? ((u_hi * 8 - 1) >> 12) : b_lo;
    for (int idx = tid; idx < 2 * DM; idx += 512) {
        const int b = idx >> 11, k = idx & 2047;
        if (b >= b_lo && b <= b_hi) {
            const float sh = mod_from_part(p, b, k), sc = mod_from_part(p, b, DM + k);
            A1[idx] = p.norm1_g[k] * (1.f + sc); S1[idx] = sh;
        }
    }
    __syncthreads();
    for (int u = u_lo; u < u_hi; ++u) {
        {
            const int row = u * 8 + wave, b = row >> 12;
            const float* xr = p.x + (size_t)row * DM;
            float4 v[8]; float ss = 0.f;
#pragma unroll
            for (int i = 0; i < 8; ++i) { v[i] = *(const float4*)(xr + i * 256 + lane * 4); ss += v[i].x * v[i].x + v[i].y * v[i].y + v[i].z * v[i].z + v[i].w * v[i].w; }
            ss = wave_sum(ss);
            const float rstd = rsqrtf(ss * (1.f / DM) + 1e-6f);
#pragma unroll
            for (int i = 0; i < 8; ++i) {
                const int k = i * 256 + lane * 4;
                const float4 a = *(const float4*)(A1 + b * DM + k), s = *(const float4*)(S1 + b * DM + k);
                uint2 o; o.x = cvtpk(v[i].x * rstd * a.x + s.x, v[i].y * rstd * a.y + s.y); o.y = cvtpk(v[i].z * rstd * a.z + s.z, v[i].w * rstd * a.w + s.w);
                *(uint2*)(h + (size_t)row * DM + k) = o;
            }
        }
    }
}

DEVI void phase2(const Params& p, char* smem) {
    pg8::Gemm g{(const pg8::bf16_t*)(p.ws + WS_H), (const pg8::bf16_t*)(p.ws + WS_WTI), NTOK, 4864, DM};
    pg8::StaticOrder S; S.init(NTOK, 4864, (int)gridDim.x, (int)blockIdx.x);
    pg8::EpiZ E{(pg8::bf16_t*)(p.ws + WS_Z), INC, INC};
    pg8::gemm_phase<pg8::EpiZ, pg8::StaticOrder, true, true>((PG8_LAS unsigned char*)smem, g, S, E);
    const int nthird = 608 - 2 * (int)gridDim.x;
    if (gridDim.x == 256 ? (int)blockIdx.x >= nthird : true) {
        const int nw = gridDim.x == 256 ? 256 - nthird : (int)gridDim.x, wi = gridDim.x == 256 ? (int)blockIdx.x - nthird : (int)blockIdx.x;
        __syncthreads();
        for (int u = wi; u < 512; u += nw) {
            if (u < 256) ada_unit(p, smem, 8 + (u & 15), u >> 4);
            else { __syncthreads(); transpose_item(p.w_o, DM, (bf16_t*)(p.ws + WS_WTO), (u - 256) * 8 + (int)(threadIdx.x >> 6), smem); }
        }
    }
}

DEVI float dpp_xor1(float x) { return __builtin_bit_cast(float, __builtin_amdgcn_update_dpp(0, __builtin_bit_cast(int, x), 0xB1, 0xF, 0xF, true)); }
DEVI float dpp_xor2(float x) { return __builtin_bit_cast(float, __builtin_amdgcn_update_dpp(0, __builtin_bit_cast(int, x), 0x4E, 0xF, 0xF, true)); }
DEVI float xor32_sum(float x) {
    float a = x, b = x;
    asm volatile("s_nop 1\n\tv_permlane32_swap_b32 %0, %1\n\ts_nop 1" : "+v"(a), "+v"(b));
    return a + b;
}
DEVI unsigned m64_off(int row, int chunk) { return row * 128 + ((chunk ^ ((row >> 1) & 7)) << 4); }
DEVI void mm_tile(f32x16& acc, const char* X, int xr0, const char* Y, int yr0, int l31, int hh) {
#pragma unroll
    for (int s4 = 0; s4 < 4; ++s4) {
        const bf16x8 a = *(const bf16x8*)(X + m64_off(xr0 + l31, 2 * s4 + hh));
        const bf16x8 b = *(const bf16x8*)(Y + m64_off(yr0 + l31, 2 * s4 + hh));
        acc = __builtin_amdgcn_mfma_f32_32x32x16_bf16(a, b, acc, 0, 0, 0);
    }
}
DEVI f32x16 zero16() { f32x16 z;
#pragma unroll
    for (int i = 0; i < 16; ++i) z[i] = 0.f;
    return z; }


DEVI float tokshift(const bf16_t* z, const float* mu, int tok, int c) {
    const float zc = bf2f(z[(size_t)tok * INC + ZC_RW + c]);
    const float zp = (tok & (SEQ - 1)) ? bf2f(z[(size_t)(tok - 1) * INC + ZC_RW + c]) : 0.f;
    return zc + (zp - zc) * mu[c];
}

DEVI void p3_unit(const Params& p, char* smem, int u) {
    const bf16_t* z = (const bf16_t*)(p.ws + WS_Z);
    bf16_t* mix = (bf16_t*)(p.ws + WS_MIX);
    const float* rope = (const float*)(p.ws + WS_ROPE);
    const int tid = threadIdx.x, lane = tid & 63, wave = tid >> 6;
    constexpr int N_ATT = 256;
    {
        __syncthreads();
        if (u < N_ATT) {
            constexpr int VTS = 392;
            char* Ks = smem;
            char* Vt = smem + 192 * 128;
            const int b = u >> 7, kvh = (u >> 6) & 1, qb = u & 63, t0 = qb * 64, kbase = t0 - 128;
            for (int idx = tid; idx < 192 * 4; idx += 512) {
                const int j = idx >> 2, c = idx & 3, t = kbase + j;
                uint4 o1 = make_uint4(0u, 0u, 0u, 0u), o2 = o1;
                if (t >= 0) {
                    const bf16_t* zr = z + (size_t)(b * SEQ + t) * INC + ZC_K + kvh * 64 + 8 * c;
                    const uint4 ka = *(const uint4*)zr, kb = *(const uint4*)(zr + 32);
                    const float4 c0 = *(const float4*)(rope + t * 32 + 8 * c), c1 = *(const float4*)(rope + t * 32 + 8 * c + 4);
                    const float4 s0 = *(const float4*)(rope + SEQ * 32 + t * 32 + 8 * c), s1 = *(const float4*)(rope + SEQ * 32 + t * 32 + 8 * c + 4);
                    const float a[8] = {bflo(ka.x), bfhi(ka.x), bflo(ka.y), bfhi(ka.y), bflo(ka.z), bfhi(ka.z), bflo(ka.w), bfhi(ka.w)};
                    const float bq[8] = {bflo(kb.x), bfhi(kb.x), bflo(kb.y), bfhi(kb.y), bflo(kb.z), bfhi(kb.z), bflo(kb.w), bfhi(kb.w)};
                    const float cs[8] = {c0.x, c0.y, c0.z, c0.w, c1.x, c1.y, c1.z, c1.w}, sn[8] = {s0.x, s0.y, s0.z, s0.w, s1.x, s1.y, s1.z, s1.w};
                    float r1[8], r2[8];
#pragma unroll
                    for (int e = 0; e < 8; ++e) { r1[e] = a[e] * cs[e] - bq[e] * sn[e]; r2[e] = bq[e] * cs[e] + a[e] * sn[e]; }
                    o1 = make_uint4(cvtpk(r1[0], r1[1]), cvtpk(r1[2], r1[3]), cvtpk(r1[4], r1[5]), cvtpk(r1[6], r1[7]));
                    o2 = make_uint4(cvtpk(r2[0], r2[1]), cvtpk(r2[2], r2[3]), cvtpk(r2[4], r2[5]), cvtpk(r2[6], r2[7]));
                }
                *(uint4*)(Ks + m64_off(j, c)) = o1; *(uint4*)(Ks + m64_off(j, c + 4)) = o2;
            }
            for (int idx = tid; idx < 192 * 8; idx += 512) {
                const int j = idx >> 3, c = idx & 7, t = kbase + j;
                uint4 vv = make_uint4(0u, 0u, 0u, 0u);
                if (t >= 0) vv = *(const uint4*)(z + (size_t)(b * SEQ + t) * INC + ZC_V + kvh * 64 + 8 * c);
                char* vp = Vt + (8 * c) * VTS + j * 2;
                *(bf16_t*)(vp + 0 * VTS) = (bf16_t)(vv.x & 0xffffu); *(bf16_t*)(vp + 1 * VTS) = (bf16_t)(vv.x >> 16);
                *(bf16_t*)(vp + 2 * VTS) = (bf16_t)(vv.y & 0xffffu); *(bf16_t*)(vp + 3 * VTS) = (bf16_t)(vv.y >> 16);
                *(bf16_t*)(vp + 4 * VTS) = (bf16_t)(vv.z & 0xffffu); *(bf16_t*)(vp + 5 * VTS) = (bf16_t)(vv.z >> 16);
                *(bf16_t*)(vp + 6 * VTS) = (bf16_t)(vv.w & 0xffffu); *(bf16_t*)(vp + 7 * VTS) = (bf16_t)(vv.w >> 16);
            }
            __syncthreads();
            const int h = kvh * 8 + wave, l31 = lane & 31, hh = lane >> 5;
            const float sink = p.sinks[h];
#pragma unroll 1
            for (int qt = 0; qt < 2; ++qt) {
                const int T0 = t0 + qt * 32, tq = T0 + l31;
                bf16x8 qf[4];
                {
                    const bf16_t* zr = z + (size_t)(b * SEQ + tq) * INC + h * 64 + 8 * hh;
                    uint4 raw[4];
#pragma unroll
                    for (int s4 = 0; s4 < 4; ++s4) raw[s4] = *(const uint4*)(zr + 16 * s4);
#pragma unroll
                    for (int s2 = 0; s2 < 2; ++s2) {
                        const int d0 = 16 * s2 + 8 * hh;
                        const float4 c0 = *(const float4*)(rope + tq * 32 + d0), c1 = *(const float4*)(rope + tq * 32 + d0 + 4);
                        const float4 s0 = *(const float4*)(rope + SEQ * 32 + tq * 32 + d0), s1 = *(const float4*)(rope + SEQ * 32 + tq * 32 + d0 + 4);
                        const uint4 ua = raw[s2], ub = raw[s2 + 2];
                        const float a[8] = {bflo(ua.x), bfhi(ua.x), bflo(ua.y), bfhi(ua.y), bflo(ua.z), bfhi(ua.z), bflo(ua.w), bfhi(ua.w)};
                        const float bq[8] = {bflo(ub.x), bfhi(ub.x), bflo(ub.y), bfhi(ub.y), bflo(ub.z), bfhi(ub.z), bflo(ub.w), bfhi(ub.w)};
                        const float cs[8] = {c0.x, c0.y, c0.z, c0.w, c1.x, c1.y, c1.z, c1.w}, sn[8] = {s0.x, s0.y, s0.z, s0.w, s1.x, s1.y, s1.z, s1.w};
                        float r1[8], r2[8];
#pragma unroll
                        for (int e = 0; e < 8; ++e) { r1[e] = (a[e] * cs[e] - bq[e] * sn[e]) * 0.125f; r2[e] = (bq[e] * cs[e] + a[e] * sn[e]) * 0.125f; }
                        qf[s2] = __builtin_bit_cast(bf16x8, make_uint4(cvtpk(r1[0], r1[1]), cvtpk(r1[2], r1[3]), cvtpk(r1[4], r1[5]), cvtpk(r1[6], r1[7])));
                        qf[s2 + 2] = __builtin_bit_cast(bf16x8, make_uint4(cvtpk(r2[0], r2[1]), cvtpk(r2[2], r2[3]), cvtpk(r2[4], r2[5]), cvtpk(r2[6], r2[7])));
                    }
                }
                f32x16 sc[5];
#pragma unroll
                for (int kt = 0; kt < 5; ++kt) {
                    sc[kt] = zero16();
                    const int krow = 32 * qt + 32 * kt + l31;
#pragma unroll
                    for (int s4 = 0; s4 < 4; ++s4) {
                        const bf16x8 kf = *(const bf16x8*)(Ks + m64_off(krow, 2 * s4 + hh));
                        sc[kt] = __builtin_amdgcn_mfma_f32_32x32x16_bf16(kf, qf[s4], sc[kt], 0, 0, 0);
                    }
                }
                float mx = -1e30f;
#pragma unroll
                for (int kt = 0; kt < 5; ++kt)
#pragma unroll
                    for (int i = 0; i < 16; ++i) {
                        const int r = (i & 3) + 8 * (i >> 2) + 4 * hh;
                        bool ok = (T0 - 128 + 32 * kt + r) >= 0;
                        if (kt == 0) ok = ok && (r > l31);
                        if (kt == 4) ok = ok && (r <= l31);
                        sc[kt][i] = ok ? sc[kt][i] : -1e30f;
                        mx = fmaxf(mx, sc[kt][i]);
                    }
                {
                    float a = mx, bq = mx;
                    asm volatile("s_nop 1\n\tv_permlane32_swap_b32 %0, %1\n\ts_nop 1" : "+v"(a), "+v"(bq));
                    mx = fmaxf(fmaxf(a, bq), sink);
                }
                float lsum = 0.f;
#pragma unroll
                for (int kt = 0; kt < 5; ++kt)
#pragma unroll
                    for (int i = 0; i < 16; ++i) { const float pe = __expf(sc[kt][i] - mx); sc[kt][i] = pe; lsum += pe; }
                lsum = xor32_sum(lsum) + __expf(sink - mx);
                const float inv = 1.f / lsum;
                f32x16 oacc[2];
                oacc[0] = zero16(); oacc[1] = zero16();
#pragma unroll
                for (int kt = 0; kt < 5; ++kt)
#pragma unroll
                    for (int s2 = 0; s2 < 2; ++s2) {
                        uint4 pb;
                        pb.x = cvtpk(sc[kt][8 * s2 + 0], sc[kt][8 * s2 + 1]); pb.y = cvtpk(sc[kt][8 * s2 + 2], sc[kt][8 * s2 + 3]);
                        pb.z = cvtpk(sc[kt][8 * s2 + 4], sc[kt][8 * s2 + 5]); pb.w = cvtpk(sc[kt][8 * s2 + 6], sc[kt][8 * s2 + 7]);
                        const int kloc = 32 * qt + 32 * kt + 16 * s2 + 4 * hh;
#pragma unroll
                        for (int dt = 0; dt < 2; ++dt) {
                            const char* vp = Vt + (dt * 32 + l31) * VTS + kloc * 2;
                            const uint2 v0 = *(const uint2*)vp, v1 = *(const uint2*)(vp + 16);
                            const bf16x8 vf = __builtin_bit_cast(bf16x8, make_uint4(v0.x, v0.y, v1.x, v1.y));
                            oacc[dt] = __builtin_amdgcn_mfma_f32_32x32x16_bf16(vf, __builtin_bit_cast(bf16x8, pb), oacc[dt], 0, 0, 0);
                        }
                    }
                bf16_t* orow = mix + (size_t)(b * SEQ + tq) * DM + h * 64;
#pragma unroll
                for (int dt = 0; dt < 2; ++dt)
#pragma unroll
                    for (int q = 0; q < 4; ++q) {
                        uint2 o; o.x = cvtpk(oacc[dt][4 * q] * inv, oacc[dt][4 * q + 1] * inv); o.y = cvtpk(oacc[dt][4 * q + 2] * inv, oacc[dt][4 * q + 3] * inv);
                        *(uint2*)(orow + dt * 32 + 8 * q + 4 * hh) = o;
                    }
            }
        } else {
            const int v = u - N_ATT, prod = 2 - (v >> 7), mt = v & 31, nt = (v >> 5) & 3;
            const int row0 = mt * 256, col0 = nt * 256 + wave * 32, li = lane & 15, lg = lane >> 4;
            const int koff = prod == 0 ? 3072 : (prod == 1 ? 3136 : 3200), nk = prod == 2 ? 5 : 2;
            const float* W = prod == 0 ? p.wd_up : (prod == 1 ? p.wa_up : p.wg_up);
            const float* bp0 = W + (size_t)(8 * lg) * RW + col0 + li; const float* bp1 = bp0 + 16;
            const int srow = row0 + (tid >> 2), scol = koff + (tid & 3) * 8;
            auto aload = [&](int i, int kt) -> uint4 {
                const int tok = srow + 128 * i, c = scol + kt * 32;
                const uint4 zc = *(const uint4*)(z + (size_t)tok * INC + ZC_RW + c);
                uint4 zp = make_uint4(0u, 0u, 0u, 0u);
                if (tok & (SEQ - 1)) zp = *(const uint4*)(z + (size_t)(tok - 1) * INC + ZC_RW + c);
                const float4 m0 = *(const float4*)(p.mu + c), m1 = *(const float4*)(p.mu + c + 4);
                const float a[8] = {bflo(zc.x), bfhi(zc.x), bflo(zc.y), bfhi(zc.y), bflo(zc.z), bfhi(zc.z), bflo(zc.w), bfhi(zc.w)};
                const float q[8] = {bflo(zp.x), bfhi(zp.x), bflo(zp.y), bfhi(zp.y), bflo(zp.z), bfhi(zp.z), bflo(zp.w), bfhi(zp.w)};
                const float mm[8] = {m0.x, m0.y, m0.z, m0.w, m1.x, m1.y, m1.z, m1.w};
                float o[8];
#pragma unroll
                for (int e = 0; e < 8; ++e) {
                    const float zs = a[e] + (q[e] - a[e]) * mm[e];
                    o[e] = prod == 0 ? (1.f - 2.f / (1.f + __expf(2.f * zs))) : (prod == 1 ? zs : sigmoidf_(zs));
                }
                return make_uint4(cvtpk(o[0], o[1]), cvtpk(o[2], o[3]), cvtpk(o[4], o[5]), cvtpk(o[6], o[7]));
            };
            float* LWb = (float*)(p.ws + WS_LW); bf16_t* AVb = (bf16_t*)(p.ws + WS_AV); bf16_t* GVb = (bf16_t*)(p.ws + WS_GV);
            gemm_tile_f<1, 2>(smem, nk, RW, bp0, bp1, aload, [&](f32x4 (&acc)[16][2]) {
#pragma unroll
                for (int nf = 0; nf < 2; ++nf) {
                    const int col = col0 + nf * 16 + 4 * lg;
                    const float4 w0c = *(const float4*)(p.w0 + col), a0c = *(const float4*)(p.a0 + col);
                    const float wc[4] = {w0c.x, w0c.y, w0c.z, w0c.w}, ac[4] = {a0c.x, a0c.y, a0c.z, a0c.w};
#pragma unroll
                    for (int m = 0; m < 16; ++m) {
                        const size_t o = (size_t)(row0 + 16 * m + li) * RW + col;
                        if (prod == 0) {
                            float r[4];
#pragma unroll
                            for (int e = 0; e < 4; ++e) r[e] = -0.60653065971f * sigmoidf_(wc[e] + acc[m][nf][e]);
                            *(float4*)(LWb + o) = make_float4(r[0], r[1], r[2], r[3]);
                        } else if (prod == 1) {
                            uint2 ob; ob.x = cvtpk(sigmoidf_(ac[0] + acc[m][nf][0]), sigmoidf_(ac[1] + acc[m][nf][1])); ob.y = cvtpk(sigmoidf_(ac[2] + acc[m][nf][2]), sigmoidf_(ac[3] + acc[m][nf][3]));
                            *(uint2*)(AVb + o) = ob;
                        } else {
                            uint2 ob; ob.x = cvtpk(acc[m][nf][0], acc[m][nf][1]); ob.y = cvtpk(acc[m][nf][2], acc[m][nf][3]);
                            *(uint2*)(GVb + o) = ob;
                        }
                    }
                }
            });
        }
    }
}
DEVI void phase3(const Params& p, char* smem) {
    for (int v = blockIdx.x; v < 384; v += gridDim.x) p3_unit(p, smem, 256 + v);
}

DEVI void phase4(const Params& p, char* smem) {
    const int tid = threadIdx.x, lane = tid & 63, wave = tid >> 6;
    const float* const pAA = (const float*)(p.ws + WS_AA); const float* const pDE = (const float*)(p.ws + WS_DEC); const float* const pBB = (const float*)(p.ws + WS_BB);
    const float* const pK2 = (const float*)(p.ws + WS_K2); const float* const pR = (const float*)(p.ws + WS_R); const float* const pV = (const float*)(p.ws + WS_V);
    float* Y = (float*)(p.ws + WS_Y);
    constexpr int CH = 32;
    float* bufs = (float*)smem;
    for (int u = blockIdx.x; u < 32; u += gridDim.x) {
        const int b = u >> 4, h = u & 15;
        const int vr = lane >> 2, kq = lane & 3;
        float s[16];
#pragma unroll
        for (int j = 0; j < 16; ++j) s[j] = 0.f;
        __syncthreads();
        const int lst = tid >> 4, lc4 = tid & 15;
        const size_t goff = (size_t)(b * SEQ + lst) * RW + h * 64 + lc4 * 4;
        const int loff = lst * 64 + lc4 * 4;
        {
            *(float4*)(bufs + 0 * CH * 64 + loff) = *(const float4*)(pAA + goff); *(float4*)(bufs + 1 * CH * 64 + loff) = *(const float4*)(pDE + goff);
            *(float4*)(bufs + 2 * CH * 64 + loff) = *(const float4*)(pBB + goff); *(float4*)(bufs + 3 * CH * 64 + loff) = *(const float4*)(pK2 + goff);
            *(float4*)(bufs + 4 * CH * 64 + loff) = *(const float4*)(pR + goff); *(float4*)(bufs + 5 * CH * 64 + loff) = *(const float4*)(pV + goff);
        }
        __syncthreads();
        for (int c = 0; c < SEQ / CH; ++c) {
            float* cur = bufs + (c & 1) * (6 * CH * 64);
            float* nxt = bufs + ((c + 1) & 1) * (6 * CH * 64);
            float4 pre0, pre1, pre2, pre3, pre4, pre5;
            if (c + 1 < SEQ / CH) {
                const size_t g2 = goff + (size_t)(c + 1) * CH * RW;
                pre0 = *(const float4*)(pAA + g2); pre1 = *(const float4*)(pDE + g2); pre2 = *(const float4*)(pBB + g2);
                pre3 = *(const float4*)(pK2 + g2); pre4 = *(const float4*)(pR + g2); pre5 = *(const float4*)(pV + g2);
            }
            if (wave < 4) {
                for (int st = 0; st < CH; ++st) {
                    const float* aa = cur + (0 * CH + st) * 64 + kq * 16;
                    const float* de = cur + (1 * CH + st) * 64 + kq * 16;
                    const float* bb = cur + (2 * CH + st) * 64 + kq * 16;
                    const float* k2 = cur + (3 * CH + st) * 64 + kq * 16;
                    const float* rr = cur + (4 * CH + st) * 64 + kq * 16;
                    const float v = cur[(5 * CH + st) * 64 + wave * 16 + vr];
                    float sa = 0.f;
#pragma unroll
                    for (int j = 0; j < 16; ++j) sa += s[j] * aa[j];
                    sa += __shfl_xor(sa, 1, 64); sa += __shfl_xor(sa, 2, 64);
                    float y = 0.f;
#pragma unroll
                    for (int j = 0; j < 16; ++j) { s[j] = s[j] * de[j] + sa * bb[j] + v * k2[j]; y += s[j] * rr[j]; }
                    y += __shfl_xor(y, 1, 64); y += __shfl_xor(y, 2, 64);
                    if (kq == 0) Y[(size_t)(b * SEQ + c * CH + st) * RW + h * 64 + wave * 16 + vr] = y;
                }
            }
            if (c + 1 < SEQ / CH) {
                *(float4*)(nxt + 0 * CH * 64 + loff) = pre0; *(float4*)(nxt + 1 * CH * 64 + loff) = pre1; *(float4*)(nxt + 2 * CH * 64 + loff) = pre2;
                *(float4*)(nxt + 3 * CH * 64 + loff) = pre3; *(float4*)(nxt + 4 * CH * 64 + loff) = pre4; *(float4*)(nxt + 5 * CH * 64 + loff) = pre5;
            }
            __syncthreads();
        }
    }
}

DEVI void phase5(const Params& p, char* smem) {
    const int tid = threadIdx.x, lane = tid & 63, wave = tid >> 6;
    const float* Y = (const float*)(p.ws + WS_Y); const float* Vb = (const float*)(p.ws + WS_V); const float* Gb = (const float*)(p.ws + WS_G); const float* RKSb = (const float*)(p.ws + WS_RKS);
    bf16_t* mix = (bf16_t*)(p.ws + WS_MIX);
    for (int u = blockIdx.x; u < NTOK * 16 / 8; u += gridDim.x) {
        const int pi = u * 8 + wave, tok = pi >> 4, head = pi & 15, ch = head * 64 + lane;
        const float y = Y[(size_t)tok * RW + ch];
        const float mean = wave_sum(y) * (1.f / 64.f);
        const float d = y - mean;
        const float var = wave_sum(d * d) * (1.f / 64.f);
        const float yn = d * rsqrtf(var + 64e-5f) * p.ln_w[ch] + p.ln_b[ch];
        const float o = (yn + RKSb[tok * 16 + head] * Vb[(size_t)tok * RW + ch]) * Gb[(size_t)tok * RW + ch];
        mix[(size_t)tok * DM + 1024 + ch] = (bf16_t)(cvtpk(o, 0.f) & 0xffffu);
    }
}


constexpr int RA_AT = 0, RA_BT = 8192, RA_KT = 16384, RA_RT = 24576, RA_BPT = 32768, RA_KPT = 40960, RA_VT = 49152, RA_AAK = 57344, RA_ARB = 65536, RA_ARK = 73728,
              RA_AABP = 81920, RA_RHS = 98304, RA_WL = 131072, RA_SEG = 131328, RA_P1T = RA_BT, RA_P2T = RA_KT, RA_CUM = RA_AABP;

DEVI void phaseRA(const Params& p, char* smem) {
    const int tid = threadIdx.x, lane = tid & 63, wave = tid >> 6, l31 = lane & 31, hh = lane >> 5;
    const bf16_t* z = (const bf16_t*)(p.ws + WS_Z);
    float* cumb = (float*)(smem + RA_CUM); float* segs = (float*)(smem + RA_SEG); float* wl = (float*)(smem + RA_WL);
    float* rhs = (float*)(smem + RA_RHS); float* aabp = (float*)(smem + RA_AABP);
    uint4 n_cr, n_ck, n_cv, n_pr, n_pk, n_pv, n_au; float4 n_lw0, n_lw1;
    auto load_raw = [&](int unit_) {
        const int bh_ = unit_ >> 6, c_ = unit_ & 63, b_ = bh_ >> 4, h_ = bh_ & 15;
        const int tok = b_ * SEQ + c_ * 64 + (tid >> 3), ch0 = h_ * 64 + (tid & 7) * 8;
        const bf16_t* zr = z + (size_t)tok * INC + ZC_RW + ch0;
        const bool hasp = (tok & (SEQ - 1)) != 0;
        const uint4 zero4 = make_uint4(0u, 0u, 0u, 0u);
        n_cr = *(const uint4*)zr; n_ck = *(const uint4*)(zr + 1024); n_cv = *(const uint4*)(zr + 2048);
        n_pr = hasp ? *(const uint4*)(zr - INC) : zero4; n_pk = hasp ? *(const uint4*)(zr - INC + 1024) : zero4; n_pv = hasp ? *(const uint4*)(zr - INC + 2048) : zero4;
        n_au = *(const uint4*)((const bf16_t*)(p.ws + WS_AV) + (size_t)tok * RW + ch0);
        const float* lwp = (const float*)(p.ws + WS_LW) + (size_t)tok * RW + ch0;
        n_lw0 = *(const float4*)lwp; n_lw1 = *(const float4*)(lwp + 4);
    };
    if (((int)blockIdx.x >> 3) < 256) load_raw((((int)blockIdx.x & 7) + 8 * (((int)blockIdx.x >> 3) >> 6)) * 64 + (((int)blockIdx.x >> 3) & 63));
    const int ra_x = (int)blockIdx.x & 7, ra_slot = (int)blockIdx.x >> 3, ra_nslot = ((int)gridDim.x - ra_x + 7) >> 3;
    for (int uu = ra_slot; uu < 256; uu += ra_nslot) {
        const int bh = ra_x + 8 * (uu >> 6), c = uu & 63, b = bh >> 4, h = bh & 15;
        const int unit = bh * 64 + c;
        const int tokbase = b * SEQ + c * 64;
        __syncthreads();
        const int t = tid >> 3, c8 = tid & 7;
        float r_[8], k2[8], v_[8], aa[8], bb[8], lw[8];
        {
            const int tok = tokbase + t, ch0 = h * 64 + c8 * 8;
            const uint4 cr = n_cr, ck = n_ck, cv = n_cv, pr = n_pr, pk_ = n_pk, pv = n_pv, au = n_au;
            float fr[8], fk[8], fpr[8], fpk[8], fpv[8], mur[8], muk[8], muv[8], av[8], kkc[8], kac[8], rkc[8];
#define UNPK8(dst, u) { dst[0] = bflo(u.x); dst[1] = bfhi(u.x); dst[2] = bflo(u.y); dst[3] = bfhi(u.y); dst[4] = bflo(u.z); dst[5] = bfhi(u.z); dst[6] = bflo(u.w); dst[7] = bfhi(u.w); }
#define LDF8(dst, ptr) { const float4 q0_ = *(const float4*)(ptr), q1_ = *(const float4*)((ptr) + 4); dst[0] = q0_.x; dst[1] = q0_.y; dst[2] = q0_.z; dst[3] = q0_.w; dst[4] = q1_.x; dst[5] = q1_.y; dst[6] = q1_.z; dst[7] = q1_.w; }
            UNPK8(fr, cr) UNPK8(fk, ck) UNPK8(v_, cv) UNPK8(fpr, pr) UNPK8(fpk, pk_) UNPK8(fpv, pv) UNPK8(av, au)
            LDF8(mur, p.mu + ch0) LDF8(muk, p.mu + 1024 + ch0) LDF8(muv, p.mu + 2048 + ch0)
            LDF8(kkc, p.k_k + ch0) LDF8(kac, p.k_a + ch0) LDF8(rkc, p.r_k + ch0)
            lw[0] = n_lw0.x; lw[1] = n_lw0.y; lw[2] = n_lw0.z; lw[3] = n_lw0.w; lw[4] = n_lw1.x; lw[5] = n_lw1.y; lw[6] = n_lw1.z; lw[7] = n_lw1.w;
            float ssq = 0.f, rk = 0.f, kk[8];
#pragma unroll
            for (int i = 0; i < 8; ++i) {
                r_[i] = fr[i] + (fpr[i] - fr[i]) * mur[i];
                const float kx = fk[i] + (fpk[i] - fk[i]) * muk[i];
                v_[i] = v_[i] + (fpv[i] - v_[i]) * muv[i];
                kk[i] = kx * kkc[i]; ssq += kk[i] * kk[i];
                k2[i] = kx * (1.f + (av[i] - 1.f) * kac[i]);
                rk += r_[i] * k2[i] * rkc[i];
            }
            ssq += dpp_xor1(ssq); ssq += dpp_xor2(ssq); ssq += __shfl_xor(ssq, 4, 64);
            rk += dpp_xor1(rk); rk += dpp_xor2(rk); rk += __shfl_xor(rk, 4, 64);
            const float invn = 1.f / fmaxf(sqrtf(ssq), 1e-12f);
#pragma unroll
            for (int i = 0; i < 8; ++i) { const float kn = kk[i] * invn; aa[i] = -kn; bb[i] = kn * av[i]; }
            if (c8 == 0) ((float*)(p.ws + WS_RKS))[tok * 16 + h] = rk;
        }
#pragma unroll
        for (int i = 0; i < 8; ++i) cumb[t * 64 + c8 * 8 + i] = lw[i];
        __syncthreads();
        if (uu + ra_nslot < 256) { const int u2 = uu + ra_nslot; load_raw((ra_x + 8 * (u2 >> 6)) * 64 + (u2 & 63)); }
        {
            const int ch = tid & 63, seg = tid >> 6;
            float loc[8]; float run = 0.f;
#pragma unroll
            for (int j = 0; j < 8; ++j) { run += cumb[(seg * 8 + j) * 64 + ch]; loc[j] = run; }
            segs[seg * 64 + ch] = run;
            __syncthreads();
            float off = 0.f;
#pragma unroll
            for (int s2 = 0; s2 < 8; ++s2) off += (s2 < seg) ? segs[s2 * 64 + ch] : 0.f;
#pragma unroll
            for (int j = 0; j < 8; ++j) cumb[(seg * 8 + j) * 64 + ch] = off + loc[j];
        }
        __syncthreads();
        {
            unsigned pk[7][4];
            float atf[8];
#pragma unroll
            for (int i = 0; i < 8; i += 2) {
                float o[7][2];
#pragma unroll
                for (int e = 0; e < 2; ++e) {
                    const float cu = cumb[t * 64 + c8 * 8 + i + e], cl = cumb[63 * 64 + c8 * 8 + i + e];
                    const float e1 = __expf(cu), e2 = 1.f / e1, ex = __expf(cu - lw[i + e]), ew = __expf(cl - cu);
                    o[0][e] = aa[i + e] * ex; o[1][e] = bb[i + e] * e2; o[2][e] = k2[i + e] * e2; o[3][e] = r_[i + e] * e1;
                    o[4][e] = bb[i + e] * ew; o[5][e] = k2[i + e] * ew; o[6][e] = v_[i + e];
                    atf[i + e] = o[0][e];
                    if (t == 63) wl[c8 * 8 + i + e] = e1;
                }
#pragma unroll
                for (int m = 0; m < 7; ++m) pk[m][i >> 1] = cvtpk(o[m][0], o[m][1]);
            }
            const unsigned ro = m64_off(t, c8);
            *(uint4*)(smem + RA_AT + ro) = make_uint4(pk[0][0], pk[0][1], pk[0][2], pk[0][3]);
            *(uint4*)(smem + RA_BT + ro) = make_uint4(pk[1][0], pk[1][1], pk[1][2], pk[1][3]);
            *(uint4*)(smem + RA_KT + ro) = make_uint4(pk[2][0], pk[2][1], pk[2][2], pk[2][3]);
            *(uint4*)(smem + RA_RT + ro) = make_uint4(pk[3][0], pk[3][1], pk[3][2], pk[3][3]);
            *(float4*)(rhs + t * 128 + c8 * 8) = make_float4(atf[0], atf[1], atf[2], atf[3]);
            *(float4*)(rhs + t * 128 + c8 * 8 + 4) = make_float4(atf[4], atf[5], atf[6], atf[7]);
#pragma unroll
            for (int i = 0; i < 8; ++i) {
                const int ch = c8 * 8 + i;
                const unsigned to = m64_off(ch, t >> 3) + (t & 7) * 2;
                const unsigned w4 = pk[4][i >> 1], w5 = pk[5][i >> 1], w6 = pk[6][i >> 1];
                *(bf16_t*)(smem + RA_BPT + to) = (bf16_t)((i & 1) ? (w4 >> 16) : (w4 & 0xffffu));
                *(bf16_t*)(smem + RA_KPT + to) = (bf16_t)((i & 1) ? (w5 >> 16) : (w5 & 0xffffu));
                *(bf16_t*)(smem + RA_VT + to) = (bf16_t)((i & 1) ? (w6 >> 16) : (w6 & 0xffffu));
            }
        }
        __syncthreads();
        {
            const int pr = wave >> 1, sub = wave & 1;
            const char* X = smem + ((pr & 1) ? RA_KT : RA_BT);
            const char* Y = smem + ((pr & 2) ? RA_RT : RA_AT);
            const int incl = (pr & 2) ? 1 : 0;
            char* dst = smem + (pr == 1 ? RA_AAK : pr == 2 ? RA_ARB : RA_ARK);
#pragma unroll
            for (int tt = 0; tt < 2; ++tt) {
                const int i0 = sub ? (tt ? 32 : 0) : (tt ? 32 : 0);
                const int t0 = sub ? (tt ? 0 : 32) : (tt ? 32 : 0);
                const bool zero_tile = sub && tt;
                f32x16 acc = zero16();
                if (!zero_tile) mm_tile(acc, X, i0, Y, t0, l31, hh);
                const int tq = t0 + l31;
#pragma unroll
                for (int q = 0; q < 4; ++q) {
                    float vv[4];
#pragma unroll
                    for (int e = 0; e < 4; ++e) { const int ii = i0 + 8 * q + 4 * hh + e; vv[e] = (ii < tq + incl) ? acc[4 * q + e] : 0.f; }
                    if (pr == 0) {
                        if (!zero_tile) {
#pragma unroll
                            for (int e = 0; e < 4; ++e) aabp[tq * 64 + e * 16 + (i0 >> 2) + 2 * q + hh] = vv[e];
                        }
                    } else {
                        uint2 o; o.x = cvtpk(vv[0], vv[1]); o.y = cvtpk(vv[2], vv[3]);
                        *(uint2*)(dst + m64_off(tq, (i0 >> 3) + q) + 8 * hh) = o;
                    }
                }
            }
        }
        __syncthreads();
        f32x16 accA = zero16();
        const int w4 = wave & 3, ta = w4 & 1, tb2 = w4 >> 1;
        if (wave < 4) {
            f32x16 x2 = zero16();
            mm_tile(x2, smem + RA_VT, ta * 32, smem + RA_AAK, tb2 * 32, l31, hh);
            const int tq = tb2 * 32 + l31;
#pragma unroll
            for (int q = 0; q < 4; ++q) *(float4*)(rhs + tq * 128 + 64 + ta * 32 + 8 * q + 4 * hh) = make_float4(x2[4 * q], x2[4 * q + 1], x2[4 * q + 2], x2[4 * q + 3]);
            mm_tile(accA, smem + RA_VT, ta * 32, smem + RA_ARK, tb2 * 32, l31, hh);
        } else {
            mm_tile(accA, smem + RA_KPT, ta * 32, smem + RA_VT, tb2 * 32, l31, hh);
        }
        __syncthreads();
        {
            const int g = lane & 3, col = wave * 16 + (lane >> 2);
            float P[16];
#pragma unroll
            for (int q = 0; q < 16; ++q) P[q] = 0.f;
            float last[4];
            char* pt = smem + (col < 64 ? RA_P1T : RA_P2T);
            const int prow = col & 63;
            float4 acur[4]; float rcur = rhs[col];
#pragma unroll
            for (int q4 = 0; q4 < 4; ++q4) acur[q4] = make_float4(0.f, 0.f, 0.f, 0.f);
#pragma unroll
            for (int ts = 0; ts < 64; ++ts) {
                float4 anxt[4]; float rnxt = 0.f;
#pragma unroll
                for (int q4 = 0; q4 < 4; ++q4) anxt[q4] = make_float4(0.f, 0.f, 0.f, 0.f);
                if (ts + 1 < 64) {
                    const int nq4n = (((ts + 4) >> 2) + 3) >> 2;
#pragma unroll
                    for (int q4 = 0; q4 < nq4n; ++q4) anxt[q4] = *(const float4*)(aabp + (ts + 1) * 64 + g * 16 + q4 * 4);
                    rnxt = rhs[(ts + 1) * 128 + col];
                }
                float part = 0.f;
                const int nq4 = (((ts + 3) >> 2) + 3) >> 2;
#pragma unroll
                for (int q4 = 0; q4 < nq4; ++q4) {
                    const float4 a = acur[q4];
                    part += a.x * P[4 * q4] + a.y * P[4 * q4 + 1] + a.z * P[4 * q4 + 2] + a.w * P[4 * q4 + 3];
                }
                part += dpp_xor1(part); part += dpp_xor2(part);
                const float val = rcur + part;
#pragma unroll
                for (int q4 = 0; q4 < 4; ++q4) acur[q4] = anxt[q4];
                rcur = rnxt;
                if (g == (ts & 3)) P[ts >> 2] = val;
                last[ts & 3] = val;
                if ((ts & 3) == 3 && g == 0) {
                    uint2 o; o.x = cvtpk(last[0], last[1]); o.y = cvtpk(last[2], last[3]);
                    *(uint2*)(pt + m64_off(prow, ts >> 3) + ((ts >> 2) & 1) * 8) = o;
                }
            }
        }
        __syncthreads();
        if (wave < 4) {
            mm_tile(accA, smem + RA_P2T, ta * 32, smem + RA_ARB, tb2 * 32, l31, hh);
            float* q2 = (float*)(p.ws + WS_Q2) + ((size_t)unit * 4 + (ta * 2 + tb2)) * 1024;
#pragma unroll
            for (int i = 0; i < 16; ++i) q2[i * 64 + lane] = accA[i];
            f32x16 q1 = zero16();
            mm_tile(q1, smem + RA_P1T, ta * 32, smem + RA_ARB, tb2 * 32, l31, hh);
            const int tq = tb2 * 32 + l31;
            bf16_t* q1g = (bf16_t*)(p.ws + WS_Q1) + (size_t)unit * 4096 + tq * 64;
#pragma unroll
            for (int q = 0; q < 4; ++q) {
                const int k0 = ta * 32 + 8 * q + 4 * hh;
                const uint2 rr = *(const uint2*)(smem + RA_RT + m64_off(tq, k0 >> 3) + (k0 & 7) * 2);
                uint2 o; o.x = cvtpk(q1[4 * q] + bflo(rr.x), q1[4 * q + 1] + bfhi(rr.x)); o.y = cvtpk(q1[4 * q + 2] + bflo(rr.y), q1[4 * q + 3] + bfhi(rr.y));
                *(uint2*)(q1g + k0) = o;
            }
        } else {
            mm_tile(accA, smem + RA_BPT, ta * 32, smem + RA_P2T, tb2 * 32, l31, hh);
            unsigned* hb = (unsigned*)(p.ws + WS_HB) + ((size_t)unit * 4 + (ta * 2 + tb2)) * 512;
#pragma unroll
            for (int j = 0; j < 8; ++j) hb[j * 64 + lane] = cvtpk(accA[2 * j], accA[2 * j + 1]);
            f32x16 gg = zero16();
            mm_tile(gg, smem + RA_P1T, ta * 32, smem + RA_BPT, tb2 * 32, l31, hh);
            if (ta == tb2) {
#pragma unroll
                for (int i = 0; i < 16; ++i) { const int kk = (i & 3) + 8 * (i >> 2) + 4 * hh; if (kk == l31) gg[i] += wl[ta * 32 + kk]; }
            }
            unsigned* gb = (unsigned*)(p.ws + WS_GB) + ((size_t)unit * 4 + (ta * 2 + tb2)) * 512 + lane * 8;
            uint4 o0, o1;
            o0.x = cvtpk(gg[0], gg[1]); o0.y = cvtpk(gg[2], gg[3]); o0.z = cvtpk(gg[4], gg[5]); o0.w = cvtpk(gg[6], gg[7]);
            o1.x = cvtpk(gg[8], gg[9]); o1.y = cvtpk(gg[10], gg[11]); o1.z = cvtpk(gg[12], gg[13]); o1.w = cvtpk(gg[14], gg[15]);
            *(uint4*)(gb) = o0; *(uint4*)(gb + 4) = o1;
        }
    }
}

struct RbH { unsigned w[2][8]; };
DEVI void rb_load(const Params& p, int unit, int vh, int lane, uint4 (&g)[8], RbH& hq) {
    const unsigned* gb = (const unsigned*)(p.ws + WS_GB) + (size_t)unit * 2048 + lane * 8;
    const unsigned* hb = (const unsigned*)(p.ws + WS_HB) + (size_t)unit * 2048 + lane;
#pragma unroll
    for (int t4 = 0; t4 < 4; ++t4) { g[2 * t4] = *(const uint4*)(gb + t4 * 512); g[2 * t4 + 1] = *(const uint4*)(gb + t4 * 512 + 4); }
#pragma unroll
    for (int j = 0; j < 8; ++j) { hq.w[0][j] = hb[(0 * 2 + vh) * 512 + j * 64]; hq.w[1][j] = hb[(1 * 2 + vh) * 512 + j * 64]; }
}
DEVI void rb_store(const Params& p, int unit, int vh, int l31, int hh, const f32x16& X0, const f32x16& X1) {
    bf16_t* s0 = (bf16_t*)(p.ws + WS_S0) + (size_t)unit * 4096 + (vh * 32 + l31) * 64;
#pragma unroll
    for (int q = 0; q < 4; ++q) {
        uint2 o; o.x = cvtpk(X0[4 * q], X0[4 * q + 1]); o.y = cvtpk(X0[4 * q + 2], X0[4 * q + 3]);
        *(uint2*)(s0 + 8 * q + 4 * hh) = o;
        uint2 o2; o2.x = cvtpk(X1[4 * q], X1[4 * q + 1]); o2.y = cvtpk(X1[4 * q + 2], X1[4 * q + 3]);
        *(uint2*)(s0 + 32 + 8 * q + 4 * hh) = o2;
    }
}
#define BF8(u) __builtin_bit_cast(bf16x8, u)
DEVI void rb_step(f32x16& X0, f32x16& X1, const uint4 (&g)[8], const RbH& hq) {
    uint4 xa, xb, xc, xd;
    xa.x = cvtpk(X0[0], X0[1]); xa.y = cvtpk(X0[2], X0[3]); xa.z = cvtpk(X0[4], X0[5]); xa.w = cvtpk(X0[6], X0[7]);
    xb.x = cvtpk(X0[8], X0[9]); xb.y = cvtpk(X0[10], X0[11]); xb.z = cvtpk(X0[12], X0[13]); xb.w = cvtpk(X0[14], X0[15]);
    xc.x = cvtpk(X1[0], X1[1]); xc.y = cvtpk(X1[2], X1[3]); xc.z = cvtpk(X1[4], X1[5]); xc.w = cvtpk(X1[6], X1[7]);
    xd.x = cvtpk(X1[8], X1[9]); xd.y = cvtpk(X1[10], X1[11]); xd.z = cvtpk(X1[12], X1[13]); xd.w = cvtpk(X1[14], X1[15]);
    f32x16 N0, N1;
#pragma unroll
    for (int j = 0; j < 8; ++j) { N0[2 * j] = bflo(hq.w[0][j]); N0[2 * j + 1] = bfhi(hq.w[0][j]); N1[2 * j] = bflo(hq.w[1][j]); N1[2 * j + 1] = bfhi(hq.w[1][j]); }
    N0 = __builtin_amdgcn_mfma_f32_32x32x16_bf16(BF8(g[0]), BF8(xa), N0, 0, 0, 0);
    N1 = __builtin_amdgcn_mfma_f32_32x32x16_bf16(BF8(g[2]), BF8(xa), N1, 0, 0, 0);
    N0 = __builtin_amdgcn_mfma_f32_32x32x16_bf16(BF8(g[1]), BF8(xb), N0, 0, 0, 0);
    N1 = __builtin_amdgcn_mfma_f32_32x32x16_bf16(BF8(g[3]), BF8(xb), N1, 0, 0, 0);
    N0 = __builtin_amdgcn_mfma_f32_32x32x16_bf16(BF8(g[4]), BF8(xc), N0, 0, 0, 0);
    N1 = __builtin_amdgcn_mfma_f32_32x32x16_bf16(BF8(g[6]), BF8(xc), N1, 0, 0, 0);
    N0 = __builtin_amdgcn_mfma_f32_32x32x16_bf16(BF8(g[5]), BF8(xd), N0, 0, 0, 0);
    N1 = __builtin_amdgcn_mfma_f32_32x32x16_bf16(BF8(g[7]), BF8(xd), N1, 0, 0, 0);
    X0 = N0; X1 = N1;
}
DEVI void phaseRB_core(const Params& p, char* smem) {
    const int tid = threadIdx.x, lane = tid & 63, wave = tid >> 6, l31 = lane & 31, hh = lane >> 5;
    if (wave != 0) return;
    for (int wu = blockIdx.x; wu < 64; wu += gridDim.x) {
        const int bh = (wu & 7) | ((wu >> 4) << 3), vh = (wu >> 3) & 1;
        f32x16 X0 = zero16(), X1 = zero16();
        uint4 gA[8], gB[8], gC[8]; RbH hA, hB, hC;
        rb_load(p, bh * 64, vh, lane, gA, hA);
        rb_load(p, bh * 64 + 1, vh, lane, gB, hB);
        for (int c = 0; c < 63; c += 3) {
            rb_load(p, bh * 64 + (c + 2 < 64 ? c + 2 : 63), vh, lane, gC, hC);
            rb_store(p, bh * 64 + c, vh, l31, hh, X0, X1);
            rb_step(X0, X1, gA, hA);
            rb_load(p, bh * 64 + (c + 3 < 64 ? c + 3 : 63), vh, lane, gA, hA);
            rb_store(p, bh * 64 + c + 1, vh, l31, hh, X0, X1);
            rb_step(X0, X1, gB, hB);
            rb_load(p, bh * 64 + (c + 4 < 64 ? c + 4 : 63), vh, lane, gB, hB);
            rb_store(p, bh * 64 + c + 2, vh, l31, hh, X0, X1);
            rb_step(X0, X1, gC, hC);
        }
        rb_store(p, bh * 64 + 63, vh, l31, hh, X0, X1);
    }
}

DEVI void phaseRB(const Params& p, char* smem) {
    const bool split = gridDim.x >= 128;
    if (split && blockIdx.x < 64) { phaseRB_core(p, smem); return; }
    const int nw = split ? (int)gridDim.x - 64 : (int)gridDim.x, wi = split ? (int)blockIdx.x - 64 : (int)blockIdx.x;
    for (int u = wi; u < 256; u += nw) p3_unit(p, smem, u);
    if (!split) { __syncthreads(); phaseRB_core(p, smem); }
}

DEVI void phaseRC(const Params& p, char* smem) {
    const int tid = threadIdx.x, lane = tid & 63, wave = tid >> 6, l31 = lane & 31, hh = lane >> 5;
    const bf16_t* z = (const bf16_t*)(p.ws + WS_Z); const bf16_t* GVb = (const bf16_t*)(p.ws + WS_GV); const float* RKSb = (const float*)(p.ws + WS_RKS);
    bf16_t* mix = (bf16_t*)(p.ws + WS_MIX);
    for (int it0 = blockIdx.x; it0 < 512 + N_SPEC; it0 += gridDim.x) {
        if (it0 < N_SPEC) { spec_unit(p, smem, it0); continue; }
        const int it = it0 - N_SPEC;
        const int unit = it * 4 + (wave >> 1), tb = wave & 1;
        const int bh = unit >> 6, c = unit & 63, b = bh >> 4, h = bh & 15;
        const int tq = tb * 32 + l31, tok = b * SEQ + c * 64 + tq;
        const float* q2 = (const float*)(p.ws + WS_Q2) + (size_t)unit * 4096 + lane;
        f32x16 a0, a1;
#pragma unroll
        for (int i = 0; i < 16; ++i) { a0[i] = q2[(0 * 2 + tb) * 1024 + i * 64]; a1[i] = q2[(1 * 2 + tb) * 1024 + i * 64]; }
        const bf16_t* s0 = (const bf16_t*)(p.ws + WS_S0) + (size_t)unit * 4096;
        const bf16_t* q1 = (const bf16_t*)(p.ws + WS_Q1) + (size_t)unit * 4096 + tq * 64;
#pragma unroll
        for (int s4 = 0; s4 < 4; ++s4) {
            const bf16x8 fa0 = *(const bf16x8*)(s0 + (l31) * 64 + 16 * s4 + 8 * hh);
            const bf16x8 fa1 = *(const bf16x8*)(s0 + (32 + l31) * 64 + 16 * s4 + 8 * hh);
            const bf16x8 fb = *(const bf16x8*)(q1 + 16 * s4 + 8 * hh);
            a0 = __builtin_amdgcn_mfma_f32_32x32x16_bf16(fa0, fb, a0, 0, 0, 0);
            a1 = __builtin_amdgcn_mfma_f32_32x32x16_bf16(fa1, fb, a1, 0, 0, 0);
        }
        float sm = 0.f;
#pragma unroll
        for (int i = 0; i < 16; ++i) sm += a0[i] + a1[i];
        sm = xor32_sum(sm);
        const float mean = sm * (1.f / 64.f);
        float sq = 0.f;
#pragma unroll
        for (int i = 0; i < 16; ++i) { const float d0 = a0[i] - mean, d1 = a1[i] - mean; sq += d0 * d0 + d1 * d1; }
        sq = xor32_sum(sq);
        const float rstd = rsqrtf(sq * (1.f / 64.f) + 64e-5f);
        const float rk = RKSb[tok * 16 + h];
#pragma unroll
        for (int vb = 0; vb < 2; ++vb)
#pragma unroll
            for (int q = 0; q < 4; ++q) {
                const int ch = h * 64 + vb * 32 + 8 * q + 4 * hh;
                const int hc = ch;
                const uint2 zc2 = *(const uint2*)(z + (size_t)tok * INC + ZC_RW + 2048 + hc);
                uint2 zp2 = make_uint2(0u, 0u);
                if (tok & (SEQ - 1)) zp2 = *(const uint2*)(z + (size_t)(tok - 1) * INC + ZC_RW + 2048 + hc);
                const float4 muv = *(const float4*)(p.mu + 2048 + hc);
                const uint2 g2 = *(const uint2*)(GVb + (size_t)tok * RW + hc);
                float4 vv, gv;
                vv.x = bflo(zc2.x) + (bflo(zp2.x) - bflo(zc2.x)) * muv.x; vv.y = bfhi(zc2.x) + (bfhi(zp2.x) - bfhi(zc2.x)) * muv.y;
                vv.z = bflo(zc2.y) + (bflo(zp2.y) - bflo(zc2.y)) * muv.z; vv.w = bfhi(zc2.y) + (bfhi(zp2.y) - bfhi(zc2.y)) * muv.w;
                gv.x = bflo(g2.x); gv.y = bfhi(g2.x); gv.z = bflo(g2.y); gv.w = bfhi(g2.y);
                const float4 lnw = *(const float4*)(p.ln_w + ch), lnb = *(const float4*)(p.ln_b + ch);
                float y[4];
#pragma unroll
                for (int e = 0; e < 4; ++e) y[e] = ((vb ? a1[4 * q + e] : a0[4 * q + e]) - mean) * rstd;
                uint2 o;
                o.x = cvtpk((y[0] * lnw.x + lnb.x + rk * vv.x) * gv.x, (y[1] * lnw.y + lnb.y + rk * vv.y) * gv.y);
                o.y = cvtpk((y[2] * lnw.z + lnb.z + rk * vv.z) * gv.z, (y[3] * lnw.w + lnb.w + rk * vv.w) * gv.w);
                *(uint2*)(mix + (size_t)tok * DM + 1024 + ch) = o;
            }
    }
}

DEVI void phase6(const Params& p, char* smem) {
    pg8::Gemm g{(const pg8::bf16_t*)(p.ws + WS_MIX), (const pg8::bf16_t*)(p.ws + WS_WTO), NTOK, DM, DM};
    pg8::StaticOrder S; S.init(NTOK, DM, (int)gridDim.x, (int)blockIdx.x);
    pg8::EpiX1 E{(float*)(p.ws + WS_X1), p.x, (const float*)(p.ws + WS_MODF) + 2 * DM, DM, 12288, SEQ};
    pg8::gemm_phase<pg8::EpiX1, pg8::StaticOrder, true, true>((PG8_LAS unsigned char*)smem, g, S, E);
}

DEVI void phase7(const Params& p, char* smem) {
    float* part = (float*)smem;
    float* ssq = part + 8 * 32 * 80;
    float* rstd_s = ssq + 8 * 128;
    float* lg_ = rstd_s + 32;
    const float* x1 = (const float*)(p.ws + WS_X1);
    const uint4* wrf = (const uint4*)(p.ws + WS_WRF);
    const float* cb = (const float*)(p.ws + WS_CB);
    const float* as2 = (const float*)(p.ws + WS_AS2);
    bf16_t* h = (bf16_t*)(p.ws + WS_H);
    int* cnt = (int*)(p.ws + WS_CTL + CNT_OFF);
    int* list = (int*)(p.ws + WS_LIST); float* lw = (float*)(p.ws + WS_LWT);
    const int tid = threadIdx.x, lane = tid & 63, wave = tid >> 6, li = lane & 15, lg = lane >> 4;
    for (int u = blockIdx.x; u < NTOK / 32; u += gridDim.x) {
        const int tok0 = u * 32, b = tok0 >> 12;
        __syncthreads();
        f32x4 acc[2][5];
#pragma unroll
        for (int tg = 0; tg < 2; ++tg)
#pragma unroll
            for (int nf = 0; nf < 5; ++nf) acc[tg][nf] = f32x4{0.f, 0.f, 0.f, 0.f};
        float sq[2] = {0.f, 0.f};
        const float* xr = x1 + (size_t)(tok0 + li) * DM + wave * 256 + 8 * lg;
#pragma unroll 2
        for (int s4 = 0; s4 < 8; ++s4) {
            bf16x8 ah[2], al[2];
#pragma unroll
            for (int tg = 0; tg < 2; ++tg) {
                const float4 xa = *(const float4*)(xr + (size_t)tg * 16 * DM + s4 * 32), xb = *(const float4*)(xr + (size_t)tg * 16 * DM + s4 * 32 + 4);
                sq[tg] += xa.x * xa.x + xa.y * xa.y + xa.z * xa.z + xa.w * xa.w + xb.x * xb.x + xb.y * xb.y + xb.z * xb.z + xb.w * xb.w;
                uint4 hi, lo;
                hi.x = cvtpk(xa.x, xa.y); hi.y = cvtpk(xa.z, xa.w); hi.z = cvtpk(xb.x, xb.y); hi.w = cvtpk(xb.z, xb.w);
                lo.x = cvtpk(xa.x - bflo(hi.x), xa.y - bfhi(hi.x)); lo.y = cvtpk(xa.z - bflo(hi.y), xa.w - bfhi(hi.y));
                lo.z = cvtpk(xb.x - bflo(hi.z), xb.y - bfhi(hi.z)); lo.w = cvtpk(xb.z - bflo(hi.w), xb.w - bfhi(hi.w));
                ah[tg] = __builtin_bit_cast(bf16x8, hi); al[tg] = __builtin_bit_cast(bf16x8, lo);
            }
            const uint4* wf = wrf + ((size_t)(b * 64 + wave * 8 + s4) * 5) * 128 + lane;
#pragma unroll
            for (int nf = 0; nf < 5; ++nf) {
                const bf16x8 bh = __builtin_bit_cast(bf16x8, wf[nf * 128]), bl = __builtin_bit_cast(bf16x8, wf[nf * 128 + 64]);
#pragma unroll
                for (int tg = 0; tg < 2; ++tg) {
                    acc[tg][nf] = __builtin_amdgcn_mfma_f32_16x16x32_bf16(al[tg], bh, acc[tg][nf], 0, 0, 0);
                    acc[tg][nf] = __builtin_amdgcn_mfma_f32_16x16x32_bf16(ah[tg], bl, acc[tg][nf], 0, 0, 0);
                    acc[tg][nf] = __builtin_amdgcn_mfma_f32_16x16x32_bf16(ah[tg], bh, acc[tg][nf], 0, 0, 0);
                }
            }
        }
#pragma unroll
        for (int tg = 0; tg < 2; ++tg) {
#pragma unroll
            for (int nf = 0; nf < 5; ++nf)
#pragma unroll
                for (int r = 0; r < 4; ++r) part[(wave * 32 + 16 * tg + 4 * lg + r) * 80 + nf * 16 + li] = acc[tg][nf][r];
            ssq[(wave * 4 + lg) * 32 + 16 * tg + li] = sq[tg];
        }
        __syncthreads();
        if (tid < 32) {
            float t = 0.f;
#pragma unroll
            for (int q = 0; q < 32; ++q) t += ssq[q * 32 + tid];
            rstd_s[tid] = rsqrtf(t * (1.f / DM) + 1e-6f);
        }
        __syncthreads();
        for (int idx = tid; idx < 32 * 80; idx += 512) {
            const int tk = idx / 80, j = idx % 80;
            float t = 0.f;
#pragma unroll
            for (int w = 0; w < 8; ++w) t += part[(w * 32 + tk) * 80 + j];
            lg_[idx] = rstd_s[tk] * t + cb[b * 80 + j];
        }
        __syncthreads();
        if (tid < 32) {
            const int tok = tok0 + tid;
            const float* L = lg_ + tid * 80;
            int gi = 0; float gm = L[64];
            for (int j = 1; j < 8; ++j) if (L[64 + j] > gm) { gm = L[64 + j]; gi = j; }
            float den = 0.f;
            for (int j = 0; j < 8; ++j) den += expf(L[64 + j] - gm);
            const float ggate = 1.f / den;
            const float* E = L + gi * 8;
            int i1 = 0; float m1 = E[0];
            for (int j = 1; j < 8; ++j) if (E[j] > m1) { m1 = E[j]; i1 = j; }
            int i2 = -1; float m2 = -3.0e38f;
            for (int j = 0; j < 8; ++j) if (j != i1 && E[j] > m2) { m2 = E[j]; i2 = j; }
            const float e2 = expf(m2 - m1);
            const float p1 = 1.f / (1.f + e2), p2 = e2 / (1.f + e2);
            const int ex1 = gi * 8 + i1, ex2 = gi * 8 + i2;
            const int pos1 = atomicAdd(&cnt[ex1 * CNT_ST], 1); list[ex1 * LCAP + pos1] = tok * 2; lw[ex1 * LCAP + pos1] = ggate * p1;
            const int pos2 = atomicAdd(&cnt[ex2 * CNT_ST], 1); list[ex2 * LCAP + pos2] = tok * 2 + 1; lw[ex2 * LCAP + pos2] = ggate * p2;
        }
#pragma unroll 2
        for (int tt = 0; tt < 4; ++tt) {
            const int tk = wave * 4 + tt, tok = tok0 + tk;
            const float rs = rstd_s[tk];
            const float* xrow = x1 + (size_t)tok * DM;
#pragma unroll
            for (int i = 0; i < 8; ++i) {
                const int k = i * 256 + lane * 4;
                const float4 xv = *(const float4*)(xrow + k);
                const float4 a = *(const float4*)(as2 + b * DM + k), sft = *(const float4*)(as2 + 2 * DM + b * DM + k);
                uint2 o; o.x = cvtpk(xv.x * rs * a.x + sft.x, xv.y * rs * a.y + sft.y); o.y = cvtpk(xv.z * rs * a.z + sft.z, xv.w * rs * a.w + sft.w);
                *(uint2*)(h + (size_t)tok * DM + k) = o;
            }
        }
    }
}

struct MoeTab { int cnt[64]; int sb[65]; int ubx[9]; int np[8]; };
DEVI void moe_tables(const Params& p, MoeTab* tb, int slabs) {
    const int* cnt = (const int*)(p.ws + WS_CTL + CNT_OFF);
    const int tid = threadIdx.x, x = blockIdx.x & 7;
    __syncthreads();
    if (tid < 64) tb->cnt[tid] = cnt[tid * CNT_ST];
    __syncthreads();
    if (tid == 0) {
        int sb = 0;
        for (int e = 0; e < 64; ++e) { tb->sb[e] = sb; sb += tb->cnt[e]; }
        tb->sb[64] = sb;
        int ub = 0;
        for (int i = 0; i < 8; ++i) { const int np = (tb->cnt[x + 8 * i] + 255) >> 8; tb->np[i] = np; tb->ubx[i] = ub; ub += np * slabs; }
        tb->ubx[8] = ub;
    }
    __syncthreads();
}
struct MoeUnit { int e, s, ce, sbase, rbeg, rend; };
DEVI MoeUnit moe_unit(const MoeTab* tb, int u) {
    int i = 0;
    while (tb->ubx[i + 1] <= u) ++i;
    const int rem = u - tb->ubx[i], np = tb->np[i], ps = rem % np;
    MoeUnit m; m.e = (blockIdx.x & 7) + 8 * i; m.s = rem / np; m.ce = tb->cnt[m.e]; m.sbase = tb->sb[m.e];
    const int rp = (((m.ce + np - 1) / np) + 15) & ~15;
    m.rbeg = ps * rp; m.rend = m.rbeg + rp < m.ce ? m.rbeg + rp : m.ce;
    return m;
}

DEVI void phase8(const Params& p, char* smem) {
    MoeTab* tb = (MoeTab*)(smem + 32768);
    const bf16_t* h = (const bf16_t*)(p.ws + WS_H);
    bf16_t* hid = (bf16_t*)(p.ws + WS_HID);
    const int* list = (const int*)(p.ws + WS_LIST);
    const int tid = threadIdx.x, lane = tid & 63, wave = tid >> 6, li = lane & 15, lg = lane >> 4;
    moe_tables(p, tb, 4);
    const int total = tb->ubx[8], nslot = ((int)gridDim.x - (int)(blockIdx.x & 7) + 7) >> 3;
    for (int u = blockIdx.x >> 3; u < total; u += nslot) {
        const MoeUnit mu = moe_unit(tb, u);
        const int e = mu.e, s = mu.s;
        const int fcol = s * 128 + wave * 16;
        const float* bp0 = p.w1 + (size_t)e * DM * FF + (size_t)(8 * lg) * FF + fcol + li;
        const float* bp1 = p.w3 + (size_t)e * DM * FF + (size_t)(8 * lg) * FF + fcol + li;
        int r0 = mu.rbeg + (tid >> 2), r1 = r0 + 128; r0 = r0 < mu.rend ? r0 : mu.rend - 1; r1 = r1 < mu.rend ? r1 : mu.rend - 1;
        const bf16_t* ap0 = h + (size_t)(list[e * LCAP + r0] >> 1) * DM + (tid & 3) * 8;
        const bf16_t* ap1 = h + (size_t)(list[e * LCAP + r1] >> 1) * DM + (tid & 3) * 8;
        __syncthreads();
        gemm_tile<1, 2>(smem, DM / 32, FF, bp0, bp1, ap0, ap1, [&](f32x4 (&acc)[16][2]) {
#pragma unroll
            for (int m = 0; m < 16; ++m) {
                const int r = mu.rbeg + 16 * m + li;
                if (r < mu.rend) {
                    float hv[4];
#pragma unroll
                    for (int q = 0; q < 4; ++q) { const float a = acc[m][0][q]; hv[q] = a / (1.f + __expf(-a)) * acc[m][1][q]; }
                    uint2 o; o.x = cvtpk(hv[0], hv[1]); o.y = cvtpk(hv[2], hv[3]);
                    *(uint2*)(hid + (size_t)(mu.sbase + r) * FF + fcol + 4 * lg) = o;
                }
            }
        });
    }
}

DEVI void phase9(const Params& p, char* smem) {
    MoeTab* tb = (MoeTab*)(smem + 32768);
    const bf16_t* hid = (const bf16_t*)(p.ws + WS_HID);
    bf16_t* yb = (bf16_t*)(p.ws + WS_YB);
    const int* list = (const int*)(p.ws + WS_LIST); const float* lw = (const float*)(p.ws + WS_LWT);
    const int tid = threadIdx.x, lane = tid & 63, wave = tid >> 6, li = lane & 15, lg = lane >> 4;
    moe_tables(p, tb, 8);
    const int total = tb->ubx[8], nslot = ((int)gridDim.x - (int)(blockIdx.x & 7) + 7) >> 3;
    for (int u = blockIdx.x >> 3; u < total; u += nslot) {
        const MoeUnit mu = moe_unit(tb, u);
        const int e = mu.e, s = mu.s;
        const int col0 = s * 256 + wave * 32;
        const float* bp0 = p.w2 + (size_t)e * FF * DM + (size_t)(8 * lg) * DM + col0 + li; const float* bp1 = bp0 + 16;
        int r0 = mu.rbeg + (tid >> 2), r1 = r0 + 128; r0 = r0 < mu.rend ? r0 : mu.rend - 1; r1 = r1 < mu.rend ? r1 : mu.rend - 1;
        const bf16_t* ap0 = hid + (size_t)(mu.sbase + r0) * FF + (tid & 3) * 8; const bf16_t* ap1 = hid + (size_t)(mu.sbase + r1) * FF + (tid & 3) * 8;
        __syncthreads();
        gemm_tile<1, 2>(smem, FF / 32, DM, bp0, bp1, ap0, ap1, [&](f32x4 (&acc)[16][2]) {
#pragma unroll
            for (int m = 0; m < 16; ++m) {
                const int r = mu.rbeg + 16 * m + li;
                if (r < mu.rend) {
                    const int a = list[e * LCAP + r]; const float wgt = lw[e * LCAP + r];
#pragma unroll
                    for (int nf = 0; nf < 2; ++nf) {
                        uint2 o; o.x = cvtpk(acc[m][nf][0] * wgt, acc[m][nf][1] * wgt); o.y = cvtpk(acc[m][nf][2] * wgt, acc[m][nf][3] * wgt);
                        *(uint2*)(yb + (size_t)a * DM + col0 + nf * 16 + 4 * lg) = o;
                    }
                }
            }
        });
    }
}

DEVI void phase10(const Params& p, char* smem) {
    const float* modf = (const float*)(p.ws + WS_MODF);
    const float* x1 = (const float*)(p.ws + WS_X1);
    const bf16_t* yb = (const bf16_t*)(p.ws + WS_YB);
    const int tid = threadIdx.x, lane = tid & 63, wave = tid >> 6;
    for (int u = blockIdx.x; u < NTOK / 8; u += gridDim.x) {
        const int tok = u * 8 + wave, b = tok >> 12;
        float4 v[8]; float ss = 0.f;
#pragma unroll
        for (int i = 0; i < 8; ++i) {
            const int k = i * 256 + lane * 4;
            const float4 xv = *(const float4*)(x1 + (size_t)tok * DM + k);
            const float4 gt = *(const float4*)(modf + b * 12288 + 5 * DM + k);
            const uint2 ya = *(const uint2*)(yb + (size_t)(tok * 2) * DM + k), yc = *(const uint2*)(yb + (size_t)(tok * 2 + 1) * DM + k);
            v[i].x = xv.x + gt.x * (bflo(ya.x) + bflo(yc.x)); v[i].y = xv.y + gt.y * (bfhi(ya.x) + bfhi(yc.x));
            v[i].z = xv.z + gt.z * (bflo(ya.y) + bflo(yc.y)); v[i].w = xv.w + gt.w * (bfhi(ya.y) + bfhi(yc.y));
            ss += v[i].x * v[i].x + v[i].y * v[i].y + v[i].z * v[i].z + v[i].w * v[i].w;
        }
        ss = wave_sum(ss);
        const float rstd = rsqrtf(ss * (1.f / DM) + 1e-6f);
#pragma unroll
        for (int i = 0; i < 8; ++i) {
            const int k = i * 256 + lane * 4;
            const float4 g = *(const float4*)(p.final_g + k);
            float4 o; o.x = v[i].x * rstd * g.x; o.y = v[i].y * rstd * g.y; o.z = v[i].z * rstd * g.z; o.w = v[i].w * rstd * g.w;
            *(float4*)(p.out + (size_t)tok * DM + k) = o;
        }
    }
}

constexpr size_t WS_BAR = 4096;
constexpr int N_PHASES = 12;
#ifndef MK_N_LAUNCHES
#define MK_N_LAUNCHES 1
#endif

__global__ void __launch_bounds__(512) mega_kernel(Params p, int lo, int hi) {
    extern __shared__ __attribute__((aligned(16))) char smem[];
    volatile LAS unsigned* xb_words = (volatile LAS unsigned*)(smem + LDS_BYTES - 16);
    if (threadIdx.x == 0) { xb_words[0] = 0u; xb_words[1] = 0u; xb_words[2] = 0u; xb_words[3] = 0u; }
    __syncthreads();
    XcdBarrier bar;
    if (hi - lo > 1) bar = xcd_barrier_post((unsigned*)(p.ws + WS_BAR), xb_words);
#define IN(k) (lo <= (k) && (k) < hi)
    unsigned long long ts_a = 0ull, ts_b = 0ull;
#define STAMP(k) do { if (PROBE_TS >= 0 && blockIdx.x == 0) { if ((k) == PROBE_TS) ts_a = __builtin_amdgcn_s_memrealtime(); if ((k) == PROBE_TS + 1) ts_b = __builtin_amdgcn_s_memrealtime(); } } while (0)
#define SEAM(k) do { if (IN(k) && IN((k) + 1)) { xcd_barrier(bar); STAMP((k) + 1); } } while (0)
    STAMP(0);
#ifndef PROBE_MASK
#define PROBE_MASK 0
#endif
#define REP(k) (((PROBE_MASK >> (k)) & 1) ? 2 : 1)
    if (IN(0)) for (int rp = 0; rp < REP(0); ++rp) phase0(p, smem);
    SEAM(0);
    if (IN(1)) for (int rp = 0; rp < REP(1); ++rp) phase1(p, smem);
    SEAM(1);
    if (IN(2)) for (int rp = 0; rp < REP(2); ++rp) phase2(p, smem);
    SEAM(2);
    if (IN(3)) for (int rp = 0; rp < REP(3); ++rp) phase3(p, smem);
    SEAM(3);
    if (IN(4)) for (int rp = 0; rp < REP(4); ++rp) phaseRA(p, smem);
    SEAM(4);
    if (IN(5)) for (int rp = 0; rp < REP(5); ++rp) phaseRB(p, smem);
    SEAM(5);
    if (IN(6)) for (int rp = 0; rp < REP(6); ++rp) phaseRC(p, smem);
    SEAM(6);
    if (IN(7)) for (int rp = 0; rp < REP(7); ++rp) phase6(p, smem);
    SEAM(7);
    if (IN(8)) phase7(p, smem);
    SEAM(8);
    if (IN(9)) for (int rp = 0; rp < REP(9); ++rp) phase8(p, smem);
    SEAM(9);
    if (IN(10)) for (int rp = 0; rp < REP(10); ++rp) phase9(p, smem);
    SEAM(10);
    if (IN(11)) for (int rp = 0; rp < REP(11); ++rp) phase10(p, smem);
    STAMP(12);
    if (PROBE_TS >= 0 && blockIdx.x == 0) { const unsigned long long t0 = __builtin_amdgcn_s_memrealtime(), dt = 2ull * (ts_b - ts_a); while (__builtin_amdgcn_s_memrealtime() - t0 < dt) __builtin_amdgcn_s_sleep(8); }
#undef IN
#undef SEAM
}

extern "C" void kernel_launch(void* const* d_in, const int* in_sizes, int n_in, void* d_out, int out_size, void* d_ws, size_t ws_size, hipStream_t stream) {
    static int grid = 0;
    if (!grid) {
        int dev = 0, cus = 0, per_cu = 0;
        (void)hipGetDevice(&dev);
        (void)hipDeviceGetAttribute(&cus, hipDeviceAttributeMultiprocessorCount, dev);
        if (hipFuncSetAttribute((const void*)mega_kernel, hipFuncAttributeMaxDynamicSharedMemorySize, LDS_BYTES) != hipSuccess) { grid = -1; return; }
        if (hipOccupancyMaxActiveBlocksPerMultiprocessor(&per_cu, (const void*)mega_kernel, 512, LDS_BYTES) != hipSuccess || per_cu < 1) { grid = -1; return; }
        grid = cus;
        if (grid > 256) grid = 256;
    }
    if (grid < 0) return;
    Params p{};
    const float* const* in = (const float* const*)d_in;
    p.x = in[0]; p.c = in[1]; p.w_ada = in[2]; p.b_ada = in[3]; p.norm1_g = in[4]; p.w_in = in[5]; p.mu = in[6]; p.sinks = in[7]; p.w0 = in[8]; p.wd_up = in[9];
    p.a0 = in[10]; p.wa_up = in[11]; p.wg_up = in[12]; p.k_k = in[13]; p.k_a = in[14]; p.r_k = in[15]; p.ln_w = in[16]; p.ln_b = in[17]; p.w_o = in[18]; p.norm2_g = in[19];
    p.w_rg = in[20]; p.b_rg = in[21]; p.w_re = in[22]; p.b_re = in[23]; p.w1 = in[24]; p.w3 = in[25]; p.w2 = in[26]; p.final_g = in[27];
    p.out = (float*)d_out; p.ws = (unsigned char*)d_ws;
    (void)hipMemsetAsync((char*)d_ws + WS_CTL, 0, CTL_BYTES, stream);
#if MK_N_LAUNCHES == 1
    hipLaunchKernelGGL(mega_kernel, dim3(grid), dim3(512), LDS_BYTES, stream, p, 0, N_PHASES);
#else
    for (int k = 0; k < N_PHASES; ++k) hipLaunchKernelGGL(mega_kernel, dim3(grid), dim3(512), LDS_BYTES, stream, p, k, k + 1);
#endif
}
```

```cpp
#ifndef PROBE_TS
#define PROBE_TS -1
#endif
#include <hip/hip_runtime.h>
#include <stdint.h>

#define DEVI __device__ __forceinline__
typedef unsigned short bf16_t;
typedef short bf16x8 __attribute__((ext_vector_type(8)));
typedef float f32x4 __attribute__((ext_vector_type(4)));
typedef float f32x16 __attribute__((ext_vector_type(16)));
typedef float f32x2_t __attribute__((ext_vector_type(2)));
typedef __bf16 bf16x2_t __attribute__((ext_vector_type(2)));

constexpr int NTOK = 8192, DM = 2048, SEQ = 4096, INC = 4640, RW = 1024;
constexpr int ZC_K = 1024, ZC_V = 1152, ZC_RW = 1280;
constexpr int NEXP = 64, FF = 512, LCAP = 8192;
constexpr int NKS = 16;

constexpr size_t MiB = 1u << 20;
constexpr size_t WS_CTL = 0, CTL_BYTES = 98304;
constexpr int CNT_OFF = 32768, CNT_ST = 256;
constexpr size_t WS_PART = 1 * MiB;
constexpr size_t WS_MODF = 3 * MiB;
constexpr size_t WS_ROPE = 4 * MiB;
constexpr size_t WS_WRF = 5 * MiB;
constexpr size_t WS_CB = 7 * MiB;
constexpr size_t WS_AS2 = 7 * MiB + 4096;
constexpr size_t WS_H = 8 * MiB;
constexpr size_t WS_Z = 40 * MiB;
constexpr size_t WS_MIX = 116 * MiB;
constexpr size_t WS_X1 = 148 * MiB;
constexpr size_t WS_R = 212 * MiB, WS_DEC = 244 * MiB, WS_K2 = 276 * MiB, WS_V = 308 * MiB, WS_AA = 340 * MiB, WS_BB = 372 * MiB, WS_G = 404 * MiB, WS_Y = 436 * MiB;
constexpr size_t WS_LW = 212 * MiB;
constexpr size_t WS_AV = 244 * MiB;
constexpr size_t WS_GV = 260 * MiB;
constexpr size_t WS_RKS = 468 * MiB;
constexpr size_t WS_LIST = 469 * MiB;
constexpr size_t WS_LWT = 471 * MiB;
constexpr size_t WS_HID = 473 * MiB;
constexpr size_t WS_YB = 490 * MiB;

constexpr size_t WS_WTI = 672 * MiB;
constexpr size_t WS_WTO = 692 * MiB;
constexpr size_t WS_GB = 556 * MiB;
constexpr size_t WS_HB = 572 * MiB;
constexpr size_t WS_Q2 = 604 * MiB;
constexpr size_t WS_Q1 = 636 * MiB;
constexpr size_t WS_S0 = 652 * MiB;

constexpr int LDS_BYTES = 147456;

struct Params {
    const float *x, *c, *w_ada, *b_ada, *norm1_g, *w_in, *mu, *sinks, *w0, *wd_up, *a0, *wa_up, *wg_up, *k_k, *k_a, *r_k, *ln_w, *ln_b, *w_o, *norm2_g,
        *w_rg, *b_rg, *w_re, *b_re, *w1, *w3, *w2, *final_g;
    float* out;
    unsigned char* ws;
};

DEVI unsigned cvtpk_v(float lo, float hi) { unsigned r; asm volatile("v_cvt_pk_bf16_f32 %0, %1, %2" : "=v"(r) : "v"(lo), "v"(hi)); return r; }
DEVI unsigned cvtpk(float lo, float hi) { f32x2_t v = {lo, hi}; bf16x2_t b = __builtin_convertvector(v, bf16x2_t); return __builtin_bit_cast(unsigned, b); }
DEVI float bf2f(unsigned h) { return __builtin_bit_cast(float, h << 16); }
DEVI float bflo(unsigned u) { return __builtin_bit_cast(float, u << 16); }
DEVI float bfhi(unsigned u) { return __builtin_bit_cast(float, u & 0xffff0000u); }
DEVI float wave_sum(float v) {
#pragma unroll
    for (int o = 32; o > 0; o >>= 1) v += __shfl_xor(v, o, 64);
    return v;
}
DEVI float sigmoidf_(float x) { return 1.f / (1.f + __expf(-x)); }

#define XB_TMO      128
#define XB_XCNT(j)  (256  + 64 * (j))
#define XB_XSUB(j)  (1280 + 64 * (j))
#define XB_XGEN(j)  (2304 + 64 * (j))
#define XB_TOP      3328
#define XB_TOPGEN   3392
#define XCD_BAR_WORDS 3456
#define XB_SPIN_CAP (1u << 18)
#define LAS __attribute__((address_space(3)))

__device__ __forceinline__ unsigned xb_ld(unsigned* p)              { return __hip_atomic_load(p, __ATOMIC_RELAXED, __HIP_MEMORY_SCOPE_AGENT); }
__device__ __forceinline__ unsigned xb_add(unsigned* p, unsigned v) { return __hip_atomic_fetch_add(p, v, __ATOMIC_RELAXED, __HIP_MEMORY_SCOPE_AGENT); }
__device__ __forceinline__ unsigned xb_xcc_id() { return (unsigned)__builtin_amdgcn_s_getreg((3 << 11) | 20) & 0xFu; }
#define XB_SPIN(cond, bar) do { unsigned _sp = 0; while (cond) { __builtin_amdgcn_s_sleep(1); \
    if ((++_sp & 255u) == 0u) { if (xb_ld(&(bar)[XB_TMO])) break; if (_sp > XB_SPIN_CAP) { atomicAdd(&(bar)[XB_TMO], 1u); break; } } } } while (0)

struct XcdBarrier {
    unsigned* bar; unsigned x;
    volatile LAS unsigned* st;
};

__device__ __forceinline__ XcdBarrier xcd_barrier_post(unsigned* bar, volatile LAS unsigned* st) {
    XcdBarrier b; b.bar = bar; b.x = xb_xcc_id(); b.st = st;
    if (threadIdx.x == 0) (void)xb_add(&bar[XB_XCNT(b.x)], 1u);
    return b;
}
__device__ __forceinline__ void xcd_barrier_complete(unsigned* bar, unsigned x, unsigned& nloc, unsigned& nx) {
    const unsigned G = gridDim.x * gridDim.y * gridDim.z;
    unsigned sum, cnt, mine, sp = 0u;
    for (;;) {
        sum = 0u; cnt = 0u; mine = 0u;
#pragma unroll
        for (unsigned j = 0; j < 16; ++j) { const unsigned c = xb_ld(&bar[XB_XCNT(j)]); sum += c; cnt += (c > 0u) ? 1u : 0u; mine = (j == x) ? c : mine; }
        if (sum == G) break;
        __builtin_amdgcn_s_sleep(1);
        if ((++sp & 255u) == 0u) { if (xb_ld(&bar[XB_TMO])) break; if (sp > XB_SPIN_CAP) { atomicAdd(&bar[XB_TMO], 1u); break; } }
    }
    nloc = mine > 0u ? mine : 1u; nx = cnt > 0u ? cnt : 1u;
}

__device__ __forceinline__ void xcd_barrier(const XcdBarrier& b) {
    asm volatile("s_waitcnt vmcnt(0)" ::: "memory");
    __syncthreads();
    if (threadIdx.x == 0) {
        unsigned* bar = b.bar;
        __builtin_amdgcn_s_waitcnt(0);
        unsigned nloc = b.st[0], nx = b.st[1];
        if (nloc == 0u) { xcd_barrier_complete(bar, b.x, nloc, nx); b.st[0] = nloc; b.st[1] = nx; }
        const unsigned old = xb_add(&bar[XB_XSUB(b.x)], 1u);
        const unsigned gen = old / nloc;
        if (old + 1u == (gen + 1u) * nloc) {
            __builtin_amdgcn_fence(__ATOMIC_RELEASE, "agent");
            asm volatile("s_waitcnt vmcnt(0)" ::: "memory");
            const unsigned og = xb_add(&bar[XB_TOP], 1u);
            const unsigned tg = og / nx;
            if (og + 1u == (tg + 1u) * nx) xb_add(&bar[XB_TOPGEN], 1u);
            else XB_SPIN(xb_ld(&bar[XB_TOPGEN]) == tg, bar);
            __builtin_amdgcn_fence(__ATOMIC_ACQUIRE, "agent");
            xb_add(&bar[XB_XGEN(b.x)], 1u);
            asm volatile("s_waitcnt vmcnt(0)" ::: "memory");
        } else {
            XB_SPIN(xb_ld(&bar[XB_XGEN(b.x)]) == gen, bar);
            __builtin_amdgcn_fence(__ATOMIC_ACQUIRE, "agent");
            asm volatile("s_waitcnt vmcnt(0)" ::: "memory");
        }
    }
    __syncthreads();
}

template <int PF, int R, class ALoad, class Epi>
DEVI void gemm_tile_f(char* smem, int nk, long ldb, const float* bp0, const float* bp1, ALoad&& aload, Epi&& epi) {
    static_assert(R > PF && (R % 2) == 0, "ring");
    const int tid = threadIdx.x, lane = tid & 63, li = lane & 15, lg = lane >> 4;
    const int sr = tid >> 2, scn = tid & 3;
    const unsigned aw0 = sr * 64 + ((scn ^ ((0 - (sr >> 2)) & 3)) << 4), aw1 = aw0 + 128 * 64;
    const unsigned ar = li * 64 + ((lg ^ ((0 - (li >> 2)) & 3)) << 4);
    float breg[R][2][8];
    f32x4 acc[16][2];
#pragma unroll
    for (int m = 0; m < 16; ++m) { acc[m][0] = f32x4{0.f, 0.f, 0.f, 0.f}; acc[m][1] = f32x4{0.f, 0.f, 0.f, 0.f}; }
    uint4 areg0 = aload(0, 0), areg1 = aload(1, 0);
#pragma unroll
    for (int s = 0; s < PF; ++s) {
        if (s < nk) {
#pragma unroll
            for (int j = 0; j < 8; ++j) { breg[s][0][j] = bp0[(long)(s * 32 + j) * ldb]; breg[s][1][j] = bp1[(long)(s * 32 + j) * ldb]; }
        }
    }
    *(uint4*)(smem + aw0) = areg0; *(uint4*)(smem + aw1) = areg1;
    __syncthreads();
    for (int kt0 = 0; kt0 < nk; kt0 += R) {
#pragma unroll
        for (int u = 0; u < R; ++u) {
            const int kt = kt0 + u;
            if (kt < nk) {
                {
                    const int ka = kt + 1 < nk ? kt + 1 : nk - 1, kb = kt + PF < nk ? kt + PF : nk - 1;
                    areg0 = aload(0, ka); areg1 = aload(1, ka);
                    __builtin_amdgcn_sched_barrier(0);
                    const float* q0 = bp0 + (long)kb * 32 * ldb; const float* q1 = bp1 + (long)kb * 32 * ldb;
#pragma unroll
                    for (int j = 0; j < 8; ++j) { breg[(u + PF) % R][0][j] = q0[(long)j * ldb]; breg[(u + PF) % R][1][j] = q1[(long)j * ldb]; }
                }
                __builtin_amdgcn_sched_barrier(0);
                uint4 b0, b1;
                b0.x = cvtpk_v(breg[u][0][0], breg[u][0][1]); b0.y = cvtpk_v(breg[u][0][2], breg[u][0][3]); b0.z = cvtpk_v(breg[u][0][4], breg[u][0][5]); b0.w = cvtpk_v(breg[u][0][6], breg[u][0][7]);
                b1.x = cvtpk_v(breg[u][1][0], breg[u][1][1]); b1.y = cvtpk_v(breg[u][1][2], breg[u][1][3]); b1.z = cvtpk_v(breg[u][1][4], breg[u][1][5]); b1.w = cvtpk_v(breg[u][1][6], breg[u][1][7]);
                const bf16x8 bf0 = __builtin_bit_cast(bf16x8, b0), bf1 = __builtin_bit_cast(bf16x8, b1);
                const char* As = smem + (u & 1) * 16384 + ar;
#pragma unroll
                for (int mb = 0; mb < 16; mb += 4) {
                    bf16x8 af[4];
#pragma unroll
                    for (int m = 0; m < 4; ++m) af[m] = *(const bf16x8*)(As + (mb + m) * 1024);
                    __builtin_amdgcn_sched_barrier(0);
#pragma unroll
                    for (int m = 0; m < 4; ++m) {
                        acc[mb + m][0] = __builtin_amdgcn_mfma_f32_16x16x32_bf16(bf0, af[m], acc[mb + m][0], 0, 0, 0);
                        acc[mb + m][1] = __builtin_amdgcn_mfma_f32_16x16x32_bf16(bf1, af[m], acc[mb + m][1], 0, 0, 0);
                    }
                    __builtin_amdgcn_sched_barrier(0);
                }
                { char* Aw = smem + ((u + 1) & 1) * 16384; *(uint4*)(Aw + aw0) = areg0; *(uint4*)(Aw + aw1) = areg1; }
                __syncthreads();
            }
        }
    }
    epi(acc);
}
template <int N> struct IC { static constexpr int value = N; };
typedef const __attribute__((address_space(1))) char* gcp_t;
template <class T> DEVI gcp_t uniform_ptr(const T* p) {
    const unsigned long long v = (unsigned long long)p;
    const unsigned lo = __builtin_amdgcn_readfirstlane((unsigned)v), hi = __builtin_amdgcn_readfirstlane((unsigned)(v >> 32));
    return (gcp_t)(((unsigned long long)hi << 32) | lo);
}
DEVI float ldg_f(gcp_t sbase, unsigned voff) { return *(const __attribute__((address_space(1))) float*)(sbase + voff); }
typedef unsigned u32x4n_t __attribute__((ext_vector_type(4)));
DEVI uint4 ldg_q(gcp_t sbase, unsigned voff) { const u32x4n_t v = *(const __attribute__((address_space(1))) u32x4n_t*)(sbase + voff); return make_uint4(v.x, v.y, v.z, v.w); }
template <int AB, int NK, int LDB, int W1OFF, class Epi>
DEVI void gemm_tile_s(char* smem, gcp_t wb0, gcp_t wb1, unsigned boff, gcp_t ab, unsigned aoff0, unsigned aoff1, Epi&& epi) {
    constexpr long ldb = LDB;
    static_assert(NK >= 4, "K steps");
    int tid = threadIdx.x;
    asm volatile("" : "+v"(tid));
    const int lane = tid & 63, li = lane & 15, lg = lane >> 4;
    const int sr = tid >> 2, scn = tid & 3;
    const unsigned aw0 = sr * 64 + ((scn ^ ((0 - (sr >> 2)) & 3)) << 4), aw1 = aw0 + 128 * 64;
    const unsigned ar = li * 64 + ((lg ^ ((0 - (li >> 2)) & 3)) << 4);
    float breg[3][2][8];
    uint4 areg[2][2];
    f32x4 acc[16][2];
#pragma unroll
    for (int m = 0; m < 16; ++m) { acc[m][0] = f32x4{0.f, 0.f, 0.f, 0.f}; acc[m][1] = f32x4{0.f, 0.f, 0.f, 0.f}; }
    {
        const uint4 a0 = ldg_q(ab, aoff0), a1 = ldg_q(ab, aoff1);
        areg[1][0] = ldg_q(ab + 64, aoff0); areg[1][1] = ldg_q(ab + 64, aoff1);
#pragma unroll
        for (int s = 0; s < 2; ++s) {
#pragma unroll
            for (int j = 0; j < 8; ++j) {
                breg[s][0][j] = ldg_f(wb0 + (long)(s * 32 + j) * ldb * 4, boff);
                breg[s][1][j] = ldg_f(wb1 + (long)(s * 32 + j) * ldb * 4, boff);
            }
        }
        *(uint4*)(smem + aw0) = a0; *(uint4*)(smem + aw1) = a1;
    }
    __syncthreads();
    auto step = [&](auto uc, auto prec, auto wrc, const int kt) __attribute__((always_inline)) {
        constexpr int u = decltype(uc)::value;
        constexpr bool PRE = decltype(prec)::value != 0, WR = decltype(wrc)::value != 0;
        unsigned bo = boff;
        if constexpr (PRE) {
            unsigned ao0 = aoff0, ao1 = aoff1;
            asm volatile("" : "+v"(ao0), "+v"(ao1), "+v"(bo));
            { gcp_t sa = ab + (kt + 2) * 64; asm volatile("" : "+s"(sa)); areg[u & 1][0] = ldg_q(sa, ao0); areg[u & 1][1] = ldg_q(sa, ao1); }
        }
        __builtin_amdgcn_sched_barrier(0);
        uint4 b0, b1;
        b0.x = cvtpk_v(breg[u % 3][0][0], breg[u % 3][0][1]); b0.y = cvtpk_v(breg[u % 3][0][2], breg[u % 3][0][3]); b0.z = cvtpk_v(breg[u % 3][0][4], breg[u % 3][0][5]); b0.w = cvtpk_v(breg[u % 3][0][6], breg[u % 3][0][7]);
        b1.x = cvtpk_v(breg[u % 3][1][0], breg[u % 3][1][1]); b1.y = cvtpk_v(breg[u % 3][1][2], breg[u % 3][1][3]); b1.z = cvtpk_v(breg[u % 3][1][4], breg[u % 3][1][5]); b1.w = cvtpk_v(breg[u % 3][1][6], breg[u % 3][1][7]);
        const bf16x8 bf0 = __builtin_bit_cast(bf16x8, b0), bf1 = __builtin_bit_cast(bf16x8, b1);
        const char* As = smem + (u & 1) * 16384 + ar;
        constexpr int JS = (LDB * 4 <= 2048) ? 2 : 1;
        static_assert(AB == 2, "one weight row pair requested per batch of two A fragments");
#pragma unroll
        for (int mb = 0; mb < 16; mb += AB) {
            if constexpr (PRE) {
                constexpr int j = 0;
                const int jr = mb / 2;
                gcp_t s0 = wb0 + (long)((kt + 2) * 32 + (jr & ~(JS - 1))) * ldb * 4, s1 = wb1 + (long)((kt + 2) * 32 + (jr & ~(JS - 1))) * ldb * 4;
                if constexpr (W1OFF != 0) { asm volatile("" : "+s"(s0)); s1 = s0 + W1OFF; } else asm volatile("" : "+s"(s0), "+s"(s1));
                breg[(u + 2) % 3][0][jr] = ldg_f(s0 + (jr & (JS - 1)) * LDB * 4, bo);
                breg[(u + 2) % 3][1][jr] = ldg_f(s1 + (jr & (JS - 1)) * LDB * 4, bo);
                (void)j;
            }
            bf16x8 af[AB];
#pragma unroll
            for (int m = 0; m < AB; ++m) af[m] = *(const bf16x8*)(As + (mb + m) * 1024);
            __builtin_amdgcn_sched_barrier(0);
#pragma unroll
            for (int m = 0; m < AB; ++m) {
                acc[mb + m][0] = __builtin_amdgcn_mfma_f32_16x16x32_bf16(bf0, af[m], acc[mb + m][0], 0, 0, 0);
                acc[mb + m][1] = __builtin_amdgcn_mfma_f32_16x16x32_bf16(bf1, af[m], acc[mb + m][1], 0, 0, 0);
            }
            __builtin_amdgcn_sched_barrier(0);
        }
        if constexpr (WR) { char* Aw = smem + ((u + 1) & 1) * 16384; *(uint4*)(Aw + aw0) = areg[(u + 1) & 1][0]; *(uint4*)(Aw + aw1) = areg[(u + 1) & 1][1]; }
        __syncthreads();
    };
    constexpr int H = (NK - 2) % 6, G = (NK - 2 - H) / 6;
    static_assert(H == 2, "ring phase of the unrolled groups below assumes two head steps (NK = 16, 64, ...)");
    step(IC<0>{}, IC<1>{}, IC<1>{}, 0); step(IC<1>{}, IC<1>{}, IC<1>{}, 1);
    for (int g = 0; g < G; ++g) {
        const int kt0 = H + 6 * g;
        step(IC<2>{}, IC<1>{}, IC<1>{}, kt0); step(IC<3>{}, IC<1>{}, IC<1>{}, kt0 + 1); step(IC<4>{}, IC<1>{}, IC<1>{}, kt0 + 2);
        step(IC<5>{}, IC<1>{}, IC<1>{}, kt0 + 3); step(IC<0>{}, IC<1>{}, IC<1>{}, kt0 + 4); step(IC<1>{}, IC<1>{}, IC<1>{}, kt0 + 5);
    }
    step(IC<2>{}, IC<0>{}, IC<1>{}, NK - 2); step(IC<3>{}, IC<0>{}, IC<0>{}, NK - 1);
    epi(acc);
}
template <int PF, int R, class Epi>
DEVI void gemm_tile(char* smem, int nk, long ldb, const float* bp0, const float* bp1, const bf16_t* ap0, const bf16_t* ap1, Epi&& epi) {
    gemm_tile_f<PF, R>(smem, nk, ldb, bp0, bp1, [&](int i, int kt) { return *(const uint4*)((i ? ap1 : ap0) + kt * 32); }, epi);
}

namespace pg8 {
#define PG8_LAS __attribute__((address_space(3)))
typedef unsigned short bf16_t;
typedef short bf16x8 __attribute__((ext_vector_type(8)));
typedef float f32x4 __attribute__((ext_vector_type(4)));
typedef unsigned u32x4 __attribute__((ext_vector_type(4)));
constexpr int BM = 256, BK = 64, HALF = 128, HTB = HALF * BK * 2  , STAGE_BYTES = 8 * HTB, NXCD = 8, WGM = 8;

__host__ __device__ __forceinline__ int lds_byte(int r, int c) { const int st = (r >> 4) * 2 + (c >> 5), rr = r & 15, cc = c & 31, ob = rr * 64 + cc * 2; return st * 1024 + (ob ^ (((ob >> 9) & 1) << 5)); }
__host__ __device__ __forceinline__ void stage_rc(int b, int& R, int& C) { const int st = b / 1024, sb = b % 1024, swz = sb ^ (((sb >> 9) & 1) << 5); R = (st >> 1) * 16 + swz / 64; C = (st & 1) * 32 + (swz % 64) / 2; }
__host__ __device__ __forceinline__ int perm32(int rho) { const int n = rho >> 4, i = rho & 15; return 8 * (i >> 2) + 4 * n + (i & 3); }

struct Unit { int pm, pn; };
struct Gemm { const bf16_t* A; const bf16_t* Bt; int M, N, K; };

struct StaticOrder {
    int nM, nN, nwg, G, c;
    __host__ __device__ void init(int M, int N, int G_, int c_) { nM = M / BM; nN = N / BM; nwg = nM * nN; G = G_; c = c_; }
    __host__ __device__ bool next(int i, Unit& u) const {
        const long L = (long)i * G + c; if (L >= nwg) return false;
        int wgid = (int)L; { const int q = nwg / NXCD, r = nwg % NXCD, xcd = wgid % NXCD, off = wgid / NXCD; wgid = (xcd < r ? xcd * (q + 1) : r * (q + 1) + (xcd - r) * q) + off; }
        const int nig = WGM * nN, gid = wgid / nig, fm = gid * WGM, gsz = (nM - fm) < WGM ? (nM - fm) : WGM;
        u.pm = fm + ((wgid % nig) % gsz); u.pn = (wgid % nig) / gsz; return true;
    }
    __device__ __forceinline__ void a_ready(const Unit&) const {}
    __device__ __forceinline__ void done(const Unit&) const {}
};


__device__ __forceinline__ unsigned cvt_pk_bf16(float lo, float hi) { unsigned r; asm volatile("v_cvt_pk_bf16_f32 %0, %1, %2" : "=v"(r) : "v"(lo), "v"(hi)); return r; }
struct EpiZ {
    static constexpr bool PERM = true, AFTER_DRAIN = false;
    bf16_t* O; int ldc; int ncols;
    __device__ __forceinline__ void operator()(const f32x4 (&acc)[2][2][4][2], const Unit& u, int wr, int wc, int fr, int fq) const {
        const int row0 = u.pm * BM + wr * 64 + fr, col0 = u.pn * BM + wc * 32 + 8 * fq;
#pragma unroll
        for (int ai = 0; ai < 2; ++ai)
#pragma unroll
            for (int m = 0; m < 4; ++m) { bf16_t* rowp = O + (size_t)(row0 + ai * HALF + m * 16) * ldc;
#pragma unroll
                for (int bj = 0; bj < 2; ++bj) { const int col = col0 + bj * HALF;
                    if (col < ncols) { const f32x4 v0 = acc[ai][bj][m][0], v1 = acc[ai][bj][m][1];
                        u32x4 w; w.x = cvt_pk_bf16(v0[0], v0[1]); w.y = cvt_pk_bf16(v0[2], v0[3]); w.z = cvt_pk_bf16(v1[0], v1[1]); w.w = cvt_pk_bf16(v1[2], v1[3]);
                        *(u32x4*)(rowp + col) = w; } } }
    }
};
struct EpiX1 {
    static constexpr bool PERM = true, AFTER_DRAIN = false;
    float* O; const float* res; const float* gate; int ldc; int gate_stride; int rows_per_batch;
    __device__ __forceinline__ void operator()(const f32x4 (&acc)[2][2][4][2], const Unit& u, int wr, int wc, int fr, int fq) const {
        const int row0 = u.pm * BM + wr * 64 + fr, col0 = u.pn * BM + wc * 32 + 8 * fq;
        const float* gp = gate + (size_t)((u.pm * BM) / rows_per_batch) * gate_stride;
#pragma unroll
        for (int bj = 0; bj < 2; ++bj) { const int col = col0 + bj * HALF;
            const f32x4 g0 = *(const f32x4*)(gp + col), g1 = *(const f32x4*)(gp + col + 4);
#pragma unroll
            for (int ai = 0; ai < 2; ++ai)
#pragma unroll
                for (int m = 0; m < 4; ++m) { const size_t o = (size_t)(row0 + ai * HALF + m * 16) * ldc + col;
                    const f32x4 x0 = *(const f32x4*)(res + o), x1 = *(const f32x4*)(res + o + 4);
                    *(f32x4*)(O + o) = x0 + g0 * acc[ai][bj][m][0]; *(f32x4*)(O + o + 4) = x1 + g1 * acc[ai][bj][m][1]; } }
    }
};
template <class Epi, class Sched, bool ALIGN_EPI = false, bool SP2 = false>
__device__ __forceinline__ void gemm_phase(PG8_LAS unsigned char* lds, const Gemm g, const Sched& S, const Epi& E) {
    const int tid = threadIdx.x, wid = __builtin_amdgcn_readfirstlane(tid >> 6), lane = tid & 63, wr = wid >> 2, wc = wid & 3, fr = lane & 15, fq = lane >> 4;
    const int K = g.K, nt = K / BK;
    unsigned voffA[2], voffB[2];
#pragma unroll
    for (int i = 0; i < 2; ++i) { int R, C; stage_rc(tid * 16 + i * 8192, R, C); const int Rb = Epi::PERM ? ((R & ~31) + perm32(R & 31)) : R;
        voffA[i] = (unsigned)(R * K + C) * 2u; voffB[i] = (unsigned)(Rb * K + C) * 2u; }
    const size_t kstep = (size_t)(BK * 2);
    const size_t hstep = (size_t)HALF * K * 2;
    const size_t tstep = 2 * hstep;
    const unsigned ldsw = (unsigned)wid * 1024u;
    const int aoff = lds_byte(wr * 64 + fr, fq * 8), boff = lds_byte(wc * 32 + fr, fq * 8);
#define PG8_SA(b, h) (((b) * 2 + (h)) * HTB)
#define PG8_SB(b, h) ((4 + (b) * 2 + (h)) * HTB)
#define PG8_STAGE(bufoff, gbase, voff) do { _Pragma("unroll") for (int _i = 0; _i < 2; ++_i) \
        __builtin_amdgcn_global_load_lds((const unsigned*)((const char*)(gbase) + (voff)[_i]), (PG8_LAS unsigned*)(lds + (bufoff) + ldsw + _i * 8192), 16, 0, 0); } while (0)
#define PG8_LDA(dst, b, h) do { _Pragma("unroll") for (int m = 0; m < 4; ++m) _Pragma("unroll") for (int k = 0; k < 2; ++k) dst[m][k] = *(const PG8_LAS bf16x8*)(lds + PG8_SA(b, h) + aoff + m * 2048 + k * 1024); } while (0)
#define PG8_LDB(dst, b, h) do { _Pragma("unroll") for (int n = 0; n < 2; ++n) _Pragma("unroll") for (int k = 0; k < 2; ++k) dst[n][k] = *(const PG8_LAS bf16x8*)(lds + PG8_SB(b, h) + boff + n * 2048 + k * 1024); } while (0)
#define PG8_MMA(ai, bj, At, Bt) do { __builtin_amdgcn_s_setprio(1); _Pragma("unroll") for (int m = 0; m < 4; ++m) _Pragma("unroll") for (int n = 0; n < 2; ++n) _Pragma("unroll") for (int k = 0; k < 2; ++k) \
        acc[ai][bj][m][n] = __builtin_amdgcn_mfma_f32_16x16x32_bf16(Bt[n][k], At[m][k], acc[ai][bj][m][n], 0, 0, 0); __builtin_amdgcn_s_setprio(0); } while (0)
#define PG8_WAIT_V(n) asm volatile("s_waitcnt vmcnt(" #n ")" ::: "memory")
#define PG8_WAIT_L(n) asm volatile("s_waitcnt lgkmcnt(" #n ")" ::: "memory")
#define PG8_BAR __builtin_amdgcn_s_barrier()
#define PG8_SCHED __builtin_amdgcn_sched_barrier(0)
    Unit cur, nxt; int ui = 0;
    if (!S.next(0, cur)) return;
    f32x4 acc[2][2][4][2];
#pragma unroll
    for (int a = 0; a < 2; ++a)
#pragma unroll
        for (int b = 0; b < 2; ++b)
#pragma unroll
            for (int m = 0; m < 4; ++m)
#pragma unroll
                for (int n = 0; n < 2; ++n) acc[a][b][m][n] = (f32x4){0.f, 0.f, 0.f, 0.f};
    bf16x8 At[4][2], B0[2][2], B1[2][2];
    const char* cA = (const char*)g.A + (size_t)cur.pm * tstep; const char* cB = (const char*)g.Bt + (size_t)cur.pn * tstep;
    S.a_ready(cur);
    if constexpr (SP2) {
        PG8_STAGE(PG8_SB(0, 0), cB, voffB); PG8_STAGE(PG8_SB(0, 1), cB + hstep, voffB); PG8_STAGE(PG8_SA(0, 0), cA, voffA); PG8_STAGE(PG8_SA(0, 1), cA + hstep, voffA);
        if (wr == 1) PG8_BAR;
        PG8_WAIT_V(2); PG8_BAR;
        PG8_STAGE(PG8_SB(1, 0), cB + kstep, voffB); PG8_STAGE(PG8_SA(1, 0), cA + kstep, voffA); PG8_STAGE(PG8_SB(1, 1), cB + hstep + kstep, voffB);
        PG8_WAIT_V(6); PG8_BAR;
    } else {
        PG8_STAGE(PG8_SB(0, 0), cB, voffB); PG8_STAGE(PG8_SA(0, 0), cA, voffA); PG8_STAGE(PG8_SB(0, 1), cB + hstep, voffB); PG8_STAGE(PG8_SA(0, 1), cA + hstep, voffA);
        if (wr == 1) PG8_BAR;
        PG8_WAIT_V(4); PG8_BAR;
        PG8_STAGE(PG8_SB(1, 0), cB + kstep, voffB); PG8_STAGE(PG8_SA(1, 0), cA + kstep, voffA); PG8_STAGE(PG8_SB(1, 1), cB + hstep + kstep, voffB);
        PG8_WAIT_V(6); PG8_BAR;
    }
    for (;;) {
        const bool has_next = S.next(ui + 1, nxt);
        const char* nA = has_next ? (const char*)g.A + (size_t)nxt.pm * tstep : cA; const char* nB = has_next ? (const char*)g.Bt + (size_t)nxt.pn * tstep : cB;
        for (int t = 0; t < nt; t += 2) {
            const bool last = (t == nt - 2);
            const char* a1 = cA + (size_t)(t + 1) * kstep;
            const char* a2 = last ? nA : cA + (size_t)(t + 2) * kstep; const char* b2 = last ? nB : cB + (size_t)(t + 2) * kstep;
            const char* a3 = a2 + kstep; const char* b3 = b2 + kstep;
            if (last && has_next) S.a_ready(nxt);
            if constexpr (SP2) {
            PG8_LDB(B0, 0, 0); PG8_LDB(B1, 0, 1); PG8_SCHED; PG8_LDA(At, 0, 0); PG8_STAGE(PG8_SA(1, 1), a1 + hstep, voffA);
            PG8_WAIT_V(8); PG8_WAIT_L(0); PG8_BAR; PG8_MMA(0, 0, At, B0); PG8_MMA(0, 1, At, B1); PG8_BAR; PG8_SCHED;
            PG8_LDA(At, 0, 1); PG8_STAGE(PG8_SB(0, 0), b2, voffB); PG8_STAGE(PG8_SB(0, 1), b2 + hstep, voffB); PG8_STAGE(PG8_SA(0, 0), a2, voffA);
            PG8_WAIT_V(8); PG8_WAIT_L(0); PG8_BAR; PG8_MMA(1, 0, At, B0); PG8_MMA(1, 1, At, B1); PG8_BAR; PG8_SCHED;
            PG8_LDB(B0, 1, 0); PG8_LDB(B1, 1, 1); PG8_SCHED; PG8_LDA(At, 1, 0); PG8_STAGE(PG8_SA(0, 1), a2 + hstep, voffA);
            PG8_WAIT_V(8); PG8_WAIT_L(0); PG8_BAR; PG8_MMA(0, 0, At, B0); PG8_MMA(0, 1, At, B1); PG8_BAR; PG8_SCHED;
            PG8_LDA(At, 1, 1); PG8_STAGE(PG8_SB(1, 0), b3, voffB); PG8_STAGE(PG8_SB(1, 1), b3 + hstep, voffB); PG8_STAGE(PG8_SA(1, 0), a3, voffA);
            PG8_WAIT_V(8); PG8_WAIT_L(0); PG8_BAR; PG8_MMA(1, 0, At, B0); PG8_MMA(1, 1, At, B1); PG8_BAR; PG8_SCHED;
            } else {
            PG8_LDB(B0, 0, 0); PG8_SCHED; PG8_LDA(At, 0, 0); PG8_STAGE(PG8_SA(1, 1), a1 + hstep, voffA);
            PG8_WAIT_L(8); PG8_BAR; PG8_WAIT_L(0); PG8_MMA(0, 0, At, B0); PG8_BAR; PG8_SCHED;
            PG8_LDB(B1, 0, 1); PG8_STAGE(PG8_SB(0, 0), b2, voffB);
            PG8_BAR; PG8_WAIT_L(0); PG8_MMA(0, 1, At, B1); PG8_BAR;
            PG8_LDA(At, 0, 1); PG8_STAGE(PG8_SA(0, 0), a2, voffA);
            PG8_BAR; PG8_WAIT_L(0); PG8_MMA(1, 0, At, B0); PG8_BAR; PG8_SCHED;
            PG8_STAGE(PG8_SB(0, 1), b2 + hstep, voffB);
            PG8_WAIT_V(6); PG8_BAR; PG8_MMA(1, 1, At, B1); PG8_BAR;
            PG8_LDB(B0, 1, 0); PG8_SCHED; PG8_LDA(At, 1, 0); PG8_STAGE(PG8_SA(0, 1), a2 + hstep, voffA);
            PG8_WAIT_L(8); PG8_BAR; PG8_WAIT_L(0); PG8_MMA(0, 0, At, B0); PG8_BAR; PG8_SCHED;
            PG8_LDB(B1, 1, 1); PG8_STAGE(PG8_SB(1, 0), b3, voffB);
            PG8_BAR; PG8_WAIT_L(0); PG8_MMA(0, 1, At, B1); PG8_BAR;
            PG8_LDA(At, 1, 1); PG8_STAGE(PG8_SA(1, 0), a3, voffA);
            PG8_BAR; PG8_WAIT_L(0); PG8_MMA(1, 0, At, B0); PG8_BAR; PG8_SCHED;
            PG8_STAGE(PG8_SB(1, 1), b3 + hstep, voffB);
            PG8_WAIT_V(6); PG8_BAR; PG8_MMA(1, 1, At, B1); PG8_BAR;
            }
        }
        if constexpr (ALIGN_EPI) { if (wr == 0) PG8_BAR; }
        if constexpr (!Epi::AFTER_DRAIN) { E(acc, cur, wr, wc, fr, fq); S.done(cur); }
        if (!has_next) break;
#pragma unroll
        for (int a = 0; a < 2; ++a)
#pragma unroll
            for (int b = 0; b < 2; ++b)
#pragma unroll
                for (int m = 0; m < 4; ++m)
#pragma unroll
                    for (int n = 0; n < 2; ++n) acc[a][b][m][n] = (f32x4){0.f, 0.f, 0.f, 0.f};
        cur = nxt; cA = nA; cB = nB; ++ui;
        if constexpr (ALIGN_EPI) { if (wr == 1) PG8_BAR; }
    }
    PG8_WAIT_V(0);
    if constexpr (!ALIGN_EPI) { if (wr == 0) PG8_BAR; }
    PG8_BAR;
    if constexpr (Epi::AFTER_DRAIN) { E.fused(acc, cur, wr, wc, fr, fq, lds, wid, lane); S.done(cur); }
#undef PG8_SA
#undef PG8_SB
#undef PG8_STAGE
#undef PG8_LDA
#undef PG8_LDB
#undef PG8_MMA
#undef PG8_WAIT_V
#undef PG8_WAIT_L
#undef PG8_BAR
#undef PG8_SCHED
}
}

DEVI void ada_unit(const Params& p, char* smem, int cb, int ks) {
    float* sl = (float*)smem;
    float* part = (float*)(p.ws + WS_PART);
    const int tid = threadIdx.x;
    __syncthreads();
    if (tid < 256) { const int b = tid >> 7, kk = tid & 127; const float cv = p.c[b * DM + ks * 128 + kk]; sl[b * 128 + kk] = cv / (1.f + expf(-cv)); }
    __syncthreads();
    const int j = cb * 512 + tid;
    const float* w = p.w_ada + (size_t)(ks * 128) * 12288 + j;
    float a0 = 0.f, a1 = 0.f;
#pragma unroll 16
    for (int kk = 0; kk < 128; ++kk) { const float wv = w[(size_t)kk * 12288]; a0 += sl[kk] * wv; a1 += sl[128 + kk] * wv; }
    part[(ks * 2 + 0) * 12288 + j] = a0; part[(ks * 2 + 1) * 12288 + j] = a1;
}
DEVI void ada_unit_h(const Params& p, char* smem, int cb, int ks) {
    float* sl = (float*)smem;
    float* part = (float*)(p.ws + WS_PART);
    const int tid = threadIdx.x, hf = tid >> 8, t = tid & 255;
    __syncthreads();
    if (tid < 256) { const int b = tid >> 7, kk = tid & 127; const float cv = p.c[b * DM + ks * 128 + kk]; sl[b * 128 + kk] = cv / (1.f + expf(-cv)); }
    __syncthreads();
    const int j = cb * 256 + t;
    const float* w = p.w_ada + (size_t)(ks * 128 + hf * 64) * 12288 + j;
    const float* s0 = sl + hf * 64;
    float a0 = 0.f, a1 = 0.f;
#pragma unroll 16
    for (int kk = 0; kk < 64; ++kk) { const float wv = w[(size_t)kk * 12288]; a0 += s0[kk] * wv; a1 += s0[128 + kk] * wv; }
    if (hf) { sl[256 + t] = a0; sl[512 + t] = a1; }
    __syncthreads();
    if (!hf) { part[(ks * 2 + 0) * 12288 + j] = a0 + sl[256 + t]; part[(ks * 2 + 1) * 12288 + j] = a1 + sl[512 + t]; }
}
DEVI void transpose_item(const float* W, int N, bf16_t* WT, int r, char* smem) {
    const int lane = threadIdx.x & 63, wave = threadIdx.x >> 6;
    float* scr = (float*)(smem + 4096) + wave * (64 * 33);
    const int nblk = N / 32, kb = r / nblk, nb = r % nblk, k0 = 64 * kb, n0 = 32 * nb;
    {
        float4 t[8];
#pragma unroll
        for (int i = 0; i < 8; ++i) t[i] = *(const float4*)(W + (size_t)(k0 + (lane >> 3) + 8 * i) * N + n0 + 4 * (lane & 7));
#pragma unroll
        for (int i = 0; i < 8; ++i) { float* d = scr + ((lane >> 3) + 8 * i) * 33 + 4 * (lane & 7); d[0] = t[i].x; d[1] = t[i].y; d[2] = t[i].z; d[3] = t[i].w; }
    }
    const int c = lane & 7;
#pragma unroll
    for (int j = 0; j < 4; ++j) { const int n = (lane >> 3) + 8 * j; const float* sp = scr + (8 * c) * 33 + n;
        uint4 o; o.x = cvtpk(sp[0 * 33], sp[1 * 33]); o.y = cvtpk(sp[2 * 33], sp[3 * 33]); o.z = cvtpk(sp[4 * 33], sp[5 * 33]); o.w = cvtpk(sp[6 * 33], sp[7 * 33]);
        *(uint4*)(WT + (size_t)(n0 + n) * DM + k0 + 8 * c) = o; }
}
DEVI void phase0(const Params& p, char* smem) {
    float* rope = (float*)(p.ws + WS_ROPE);
    const int tid = threadIdx.x, lane = tid & 63, wave = tid >> 6;
    constexpr int N_ADA = 16 * NKS, N_ROPE = 256;
    for (int u = blockIdx.x; u < N_ADA + N_ROPE; u += gridDim.x) {
        if (u < N_ADA) {
            ada_unit_h(p, smem, u & 15, u >> 4);
        } else {
            const int idx = (u - N_ADA) * 512 + tid;
            const int t = idx >> 5, i = idx & 31;
            const double invf = exp(-(double)(2 * i) / 64.0 * 9.210340371976184);
            const double ang = (double)t * invf;
            rope[idx] = (float)cos(ang); rope[SEQ * 32 + idx] = (float)sin(ang);
        }
    }
    __syncthreads();
    {
        bf16_t* wti = (bf16_t*)(p.ws + WS_WTI);
        constexpr int I_IN = 32 * (INC / 32), I_Z = (4864 - INC) * DM / 8 / 64;
        for (int it = blockIdx.x * 8 + wave; it < I_IN + I_Z; it += gridDim.x * 8) {
            if (it >= I_IN) { const size_t o = (size_t)INC * DM + ((size_t)(it - I_IN) * 64 + lane) * 8; *(uint4*)(wti + o) = make_uint4(0u, 0u, 0u, 0u); continue; }
            transpose_item(p.w_in, INC, wti, it, smem);
        }
    }
}

DEVI float mod_from_part(const Params& p, int b, int j) {
    const float* part = (const float*)(p.ws + WS_PART);
    float s = p.b_ada[j];
#pragma unroll
    for (int ks = 0; ks < NKS; ++ks) s += part[(ks * 2 + b) * 12288 + j];
    return s;
}

constexpr int N_MODF = 48, N_WRF = 128, N_CB = 2, N_AS2 = 8, N_SPEC = N_WRF + N_CB + N_AS2 + N_MODF;
DEVI void spec_unit(const Params& p, char* smem, int v) {
    float* A1 = (float*)smem;
    const int tid = threadIdx.x, lane = tid & 63, wave = tid >> 6;
    if (v >= N_CB + N_WRF + N_AS2) {
        const int idx = (v - (N_CB + N_WRF + N_AS2)) * 512 + tid; const int b = idx / 12288, j = idx % 12288;
        ((float*)(p.ws + WS_MODF))[idx] = mod_from_part(p, b, j);
    } else {
            if (v < N_CB) {
                const int b = v;
                float* sh2 = A1 + 4 * DM;
                float* red = sh2 + DM;
                __syncthreads();
                for (int k = tid; k < DM; k += 512) sh2[k] = mod_from_part(p, b, 3 * DM + k);
                __syncthreads();
                float ae = 0.f, ag = 0.f;
#pragma unroll 16
                for (int kk = 0; kk < 256; ++kk) { const int k = wave * 256 + kk; const float sv = sh2[k]; ae += sv * p.w_re[k * 64 + lane]; ag += sv * p.w_rg[k * 8 + (lane & 7)]; }
                red[wave * 80 + lane] = ae; if (lane < 8) red[wave * 80 + 64 + lane] = ag;
                __syncthreads();
                if (tid < 80) {
                    float r = 0.f;
                    if (tid < 72) {
#pragma unroll
                        for (int w = 0; w < 8; ++w) r += red[w * 80 + tid];
                        r += (tid < 64 ? p.b_re[tid] : p.b_rg[tid - 64]);
                    }
                    ((float*)(p.ws + WS_CB))[b * 80 + tid] = r;
                }
            } else if (v < N_CB + N_WRF) {
                const int vv = v - N_CB, b = vv >> 6, ks = vv & 63, ln = tid & 63, e = tid >> 6;
                const int k = ks * 32 + 8 * (ln >> 4) + e;
                const float a2 = p.norm2_g[k] * (1.f + mod_from_part(p, b, 4 * DM + k));
                bf16_t* wrf = (bf16_t*)(p.ws + WS_WRF);
#pragma unroll
                for (int nf = 0; nf < 5; ++nf) {
                    const int j = nf * 16 + (ln & 15);
                    const float wv = j < 64 ? p.w_re[k * 64 + j] : (j < 72 ? p.w_rg[k * 8 + (j - 64)] : 0.f);
                    const float val = a2 * wv;
                    const unsigned hi = cvtpk(val, 0.f) & 0xffffu;
                    const unsigned lo = cvtpk(val - bf2f(hi), 0.f) & 0xffffu;
                    const size_t base = ((((size_t)(b * 64 + ks) * 5 + nf) * 2) * 64 + ln) * 8 + e;
                    wrf[base] = (bf16_t)hi; wrf[base + 512] = (bf16_t)lo;
                }
            } else {
                const int idx = (v - N_WRF - N_CB) * 512 + tid, b = idx >> 11, k = idx & 2047;
                float* as2 = (float*)(p.ws + WS_AS2);
                as2[idx] = p.norm2_g[k] * (1.f + mod_from_part(p, b, 4 * DM + k));
                as2[2 * DM + idx] = mod_from_part(p, b, 3 * DM + k);
            }
    }
}

DEVI void phase1(const Params& p, char* smem) {
    float* A1 = (float*)smem;
    float* S1 = A1 + 2 * DM;
    float* modf = (float*)(p.ws + WS_MODF);
    bf16_t* h = (bf16_t*)(p.ws + WS_H);
    const int tid = threadIdx.x, lane = tid & 63, wave = tid >> 6;
    constexpr int N_ROWS = NTOK / 8;
    const int upw = (N_ROWS + (int)gridDim.x - 1) / (int)gridDim.x, u_lo = (int)blockIdx.x * upw, u_hi = (u_lo + upw < N_ROWS) ? u_lo + upw : N_ROWS;
    const int b_lo = (u_lo * 8) >> 12, b_hi = u_hi > u_lo ? ((u_hi * 8 - 1) >> 12) : b_lo;
    for (int idx = tid; idx < 2 * DM; idx += 512) {
        const int b = idx >> 11, k = idx & 2047;
        if (b >= b_lo && b <= b_hi) {
            const float sh = mod_from_part(p, b, k), sc = mod_from_part(p, b, DM + k);
            A1[idx] = p.norm1_g[k] * (1.f + sc); S1[idx] = sh;
        }
    }
    __syncthreads();
    for (int u = u_lo; u < u_hi; ++u) {
        {
            const int row = u * 8 + wave, b = row >> 12;
            const float* xr = p.x + (size_t)row * DM;
            float4 v[8]; float ss = 0.f;
#pragma unroll
            for (int i = 0; i < 8; ++i) { v[i] = *(const float4*)(xr + i * 256 + lane * 4); ss += v[i].x * v[i].x + v[i].y * v[i].y + v[i].z * v[i].z + v[i].w * v[i].w; }
            ss = wave_sum(ss);
            const float rstd = rsqrtf(ss * (1.f / DM) + 1e-6f);
#pragma unroll
            for (int i = 0; i < 8; ++i) {
                const int k = i * 256 + lane * 4;
                const float4 a = *(const float4*)(A1 + b * DM + k), s = *(const float4*)(S1 + b * DM + k);
                uint2 o; o.x = cvtpk(v[i].x * rstd * a.x + s.x, v[i].y * rstd * a.y + s.y); o.y = cvtpk(v[i].z * rstd * a.z + s.z, v[i].w * rstd * a.w + s.w);
                *(uint2*)(h + (size_t)row * DM + k) = o;
            }
        }
    }
}

DEVI void phase2(const Params& p, char* smem) {
    pg8::Gemm g{(const pg8::bf16_t*)(p.ws + WS_H), (const pg8::bf16_t*)(p.ws + WS_WTI), NTOK, 4864, DM};
    pg8::StaticOrder S; S.init(NTOK, 4864, (int)gridDim.x, (int)blockIdx.x);
    pg8::EpiZ E{(pg8::bf16_t*)(p.ws + WS_Z), INC, INC};
    pg8::gemm_phase<pg8::EpiZ, pg8::StaticOrder, true, true>((PG8_LAS unsigned char*)smem, g, S, E);
    const int nthird = 608 - 2 * (int)gridDim.x;
    if (gridDim.x == 256 ? (int)blockIdx.x >= nthird : true) {
        const int nw = gridDim.x == 256 ? 256 - nthird : (int)gridDim.x, wi = gridDim.x == 256 ? (int)blockIdx.x - nthird : (int)blockIdx.x;
        __syncthreads();
        for (int u = wi; u < 512; u += nw) {
            if (u < 256) ada_unit(p, smem, 8 + (u & 15), u >> 4);
            else { __syncthreads(); transpose_item(p.w_o, DM, (bf16_t*)(p.ws + WS_WTO), (u - 256) * 8 + (int)(threadIdx.x >> 6), smem); }
        }
    }
}

DEVI float dpp_xor1(float x) { return __builtin_bit_cast(float, __builtin_amdgcn_update_dpp(0, __builtin_bit_cast(int, x), 0xB1, 0xF, 0xF, true)); }
DEVI float dpp_xor2(float x) { return __builtin_bit_cast(float, __builtin_amdgcn_update_dpp(0, __builtin_bit_cast(int, x), 0x4E, 0xF, 0xF, true)); }
DEVI float xor32_sum(float x) {
    float a = x, b = x;
    asm volatile("s_nop 1\n\tv_permlane32_swap_b32 %0, %1\n\ts_nop 1" : "+v"(a), "+v"(b));
    return a + b;
}
DEVI unsigned m64_off(int row, int chunk) { return row * 128 + ((chunk ^ ((row >> 1) & 7)) << 4); }
DEVI void mm_tile(f32x16& acc, const char* X, int xr0, const char* Y, int yr0, int l31, int hh) {
#pragma unroll
    for (int s4 = 0; s4 < 4; ++s4) {
        const bf16x8 a = *(const bf16x8*)(X + m64_off(xr0 + l31, 2 * s4 + hh));
        const bf16x8 b = *(const bf16x8*)(Y + m64_off(yr0 + l31, 2 * s4 + hh));
        acc = __builtin_amdgcn_mfma_f32_32x32x16_bf16(a, b, acc, 0, 0, 0);
    }
}
DEVI f32x16 zero16() { f32x16 z;
#pragma unroll
    for (int i = 0; i < 16; ++i) z[i] = 0.f;
    return z; }


DEVI float tokshift(const bf16_t* z, const float* mu, int tok, int c) {
    const float zc = bf2f(z[(size_t)tok * INC + ZC_RW + c]);
    const float zp = (tok & (SEQ - 1)) ? bf2f(z[(size_t)(tok - 1) * INC + ZC_RW + c]) : 0.f;
    return zc + (zp - zc) * mu[c];
}

DEVI void p3_unit(const Params& p, char* smem, int u) {
    const bf16_t* z = (const bf16_t*)(p.ws + WS_Z);
    bf16_t* mix = (bf16_t*)(p.ws + WS_MIX);
    const float* rope = (const float*)(p.ws + WS_ROPE);
    const int tid = threadIdx.x, lane = tid & 63, wave = tid >> 6;
    constexpr int N_ATT = 256;
    {
        __syncthreads();
        if (u < N_ATT) {
            constexpr int VTS = 392;
            char* Ks = smem;
            char* Vt = smem + 192 * 128;
            const int b = u >> 7, kvh = (u >> 6) & 1, qb = u & 63, t0 = qb * 64, kbase = t0 - 128;
            for (int idx = tid; idx < 192 * 4; idx += 512) {
                const int j = idx >> 2, c = idx & 3, t = kbase + j;
                uint4 o1 = make_uint4(0u, 0u, 0u, 0u), o2 = o1;
                if (t >= 0) {
                    const bf16_t* zr = z + (size_t)(b * SEQ + t) * INC + ZC_K + kvh * 64 + 8 * c;
                    const uint4 ka = *(const uint4*)zr, kb = *(const uint4*)(zr + 32);
                    const float4 c0 = *(const float4*)(rope + t * 32 + 8 * c), c1 = *(const float4*)(rope + t * 32 + 8 * c + 4);
                    const float4 s0 = *(const float4*)(rope + SEQ * 32 + t * 32 + 8 * c), s1 = *(const float4*)(rope + SEQ * 32 + t * 32 + 8 * c + 4);
                    const float a[8] = {bflo(ka.x), bfhi(ka.x), bflo(ka.y), bfhi(ka.y), bflo(ka.z), bfhi(ka.z), bflo(ka.w), bfhi(ka.w)};
                    const float bq[8] = {bflo(kb.x), bfhi(kb.x), bflo(kb.y), bfhi(kb.y), bflo(kb.z), bfhi(kb.z), bflo(kb.w), bfhi(kb.w)};
                    const float cs[8] = {c0.x, c0.y, c0.z, c0.w, c1.x, c1.y, c1.z, c1.w}, sn[8] = {s0.x, s0.y, s0.z, s0.w, s1.x, s1.y, s1.z, s1.w};
                    float r1[8], r2[8];
#pragma unroll
                    for (int e = 0; e < 8; ++e) { r1[e] = a[e] * cs[e] - bq[e] * sn[e]; r2[e] = bq[e] * cs[e] + a[e] * sn[e]; }
                    o1 = make_uint4(cvtpk(r1[0], r1[1]), cvtpk(r1[2], r1[3]), cvtpk(r1[4], r1[5]), cvtpk(r1[6], r1[7]));
                    o2 = make_uint4(cvtpk(r2[0], r2[1]), cvtpk(r2[2], r2[3]), cvtpk(r2[4], r2[5]), cvtpk(r2[6], r2[7]));
                }
                *(uint4*)(Ks + m64_off(j, c)) = o1; *(uint4*)(Ks + m64_off(j, c + 4)) = o2;
            }
            for (int idx = tid; idx < 192 * 8; idx += 512) {
                const int j = idx >> 3, c = idx & 7, t = kbase + j;
                uint4 vv = make_uint4(0u, 0u, 0u, 0u);
                if (t >= 0) vv = *(const uint4*)(z + (size_t)(b * SEQ + t) * INC + ZC_V + kvh * 64 + 8 * c);
                char* vp = Vt + (8 * c) * VTS + j * 2;
                *(bf16_t*)(vp + 0 * VTS) = (bf16_t)(vv.x & 0xffffu); *(bf16_t*)(vp + 1 * VTS) = (bf16_t)(vv.x >> 16);
                *(bf16_t*)(vp + 2 * VTS) = (bf16_t)(vv.y & 0xffffu); *(bf16_t*)(vp + 3 * VTS) = (bf16_t)(vv.y >> 16);
                *(bf16_t*)(vp + 4 * VTS) = (bf16_t)(vv.z & 0xffffu); *(bf16_t*)(vp + 5 * VTS) = (bf16_t)(vv.z >> 16);
                *(bf16_t*)(vp + 6 * VTS) = (bf16_t)(vv.w & 0xffffu); *(bf16_t*)(vp + 7 * VTS) = (bf16_t)(vv.w >> 16);
            }
            __syncthreads();
            const int h = kvh * 8 + wave, l31 = lane & 31, hh = lane >> 5;
            const float sink = p.sinks[h];
#pragma unroll 1
            for (int qt = 0; qt < 2; ++qt) {
                const int T0 = t0 + qt * 32, tq = T0 + l31;
                bf16x8 qf[4];
                {
                    const bf16_t* zr = z + (size_t)(b * SEQ + tq) * INC + h * 64 + 8 * hh;
                    uint4 raw[4];
#pragma unroll
                    for (int s4 = 0; s4 < 4; ++s4) raw[s4] = *(const uint4*)(zr + 16 * s4);
#pragma unroll
                    for (int s2 = 0; s2 < 2; ++s2) {
                        const int d0 = 16 * s2 + 8 * hh;
                        const float4 c0 = *(const float4*)(rope + tq * 32 + d0), c1 = *(const float4*)(rope + tq * 32 + d0 + 4);
                        const float4 s0 = *(const float4*)(rope + SEQ * 32 + tq * 32 + d0), s1 = *(const float4*)(rope + SEQ * 32 + tq * 32 + d0 + 4);
                        const uint4 ua = raw[s2], ub = raw[s2 + 2];
                        const float a[8] = {bflo(ua.x), bfhi(ua.x), bflo(ua.y), bfhi(ua.y), bflo(ua.z), bfhi(ua.z), bflo(ua.w), bfhi(ua.w)};
                        const float bq[8] = {bflo(ub.x), bfhi(ub.x), bflo(ub.y), bfhi(ub.y), bflo(ub.z), bfhi(ub.z), bflo(ub.w), bfhi(ub.w)};
                        const float cs[8] = {c0.x, c0.y, c0.z, c0.w, c1.x, c1.y, c1.z, c1.w}, sn[8] = {s0.x, s0.y, s0.z, s0.w, s1.x, s1.y, s1.z, s1.w};
                        float r1[8], r2[8];
#pragma unroll
                        for (int e = 0; e < 8; ++e) { r1[e] = (a[e] * cs[e] - bq[e] * sn[e]) * 0.125f; r2[e] = (bq[e] * cs[e] + a[e] * sn[e]) * 0.125f; }
                        qf[s2] = __builtin_bit_cast(bf16x8, make_uint4(cvtpk(r1[0], r1[1]), cvtpk(r1[2], r1[3]), cvtpk(r1[4], r1[5]), cvtpk(r1[6], r1[7])));
                        qf[s2 + 2] = __builtin_bit_cast(bf16x8, make_uint4(cvtpk(r2[0], r2[1]), cvtpk(r2[2], r2[3]), cvtpk(r2[4], r2[5]), cvtpk(r2[6], r2[7])));
                    }
                }
                f32x16 sc[5];
#pragma unroll
                for (int kt = 0; kt < 5; ++kt) {
                    sc[kt] = zero16();
                    const int krow = 32 * qt + 32 * kt + l31;
#pragma unroll
                    for (int s4 = 0; s4 < 4; ++s4) {
                        const bf16x8 kf = *(const bf16x8*)(Ks + m64_off(krow, 2 * s4 + hh));
                        sc[kt] = __builtin_amdgcn_mfma_f32_32x32x16_bf16(kf, qf[s4], sc[kt], 0, 0, 0);
                    }
                }
                float mx = -1e30f;
#pragma unroll
                for (int kt = 0; kt < 5; ++kt)
#pragma unroll
                    for (int i = 0; i < 16; ++i) {
                        const int r = (i & 3) + 8 * (i >> 2) + 4 * hh;
                        bool ok = (T0 - 128 + 32 * kt + r) >= 0;
                        if (kt == 0) ok = ok && (r > l31);
                        if (kt == 4) ok = ok && (r <= l31);
                        sc[kt][i] = ok ? sc[kt][i] : -1e30f;
                        mx = fmaxf(mx, sc[kt][i]);
                    }
                {
                    float a = mx, bq = mx;
                    asm volatile("s_nop 1\n\tv_permlane32_swap_b32 %0, %1\n\ts_nop 1" : "+v"(a), "+v"(bq));
                    mx = fmaxf(fmaxf(a, bq), sink);
                }
                float lsum = 0.f;
#pragma unroll
                for (int kt = 0; kt < 5; ++kt)
#pragma unroll
                    for (int i = 0; i < 16; ++i) { const float pe = __expf(sc[kt][i] - mx); sc[kt][i] = pe; lsum += pe; }
                lsum = xor32_sum(lsum) + __expf(sink - mx);
                const float inv = 1.f / lsum;
                f32x16 oacc[2];
                oacc[0] = zero16(); oacc[1] = zero16();
#pragma unroll
                for (int kt = 0; kt < 5; ++kt)
#pragma unroll
                    for (int s2 = 0; s2 < 2; ++s2) {
                        uint4 pb;
                        pb.x = cvtpk(sc[kt][8 * s2 + 0], sc[kt][8 * s2 + 1]); pb.y = cvtpk(sc[kt][8 * s2 + 2], sc[kt][8 * s2 + 3]);
                        pb.z = cvtpk(sc[kt][8 * s2 + 4], sc[kt][8 * s2 + 5]); pb.w = cvtpk(sc[kt][8 * s2 + 6], sc[kt][8 * s2 + 7]);
                        const int kloc = 32 * qt + 32 * kt + 16 * s2 + 4 * hh;
#pragma unroll
                        for (int dt = 0; dt < 2; ++dt) {
                            const char* vp = Vt + (dt * 32 + l31) * VTS + kloc * 2;
                            const uint2 v0 = *(const uint2*)vp, v1 = *(const uint2*)(vp + 16);
                            const bf16x8 vf = __builtin_bit_cast(bf16x8, make_uint4(v0.x, v0.y, v1.x, v1.y));
                            oacc[dt] = __builtin_amdgcn_mfma_f32_32x32x16_bf16(vf, __builtin_bit_cast(bf16x8, pb), oacc[dt], 0, 0, 0);
                        }
                    }
                bf16_t* orow = mix + (size_t)(b * SEQ + tq) * DM + h * 64;
#pragma unroll
                for (int dt = 0; dt < 2; ++dt)
#pragma unroll
                    for (int q = 0; q < 4; ++q) {
                        uint2 o; o.x = cvtpk(oacc[dt][4 * q] * inv, oacc[dt][4 * q + 1] * inv); o.y = cvtpk(oacc[dt][4 * q + 2] * inv, oacc[dt][4 * q + 3] * inv);
                        *(uint2*)(orow + dt * 32 + 8 * q + 4 * hh) = o;
                    }
            }
        } else {
            const int v = u - N_ATT, prod = 2 - (v >> 7), mt = v & 31, nt = (v >> 5) & 3;
            const int row0 = mt * 256, col0 = nt * 256 + wave * 32, li = lane & 15, lg = lane >> 4;
            const int koff = prod == 0 ? 3072 : (prod == 1 ? 3136 : 3200), nk = prod == 2 ? 5 : 2;
            const float* W = prod == 0 ? p.wd_up : (prod == 1 ? p.wa_up : p.wg_up);
            const float* bp0 = W + (size_t)(8 * lg) * RW + col0 + li; const float* bp1 = bp0 + 16;
            const int srow = row0 + (tid >> 2), scol = koff + (tid & 3) * 8;
            auto aload = [&](int i, int kt) -> uint4 {
                const int tok = srow + 128 * i, c = scol + kt * 32;
                const uint4 zc = *(const uint4*)(z + (size_t)tok * INC + ZC_RW + c);
                uint4 zp = make_uint4(0u, 0u, 0u, 0u);
                if (tok & (SEQ - 1)) zp = *(const uint4*)(z + (size_t)(tok - 1) * INC + ZC_RW + c);
                const float4 m0 = *(const float4*)(p.mu + c), m1 = *(const float4*)(p.mu + c + 4);
                const float a[8] = {bflo(zc.x), bfhi(zc.x), bflo(zc.y), bfhi(zc.y), bflo(zc.z), bfhi(zc.z), bflo(zc.w), bfhi(zc.w)};
                const float q[8] = {bflo(zp.x), bfhi(zp.x), bflo(zp.y), bfhi(zp.y), bflo(zp.z), bfhi(zp.z), bflo(zp.w), bfhi(zp.w)};
                const float mm[8] = {m0.x, m0.y, m0.z, m0.w, m1.x, m1.y, m1.z, m1.w};
                float o[8];
#pragma unroll
                for (int e = 0; e < 8; ++e) {
                    const float zs = a[e] + (q[e] - a[e]) * mm[e];
                    o[e] = prod == 0 ? (1.f - 2.f / (1.f + __expf(2.f * zs))) : (prod == 1 ? zs : sigmoidf_(zs));
                }
                return make_uint4(cvtpk(o[0], o[1]), cvtpk(o[2], o[3]), cvtpk(o[4], o[5]), cvtpk(o[6], o[7]));
            };
            float* LWb = (float*)(p.ws + WS_LW); bf16_t* AVb = (bf16_t*)(p.ws + WS_AV); bf16_t* GVb = (bf16_t*)(p.ws + WS_GV);
            gemm_tile_f<1, 2>(smem, nk, RW, bp0, bp1, aload, [&](f32x4 (&acc)[16][2]) {
#pragma unroll
                for (int nf = 0; nf < 2; ++nf) {
                    const int col = col0 + nf * 16 + 4 * lg;
                    const float4 w0c = *(const float4*)(p.w0 + col), a0c = *(const float4*)(p.a0 + col);
                    const float wc[4] = {w0c.x, w0c.y, w0c.z, w0c.w}, ac[4] = {a0c.x, a0c.y, a0c.z, a0c.w};
#pragma unroll
                    for (int m = 0; m < 16; ++m) {
                        const size_t o = (size_t)(row0 + 16 * m + li) * RW + col;
                        if (prod == 0) {
                            float r[4];
#pragma unroll
                            for (int e = 0; e < 4; ++e) r[e] = -0.60653065971f * sigmoidf_(wc[e] + acc[m][nf][e]);
                            *(float4*)(LWb + o) = make_float4(r[0], r[1], r[2], r[3]);
                        } else if (prod == 1) {
                            uint2 ob; ob.x = cvtpk(sigmoidf_(ac[0] + acc[m][nf][0]), sigmoidf_(ac[1] + acc[m][nf][1])); ob.y = cvtpk(sigmoidf_(ac[2] + acc[m][nf][2]), sigmoidf_(ac[3] + acc[m][nf][3]));
                            *(uint2*)(AVb + o) = ob;
                        } else {
                            uint2 ob; ob.x = cvtpk(acc[m][nf][0], acc[m][nf][1]); ob.y = cvtpk(acc[m][nf][2], acc[m][nf][3]);
                            *(uint2*)(GVb + o) = ob;
                        }
                    }
                }
            });
        }
    }
}
DEVI void phase3(const Params& p, char* smem) {
    for (int v = blockIdx.x; v < 384; v += gridDim.x) p3_unit(p, smem, 256 + v);
}

DEVI void phase4(const Params& p, char* smem) {
    const int tid = threadIdx.x, lane = tid & 63, wave = tid >> 6;
    const float* const pAA = (const float*)(p.ws + WS_AA); const float* const pDE = (const float*)(p.ws + WS_DEC); const float* const pBB = (const float*)(p.ws + WS_BB);
    const float* const pK2 = (const float*)(p.ws + WS_K2); const float* const pR = (const float*)(p.ws + WS_R); const float* const pV = (const float*)(p.ws + WS_V);
    float* Y = (float*)(p.ws + WS_Y);
    constexpr int CH = 32;
    float* bufs = (float*)smem;
    for (int u = blockIdx.x; u < 32; u += gridDim.x) {
        const int b = u >> 4, h = u & 15;
        const int vr = lane >> 2, kq = lane & 3;
        float s[16];
#pragma unroll
        for (int j = 0; j < 16; ++j) s[j] = 0.f;
        __syncthreads();
        const int lst = tid >> 4, lc4 = tid & 15;
        const size_t goff = (size_t)(b * SEQ + lst) * RW + h * 64 + lc4 * 4;
        const int loff = lst * 64 + lc4 * 4;
        {
            *(float4*)(bufs + 0 * CH * 64 + loff) = *(const float4*)(pAA + goff); *(float4*)(bufs + 1 * CH * 64 + loff) = *(const float4*)(pDE + goff);
            *(float4*)(bufs + 2 * CH * 64 + loff) = *(const float4*)(pBB + goff); *(float4*)(bufs + 3 * CH * 64 + loff) = *(const float4*)(pK2 + goff);
            *(float4*)(bufs + 4 * CH * 64 + loff) = *(const float4*)(pR + goff); *(float4*)(bufs + 5 * CH * 64 + loff) = *(const float4*)(pV + goff);
        }
        __syncthreads();
        for (int c = 0; c < SEQ / CH; ++c) {
            float* cur = bufs + (c & 1) * (6 * CH * 64);
            float* nxt = bufs + ((c + 1) & 1) * (6 * CH * 64);
            float4 pre0, pre1, pre2, pre3, pre4, pre5;
            if (c + 1 < SEQ / CH) {
                const size_t g2 = goff + (size_t)(c + 1) * CH * RW;
                pre0 = *(const float4*)(pAA + g2); pre1 = *(const float4*)(pDE + g2); pre2 = *(const float4*)(pBB + g2);
                pre3 = *(const float4*)(pK2 + g2); pre4 = *(const float4*)(pR + g2); pre5 = *(const float4*)(pV + g2);
            }
            if (wave < 4) {
                for (int st = 0; st < CH; ++st) {
                    const float* aa = cur + (0 * CH + st) * 64 + kq * 16;
                    const float* de = cur + (1 * CH + st) * 64 + kq * 16;
                    const float* bb = cur + (2 * CH + st) * 64 + kq * 16;
                    const float* k2 = cur + (3 * CH + st) * 64 + kq * 16;
                    const float* rr = cur + (4 * CH + st) * 64 + kq * 16;
                    const float v = cur[(5 * CH + st) * 64 + wave * 16 + vr];
                    float sa = 0.f;
#pragma unroll
                    for (int j = 0; j < 16; ++j) sa += s[j] * aa[j];
                    sa += __shfl_xor(sa, 1, 64); sa += __shfl_xor(sa, 2, 64);
                    float y = 0.f;
#pragma unroll
                    for (int j = 0; j < 16; ++j) { s[j] = s[j] * de[j] + sa * bb[j] + v * k2[j]; y += s[j] * rr[j]; }
                    y += __shfl_xor(y, 1, 64); y += __shfl_xor(y, 2, 64);
                    if (kq == 0) Y[(size_t)(b * SEQ + c * CH + st) * RW + h * 64 + wave * 16 + vr] = y;
                }
            }
            if (c + 1 < SEQ / CH) {
                *(float4*)(nxt + 0 * CH * 64 + loff) = pre0; *(float4*)(nxt + 1 * CH * 64 + loff) = pre1; *(float4*)(nxt + 2 * CH * 64 + loff) = pre2;
                *(float4*)(nxt + 3 * CH * 64 + loff) = pre3; *(float4*)(nxt + 4 * CH * 64 + loff) = pre4; *(float4*)(nxt + 5 * CH * 64 + loff) = pre5;
            }
            __syncthreads();
        }
    }
}

DEVI void phase5(const Params& p, char* smem) {
    const int tid = threadIdx.x, lane = tid & 63, wave = tid >> 6;
    const float* Y = (const float*)(p.ws + WS_Y); const float* Vb = (const float*)(p.ws + WS_V); const float* Gb = (const float*)(p.ws + WS_G); const float* RKSb = (const float*)(p.ws + WS_RKS);
    bf16_t* mix = (bf16_t*)(p.ws + WS_MIX);
    for (int u = blockIdx.x; u < NTOK * 16 / 8; u += gridDim.x) {
        const int pi = u * 8 + wave, tok = pi >> 4, head = pi & 15, ch = head * 64 + lane;
        const float y = Y[(size_t)tok * RW + ch];
        const float mean = wave_sum(y) * (1.f / 64.f);
        const float d = y - mean;
        const float var = wave_sum(d * d) * (1.f / 64.f);
        const float yn = d * rsqrtf(var + 64e-5f) * p.ln_w[ch] + p.ln_b[ch];
        const float o = (yn + RKSb[tok * 16 + head] * Vb[(size_t)tok * RW + ch]) * Gb[(size_t)tok * RW + ch];
        mix[(size_t)tok * DM + 1024 + ch] = (bf16_t)(cvtpk(o, 0.f) & 0xffffu);
    }
}


constexpr int RA_AT = 0, RA_BT = 8192, RA_KT = 16384, RA_RT = 24576, RA_BPT = 32768, RA_KPT = 40960, RA_VT = 49152, RA_AAK = 57344, RA_ARB = 65536, RA_ARK = 73728,
              RA_AABP = 81920, RA_RHS = 98304, RA_WL = 131072, RA_SEG = 131328, RA_P1T = RA_BT, RA_P2T = RA_KT, RA_CUM = RA_AABP;

DEVI void phaseRA(const Params& p, char* smem) {
    const int tid = threadIdx.x, lane = tid & 63, wave = tid >> 6, l31 = lane & 31, hh = lane >> 5;
    const bf16_t* z = (const bf16_t*)(p.ws + WS_Z);
    float* cumb = (float*)(smem + RA_CUM); float* segs = (float*)(smem + RA_SEG); float* wl = (float*)(smem + RA_WL);
    float* rhs = (float*)(smem + RA_RHS); float* aabp = (float*)(smem + RA_AABP);
    uint4 n_cr, n_ck, n_cv, n_pr, n_pk, n_pv, n_au; float4 n_lw0, n_lw1;
    auto load_raw = [&](int unit_) {
        const int bh_ = unit_ >> 6, c_ = unit_ & 63, b_ = bh_ >> 4, h_ = bh_ & 15;
        const int tok = b_ * SEQ + c_ * 64 + (tid >> 3), ch0 = h_ * 64 + (tid & 7) * 8;
        const bf16_t* zr = z + (size_t)tok * INC + ZC_RW + ch0;
        const bool hasp = (tok & (SEQ - 1)) != 0;
        const uint4 zero4 = make_uint4(0u, 0u, 0u, 0u);
        n_cr = *(const uint4*)zr; n_ck = *(const uint4*)(zr + 1024); n_cv = *(const uint4*)(zr + 2048);
        n_pr = hasp ? *(const uint4*)(zr - INC) : zero4; n_pk = hasp ? *(const uint4*)(zr - INC + 1024) : zero4; n_pv = hasp ? *(const uint4*)(zr - INC + 2048) : zero4;
        n_au = *(const uint4*)((const bf16_t*)(p.ws + WS_AV) + (size_t)tok * RW + ch0);
        const float* lwp = (const float*)(p.ws + WS_LW) + (size_t)tok * RW + ch0;
        n_lw0 = *(const float4*)lwp; n_lw1 = *(const float4*)(lwp + 4);
    };
    if (((int)blockIdx.x >> 3) < 256) load_raw((((int)blockIdx.x & 7) + 8 * (((int)blockIdx.x >> 3) >> 6)) * 64 + (((int)blockIdx.x >> 3) & 63));
    const int ra_x = (int)blockIdx.x & 7, ra_slot = (int)blockIdx.x >> 3, ra_nslot = ((int)gridDim.x - ra_x + 7) >> 3;
    for (int uu = ra_slot; uu < 256; uu += ra_nslot) {
        const int bh = ra_x + 8 * (uu >> 6), c = uu & 63, b = bh >> 4, h = bh & 15;
        const int unit = bh * 64 + c;
        const int tokbase = b * SEQ + c * 64;
        __syncthreads();
        const int t = tid >> 3, c8 = tid & 7;
        float r_[8], k2[8], v_[8], aa[8], bb[8], lw[8];
        {
            const int tok = tokbase + t, ch0 = h * 64 + c8 * 8;
            const uint4 cr = n_cr, ck = n_ck, cv = n_cv, pr = n_pr, pk_ = n_pk, pv = n_pv, au = n_au;
            float fr[8], fk[8], fpr[8], fpk[8], fpv[8], mur[8], muk[8], muv[8], av[8], kkc[8], kac[8], rkc[8];
#define UNPK8(dst, u) { dst[0] = bflo(u.x); dst[1] = bfhi(u.x); dst[2] = bflo(u.y); dst[3] = bfhi(u.y); dst[4] = bflo(u.z); dst[5] = bfhi(u.z); dst[6] = bflo(u.w); dst[7] = bfhi(u.w); }
#define LDF8(dst, ptr) { const float4 q0_ = *(const float4*)(ptr), q1_ = *(const float4*)((ptr) + 4); dst[0] = q0_.x; dst[1] = q0_.y; dst[2] = q0_.z; dst[3] = q0_.w; dst[4] = q1_.x; dst[5] = q1_.y; dst[6] = q1_.z; dst[7] = q1_.w; }
            UNPK8(fr, cr) UNPK8(fk, ck) UNPK8(v_, cv) UNPK8(fpr, pr) UNPK8(fpk, pk_) UNPK8(fpv, pv) UNPK8(av, au)
            LDF8(mur, p.mu + ch0) LDF8(muk, p.mu + 1024 + ch0) LDF8(muv, p.mu + 2048 + ch0)
            LDF8(kkc, p.k_k + ch0) LDF8(kac, p.k_a + ch0) LDF8(rkc, p.r_k + ch0)
            lw[0] = n_lw0.x; lw[1] = n_lw0.y; lw[2] = n_lw0.z; lw[3] = n_lw0.w; lw[4] = n_lw1.x; lw[5] = n_lw1.y; lw[6] = n_lw1.z; lw[7] = n_lw1.w;
            float ssq = 0.f, rk = 0.f, kk[8];
#pragma unroll
            for (int i = 0; i < 8; ++i) {
                r_[i] = fr[i] + (fpr[i] - fr[i]) * mur[i];
                const float kx = fk[i] + (fpk[i] - fk[i]) * muk[i];
                v_[i] = v_[i] + (fpv[i] - v_[i]) * muv[i];
                kk[i] = kx * kkc[i]; ssq += kk[i] * kk[i];
                k2[i] = kx * (1.f + (av[i] - 1.f) * kac[i]);
                rk += r_[i] * k2[i] * rkc[i];
            }
            ssq += dpp_xor1(ssq); ssq += dpp_xor2(ssq); ssq += __shfl_xor(ssq, 4, 64);
            rk += dpp_xor1(rk); rk += dpp_xor2(rk); rk += __shfl_xor(rk, 4, 64);
            const float invn = 1.f / fmaxf(sqrtf(ssq), 1e-12f);
#pragma unroll
            for (int i = 0; i < 8; ++i) { const float kn = kk[i] * invn; aa[i] = -kn; bb[i] = kn * av[i]; }
            if (c8 == 0) ((float*)(p.ws + WS_RKS))[tok * 16 + h] = rk;
        }
#pragma unroll
        for (int i = 0; i < 8; ++i) cumb[t * 64 + c8 * 8 + i] = lw[i];
        __syncthreads();
        if (uu + ra_nslot < 256) { const int u2 = uu + ra_nslot; load_raw((ra_x + 8 * (u2 >> 6)) * 64 + (u2 & 63)); }
        {
            const int ch = tid & 63, seg = tid >> 6;
            float loc[8]; float run = 0.f;
#pragma unroll
            for (int j = 0; j < 8; ++j) { run += cumb[(seg * 8 + j) * 64 + ch]; loc[j] = run; }
            segs[seg * 64 + ch] = run;
            __syncthreads();
            float off = 0.f;
#pragma unroll
            for (int s2 = 0; s2 < 8; ++s2) off += (s2 < seg) ? segs[s2 * 64 + ch] : 0.f;
#pragma unroll
            for (int j = 0; j < 8; ++j) cumb[(seg * 8 + j) * 64 + ch] = off + loc[j];
        }
        __syncthreads();
        {
            unsigned pk[7][4];
            float atf[8];
#pragma unroll
            for (int i = 0; i < 8; i += 2) {
                float o[7][2];
#pragma unroll
                for (int e = 0; e < 2; ++e) {
                    const float cu = cumb[t * 64 + c8 * 8 + i + e], cl = cumb[63 * 64 + c8 * 8 + i + e];
                    const float e1 = __expf(cu), e2 = 1.f / e1, ex = __expf(cu - lw[i + e]), ew = __expf(cl - cu);
                    o[0][e] = aa[i + e] * ex; o[1][e] = bb[i + e] * e2; o[2][e] = k2[i + e] * e2; o[3][e] = r_[i + e] * e1;
                    o[4][e] = bb[i + e] * ew; o[5][e] = k2[i + e] * ew; o[6][e] = v_[i + e];
                    atf[i + e] = o[0][e];
                    if (t == 63) wl[c8 * 8 + i + e] = e1;
                }
#pragma unroll
                for (int m = 0; m < 7; ++m) pk[m][i >> 1] = cvtpk(o[m][0], o[m][1]);
            }
            const unsigned ro = m64_off(t, c8);
            *(uint4*)(smem + RA_AT + ro) = make_uint4(pk[0][0], pk[0][1], pk[0][2], pk[0][3]);
            *(uint4*)(smem + RA_BT + ro) = make_uint4(pk[1][0], pk[1][1], pk[1][2], pk[1][3]);
            *(uint4*)(smem + RA_KT + ro) = make_uint4(pk[2][0], pk[2][1], pk[2][2], pk[2][3]);
            *(uint4*)(smem + RA_RT + ro) = make_uint4(pk[3][0], pk[3][1], pk[3][2], pk[3][3]);
            *(float4*)(rhs + t * 128 + c8 * 8) = make_float4(atf[0], atf[1], atf[2], atf[3]);
            *(float4*)(rhs + t * 128 + c8 * 8 + 4) = make_float4(atf[4], atf[5], atf[6], atf[7]);
#pragma unroll
            for (int i = 0; i < 8; ++i) {
                const int ch = c8 * 8 + i;
                const unsigned to = m64_off(ch, t >> 3) + (t & 7) * 2;
                const unsigned w4 = pk[4][i >> 1], w5 = pk[5][i >> 1], w6 = pk[6][i >> 1];
                *(bf16_t*)(smem + RA_BPT + to) = (bf16_t)((i & 1) ? (w4 >> 16) : (w4 & 0xffffu));
                *(bf16_t*)(smem + RA_KPT + to) = (bf16_t)((i & 1) ? (w5 >> 16) : (w5 & 0xffffu));
                *(bf16_t*)(smem + RA_VT + to) = (bf16_t)((i & 1) ? (w6 >> 16) : (w6 & 0xffffu));
            }
        }
        __syncthreads();
        {
            const int pr = wave >> 1, sub = wave & 1;
            const char* X = smem + ((pr & 1) ? RA_KT : RA_BT);
            const char* Y = smem + ((pr & 2) ? RA_RT : RA_AT);
            const int incl = (pr & 2) ? 1 : 0;
            char* dst = smem + (pr == 1 ? RA_AAK : pr == 2 ? RA_ARB : RA_ARK);
#pragma unroll
            for (int tt = 0; tt < 2; ++tt) {
                const int i0 = sub ? (tt ? 32 : 0) : (tt ? 32 : 0);
                const int t0 = sub ? (tt ? 0 : 32) : (tt ? 32 : 0);
                const bool zero_tile = sub && tt;
                f32x16 acc = zero16();
                if (!zero_tile) mm_tile(acc, X, i0, Y, t0, l31, hh);
                const int tq = t0 + l31;
#pragma unroll
                for (int q = 0; q < 4; ++q) {
                    float vv[4];
#pragma unroll
                    for (int e = 0; e < 4; ++e) { const int ii = i0 + 8 * q + 4 * hh + e; vv[e] = (ii < tq + incl) ? acc[4 * q + e] : 0.f; }
                    if (pr == 0) {
                        if (!zero_tile) {
#pragma unroll
                            for (int e = 0; e < 4; ++e) aabp[tq * 64 + e * 16 + (i0 >> 2) + 2 * q + hh] = vv[e];
                        }
                    } else {
                        uint2 o; o.x = cvtpk(vv[0], vv[1]); o.y = cvtpk(vv[2], vv[3]);
                        *(uint2*)(dst + m64_off(tq, (i0 >> 3) + q) + 8 * hh) = o;
                    }
                }
            }
        }
        __syncthreads();
        f32x16 accA = zero16();
        const int w4 = wave & 3, ta = w4 & 1, tb2 = w4 >> 1;
        if (wave < 4) {
            f32x16 x2 = zero16();
            mm_tile(x2, smem + RA_VT, ta * 32, smem + RA_AAK, tb2 * 32, l31, hh);
            const int tq = tb2 * 32 + l31;
#pragma unroll
            for (int q = 0; q < 4; ++q) *(float4*)(rhs + tq * 128 + 64 + ta * 32 + 8 * q + 4 * hh) = make_float4(x2[4 * q], x2[4 * q + 1], x2[4 * q + 2], x2[4 * q + 3]);
            mm_tile(accA, smem + RA_VT, ta * 32, smem + RA_ARK, tb2 * 32, l31, hh);
        } else {
            mm_tile(accA, smem + RA_KPT, ta * 32, smem + RA_VT, tb2 * 32, l31, hh);
        }
        __syncthreads();
        {
            const int g = lane & 3, col = wave * 16 + (lane >> 2);
            float P[16];
#pragma unroll
            for (int q = 0; q < 16; ++q) P[q] = 0.f;
            float last[4];
            char* pt = smem + (col < 64 ? RA_P1T : RA_P2T);
            const int prow = col & 63;
            float4 acur[4]; float rcur = rhs[col];
#pragma unroll
            for (int q4 = 0; q4 < 4; ++q4) acur[q4] = make_float4(0.f, 0.f, 0.f, 0.f);
#pragma unroll
            for (int ts = 0; ts < 64; ++ts) {
                float4 anxt[4]; float rnxt = 0.f;
#pragma unroll
                for (int q4 = 0; q4 < 4; ++q4) anxt[q4] = make_float4(0.f, 0.f, 0.f, 0.f);
                if (ts + 1 < 64) {
                    const int nq4n = (((ts + 4) >> 2) + 3) >> 2;
#pragma unroll
                    for (int q4 = 0; q4 < nq4n; ++q4) anxt[q4] = *(const float4*)(aabp + (ts + 1) * 64 + g * 16 + q4 * 4);
                    rnxt = rhs[(ts + 1) * 128 + col];
                }
                float part = 0.f;
                const int nq4 = (((ts + 3) >> 2) + 3) >> 2;
#pragma unroll
                for (int q4 = 0; q4 < nq4; ++q4) {
                    const float4 a = acur[q4];
                    part += a.x * P[4 * q4] + a.y * P[4 * q4 + 1] + a.z * P[4 * q4 + 2] + a.w * P[4 * q4 + 3];
                }
                part += dpp_xor1(part); part += dpp_xor2(part);
                const float val = rcur + part;
#pragma unroll
                for (int q4 = 0; q4 < 4; ++q4) acur[q4] = anxt[q4];
                rcur = rnxt;
                if (g == (ts & 3)) P[ts >> 2] = val;
                last[ts & 3] = val;
                if ((ts & 3) == 3 && g == 0) {
                    uint2 o; o.x = cvtpk(last[0], last[1]); o.y = cvtpk(last[2], last[3]);
                    *(uint2*)(pt + m64_off(prow, ts >> 3) + ((ts >> 2) & 1) * 8) = o;
                }
            }
        }
        __syncthreads();
        if (wave < 4) {
            mm_tile(accA, smem + RA_P2T, ta * 32, smem + RA_ARB, tb2 * 32, l31, hh);
            float* q2 = (float*)(p.ws + WS_Q2) + ((size_t)unit * 4 + (ta * 2 + tb2)) * 1024;
#pragma unroll
            for (int i = 0; i < 16; ++i) q2[i * 64 + lane] = accA[i];
            f32x16 q1 = zero16();
            mm_tile(q1, smem + RA_P1T, ta * 32, smem + RA_ARB, tb2 * 32, l31, hh);
            const int tq = tb2 * 32 + l31;
            bf16_t* q1g = (bf16_t*)(p.ws + WS_Q1) + (size_t)unit * 4096 + tq * 64;
#pragma unroll
            for (int q = 0; q < 4; ++q) {
                const int k0 = ta * 32 + 8 * q + 4 * hh;
                const uint2 rr = *(const uint2*)(smem + RA_RT + m64_off(tq, k0 >> 3) + (k0 & 7) * 2);
                uint2 o; o.x = cvtpk(q1[4 * q] + bflo(rr.x), q1[4 * q + 1] + bfhi(rr.x)); o.y = cvtpk(q1[4 * q + 2] + bflo(rr.y), q1[4 * q + 3] + bfhi(rr.y));
                *(uint2*)(q1g + k0) = o;
            }
        } else {
            mm_tile(accA, smem + RA_BPT, ta * 32, smem + RA_P2T, tb2 * 32, l31, hh);
            unsigned* hb = (unsigned*)(p.ws + WS_HB) + ((size_t)unit * 4 + (ta * 2 + tb2)) * 512;
#pragma unroll
            for (int j = 0; j < 8; ++j) hb[j * 64 + lane] = cvtpk(accA[2 * j], accA[2 * j + 1]);
            f32x16 gg = zero16();
            mm_tile(gg, smem + RA_P1T, ta * 32, smem + RA_BPT, tb2 * 32, l31, hh);
            if (ta == tb2) {
#pragma unroll
                for (int i = 0; i < 16; ++i) { const int kk = (i & 3) + 8 * (i >> 2) + 4 * hh; if (kk == l31) gg[i] += wl[ta * 32 + kk]; }
            }
            unsigned* gb = (unsigned*)(p.ws + WS_GB) + ((size_t)unit * 4 + (ta * 2 + tb2)) * 512 + lane * 8;
            uint4 o0, o1;
            o0.x = cvtpk(gg[0], gg[1]); o0.y = cvtpk(gg[2], gg[3]); o0.z = cvtpk(gg[4], gg[5]); o0.w = cvtpk(gg[6], gg[7]);
            o1.x = cvtpk(gg[8], gg[9]); o1.y = cvtpk(gg[10], gg[11]); o1.z = cvtpk(gg[12], gg[13]); o1.w = cvtpk(gg[14], gg[15]);
            *(uint4*)(gb) = o0; *(uint4*)(gb + 4) = o1;
        }
    }
}

struct RbH { unsigned w[2][8]; };
DEVI void rb_load(const Params& p, int unit, int vh, int lane, uint4 (&g)[8], RbH& hq) {
    const unsigned* gb = (const unsigned*)(p.ws + WS_GB) + (size_t)unit * 2048 + lane * 8;
    const unsigned* hb = (const unsigned*)(p.ws + WS_HB) + (size_t)unit * 2048 + lane;
#pragma unroll
    for (int t4 = 0; t4 < 4; ++t4) { g[2 * t4] = *(const uint4*)(gb + t4 * 512); g[2 * t4 + 1] = *(const uint4*)(gb + t4 * 512 + 4); }
#pragma unroll
    for (int j = 0; j < 8; ++j) { hq.w[0][j] = hb[(0 * 2 + vh) * 512 + j * 64]; hq.w[1][j] = hb[(1 * 2 + vh) * 512 + j * 64]; }
}
DEVI void rb_store(const Params& p, int unit, int vh, int l31, int hh, const f32x16& X0, const f32x16& X1) {
    bf16_t* s0 = (bf16_t*)(p.ws + WS_S0) + (size_t)unit * 4096 + (vh * 32 + l31) * 64;
#pragma unroll
    for (int q = 0; q < 4; ++q) {
        uint2 o; o.x = cvtpk(X0[4 * q], X0[4 * q + 1]); o.y = cvtpk(X0[4 * q + 2], X0[4 * q + 3]);
        *(uint2*)(s0 + 8 * q + 4 * hh) = o;
        uint2 o2; o2.x = cvtpk(X1[4 * q], X1[4 * q + 1]); o2.y = cvtpk(X1[4 * q + 2], X1[4 * q + 3]);
        *(uint2*)(s0 + 32 + 8 * q + 4 * hh) = o2;
    }
}
#define BF8(u) __builtin_bit_cast(bf16x8, u)
DEVI void rb_step(f32x16& X0, f32x16& X1, const uint4 (&g)[8], const RbH& hq) {
    uint4 xa, xb, xc, xd;
    xa.x = cvtpk(X0[0], X0[1]); xa.y = cvtpk(X0[2], X0[3]); xa.z = cvtpk(X0[4], X0[5]); xa.w = cvtpk(X0[6], X0[7]);
    xb.x = cvtpk(X0[8], X0[9]); xb.y = cvtpk(X0[10], X0[11]); xb.z = cvtpk(X0[12], X0[13]); xb.w = cvtpk(X0[14], X0[15]);
    xc.x = cvtpk(X1[0], X1[1]); xc.y = cvtpk(X1[2], X1[3]); xc.z = cvtpk(X1[4], X1[5]); xc.w = cvtpk(X1[6], X1[7]);
    xd.x = cvtpk(X1[8], X1[9]); xd.y = cvtpk(X1[10], X1[11]); xd.z = cvtpk(X1[12], X1[13]); xd.w = cvtpk(X1[14], X1[15]);
    f32x16 N0, N1;
#pragma unroll
    for (int j = 0; j < 8; ++j) { N0[2 * j] = bflo(hq.w[0][j]); N0[2 * j + 1] = bfhi(hq.w[0][j]); N1[2 * j] = bflo(hq.w[1][j]); N1[2 * j + 1] = bfhi(hq.w[1][j]); }
    N0 = __builtin_amdgcn_mfma_f32_32x32x16_bf16(BF8(g[0]), BF8(xa), N0, 0, 0, 0);
    N1 = __builtin_amdgcn_mfma_f32_32x32x16_bf16(BF8(g[2]), BF8(xa), N1, 0, 0, 0);
    N0 = __builtin_amdgcn_mfma_f32_32x32x16_bf16(BF8(g[1]), BF8(xb), N0, 0, 0, 0);
    N1 = __builtin_amdgcn_mfma_f32_32x32x16_bf16(BF8(g[3]), BF8(xb), N1, 0, 0, 0);
    N0 = __builtin_amdgcn_mfma_f32_32x32x16_bf16(BF8(g[4]), BF8(xc), N0, 0, 0, 0);
    N1 = __builtin_amdgcn_mfma_f32_32x32x16_bf16(BF8(g[6]), BF8(xc), N1, 0, 0, 0);
    N0 = __builtin_amdgcn_mfma_f32_32x32x16_bf16(BF8(g[5]), BF8(xd), N0, 0, 0, 0);
    N1 = __builtin_amdgcn_mfma_f32_32x32x16_bf16(BF8(g[7]), BF8(xd), N1, 0, 0, 0);
    X0 = N0; X1 = N1;
}
DEVI void phaseRB_core(const Params& p, char* smem) {
    const int tid = threadIdx.x, lane = tid & 63, wave = tid >> 6, l31 = lane & 31, hh = lane >> 5;
    if (wave != 0) return;
    for (int wu = blockIdx.x; wu < 64; wu += gridDim.x) {
        const int bh = (wu & 7) | ((wu >> 4) << 3), vh = (wu >> 3) & 1;
        f32x16 X0 = zero16(), X1 = zero16();
        uint4 gA[8], gB[8], gC[8]; RbH hA, hB, hC;
        rb_load(p, bh * 64, vh, lane, gA, hA);
        rb_load(p, bh * 64 + 1, vh, lane, gB, hB);
        for (int c = 0; c < 63; c += 3) {
            rb_load(p, bh * 64 + (c + 2 < 64 ? c + 2 : 63), vh, lane, gC, hC);
            rb_store(p, bh * 64 + c, vh, l31, hh, X0, X1);
            rb_step(X0, X1, gA, hA);
            rb_load(p, bh * 64 + (c + 3 < 64 ? c + 3 : 63), vh, lane, gA, hA);
            rb_store(p, bh * 64 + c + 1, vh, l31, hh, X0, X1);
            rb_step(X0, X1, gB, hB);
            rb_load(p, bh * 64 + (c + 4 < 64 ? c + 4 : 63), vh, lane, gB, hB);
            rb_store(p, bh * 64 + c + 2, vh, l31, hh, X0, X1);
            rb_step(X0, X1, gC, hC);
        }
        rb_store(p, bh * 64 + 63, vh, l31, hh, X0, X1);
    }
}

DEVI void phaseRB(const Params& p, char* smem) {
    const bool split = gridDim.x >= 128;
    if (split && blockIdx.x < 64) { phaseRB_core(p, smem); return; }
    const int nw = split ? (int)gridDim.x - 64 : (int)gridDim.x, wi = split ? (int)blockIdx.x - 64 : (int)blockIdx.x;
    for (int u = wi; u < 256; u += nw) p3_unit(p, smem, u);
    if (!split) { __syncthreads(); phaseRB_core(p, smem); }
}

DEVI void phaseRC(const Params& p, char* smem) {
    const int tid = threadIdx.x, lane = tid & 63, wave = tid >> 6, l31 = lane & 31, hh = lane >> 5;
    const bf16_t* z = (const bf16_t*)(p.ws + WS_Z); const bf16_t* GVb = (const bf16_t*)(p.ws + WS_GV); const float* RKSb = (const float*)(p.ws + WS_RKS);
    bf16_t* mix = (bf16_t*)(p.ws + WS_MIX);
    for (int it0 = blockIdx.x; it0 < 512 + N_SPEC; it0 += gridDim.x) {
        if (it0 < N_SPEC) { spec_unit(p, smem, it0); continue; }
        const int it = it0 - N_SPEC;
        const int unit = it * 4 + (wave >> 1), tb = wave & 1;
        const int bh = unit >> 6, c = unit & 63, b = bh >> 4, h = bh & 15;
        const int tq = tb * 32 + l31, tok = b * SEQ + c * 64 + tq;
        const float* q2 = (const float*)(p.ws + WS_Q2) + (size_t)unit * 4096 + lane;
        f32x16 a0, a1;
#pragma unroll
        for (int i = 0; i < 16; ++i) { a0[i] = q2[(0 * 2 + tb) * 1024 + i * 64]; a1[i] = q2[(1 * 2 + tb) * 1024 + i * 64]; }
        const bf16_t* s0 = (const bf16_t*)(p.ws + WS_S0) + (size_t)unit * 4096;
        const bf16_t* q1 = (const bf16_t*)(p.ws + WS_Q1) + (size_t)unit * 4096 + tq * 64;
#pragma unroll
        for (int s4 = 0; s4 < 4; ++s4) {
            const bf16x8 fa0 = *(const bf16x8*)(s0 + (l31) * 64 + 16 * s4 + 8 * hh);
            const bf16x8 fa1 = *(const bf16x8*)(s0 + (32 + l31) * 64 + 16 * s4 + 8 * hh);
            const bf16x8 fb = *(const bf16x8*)(q1 + 16 * s4 + 8 * hh);
            a0 = __builtin_amdgcn_mfma_f32_32x32x16_bf16(fa0, fb, a0, 0, 0, 0);
            a1 = __builtin_amdgcn_mfma_f32_32x32x16_bf16(fa1, fb, a1, 0, 0, 0);
        }
        float sm = 0.f;
#pragma unroll
        for (int i = 0; i < 16; ++i) sm += a0[i] + a1[i];
        sm = xor32_sum(sm);
        const float mean = sm * (1.f / 64.f);
        float sq = 0.f;
#pragma unroll
        for (int i = 0; i < 16; ++i) { const float d0 = a0[i] - mean, d1 = a1[i] - mean; sq += d0 * d0 + d1 * d1; }
        sq = xor32_sum(sq);
        const float rstd = rsqrtf(sq * (1.f / 64.f) + 64e-5f);
        const float rk = RKSb[tok * 16 + h];
#pragma unroll
        for (int vb = 0; vb < 2; ++vb)
#pragma unroll
            for (int q = 0; q < 4; ++q) {
                const int ch = h * 64 + vb * 32 + 8 * q + 4 * hh;
                const int hc = ch;
                const uint2 zc2 = *(const uint2*)(z + (size_t)tok * INC + ZC_RW + 2048 + hc);
                uint2 zp2 = make_uint2(0u, 0u);
                if (tok & (SEQ - 1)) zp2 = *(const uint2*)(z + (size_t)(tok - 1) * INC + ZC_RW + 2048 + hc);
                const float4 muv = *(const float4*)(p.mu + 2048 + hc);
                const uint2 g2 = *(const uint2*)(GVb + (size_t)tok * RW + hc);
                float4 vv, gv;
                vv.x = bflo(zc2.x) + (bflo(zp2.x) - bflo(zc2.x)) * muv.x; vv.y = bfhi(zc2.x) + (bfhi(zp2.x) - bfhi(zc2.x)) * muv.y;
                vv.z = bflo(zc2.y) + (bflo(zp2.y) - bflo(zc2.y)) * muv.z; vv.w = bfhi(zc2.y) + (bfhi(zp2.y) - bfhi(zc2.y)) * muv.w;
                gv.x = bflo(g2.x); gv.y = bfhi(g2.x); gv.z = bflo(g2.y); gv.w = bfhi(g2.y);
                const float4 lnw = *(const float4*)(p.ln_w + ch), lnb = *(const float4*)(p.ln_b + ch);
                float y[4];
#pragma unroll
                for (int e = 0; e < 4; ++e) y[e] = ((vb ? a1[4 * q + e] : a0[4 * q + e]) - mean) * rstd;
                uint2 o;
                o.x = cvtpk((y[0] * lnw.x + lnb.x + rk * vv.x) * gv.x, (y[1] * lnw.y + lnb.y + rk * vv.y) * gv.y);
                o.y = cvtpk((y[2] * lnw.z + lnb.z + rk * vv.z) * gv.z, (y[3] * lnw.w + lnb.w + rk * vv.w) * gv.w);
                *(uint2*)(mix + (size_t)tok * DM + 1024 + ch) = o;
            }
    }
}

DEVI void phase6(const Params& p, char* smem) {
    pg8::Gemm g{(const pg8::bf16_t*)(p.ws + WS_MIX), (const pg8::bf16_t*)(p.ws + WS_WTO), NTOK, DM, DM};
    pg8::StaticOrder S; S.init(NTOK, DM, (int)gridDim.x, (int)blockIdx.x);
    pg8::EpiX1 E{(float*)(p.ws + WS_X1), p.x, (const float*)(p.ws + WS_MODF) + 2 * DM, DM, 12288, SEQ};
    pg8::gemm_phase<pg8::EpiX1, pg8::StaticOrder, true, true>((PG8_LAS unsigned char*)smem, g, S, E);
}

DEVI void phase7(const Params& p, char* smem) {
    float* part = (float*)smem;
    float* ssq = part + 8 * 32 * 80;
    float* rstd_s = ssq + 8 * 128;
    float* lg_ = rstd_s + 32;
    const float* x1 = (const float*)(p.ws + WS_X1);
    const uint4* wrf = (const uint4*)(p.ws + WS_WRF);
    const float* cb = (const float*)(p.ws + WS_CB);
    const float* as2 = (const float*)(p.ws + WS_AS2);
    bf16_t* h = (bf16_t*)(p.ws + WS_H);
    int* cnt = (int*)(p.ws + WS_CTL + CNT_OFF);
    int* list = (int*)(p.ws + WS_LIST); float* lw = (float*)(p.ws + WS_LWT);
    const int tid = threadIdx.x, lane = tid & 63, wave = tid >> 6, li = lane & 15, lg = lane >> 4;
    for (int u = blockIdx.x; u < NTOK / 32; u += gridDim.x) {
        const int tok0 = u * 32, b = tok0 >> 12;
        __syncthreads();
        f32x4 acc[2][5];
#pragma unroll
        for (int tg = 0; tg < 2; ++tg)
#pragma unroll
            for (int nf = 0; nf < 5; ++nf) acc[tg][nf] = f32x4{0.f, 0.f, 0.f, 0.f};
        float sq[2] = {0.f, 0.f};
        const float* xr = x1 + (size_t)(tok0 + li) * DM + wave * 256 + 8 * lg;
#pragma unroll 2
        for (int s4 = 0; s4 < 8; ++s4) {
            bf16x8 ah[2], al[2];
#pragma unroll
            for (int tg = 0; tg < 2; ++tg) {
                const float4 xa = *(const float4*)(xr + (size_t)tg * 16 * DM + s4 * 32), xb = *(const float4*)(xr + (size_t)tg * 16 * DM + s4 * 32 + 4);
                sq[tg] += xa.x * xa.x + xa.y * xa.y + xa.z * xa.z + xa.w * xa.w + xb.x * xb.x + xb.y * xb.y + xb.z * xb.z + xb.w * xb.w;
                uint4 hi, lo;
                hi.x = cvtpk(xa.x, xa.y); hi.y = cvtpk(xa.z, xa.w); hi.z = cvtpk(xb.x, xb.y); hi.w = cvtpk(xb.z, xb.w);
                lo.x = cvtpk(xa.x - bflo(hi.x), xa.y - bfhi(hi.x)); lo.y = cvtpk(xa.z - bflo(hi.y), xa.w - bfhi(hi.y));
                lo.z = cvtpk(xb.x - bflo(hi.z), xb.y - bfhi(hi.z)); lo.w = cvtpk(xb.z - bflo(hi.w), xb.w - bfhi(hi.w));
                ah[tg] = __builtin_bit_cast(bf16x8, hi); al[tg] = __builtin_bit_cast(bf16x8, lo);
            }
            const uint4* wf = wrf + ((size_t)(b * 64 + wave * 8 + s4) * 5) * 128 + lane;
#pragma unroll
            for (int nf = 0; nf < 5; ++nf) {
                const bf16x8 bh = __builtin_bit_cast(bf16x8, wf[nf * 128]), bl = __builtin_bit_cast(bf16x8, wf[nf * 128 + 64]);
#pragma unroll
                for (int tg = 0; tg < 2; ++tg) {
                    acc[tg][nf] = __builtin_amdgcn_mfma_f32_16x16x32_bf16(al[tg], bh, acc[tg][nf], 0, 0, 0);
                    acc[tg][nf] = __builtin_amdgcn_mfma_f32_16x16x32_bf16(ah[tg], bl, acc[tg][nf], 0, 0, 0);
                    acc[tg][nf] = __builtin_amdgcn_mfma_f32_16x16x32_bf16(ah[tg], bh, acc[tg][nf], 0, 0, 0);
                }
            }
        }
#pragma unroll
        for (int tg = 0; tg < 2; ++tg) {
#pragma unroll
            for (int nf = 0; nf < 5; ++nf)
#pragma unroll
                for (int r = 0; r < 4; ++r) part[(wave * 32 + 16 * tg + 4 * lg + r) * 80 + nf * 16 + li] = acc[tg][nf][r];
            ssq[(wave * 4 + lg) * 32 + 16 * tg + li] = sq[tg];
        }
        __syncthreads();
        if (tid < 32) {
            float t = 0.f;
#pragma unroll
            for (int q = 0; q < 32; ++q) t += ssq[q * 32 + tid];
            rstd_s[tid] = rsqrtf(t * (1.f / DM) + 1e-6f);
        }
        __syncthreads();
        for (int idx = tid; idx < 32 * 80; idx += 512) {
            const int tk = idx / 80, j = idx % 80;
            float t = 0.f;
#pragma unroll
            for (int w = 0; w < 8; ++w) t += part[(w * 32 + tk) * 80 + j];
            lg_[idx] = rstd_s[tk] * t + cb[b * 80 + j];
        }
        __syncthreads();
        if (tid < 32) {
            const int tok = tok0 + tid;
            const float* L = lg_ + tid * 80;
            int gi = 0; float gm = L[64];
            for (int j = 1; j < 8; ++j) if (L[64 + j] > gm) { gm = L[64 + j]; gi = j; }
            float den = 0.f;
            for (int j = 0; j < 8; ++j) den += expf(L[64 + j] - gm);
            const float ggate = 1.f / den;
            const float* E = L + gi * 8;
            int i1 = 0; float m1 = E[0];
            for (int j = 1; j < 8; ++j) if (E[j] > m1) { m1 = E[j]; i1 = j; }
            int i2 = -1; float m2 = -3.0e38f;
            for (int j = 0; j < 8; ++j) if (j != i1 && E[j] > m2) { m2 = E[j]; i2 = j; }
            const float e2 = expf(m2 - m1);
            const float p1 = 1.f / (1.f + e2), p2 = e2 / (1.f + e2);
            const int ex1 = gi * 8 + i1, ex2 = gi * 8 + i2;
            const int pos1 = atomicAdd(&cnt[ex1 * CNT_ST], 1); list[ex1 * LCAP + pos1] = tok * 2; lw[ex1 * LCAP + pos1] = ggate * p1;
            const int pos2 = atomicAdd(&cnt[ex2 * CNT_ST], 1); list[ex2 * LCAP + pos2] = tok * 2 + 1; lw[ex2 * LCAP + pos2] = ggate * p2;
        }
#pragma unroll 2
        for (int tt = 0; tt < 4; ++tt) {
            const int tk = wave * 4 + tt, tok = tok0 + tk;
            const float rs = rstd_s[tk];
            const float* xrow = x1 + (size_t)tok * DM;
#pragma unroll
            for (int i = 0; i < 8; ++i) {
                const int k = i * 256 + lane * 4;
                const float4 xv = *(const float4*)(xrow + k);
                const float4 a = *(const float4*)(as2 + b * DM + k), sft = *(const float4*)(as2 + 2 * DM + b * DM + k);
                uint2 o; o.x = cvtpk(xv.x * rs * a.x + sft.x, xv.y * rs * a.y + sft.y); o.y = cvtpk(xv.z * rs * a.z + sft.z, xv.w * rs * a.w + sft.w);
                *(uint2*)(h + (size_t)tok * DM + k) = o;
            }
        }
    }
}

struct MoeTab { int cnt[64]; int sb[65]; int ubx[9]; int np[8]; };
DEVI void moe_tables(const Params& p, MoeTab* tb, int slabs) {
    const int* cnt = (const int*)(p.ws + WS_CTL + CNT_OFF);
    const int tid = threadIdx.x, x = blockIdx.x & 7;
    __syncthreads();
    if (tid < 64) tb->cnt[tid] = cnt[tid * CNT_ST];
    __syncthreads();
    if (tid == 0) {
        int sb = 0;
        for (int e = 0; e < 64; ++e) { tb->sb[e] = sb; sb += tb->cnt[e]; }
        tb->sb[64] = sb;
        int ub = 0;
        for (int i = 0; i < 8; ++i) { const int np = (tb->cnt[x + 8 * i] + 255) >> 8; tb->np[i] = np; tb->ubx[i] = ub; ub += np * slabs; }
        tb->ubx[8] = ub;
    }
    __syncthreads();
}
struct MoeUnit { int e, s, ce, sbase, rbeg, rend; };
DEVI MoeUnit moe_unit(const MoeTab* tb, int u) {
    int i = 0;
    while (tb->ubx[i + 1] <= u) ++i;
    const int rem = u - tb->ubx[i], np = tb->np[i], ps = rem % np;
    MoeUnit m; m.e = (blockIdx.x & 7) + 8 * i; m.s = rem / np; m.ce = tb->cnt[m.e]; m.sbase = tb->sb[m.e];
    const int rp = (((m.ce + np - 1) / np) + 15) & ~15;
    m.rbeg = ps * rp; m.rend = m.rbeg + rp < m.ce ? m.rbeg + rp : m.ce;
    m.e = __builtin_amdgcn_readfirstlane(m.e); m.s = __builtin_amdgcn_readfirstlane(m.s); m.ce = __builtin_amdgcn_readfirstlane(m.ce);
    m.sbase = __builtin_amdgcn_readfirstlane(m.sbase); m.rbeg = __builtin_amdgcn_readfirstlane(m.rbeg); m.rend = __builtin_amdgcn_readfirstlane(m.rend);
    return m;
}

DEVI void phase8(const Params& p, char* smem) {
    MoeTab* tb = (MoeTab*)(smem + 32768);
    const bf16_t* h = (const bf16_t*)(p.ws + WS_H);
    bf16_t* hid = (bf16_t*)(p.ws + WS_HID);
    const int* list = (const int*)(p.ws + WS_LIST);
    moe_tables(p, tb, 4);
    const int total = __builtin_amdgcn_readfirstlane(tb->ubx[8]), nslot = ((int)gridDim.x - (int)(blockIdx.x & 7) + 7) >> 3;
    for (int u = blockIdx.x >> 3; u < total; u += nslot) {
        int tid = threadIdx.x;
        asm volatile("" : "+v"(tid));
        const int lane = tid & 63, wave = tid >> 6, li = lane & 15, lg = lane >> 4;
        const MoeUnit mu = moe_unit(tb, u);
        const int e = mu.e, s = mu.s;
        const int fcol = s * 128 + wave * 16;
        const gcp_t wb0 = uniform_ptr(p.w1 + (size_t)e * DM * FF), wb1 = uniform_ptr(p.w3 + (size_t)e * DM * FF);
        const unsigned boff = (unsigned)(((8 * lg) * FF + fcol + li) * 4);
        int r0 = mu.rbeg + (tid >> 2), r1 = r0 + 128; r0 = r0 < mu.rend ? r0 : mu.rend - 1; r1 = r1 < mu.rend ? r1 : mu.rend - 1;
        const unsigned aoff0 = (unsigned)(((list[e * LCAP + r0] >> 1) * DM + (tid & 3) * 8) * 2), aoff1 = (unsigned)(((list[e * LCAP + r1] >> 1) * DM + (tid & 3) * 8) * 2);
        __syncthreads();
        gemm_tile_s<2, DM / 32, FF, 0>(smem, wb0, wb1, boff, uniform_ptr(h), aoff0, aoff1, [&](f32x4 (&acc)[16][2]) {
            int t2 = threadIdx.x;
            asm volatile("" : "+v"(t2));
            const int lio = t2 & 15, cof = ((t2 >> 6) * 16 + 4 * ((t2 >> 4) & 3));
#pragma unroll
            for (int m = 0; m < 16; ++m) {
                const int r = mu.rbeg + 16 * m + lio;
                if (r < mu.rend) {
                    float hv[4];
#pragma unroll
                    for (int q = 0; q < 4; ++q) { const float a = acc[m][0][q]; hv[q] = a / (1.f + __expf(-a)) * acc[m][1][q]; }
                    uint2 o; o.x = cvtpk(hv[0], hv[1]); o.y = cvtpk(hv[2], hv[3]);
                    *(uint2*)(hid + (size_t)(mu.sbase + r) * FF + s * 128 + cof) = o;
                }
            }
        });
    }
}

DEVI void phase9(const Params& p, char* smem) {
    MoeTab* tb = (MoeTab*)(smem + 32768);
    const bf16_t* hid = (const bf16_t*)(p.ws + WS_HID);
    bf16_t* yb = (bf16_t*)(p.ws + WS_YB);
    const int* list = (const int*)(p.ws + WS_LIST); const float* lw = (const float*)(p.ws + WS_LWT);
    moe_tables(p, tb, 8);
    const int total = __builtin_amdgcn_readfirstlane(tb->ubx[8]), nslot = ((int)gridDim.x - (int)(blockIdx.x & 7) + 7) >> 3;
    for (int u = blockIdx.x >> 3; u < total; u += nslot) {
        int tid = threadIdx.x;
        asm volatile("" : "+v"(tid));
        const int lane = tid & 63, wave = tid >> 6, li = lane & 15, lg = lane >> 4;
        const MoeUnit mu = moe_unit(tb, u);
        const int e = mu.e, s = mu.s;
        const int col0 = s * 256 + wave * 32;
        const gcp_t wb0 = uniform_ptr(p.w2 + (size_t)e * FF * DM), wb1 = wb0 + 64;
        const unsigned boff = (unsigned)(((8 * lg) * DM + col0 + li) * 4);
        int r0 = mu.rbeg + (tid >> 2), r1 = r0 + 128; r0 = r0 < mu.rend ? r0 : mu.rend - 1; r1 = r1 < mu.rend ? r1 : mu.rend - 1;
        const unsigned aoff0 = (unsigned)(((mu.sbase + r0) * FF + (tid & 3) * 8) * 2), aoff1 = (unsigned)(((mu.sbase + r1) * FF + (tid & 3) * 8) * 2);
        __syncthreads();
        gemm_tile_s<2, FF / 32, DM, 64>(smem, wb0, wb1, boff, uniform_ptr(hid), aoff0, aoff1, [&](f32x4 (&acc)[16][2]) {
            int t2 = threadIdx.x;
            asm volatile("" : "+v"(t2));
            const int lio = t2 & 15, cof = ((t2 >> 6) * 32 + 4 * ((t2 >> 4) & 3));
#pragma unroll
            for (int m = 0; m < 16; ++m) {
                const int r = mu.rbeg + 16 * m + lio;
                if (r < mu.rend) {
                    const int a = list[e * LCAP + r]; const float wgt = lw[e * LCAP + r];
#pragma unroll
                    for (int nf = 0; nf < 2; ++nf) {
                        uint2 o; o.x = cvtpk(acc[m][nf][0] * wgt, acc[m][nf][1] * wgt); o.y = cvtpk(acc[m][nf][2] * wgt, acc[m][nf][3] * wgt);
                        *(uint2*)(yb + (size_t)a * DM + s * 256 + cof + nf * 16) = o;
                    }
                }
            }
        });
    }
}

DEVI void phase10(const Params& p, char* smem) {
    const float* modf = (const float*)(p.ws + WS_MODF);
    const float* x1 = (const float*)(p.ws + WS_X1);
    const bf16_t* yb = (const bf16_t*)(p.ws + WS_YB);
    const int tid = threadIdx.x, lane = tid & 63, wave = tid >> 6;
    for (int u = blockIdx.x; u < NTOK / 8; u += gridDim.x) {
        const int tok = u * 8 + wave, b = tok >> 12;
        float4 v[8]; float ss = 0.f;
#pragma unroll
        for (int i = 0; i < 8; ++i) {
            const int k = i * 256 + lane * 4;
            const float4 xv = *(const float4*)(x1 + (size_t)tok * DM + k);
            const float4 gt = *(const float4*)(modf + b * 12288 + 5 * DM + k);
            const uint2 ya = *(const uint2*)(yb + (size_t)(tok * 2) * DM + k), yc = *(const uint2*)(yb + (size_t)(tok * 2 + 1) * DM + k);
            v[i].x = xv.x + gt.x * (bflo(ya.x) + bflo(yc.x)); v[i].y = xv.y + gt.y * (bfhi(ya.x) + bfhi(yc.x));
            v[i].z = xv.z + gt.z * (bflo(ya.y) + bflo(yc.y)); v[i].w = xv.w + gt.w * (bfhi(ya.y) + bfhi(yc.y));
            ss += v[i].x * v[i].x + v[i].y * v[i].y + v[i].z * v[i].z + v[i].w * v[i].w;
        }
        ss = wave_sum(ss);
        const float rstd = rsqrtf(ss * (1.f / DM) + 1e-6f);
#pragma unroll
        for (int i = 0; i < 8; ++i) {
            const int k = i * 256 + lane * 4;
            const float4 g = *(const float4*)(p.final_g + k);
            float4 o; o.x = v[i].x * rstd * g.x; o.y = v[i].y * rstd * g.y; o.z = v[i].z * rstd * g.z; o.w = v[i].w * rstd * g.w;
            *(float4*)(p.out + (size_t)tok * DM + k) = o;
        }
    }
}

constexpr size_t WS_BAR = 4096;
constexpr int N_PHASES = 12;
#ifndef MK_N_LAUNCHES
#define MK_N_LAUNCHES 1
#endif

__global__ void __launch_bounds__(512) mega_kernel(Params p, int lo, int hi) {
    extern __shared__ __attribute__((aligned(16))) char smem[];
    volatile LAS unsigned* xb_words = (volatile LAS unsigned*)(smem + LDS_BYTES - 16);
    if (threadIdx.x == 0) { xb_words[0] = 0u; xb_words[1] = 0u; xb_words[2] = 0u; xb_words[3] = 0u; }
    __syncthreads();
    XcdBarrier bar;
    if (hi - lo > 1) bar = xcd_barrier_post((unsigned*)(p.ws + WS_BAR), xb_words);
#define IN(k) (lo <= (k) && (k) < hi)
    unsigned long long ts_a = 0ull, ts_b = 0ull;
#define STAMP(k) do { if (PROBE_TS >= 0 && blockIdx.x == 0) { if ((k) == PROBE_TS) ts_a = __builtin_amdgcn_s_memrealtime(); if ((k) == PROBE_TS + 1) ts_b = __builtin_amdgcn_s_memrealtime(); } } while (0)
#define SEAM(k) do { if (IN(k) && IN((k) + 1)) { xcd_barrier(bar); STAMP((k) + 1); } } while (0)
    STAMP(0);
#ifndef PROBE_MASK
#define PROBE_MASK 0
#endif
#define REP(k) (((PROBE_MASK >> (k)) & 1) ? 2 : 1)
    if (IN(0)) for (int rp = 0; rp < REP(0); ++rp) phase0(p, smem);
    SEAM(0);
    if (IN(1)) for (int rp = 0; rp < REP(1); ++rp) phase1(p, smem);
    SEAM(1);
    if (IN(2)) for (int rp = 0; rp < REP(2); ++rp) phase2(p, smem);
    SEAM(2);
    if (IN(3)) for (int rp = 0; rp < REP(3); ++rp) phase3(p, smem);
    SEAM(3);
    if (IN(4)) for (int rp = 0; rp < REP(4); ++rp) phaseRA(p, smem);
    SEAM(4);
    if (IN(5)) for (int rp = 0; rp < REP(5); ++rp) phaseRB(p, smem);
    SEAM(5);
    if (IN(6)) for (int rp = 0; rp < REP(6); ++rp) phaseRC(p, smem);
    SEAM(6);
    if (IN(7)) for (int rp = 0; rp < REP(7); ++rp) phase6(p, smem);
    SEAM(7);
    if (IN(8)) phase7(p, smem);
    SEAM(8);
    if (IN(9)) for (int rp = 0; rp < REP(9); ++rp) phase8(p, smem);
    SEAM(9);
    if (IN(10)) for (int rp = 0; rp < REP(10); ++rp) phase9(p, smem);
    SEAM(10);
    if (IN(11)) for (int rp = 0; rp < REP(11); ++rp) phase10(p, smem);
    STAMP(12);
    if (PROBE_TS >= 0 && blockIdx.x == 0) { const unsigned long long t0 = __builtin_amdgcn_s_memrealtime(), dt = 2ull * (ts_b - ts_a); while (__builtin_amdgcn_s_memrealtime() - t0 < dt) __builtin_amdgcn_s_sleep(8); }
#undef IN
#undef SEAM
}

extern "C" void kernel_launch(void* const* d_in, const int* in_sizes, int n_in, void* d_out, int out_size, void* d_ws, size_t ws_size, hipStream_t stream) {
    static int grid = 0;
    if (!grid) {
        int dev = 0, cus = 0, per_cu = 0;
        (void)hipGetDevice(&dev);
        (void)hipDeviceGetAttribute(&cus, hipDeviceAttributeMultiprocessorCount, dev);
        if (hipFuncSetAttribute((const void*)mega_kernel, hipFuncAttributeMaxDynamicSharedMemorySize, LDS_BYTES) != hipSuccess) { grid = -1; return; }
        if (hipOccupancyMaxActiveBlocksPerMultiprocessor(&per_cu, (const void*)mega_kernel, 512, LDS_BYTES) != hipSuccess || per_cu < 1) { grid = -1; return; }
        grid = cus;
        if (grid > 256) grid = 256;
    }
    if (grid < 0) return;
    Params p{};
    const float* const* in = (const float* const*)d_in;
    p.x = in[0]; p.c = in[1]; p.w_ada = in[2]; p.b_ada = in[3]; p.norm1_g = in[4]; p.w_in = in[5]; p.mu = in[6]; p.sinks = in[7]; p.w0 = in[8]; p.wd_up = in[9];
    p.a0 = in[10]; p.wa_up = in[11]; p.wg_up = in[12]; p.k_k = in[13]; p.k_a = in[14]; p.r_k = in[15]; p.ln_w = in[16]; p.ln_b = in[17]; p.w_o = in[18]; p.norm2_g = in[19];
    p.w_rg = in[20]; p.b_rg = in[21]; p.w_re = in[22]; p.b_re = in[23]; p.w1 = in[24]; p.w3 = in[25]; p.w2 = in[26]; p.final_g = in[27];
    p.out = (float*)d_out; p.ws = (unsigned char*)d_ws;
    (void)hipMemsetAsync((char*)d_ws + WS_CTL, 0, CTL_BYTES, stream);
#if MK_N_LAUNCHES == 1
    hipLaunchKernelGGL(mega_kernel, dim3(grid), dim3(512), LDS_BYTES, stream, p, 0, N_PHASES);
#else
    for (int k = 0; k < N_PHASES; ++k) hipLaunchKernelGGL(mega_kernel, dim3(grid), dim3(512), LDS_BYTES, stream, p, k, k + 1);
#endif
}
```

```cpp
#ifndef PROBE_TS
#define PROBE_TS -1
#endif
#include <hip/hip_runtime.h>
#include <stdint.h>

#define DEVI __device__ __forceinline__
typedef unsigned short bf16_t;
typedef short bf16x8 __attribute__((ext_vector_type(8)));
typedef float f32x4 __attribute__((ext_vector_type(4)));
typedef float f32x16 __attribute__((ext_vector_type(16)));
typedef float f32x2_t __attribute__((ext_vector_type(2)));
typedef __bf16 bf16x2_t __attribute__((ext_vector_type(2)));

constexpr int NTOK = 8192, DM = 2048, SEQ = 4096, INC = 4640, RW = 1024;
constexpr int ZC_K = 1024, ZC_V = 1152, ZC_RW = 1280;
constexpr int NEXP = 64, FF = 512, LCAP = 8192;
constexpr int NKS = 16;

constexpr size_t MiB = 1u << 20;
constexpr size_t WS_CTL = 0, CTL_BYTES = 98304;
constexpr int CNT_OFF = 32768, CNT_ST = 256;
constexpr size_t WS_PART = 1 * MiB;
constexpr size_t WS_MODF = 3 * MiB;
constexpr size_t WS_ROPE = 4 * MiB;
constexpr size_t WS_WRF = 5 * MiB;
constexpr size_t WS_CB = 7 * MiB;
constexpr size_t WS_AS2 = 7 * MiB + 4096;
constexpr size_t WS_H = 8 * MiB;
constexpr size_t WS_Z = 40 * MiB;
constexpr size_t WS_MIX = 116 * MiB;
constexpr size_t WS_X1 = 148 * MiB;
constexpr size_t WS_R = 212 * MiB, WS_DEC = 244 * MiB, WS_K2 = 276 * MiB, WS_V = 308 * MiB, WS_AA = 340 * MiB, WS_BB = 372 * MiB, WS_G = 404 * MiB, WS_Y = 436 * MiB;
constexpr size_t WS_LW = 212 * MiB;
constexpr size_t WS_AV = 244 * MiB;
constexpr size_t WS_GV = 260 * MiB;
constexpr size_t WS_RKS = 468 * MiB;
constexpr size_t WS_LIST = 469 * MiB;
constexpr size_t WS_LWT = 471 * MiB;
constexpr size_t WS_HID = 473 * MiB;
constexpr size_t WS_YB = 490 * MiB;

constexpr size_t WS_WTI = 672 * MiB;
constexpr size_t WS_WTO = 692 * MiB;
constexpr size_t WS_GB = 556 * MiB;
constexpr size_t WS_HB = 572 * MiB;
constexpr size_t WS_Q2 = 604 * MiB;
constexpr size_t WS_Q1 = 636 * MiB;
constexpr size_t WS_S0 = 652 * MiB;

constexpr int LDS_BYTES = 147456;

struct Params {
    const float *x, *c, *w_ada, *b_ada, *norm1_g, *w_in, *mu, *sinks, *w0, *wd_up, *a0, *wa_up, *wg_up, *k_k, *k_a, *r_k, *ln_w, *ln_b, *w_o, *norm2_g,
        *w_rg, *b_rg, *w_re, *b_re, *w1, *w3, *w2, *final_g;
    float* out;
    unsigned char* ws;
};

DEVI unsigned cvtpk_v(float lo, float hi) { unsigned r; asm volatile("v_cvt_pk_bf16_f32 %0, %1, %2" : "=v"(r) : "v"(lo), "v"(hi)); return r; }
DEVI unsigned cvtpk(float lo, float hi) { f32x2_t v = {lo, hi}; bf16x2_t b = __builtin_convertvector(v, bf16x2_t); return __builtin_bit_cast(unsigned, b); }
DEVI float bf2f(unsigned h) { return __builtin_bit_cast(float, h << 16); }
DEVI float bflo(unsigned u) { return __builtin_bit_cast(float, u << 16); }
DEVI float bfhi(unsigned u) { return __builtin_bit_cast(float, u & 0xffff0000u); }
DEVI float wave_sum(float v) {
#pragma unroll
    for (int o = 32; o > 0; o >>= 1) v += __shfl_xor(v, o, 64);
    return v;
}
DEVI float sigmoidf_(float x) { return 1.f / (1.f + __expf(-x)); }

#define XB_TMO      128
#define XB_XCNT(j)  (256  + 64 * (j))
#define XB_XSUB(j)  (1280 + 64 * (j))
#define XB_XGEN(j)  (2304 + 64 * (j))
#define XB_TOP      3328
#define XB_TOPGEN   3392
#define XCD_BAR_WORDS 3456
#define XB_SPIN_CAP (1u << 18)
#define LAS __attribute__((address_space(3)))

__device__ __forceinline__ unsigned xb_ld(unsigned* p)              { return __hip_atomic_load(p, __ATOMIC_RELAXED, __HIP_MEMORY_SCOPE_AGENT); }
__device__ __forceinline__ unsigned xb_add(unsigned* p, unsigned v) { return __hip_atomic_fetch_add(p, v, __ATOMIC_RELAXED, __HIP_MEMORY_SCOPE_AGENT); }
__device__ __forceinline__ unsigned xb_xcc_id() { return (unsigned)__builtin_amdgcn_s_getreg((3 << 11) | 20) & 0xFu; }
#define XB_SPIN(cond, bar) do { unsigned _sp = 0; while (cond) { __builtin_amdgcn_s_sleep(1); \
    if ((++_sp & 255u) == 0u) { if (xb_ld(&(bar)[XB_TMO])) break; if (_sp > XB_SPIN_CAP) { atomicAdd(&(bar)[XB_TMO], 1u); break; } } } } while (0)

struct XcdBarrier {
    unsigned* bar; unsigned x;
    volatile LAS unsigned* st;
};

__device__ __forceinline__ XcdBarrier xcd_barrier_post(unsigned* bar, volatile LAS unsigned* st) {
    XcdBarrier b; b.bar = bar; b.x = xb_xcc_id(); b.st = st;
    if (threadIdx.x == 0) (void)xb_add(&bar[XB_XCNT(b.x)], 1u);
    return b;
}
__device__ __forceinline__ void xcd_barrier_complete(unsigned* bar, unsigned x, unsigned& nloc, unsigned& nx) {
    const unsigned G = gridDim.x * gridDim.y * gridDim.z;
    unsigned sum, cnt, mine, sp = 0u;
    for (;;) {
        sum = 0u; cnt = 0u; mine = 0u;
#pragma unroll
        for (unsigned j = 0; j < 16; ++j) { const unsigned c = xb_ld(&bar[XB_XCNT(j)]); sum += c; cnt += (c > 0u) ? 1u : 0u; mine = (j == x) ? c : mine; }
        if (sum == G) break;
        __builtin_amdgcn_s_sleep(1);
        if ((++sp & 255u) == 0u) { if (xb_ld(&bar[XB_TMO])) break; if (sp > XB_SPIN_CAP) { atomicAdd(&bar[XB_TMO], 1u); break; } }
    }
    nloc = mine > 0u ? mine : 1u; nx = cnt > 0u ? cnt : 1u;
}

__device__ __forceinline__ void xcd_barrier(const XcdBarrier& b) {
    asm volatile("s_waitcnt vmcnt(0)" ::: "memory");
    __syncthreads();
    if (threadIdx.x == 0) {
        unsigned* bar = b.bar;
        __builtin_amdgcn_s_waitcnt(0);
        unsigned nloc = b.st[0], nx = b.st[1];
        if (nloc == 0u) { xcd_barrier_complete(bar, b.x, nloc, nx); b.st[0] = nloc; b.st[1] = nx; }
        const unsigned old = xb_add(&bar[XB_XSUB(b.x)], 1u);
        const unsigned gen = old / nloc;
        if (old + 1u == (gen + 1u) * nloc) {
            __builtin_amdgcn_fence(__ATOMIC_RELEASE, "agent");
            asm volatile("s_waitcnt vmcnt(0)" ::: "memory");
            const unsigned og = xb_add(&bar[XB_TOP], 1u);
            const unsigned tg = og / nx;
            if (og + 1u == (tg + 1u) * nx) xb_add(&bar[XB_TOPGEN], 1u);
            else XB_SPIN(xb_ld(&bar[XB_TOPGEN]) == tg, bar);
            __builtin_amdgcn_fence(__ATOMIC_ACQUIRE, "agent");
            xb_add(&bar[XB_XGEN(b.x)], 1u);
            asm volatile("s_waitcnt vmcnt(0)" ::: "memory");
        } else {
            XB_SPIN(xb_ld(&bar[XB_XGEN(b.x)]) == gen, bar);
            __builtin_amdgcn_fence(__ATOMIC_ACQUIRE, "agent");
            asm volatile("s_waitcnt vmcnt(0)" ::: "memory");
        }
    }
    __syncthreads();
}

template <int PF, int R, class ALoad, class Epi>
DEVI void gemm_tile_f(char* smem, int nk, long ldb, const float* bp0, const float* bp1, ALoad&& aload, Epi&& epi) {
    static_assert(R > PF && (R % 2) == 0, "ring");
    const int tid = threadIdx.x, lane = tid & 63, li = lane & 15, lg = lane >> 4;
    const int sr = tid >> 2, scn = tid & 3;
    const unsigned aw0 = sr * 64 + ((scn ^ ((0 - (sr >> 2)) & 3)) << 4), aw1 = aw0 + 128 * 64;
    const unsigned ar = li * 64 + ((lg ^ ((0 - (li >> 2)) & 3)) << 4);
    float breg[R][2][8];
    f32x4 acc[16][2];
#pragma unroll
    for (int m = 0; m < 16; ++m) { acc[m][0] = f32x4{0.f, 0.f, 0.f, 0.f}; acc[m][1] = f32x4{0.f, 0.f, 0.f, 0.f}; }
    uint4 areg0 = aload(0, 0), areg1 = aload(1, 0);
#pragma unroll
    for (int s = 0; s < PF; ++s) {
        if (s < nk) {
#pragma unroll
            for (int j = 0; j < 8; ++j) { breg[s][0][j] = bp0[(long)(s * 32 + j) * ldb]; breg[s][1][j] = bp1[(long)(s * 32 + j) * ldb]; }
        }
    }
    *(uint4*)(smem + aw0) = areg0; *(uint4*)(smem + aw1) = areg1;
    __syncthreads();
    for (int kt0 = 0; kt0 < nk; kt0 += R) {
#pragma unroll
        for (int u = 0; u < R; ++u) {
            const int kt = kt0 + u;
            if (kt < nk) {
                {
                    const int ka = kt + 1 < nk ? kt + 1 : nk - 1, kb = kt + PF < nk ? kt + PF : nk - 1;
                    areg0 = aload(0, ka); areg1 = aload(1, ka);
                    __builtin_amdgcn_sched_barrier(0);
                    const float* q0 = bp0 + (long)kb * 32 * ldb; const float* q1 = bp1 + (long)kb * 32 * ldb;
#pragma unroll
                    for (int j = 0; j < 8; ++j) { breg[(u + PF) % R][0][j] = q0[(long)j * ldb]; breg[(u + PF) % R][1][j] = q1[(long)j * ldb]; }
                }
                __builtin_amdgcn_sched_barrier(0);
                uint4 b0, b1;
                b0.x = cvtpk_v(breg[u][0][0], breg[u][0][1]); b0.y = cvtpk_v(breg[u][0][2], breg[u][0][3]); b0.z = cvtpk_v(breg[u][0][4], breg[u][0][5]); b0.w = cvtpk_v(breg[u][0][6], breg[u][0][7]);
                b1.x = cvtpk_v(breg[u][1][0], breg[u][1][1]); b1.y = cvtpk_v(breg[u][1][2], breg[u][1][3]); b1.z = cvtpk_v(breg[u][1][4], breg[u][1][5]); b1.w = cvtpk_v(breg[u][1][6], breg[u][1][7]);
                const bf16x8 bf0 = __builtin_bit_cast(bf16x8, b0), bf1 = __builtin_bit_cast(bf16x8, b1);
                const char* As = smem + (u & 1) * 16384 + ar;
#pragma unroll
                for (int mb = 0; mb < 16; mb += 4) {
                    bf16x8 af[4];
#pragma unroll
                    for (int m = 0; m < 4; ++m) af[m] = *(const bf16x8*)(As + (mb + m) * 1024);
                    __builtin_amdgcn_sched_barrier(0);
#pragma unroll
                    for (int m = 0; m < 4; ++m) {
                        acc[mb + m][0] = __builtin_amdgcn_mfma_f32_16x16x32_bf16(bf0, af[m], acc[mb + m][0], 0, 0, 0);
                        acc[mb + m][1] = __builtin_amdgcn_mfma_f32_16x16x32_bf16(bf1, af[m], acc[mb + m][1], 0, 0, 0);
                    }
                    __builtin_amdgcn_sched_barrier(0);
                }
                { char* Aw = smem + ((u + 1) & 1) * 16384; *(uint4*)(Aw + aw0) = areg0; *(uint4*)(Aw + aw1) = areg1; }
                __syncthreads();
            }
        }
    }
    epi(acc);
}
template <int N> struct IC { static constexpr int value = N; };
typedef const __attribute__((address_space(1))) char* gcp_t;
template <class T> DEVI gcp_t uniform_ptr(const T* p) {
    const unsigned long long v = (unsigned long long)p;
    const unsigned lo = __builtin_amdgcn_readfirstlane((unsigned)v), hi = __builtin_amdgcn_readfirstlane((unsigned)(v >> 32));
    return (gcp_t)(((unsigned long long)hi << 32) | lo);
}
DEVI float ldg_f(gcp_t sbase, unsigned voff) { return *(const __attribute__((address_space(1))) float*)(sbase + voff); }
typedef unsigned u32x4n_t __attribute__((ext_vector_type(4)));
DEVI uint4 ldg_q(gcp_t sbase, unsigned voff) { const u32x4n_t v = *(const __attribute__((address_space(1))) u32x4n_t*)(sbase + voff); return make_uint4(v.x, v.y, v.z, v.w); }
template <int AB, int NK, int LDB, int W1OFF, class Epi>
DEVI void gemm_tile_s(char* smem, gcp_t wb0, gcp_t wb1, unsigned boff, gcp_t ab, unsigned aoff0, unsigned aoff1, Epi&& epi) {
    constexpr long ldb = LDB;
    static_assert(NK >= 4, "K steps");
    int tid = threadIdx.x;
    asm volatile("" : "+v"(tid));
    const int lane = tid & 63, li = lane & 15, lg = lane >> 4;
    const int sr = tid >> 2, scn = tid & 3;
    const unsigned aw0 = sr * 64 + ((scn ^ ((0 - (sr >> 2)) & 3)) << 4), aw1 = aw0 + 128 * 64;
    const unsigned ar = li * 64 + ((lg ^ ((0 - (li >> 2)) & 3)) << 4);
    float breg[3][2][8];
    uint4 areg[2][2];
    f32x4 acc[16][2];
#pragma unroll
    for (int m = 0; m < 16; ++m) { acc[m][0] = f32x4{0.f, 0.f, 0.f, 0.f}; acc[m][1] = f32x4{0.f, 0.f, 0.f, 0.f}; }
    {
        const uint4 a0 = ldg_q(ab, aoff0), a1 = ldg_q(ab, aoff1);
        areg[1][0] = ldg_q(ab + 64, aoff0); areg[1][1] = ldg_q(ab + 64, aoff1);
#pragma unroll
        for (int s = 0; s < 2; ++s) {
#pragma unroll
            for (int j = 0; j < 8; ++j) {
                breg[s][0][j] = ldg_f(wb0 + (long)(s * 32 + j) * ldb * 4, boff);
                breg[s][1][j] = ldg_f(wb1 + (long)(s * 32 + j) * ldb * 4, boff);
            }
        }
        *(uint4*)(smem + aw0) = a0; *(uint4*)(smem + aw1) = a1;
    }
    __syncthreads();
    auto step = [&](auto uc, auto prec, auto wrc, const int kt) __attribute__((always_inline)) {
        constexpr int u = decltype(uc)::value;
        constexpr bool PRE = decltype(prec)::value != 0, WR = decltype(wrc)::value != 0;
        unsigned bo = boff;
        if constexpr (PRE) {
            unsigned ao0 = aoff0, ao1 = aoff1;
            asm volatile("" : "+v"(ao0), "+v"(ao1), "+v"(bo));
            { gcp_t sa = ab + (kt + 2) * 64; asm volatile("" : "+s"(sa)); areg[u & 1][0] = ldg_q(sa, ao0); areg[u & 1][1] = ldg_q(sa, ao1); }
        }
        __builtin_amdgcn_sched_barrier(0);
        uint4 b0, b1;
        b0.x = cvtpk_v(breg[u % 3][0][0], breg[u % 3][0][1]); b0.y = cvtpk_v(breg[u % 3][0][2], breg[u % 3][0][3]); b0.z = cvtpk_v(breg[u % 3][0][4], breg[u % 3][0][5]); b0.w = cvtpk_v(breg[u % 3][0][6], breg[u % 3][0][7]);
        b1.x = cvtpk_v(breg[u % 3][1][0], breg[u % 3][1][1]); b1.y = cvtpk_v(breg[u % 3][1][2], breg[u % 3][1][3]); b1.z = cvtpk_v(breg[u % 3][1][4], breg[u % 3][1][5]); b1.w = cvtpk_v(breg[u % 3][1][6], breg[u % 3][1][7]);
        const bf16x8 bf0 = __builtin_bit_cast(bf16x8, b0), bf1 = __builtin_bit_cast(bf16x8, b1);
        const char* As = smem + (u & 1) * 16384 + ar;
        constexpr int JS = (LDB * 4 <= 2048) ? 2 : 1;
        static_assert(AB == 2, "one weight row pair requested per batch of two A fragments");
#pragma unroll
        for (int mb = 0; mb < 16; mb += AB) {
            if constexpr (PRE) {
                constexpr int j = 0;
                const int jr = mb / 2;
                gcp_t s0 = wb0 + (long)((kt + 2) * 32 + (jr & ~(JS - 1))) * ldb * 4, s1 = wb1 + (long)((kt + 2) * 32 + (jr & ~(JS - 1))) * ldb * 4;
                if constexpr (W1OFF != 0) { asm volatile("" : "+s"(s0)); s1 = s0 + W1OFF; } else asm volatile("" : "+s"(s0), "+s"(s1));
                breg[(u + 2) % 3][0][jr] = ldg_f(s0 + (jr & (JS - 1)) * LDB * 4, bo);
                breg[(u + 2) % 3][1][jr] = ldg_f(s1 + (jr & (JS - 1)) * LDB * 4, bo);
                (void)j;
            }
            bf16x8 af[AB];
#pragma unroll
            for (int m = 0; m < AB; ++m) af[m] = *(const bf16x8*)(As + (mb + m) * 1024);
            __builtin_amdgcn_sched_barrier(0);
#pragma unroll
            for (int m = 0; m < AB; ++m) {
                acc[mb + m][0] = __builtin_amdgcn_mfma_f32_16x16x32_bf16(bf0, af[m], acc[mb + m][0], 0, 0, 0);
                acc[mb + m][1] = __builtin_amdgcn_mfma_f32_16x16x32_bf16(bf1, af[m], acc[mb + m][1], 0, 0, 0);
            }
            __builtin_amdgcn_sched_barrier(0);
        }
        if constexpr (WR) { char* Aw = smem + ((u + 1) & 1) * 16384; *(uint4*)(Aw + aw0) = areg[(u + 1) & 1][0]; *(uint4*)(Aw + aw1) = areg[(u + 1) & 1][1]; }
        __syncthreads();
    };
    constexpr int H = (NK - 2) % 6, G = (NK - 2 - H) / 6;
    static_assert(H == 2, "ring phase of the unrolled groups below assumes two head steps (NK = 16, 64, ...)");
    step(IC<0>{}, IC<1>{}, IC<1>{}, 0); step(IC<1>{}, IC<1>{}, IC<1>{}, 1);
    for (int g = 0; g < G; ++g) {
        const int kt0 = H + 6 * g;
        step(IC<2>{}, IC<1>{}, IC<1>{}, kt0); step(IC<3>{}, IC<1>{}, IC<1>{}, kt0 + 1); step(IC<4>{}, IC<1>{}, IC<1>{}, kt0 + 2);
        step(IC<5>{}, IC<1>{}, IC<1>{}, kt0 + 3); step(IC<0>{}, IC<1>{}, IC<1>{}, kt0 + 4); step(IC<1>{}, IC<1>{}, IC<1>{}, kt0 + 5);
    }
    step(IC<2>{}, IC<0>{}, IC<1>{}, NK - 2); step(IC<3>{}, IC<0>{}, IC<0>{}, NK - 1);
    epi(acc);
}
template <int PF, int R, class Epi>
DEVI void gemm_tile(char* smem, int nk, long ldb, const float* bp0, const float* bp1, const bf16_t* ap0, const bf16_t* ap1, Epi&& epi) {
    gemm_tile_f<PF, R>(smem, nk, ldb, bp0, bp1, [&](int i, int kt) { return *(const uint4*)((i ? ap1 : ap0) + kt * 32); }, epi);
}

namespace pg8 {
#define PG8_LAS __attribute__((address_space(3)))
typedef unsigned short bf16_t;
typedef short bf16x8 __attribute__((ext_vector_type(8)));
typedef float f32x4 __attribute__((ext_vector_type(4)));
typedef unsigned u32x4 __attribute__((ext_vector_type(4)));
constexpr int BM = 256, BK = 64, HALF = 128, HTB = HALF * BK * 2  , STAGE_BYTES = 8 * HTB, NXCD = 8, WGM = 8;

__host__ __device__ __forceinline__ int lds_byte(int r, int c) { const int st = (r >> 4) * 2 + (c >> 5), rr = r & 15, cc = c & 31, ob = rr * 64 + cc * 2; return st * 1024 + (ob ^ (((ob >> 9) & 1) << 5)); }
__host__ __device__ __forceinline__ void stage_rc(int b, int& R, int& C) { const int st = b / 1024, sb = b % 1024, swz = sb ^ (((sb >> 9) & 1) << 5); R = (st >> 1) * 16 + swz / 64; C = (st & 1) * 32 + (swz % 64) / 2; }
__host__ __device__ __forceinline__ int perm32(int rho) { const int n = rho >> 4, i = rho & 15; return 8 * (i >> 2) + 4 * n + (i & 3); }

struct Unit { int pm, pn; };
struct Gemm { const bf16_t* A; const bf16_t* Bt; int M, N, K; };

struct StaticOrder {
    int nM, nN, nwg, G, c;
    __host__ __device__ void init(int M, int N, int G_, int c_) { nM = M / BM; nN = N / BM; nwg = nM * nN; G = G_; c = c_; }
    __host__ __device__ bool next(int i, Unit& u) const {
        const long L = (long)i * G + c; if (L >= nwg) return false;
        int wgid = (int)L; { const int q = nwg / NXCD, r = nwg % NXCD, xcd = wgid % NXCD, off = wgid / NXCD; wgid = (xcd < r ? xcd * (q + 1) : r * (q + 1) + (xcd - r) * q) + off; }
        const int nig = WGM * nN, gid = wgid / nig, fm = gid * WGM, gsz = (nM - fm) < WGM ? (nM - fm) : WGM;
        u.pm = fm + ((wgid % nig) % gsz); u.pn = (wgid % nig) / gsz; return true;
    }
    __device__ __forceinline__ void a_ready(const Unit&) const {}
    __device__ __forceinline__ void done(const Unit&) const {}
};


__device__ __forceinline__ unsigned cvt_pk_bf16(float lo, float hi) { unsigned r; asm volatile("v_cvt_pk_bf16_f32 %0, %1, %2" : "=v"(r) : "v"(lo), "v"(hi)); return r; }
struct EpiZ {
    static constexpr bool PERM = true, AFTER_DRAIN = false;
    bf16_t* O; int ldc; int ncols;
    __device__ __forceinline__ void operator()(const f32x4 (&acc)[2][2][4][2], const Unit& u, int wr, int wc, int fr, int fq) const {
        const int row0 = u.pm * BM + wr * 64 + fr, col0 = u.pn * BM + wc * 32 + 8 * fq;
#pragma unroll
        for (int ai = 0; ai < 2; ++ai)
#pragma unroll
            for (int m = 0; m < 4; ++m) { bf16_t* rowp = O + (size_t)(row0 + ai * HALF + m * 16) * ldc;
#pragma unroll
                for (int bj = 0; bj < 2; ++bj) { const int col = col0 + bj * HALF;
                    if (col < ncols) { const f32x4 v0 = acc[ai][bj][m][0], v1 = acc[ai][bj][m][1];
                        u32x4 w; w.x = cvt_pk_bf16(v0[0], v0[1]); w.y = cvt_pk_bf16(v0[2], v0[3]); w.z = cvt_pk_bf16(v1[0], v1[1]); w.w = cvt_pk_bf16(v1[2], v1[3]);
                        *(u32x4*)(rowp + col) = w; } } }
    }
};
struct EpiX1 {
    static constexpr bool PERM = true, AFTER_DRAIN = false;
    float* O; const float* res; const float* gate; int ldc; int gate_stride; int rows_per_batch;
    __device__ __forceinline__ void operator()(const f32x4 (&acc)[2][2][4][2], const Unit& u, int wr, int wc, int fr, int fq) const {
        const int row0 = u.pm * BM + wr * 64 + fr, col0 = u.pn * BM + wc * 32 + 8 * fq;
        const float* gp = gate + (size_t)((u.pm * BM) / rows_per_batch) * gate_stride;
#pragma unroll
        for (int bj = 0; bj < 2; ++bj) { const int col = col0 + bj * HALF;
            const f32x4 g0 = *(const f32x4*)(gp + col), g1 = *(const f32x4*)(gp + col + 4);
#pragma unroll
            for (int ai = 0; ai < 2; ++ai) {
                f32x4 x0[4], x1[4];
#pragma unroll
                for (int m = 0; m < 4; ++m) { const size_t o = (size_t)(row0 + ai * HALF + m * 16) * ldc + col; x0[m] = *(const f32x4*)(res + o); x1[m] = *(const f32x4*)(res + o + 4); }
#pragma unroll
                for (int m = 0; m < 4; ++m) { const size_t o = (size_t)(row0 + ai * HALF + m * 16) * ldc + col;
                    *(f32x4*)(O + o) = x0[m] + g0 * acc[ai][bj][m][0]; *(f32x4*)(O + o + 4) = x1[m] + g1 * acc[ai][bj][m][1]; }
            } }
    }
};
template <class Epi, class Sched, bool ALIGN_EPI = false, bool SP2 = false>
__device__ __forceinline__ void gemm_phase(PG8_LAS unsigned char* lds, const Gemm g, const Sched& S, const Epi& E) {
    const int tid = threadIdx.x, wid = __builtin_amdgcn_readfirstlane(tid >> 6), lane = tid & 63, wr = wid >> 2, wc = wid & 3, fr = lane & 15, fq = lane >> 4;
    const int K = g.K, nt = K / BK;
    unsigned voffA[2], voffB[2];
#pragma unroll
    for (int i = 0; i < 2; ++i) { int R, C; stage_rc(tid * 16 + i * 8192, R, C); const int Rb = Epi::PERM ? ((R & ~31) + perm32(R & 31)) : R;
        voffA[i] = (unsigned)(R * K + C) * 2u; voffB[i] = (unsigned)(Rb * K + C) * 2u; }
    const size_t kstep = (size_t)(BK * 2);
    const size_t hstep = (size_t)HALF * K * 2;
    const size_t tstep = 2 * hstep;
    const unsigned ldsw = (unsigned)wid * 1024u;
    const int aoff = lds_byte(wr * 64 + fr, fq * 8), boff = lds_byte(wc * 32 + fr, fq * 8);
#define PG8_SA(b, h) (((b) * 2 + (h)) * HTB)
#define PG8_SB(b, h) ((4 + (b) * 2 + (h)) * HTB)
#define PG8_STAGE(bufoff, gbase, voff) do { _Pragma("unroll") for (int _i = 0; _i < 2; ++_i) \
        __builtin_amdgcn_global_load_lds((const unsigned*)((const char*)(gbase) + (voff)[_i]), (PG8_LAS unsigned*)(lds + (bufoff) + ldsw + _i * 8192), 16, 0, 0); } while (0)
#define PG8_LDA(dst, b, h) do { _Pragma("unroll") for (int m = 0; m < 4; ++m) _Pragma("unroll") for (int k = 0; k < 2; ++k) dst[m][k] = *(const PG8_LAS bf16x8*)(lds + PG8_SA(b, h) + aoff + m * 2048 + k * 1024); } while (0)
#define PG8_LDB(dst, b, h) do { _Pragma("unroll") for (int n = 0; n < 2; ++n) _Pragma("unroll") for (int k = 0; k < 2; ++k) dst[n][k] = *(const PG8_LAS bf16x8*)(lds + PG8_SB(b, h) + boff + n * 2048 + k * 1024); } while (0)
#define PG8_MMA(ai, bj, At, Bt) do { __builtin_amdgcn_s_setprio(1); _Pragma("unroll") for (int m = 0; m < 4; ++m) _Pragma("unroll") for (int n = 0; n < 2; ++n) _Pragma("unroll") for (int k = 0; k < 2; ++k) \
        acc[ai][bj][m][n] = __builtin_amdgcn_mfma_f32_16x16x32_bf16(Bt[n][k], At[m][k], acc[ai][bj][m][n], 0, 0, 0); __builtin_amdgcn_s_setprio(0); } while (0)
#define PG8_WAIT_V(n) asm volatile("s_waitcnt vmcnt(" #n ")" ::: "memory")
#define PG8_WAIT_L(n) asm volatile("s_waitcnt lgkmcnt(" #n ")" ::: "memory")
#define PG8_BAR __builtin_amdgcn_s_barrier()
#define PG8_SCHED __builtin_amdgcn_sched_barrier(0)
    Unit cur, nxt; int ui = 0;
    if (!S.next(0, cur)) return;
    f32x4 acc[2][2][4][2];
#pragma unroll
    for (int a = 0; a < 2; ++a)
#pragma unroll
        for (int b = 0; b < 2; ++b)
#pragma unroll
            for (int m = 0; m < 4; ++m)
#pragma unroll
                for (int n = 0; n < 2; ++n) acc[a][b][m][n] = (f32x4){0.f, 0.f, 0.f, 0.f};
    bf16x8 At[4][2], B0[2][2], B1[2][2];
    const char* cA = (const char*)g.A + (size_t)cur.pm * tstep; const char* cB = (const char*)g.Bt + (size_t)cur.pn * tstep;
    S.a_ready(cur);
    if constexpr (SP2) {
        PG8_STAGE(PG8_SB(0, 0), cB, voffB); PG8_STAGE(PG8_SB(0, 1), cB + hstep, voffB); PG8_STAGE(PG8_SA(0, 0), cA, voffA); PG8_STAGE(PG8_SA(0, 1), cA + hstep, voffA);
        if (wr == 1) PG8_BAR;
        PG8_WAIT_V(2); PG8_BAR;
        PG8_STAGE(PG8_SB(1, 0), cB + kstep, voffB); PG8_STAGE(PG8_SA(1, 0), cA + kstep, voffA); PG8_STAGE(PG8_SB(1, 1), cB + hstep + kstep, voffB);
        PG8_WAIT_V(6); PG8_BAR;
    } else {
        PG8_STAGE(PG8_SB(0, 0), cB, voffB); PG8_STAGE(PG8_SA(0, 0), cA, voffA); PG8_STAGE(PG8_SB(0, 1), cB + hstep, voffB); PG8_STAGE(PG8_SA(0, 1), cA + hstep, voffA);
        if (wr == 1) PG8_BAR;
        PG8_WAIT_V(4); PG8_BAR;
        PG8_STAGE(PG8_SB(1, 0), cB + kstep, voffB); PG8_STAGE(PG8_SA(1, 0), cA + kstep, voffA); PG8_STAGE(PG8_SB(1, 1), cB + hstep + kstep, voffB);
        PG8_WAIT_V(6); PG8_BAR;
    }
    for (;;) {
        const bool has_next = S.next(ui + 1, nxt);
        const char* nA = has_next ? (const char*)g.A + (size_t)nxt.pm * tstep : cA; const char* nB = has_next ? (const char*)g.Bt + (size_t)nxt.pn * tstep : cB;
        for (int t = 0; t < nt; t += 2) {
            const bool last = (t == nt - 2);
            const char* a1 = cA + (size_t)(t + 1) * kstep;
            const char* a2 = last ? nA : cA + (size_t)(t + 2) * kstep; const char* b2 = last ? nB : cB + (size_t)(t + 2) * kstep;
            const char* a3 = a2 + kstep; const char* b3 = b2 + kstep;
            if (last && has_next) S.a_ready(nxt);
            if constexpr (SP2) {
            PG8_LDB(B0, 0, 0); PG8_LDB(B1, 0, 1); PG8_SCHED; PG8_LDA(At, 0, 0); PG8_STAGE(PG8_SA(1, 1), a1 + hstep, voffA);
            PG8_WAIT_V(8); PG8_WAIT_L(0); PG8_BAR; PG8_MMA(0, 0, At, B0); PG8_MMA(0, 1, At, B1); PG8_BAR; PG8_SCHED;
            PG8_LDA(At, 0, 1); PG8_STAGE(PG8_SB(0, 0), b2, voffB); PG8_STAGE(PG8_SB(0, 1), b2 + hstep, voffB); PG8_STAGE(PG8_SA(0, 0), a2, voffA);
            PG8_WAIT_V(8); PG8_WAIT_L(0); PG8_BAR; PG8_MMA(1, 0, At, B0); PG8_MMA(1, 1, At, B1); PG8_BAR; PG8_SCHED;
            PG8_LDB(B0, 1, 0); PG8_LDB(B1, 1, 1); PG8_SCHED; PG8_LDA(At, 1, 0); PG8_STAGE(PG8_SA(0, 1), a2 + hstep, voffA);
            PG8_WAIT_V(8); PG8_WAIT_L(0); PG8_BAR; PG8_MMA(0, 0, At, B0); PG8_MMA(0, 1, At, B1); PG8_BAR; PG8_SCHED;
            PG8_LDA(At, 1, 1); PG8_STAGE(PG8_SB(1, 0), b3, voffB); PG8_STAGE(PG8_SB(1, 1), b3 + hstep, voffB); PG8_STAGE(PG8_SA(1, 0), a3, voffA);
            PG8_WAIT_V(8); PG8_WAIT_L(0); PG8_BAR; PG8_MMA(1, 0, At, B0); PG8_MMA(1, 1, At, B1); PG8_BAR; PG8_SCHED;
            } else {
            PG8_LDB(B0, 0, 0); PG8_SCHED; PG8_LDA(At, 0, 0); PG8_STAGE(PG8_SA(1, 1), a1 + hstep, voffA);
            PG8_WAIT_L(8); PG8_BAR; PG8_WAIT_L(0); PG8_MMA(0, 0, At, B0); PG8_BAR; PG8_SCHED;
            PG8_LDB(B1, 0, 1); PG8_STAGE(PG8_SB(0, 0), b2, voffB);
            PG8_BAR; PG8_WAIT_L(0); PG8_MMA(0, 1, At, B1); PG8_BAR;
            PG8_LDA(At, 0, 1); PG8_STAGE(PG8_SA(0, 0), a2, voffA);
            PG8_BAR; PG8_WAIT_L(0); PG8_MMA(1, 0, At, B0); PG8_BAR; PG8_SCHED;
            PG8_STAGE(PG8_SB(0, 1), b2 + hstep, voffB);
            PG8_WAIT_V(6); PG8_BAR; PG8_MMA(1, 1, At, B1); PG8_BAR;
            PG8_LDB(B0, 1, 0); PG8_SCHED; PG8_LDA(At, 1, 0); PG8_STAGE(PG8_SA(0, 1), a2 + hstep, voffA);
            PG8_WAIT_L(8); PG8_BAR; PG8_WAIT_L(0); PG8_MMA(0, 0, At, B0); PG8_BAR; PG8_SCHED;
            PG8_LDB(B1, 1, 1); PG8_STAGE(PG8_SB(1, 0), b3, voffB);
            PG8_BAR; PG8_WAIT_L(0); PG8_MMA(0, 1, At, B1); PG8_BAR;
            PG8_LDA(At, 1, 1); PG8_STAGE(PG8_SA(1, 0), a3, voffA);
            PG8_BAR; PG8_WAIT_L(0); PG8_MMA(1, 0, At, B0); PG8_BAR; PG8_SCHED;
            PG8_STAGE(PG8_SB(1, 1), b3 + hstep, voffB);
            PG8_WAIT_V(6); PG8_BAR; PG8_MMA(1, 1, At, B1); PG8_BAR;
            }
        }
        if constexpr (ALIGN_EPI) { if (wr == 0) PG8_BAR; }
        if constexpr (!Epi::AFTER_DRAIN) { E(acc, cur, wr, wc, fr, fq); S.done(cur); }
        if (!has_next) break;
#pragma unroll
        for (int a = 0; a < 2; ++a)
#pragma unroll
            for (int b = 0; b < 2; ++b)
#pragma unroll
                for (int m = 0; m < 4; ++m)
#pragma unroll
                    for (int n = 0; n < 2; ++n) acc[a][b][m][n] = (f32x4){0.f, 0.f, 0.f, 0.f};
        cur = nxt; cA = nA; cB = nB; ++ui;
        if constexpr (ALIGN_EPI) { if (wr == 1) PG8_BAR; }
    }
    PG8_WAIT_V(0);
    if constexpr (!ALIGN_EPI) { if (wr == 0) PG8_BAR; }
    PG8_BAR;
    if constexpr (Epi::AFTER_DRAIN) { E.fused(acc, cur, wr, wc, fr, fq, lds, wid, lane); S.done(cur); }
#undef PG8_SA
#undef PG8_SB
#undef PG8_STAGE
#undef PG8_LDA
#undef PG8_LDB
#undef PG8_MMA
#undef PG8_WAIT_V
#undef PG8_WAIT_L
#undef PG8_BAR
#undef PG8_SCHED
}
}

DEVI void ada_unit(const Params& p, char* smem, int cb, int ks) {
    float* sl = (float*)smem;
    float* part = (float*)(p.ws + WS_PART);
    const int tid = threadIdx.x;
    __syncthreads();
    if (tid < 256) { const int b = tid >> 7, kk = tid & 127; const float cv = p.c[b * DM + ks * 128 + kk]; sl[b * 128 + kk] = cv / (1.f + expf(-cv)); }
    __syncthreads();
    const int j = cb * 512 + tid;
    const float* w = p.w_ada + (size_t)(ks * 128) * 12288 + j;
    float a0 = 0.f, a1 = 0.f;
#pragma unroll 16
    for (int kk = 0; kk < 128; ++kk) { const float wv = w[(size_t)kk * 12288]; a0 += sl[kk] * wv; a1 += sl[128 + kk] * wv; }
    part[(ks * 2 + 0) * 12288 + j] = a0; part[(ks * 2 + 1) * 12288 + j] = a1;
}
DEVI void ada_unit_h(const Params& p, char* smem, int cb, int ks) {
    float* sl = (float*)smem;
    float* part = (float*)(p.ws + WS_PART);
    const int tid = threadIdx.x, hf = tid >> 8, t = tid & 255;
    __syncthreads();
    if (tid < 256) { const int b = tid >> 7, kk = tid & 127; const float cv = p.c[b * DM + ks * 128 + kk]; sl[b * 128 + kk] = cv / (1.f + expf(-cv)); }
    __syncthreads();
    const int j = cb * 256 + t;
    const float* w = p.w_ada + (size_t)(ks * 128 + hf * 64) * 12288 + j;
    const float* s0 = sl + hf * 64;
    float a0 = 0.f, a1 = 0.f;
#pragma unroll 16
    for (int kk = 0; kk < 64; ++kk) { const float wv = w[(size_t)kk * 12288]; a0 += s0[kk] * wv; a1 += s0[128 + kk] * wv; }
    if (hf) { sl[256 + t] = a0; sl[512 + t] = a1; }
    __syncthreads();
    if (!hf) { part[(ks * 2 + 0) * 12288 + j] = a0 + sl[256 + t]; part[(ks * 2 + 1) * 12288 + j] = a1 + sl[512 + t]; }
}
DEVI void transpose_item(const float* W, int N, bf16_t* WT, int r, char* smem) {
    const int lane = threadIdx.x & 63, wave = threadIdx.x >> 6;
    float* scr = (float*)(smem + 4096) + wave * (64 * 33);
    const int nblk = N / 32, kb = r / nblk, nb = r % nblk, k0 = 64 * kb, n0 = 32 * nb;
    {
        float4 t[8];
#pragma unroll
        for (int i = 0; i < 8; ++i) t[i] = *(const float4*)(W + (size_t)(k0 + (lane >> 3) + 8 * i) * N + n0 + 4 * (lane & 7));
#pragma unroll
        for (int i = 0; i < 8; ++i) { float* d = scr + ((lane >> 3) + 8 * i) * 33 + 4 * (lane & 7); d[0] = t[i].x; d[1] = t[i].y; d[2] = t[i].z; d[3] = t[i].w; }
    }
    const int c = lane & 7;
#pragma unroll
    for (int j = 0; j < 4; ++j) { const int n = (lane >> 3) + 8 * j; const float* sp = scr + (8 * c) * 33 + n;
        uint4 o; o.x = cvtpk(sp[0 * 33], sp[1 * 33]); o.y = cvtpk(sp[2 * 33], sp[3 * 33]); o.z = cvtpk(sp[4 * 33], sp[5 * 33]); o.w = cvtpk(sp[6 * 33], sp[7 * 33]);
        *(uint4*)(WT + (size_t)(n0 + n) * DM + k0 + 8 * c) = o; }
}
DEVI void phase0(const Params& p, char* smem) {
    float* rope = (float*)(p.ws + WS_ROPE);
    const int tid = threadIdx.x, lane = tid & 63, wave = tid >> 6;
    constexpr int N_ADA = 16 * NKS, N_ROPE = 256;
    for (int u = blockIdx.x; u < N_ADA + N_ROPE; u += gridDim.x) {
        if (u < N_ADA) {
            ada_unit_h(p, smem, u & 15, u >> 4);
        } else {
            const int idx = (u - N_ADA) * 512 + tid;
            const int t = idx >> 5, i = idx & 31;
            const double invf = exp(-(double)(2 * i) / 64.0 * 9.210340371976184);
            const double ang = (double)t * invf;
            rope[idx] = (float)cos(ang); rope[SEQ * 32 + idx] = (float)sin(ang);
        }
    }
    __syncthreads();
    {
        bf16_t* wti = (bf16_t*)(p.ws + WS_WTI);
        constexpr int I_IN = 32 * (INC / 32), I_Z = (4864 - INC) * DM / 8 / 64;
        for (int it = blockIdx.x * 8 + wave; it < I_IN + I_Z; it += gridDim.x * 8) {
            if (it >= I_IN) { const size_t o = (size_t)INC * DM + ((size_t)(it - I_IN) * 64 + lane) * 8; *(uint4*)(wti + o) = make_uint4(0u, 0u, 0u, 0u); continue; }
            transpose_item(p.w_in, INC, wti, it, smem);
        }
    }
}

DEVI float mod_from_part(const Params& p, int b, int j) {
    const float* part = (const float*)(p.ws + WS_PART);
    float s = p.b_ada[j];
#pragma unroll
    for (int ks = 0; ks < NKS; ++ks) s += part[(ks * 2 + b) * 12288 + j];
    return s;
}

constexpr int N_MODF = 48, N_WRF = 128, N_CB = 2, N_AS2 = 8, N_SPEC = N_WRF + N_CB + N_AS2 + N_MODF;
DEVI void spec_unit(const Params& p, char* smem, int v) {
    float* A1 = (float*)smem;
    const int tid = threadIdx.x, lane = tid & 63, wave = tid >> 6;
    if (v >= N_CB + N_WRF + N_AS2) {
        const int idx = (v - (N_CB + N_WRF + N_AS2)) * 512 + tid; const int b = idx / 12288, j = idx % 12288;
        ((float*)(p.ws + WS_MODF))[idx] = mod_from_part(p, b, j);
    } else {
            if (v < N_CB) {
                const int b = v;
                float* sh2 = A1 + 4 * DM;
                float* red = sh2 + DM;
                __syncthreads();
                for (int k = tid; k < DM; k += 512) sh2[k] = mod_from_part(p, b, 3 * DM + k);
                __syncthreads();
                float ae = 0.f, ag = 0.f;
#pragma unroll 16
                for (int kk = 0; kk < 256; ++kk) { const int k = wave * 256 + kk; const float sv = sh2[k]; ae += sv * p.w_re[k * 64 + lane]; ag += sv * p.w_rg[k * 8 + (lane & 7)]; }
                red[wave * 80 + lane] = ae; if (lane < 8) red[wave * 80 + 64 + lane] = ag;
                __syncthreads();
                if (tid < 80) {
                    float r = 0.f;
                    if (tid < 72) {
#pragma unroll
                        for (int w = 0; w < 8; ++w) r += red[w * 80 + tid];
                        r += (tid < 64 ? p.b_re[tid] : p.b_rg[tid - 64]);
                    }
                    ((float*)(p.ws + WS_CB))[b * 80 + tid] = r;
                }
            } else if (v < N_CB + N_WRF) {
                const int vv = v - N_CB, b = vv >> 6, ks = vv & 63, ln = tid & 63, e = tid >> 6;
                const int k = ks * 32 + 8 * (ln >> 4) + e;
                const float a2 = p.norm2_g[k] * (1.f + mod_from_part(p, b, 4 * DM + k));
                bf16_t* wrf = (bf16_t*)(p.ws + WS_WRF);
#pragma unroll
                for (int nf = 0; nf < 5; ++nf) {
                    const int j = nf * 16 + (ln & 15);
                    const float wv = j < 64 ? p.w_re[k * 64 + j] : (j < 72 ? p.w_rg[k * 8 + (j - 64)] : 0.f);
                    const float val = a2 * wv;
                    const unsigned hi = cvtpk(val, 0.f) & 0xffffu;
                    const unsigned lo = cvtpk(val - bf2f(hi), 0.f) & 0xffffu;
                    const size_t base = ((((size_t)(b * 64 + ks) * 5 + nf) * 2) * 64 + ln) * 8 + e;
                    wrf[base] = (bf16_t)hi; wrf[base + 512] = (bf16_t)lo;
                }
            } else {
                const int idx = (v - N_WRF - N_CB) * 512 + tid, b = idx >> 11, k = idx & 2047;
                float* as2 = (float*)(p.ws + WS_AS2);
                as2[idx] = p.norm2_g[k] * (1.f + mod_from_part(p, b, 4 * DM + k));
                as2[2 * DM + idx] = mod_from_part(p, b, 3 * DM + k);
            }
    }
}

DEVI void phase1(const Params& p, char* smem) {
    float* A1 = (float*)smem;
    float* S1 = A1 + 2 * DM;
    float* modf = (float*)(p.ws + WS_MODF);
    bf16_t* h = (bf16_t*)(p.ws + WS_H);
    const int tid = threadIdx.x, lane = tid & 63, wave = tid >> 6;
    constexpr int N_ROWS = NTOK / 8;
    const int upw = (N_ROWS + (int)gridDim.x - 1) / (int)gridDim.x, u_lo = (int)blockIdx.x * upw, u_hi = (u_lo + upw < N_ROWS) ? u_lo + upw : N_ROWS;
    const int b_lo = (u_lo * 8) >> 12, b_hi = u_hi > u_lo ? ((u_hi * 8 - 1) >> 12) : b_lo;
    for (int idx = tid; idx < 2 * DM; idx += 512) {
        const int b = idx >> 11, k = idx & 2047;
        if (b >= b_lo && b <= b_hi) {
            const float sh = mod_from_part(p, b, k), sc = mod_from_part(p, b, DM + k);
            A1[idx] = p.norm1_g[k] * (1.f + sc); S1[idx] = sh;
        }
    }
    __syncthreads();
    for (int u = u_lo; u < u_hi; ++u) {
        {
            const int row = u * 8 + wave, b = row >> 12;
            const float* xr = p.x + (size_t)row * DM;
            float4 v[8]; float ss = 0.f;
#pragma unroll
            for (int i = 0; i < 8; ++i) { v[i] = *(const float4*)(xr + i * 256 + lane * 4); ss += v[i].x * v[i].x + v[i].y * v[i].y + v[i].z * v[i].z + v[i].w * v[i].w; }
            ss = wave_sum(ss);
            const float rstd = rsqrtf(ss * (1.f / DM) + 1e-6f);
#pragma unroll
            for (int i = 0; i < 8; ++i) {
                const int k = i * 256 + lane * 4;
                const float4 a = *(const float4*)(A1 + b * DM + k), s = *(const float4*)(S1 + b * DM + k);
                uint2 o; o.x = cvtpk(v[i].x * rstd * a.x + s.x, v[i].y * rstd * a.y + s.y); o.y = cvtpk(v[i].z * rstd * a.z + s.z, v[i].w * rstd * a.w + s.w);
                *(uint2*)(h + (size_t)row * DM + k) = o;
            }
        }
    }
}

DEVI void phase2(const Params& p, char* smem) {
    pg8::Gemm g{(const pg8::bf16_t*)(p.ws + WS_H), (const pg8::bf16_t*)(p.ws + WS_WTI), NTOK, 4864, DM};
    pg8::StaticOrder S; S.init(NTOK, 4864, (int)gridDim.x, (int)blockIdx.x);
    pg8::EpiZ E{(pg8::bf16_t*)(p.ws + WS_Z), INC, INC};
    pg8::gemm_phase<pg8::EpiZ, pg8::StaticOrder, true, true>((PG8_LAS unsigned char*)smem, g, S, E);
    const int nthird = 608 - 2 * (int)gridDim.x;
    if (gridDim.x == 256 ? (int)blockIdx.x >= nthird : true) {
        const int nw = gridDim.x == 256 ? 256 - nthird : (int)gridDim.x, wi = gridDim.x == 256 ? (int)blockIdx.x - nthird : (int)blockIdx.x;
        __syncthreads();
        for (int u = wi; u < 512; u += nw) {
            if (u < 256) ada_unit(p, smem, 8 + (u & 15), u >> 4);
            else { __syncthreads(); transpose_item(p.w_o, DM, (bf16_t*)(p.ws + WS_WTO), (u - 256) * 8 + (int)(threadIdx.x >> 6), smem); }
        }
    }
}

DEVI float dpp_xor1(float x) { return __builtin_bit_cast(float, __builtin_amdgcn_update_dpp(0, __builtin_bit_cast(int, x), 0xB1, 0xF, 0xF, true)); }
DEVI float dpp_xor2(float x) { return __builtin_bit_cast(float, __builtin_amdgcn_update_dpp(0, __builtin_bit_cast(int, x), 0x4E, 0xF, 0xF, true)); }
DEVI float xor32_sum(float x) {
    float a = x, b = x;
    asm volatile("s_nop 1\n\tv_permlane32_swap_b32 %0, %1\n\ts_nop 1" : "+v"(a), "+v"(b));
    return a + b;
}
DEVI unsigned m64_off(int row, int chunk) { return row * 128 + ((chunk ^ ((row >> 1) & 7)) << 4); }
DEVI void mm_tile(f32x16& acc, const char* X, int xr0, const char* Y, int yr0, int l31, int hh) {
#pragma unroll
    for (int s4 = 0; s4 < 4; ++s4) {
        const bf16x8 a = *(const bf16x8*)(X + m64_off(xr0 + l31, 2 * s4 + hh));
        const bf16x8 b = *(const bf16x8*)(Y + m64_off(yr0 + l31, 2 * s4 + hh));
        acc = __builtin_amdgcn_mfma_f32_32x32x16_bf16(a, b, acc, 0, 0, 0);
    }
}
DEVI f32x16 zero16() { f32x16 z;
#pragma unroll
    for (int i = 0; i < 16; ++i) z[i] = 0.f;
    return z; }


DEVI float tokshift(const bf16_t* z, const float* mu, int tok, int c) {
    const float zc = bf2f(z[(size_t)tok * INC + ZC_RW + c]);
    const float zp = (tok & (SEQ - 1)) ? bf2f(z[(size_t)(tok - 1) * INC + ZC_RW + c]) : 0.f;
    return zc + (zp - zc) * mu[c];
}

DEVI void p3_unit(const Params& p, char* smem, int u) {
    const bf16_t* z = (const bf16_t*)(p.ws + WS_Z);
    bf16_t* mix = (bf16_t*)(p.ws + WS_MIX);
    const float* rope = (const float*)(p.ws + WS_ROPE);
    const int tid = threadIdx.x, lane = tid & 63, wave = tid >> 6;
    constexpr int N_ATT = 256;
    {
        __syncthreads();
        if (u < N_ATT) {
            constexpr int VTS = 392;
            char* Ks = smem;
            char* Vt = smem + 192 * 128;
            const int b = u >> 7, kvh = (u >> 6) & 1, qb = u & 63, t0 = qb * 64, kbase = t0 - 128;
            for (int idx = tid; idx < 192 * 4; idx += 512) {
                const int j = idx >> 2, c = idx & 3, t = kbase + j;
                uint4 o1 = make_uint4(0u, 0u, 0u, 0u), o2 = o1;
                if (t >= 0) {
                    const bf16_t* zr = z + (size_t)(b * SEQ + t) * INC + ZC_K + kvh * 64 + 8 * c;
                    const uint4 ka = *(const uint4*)zr, kb = *(const uint4*)(zr + 32);
                    const float4 c0 = *(const float4*)(rope + t * 32 + 8 * c), c1 = *(const float4*)(rope + t * 32 + 8 * c + 4);
                    const float4 s0 = *(const float4*)(rope + SEQ * 32 + t * 32 + 8 * c), s1 = *(const float4*)(rope + SEQ * 32 + t * 32 + 8 * c + 4);
                    const float a[8] = {bflo(ka.x), bfhi(ka.x), bflo(ka.y), bfhi(ka.y), bflo(ka.z), bfhi(ka.z), bflo(ka.w), bfhi(ka.w)};
                    const float bq[8] = {bflo(kb.x), bfhi(kb.x), bflo(kb.y), bfhi(kb.y), bflo(kb.z), bfhi(kb.z), bflo(kb.w), bfhi(kb.w)};
                    const float cs[8] = {c0.x, c0.y, c0.z, c0.w, c1.x, c1.y, c1.z, c1.w}, sn[8] = {s0.x, s0.y, s0.z, s0.w, s1.x, s1.y, s1.z, s1.w};
                    float r1[8], r2[8];
#pragma unroll
                    for (int e = 0; e < 8; ++e) { r1[e] = a[e] * cs[e] - bq[e] * sn[e]; r2[e] = bq[e] * cs[e] + a[e] * sn[e]; }
                    o1 = make_uint4(cvtpk(r1[0], r1[1]), cvtpk(r1[2], r1[3]), cvtpk(r1[4], r1[5]), cvtpk(r1[6], r1[7]));
                    o2 = make_uint4(cvtpk(r2[0], r2[1]), cvtpk(r2[2], r2[3]), cvtpk(r2[4], r2[5]), cvtpk(r2[6], r2[7]));
                }
                *(uint4*)(Ks + m64_off(j, c)) = o1; *(uint4*)(Ks + m64_off(j, c + 4)) = o2;
            }
            for (int idx = tid; idx < 192 * 8; idx += 512) {
                const int j = idx >> 3, c = idx & 7, t = kbase + j;
                uint4 vv = make_uint4(0u, 0u, 0u, 0u);
                if (t >= 0) vv = *(const uint4*)(z + (size_t)(b * SEQ + t) * INC + ZC_V + kvh * 64 + 8 * c);
                char* vp = Vt + (8 * c) * VTS + j * 2;
                *(bf16_t*)(vp + 0 * VTS) = (bf16_t)(vv.x & 0xffffu); *(bf16_t*)(vp + 1 * VTS) = (bf16_t)(vv.x >> 16);
                *(bf16_t*)(vp + 2 * VTS) = (bf16_t)(vv.y & 0xffffu); *(bf16_t*)(vp + 3 * VTS) = (bf16_t)(vv.y >> 16);
                *(bf16_t*)(vp + 4 * VTS) = (bf16_t)(vv.z & 0xffffu); *(bf16_t*)(vp + 5 * VTS) = (bf16_t)(vv.z >> 16);
                *(bf16_t*)(vp + 6 * VTS) = (bf16_t)(vv.w & 0xffffu); *(bf16_t*)(vp + 7 * VTS) = (bf16_t)(vv.w >> 16);
            }
            __syncthreads();
            const int h = kvh * 8 + wave, l31 = lane & 31, hh = lane >> 5;
            const float sink = p.sinks[h];
#pragma unroll 1
            for (int qt = 0; qt < 2; ++qt) {
                const int T0 = t0 + qt * 32, tq = T0 + l31;
                bf16x8 qf[4];
                {
                    const bf16_t* zr = z + (size_t)(b * SEQ + tq) * INC + h * 64 + 8 * hh;
                    uint4 raw[4];
#pragma unroll
                    for (int s4 = 0; s4 < 4; ++s4) raw[s4] = *(const uint4*)(zr + 16 * s4);
#pragma unroll
                    for (int s2 = 0; s2 < 2; ++s2) {
                        const int d0 = 16 * s2 + 8 * hh;
                        const float4 c0 = *(const float4*)(rope + tq * 32 + d0), c1 = *(const float4*)(rope + tq * 32 + d0 + 4);
                        const float4 s0 = *(const float4*)(rope + SEQ * 32 + tq * 32 + d0), s1 = *(const float4*)(rope + SEQ * 32 + tq * 32 + d0 + 4);
                        const uint4 ua = raw[s2], ub = raw[s2 + 2];
                        const float a[8] = {bflo(ua.x), bfhi(ua.x), bflo(ua.y), bfhi(ua.y), bflo(ua.z), bfhi(ua.z), bflo(ua.w), bfhi(ua.w)};
                        const float bq[8] = {bflo(ub.x), bfhi(ub.x), bflo(ub.y), bfhi(ub.y), bflo(ub.z), bfhi(ub.z), bflo(ub.w), bfhi(ub.w)};
                        const float cs[8] = {c0.x, c0.y, c0.z, c0.w, c1.x, c1.y, c1.z, c1.w}, sn[8] = {s0.x, s0.y, s0.z, s0.w, s1.x, s1.y, s1.z, s1.w};
                        float r1[8], r2[8];
#pragma unroll
                        for (int e = 0; e < 8; ++e) { r1[e] = (a[e] * cs[e] - bq[e] * sn[e]) * 0.125f; r2[e] = (bq[e] * cs[e] + a[e] * sn[e]) * 0.125f; }
                        qf[s2] = __builtin_bit_cast(bf16x8, make_uint4(cvtpk(r1[0], r1[1]), cvtpk(r1[2], r1[3]), cvtpk(r1[4], r1[5]), cvtpk(r1[6], r1[7])));
                        qf[s2 + 2] = __builtin_bit_cast(bf16x8, make_uint4(cvtpk(r2[0], r2[1]), cvtpk(r2[2], r2[3]), cvtpk(r2[4], r2[5]), cvtpk(r2[6], r2[7])));
                    }
                }
                f32x16 sc[5];
#pragma unroll
                for (int kt = 0; kt < 5; ++kt) {
                    sc[kt] = zero16();
                    const int krow = 32 * qt + 32 * kt + l31;
#pragma unroll
                    for (int s4 = 0; s4 < 4; ++s4) {
                        const bf16x8 kf = *(const bf16x8*)(Ks + m64_off(krow, 2 * s4 + hh));
                        sc[kt] = __builtin_amdgcn_mfma_f32_32x32x16_bf16(kf, qf[s4], sc[kt], 0, 0, 0);
                    }
                }
                float mx = -1e30f;
#pragma unroll
                for (int kt = 0; kt < 5; ++kt)
#pragma unroll
                    for (int i = 0; i < 16; ++i) {
                        const int r = (i & 3) + 8 * (i >> 2) + 4 * hh;
                        bool ok = (T0 - 128 + 32 * kt + r) >= 0;
                        if (kt == 0) ok = ok && (r > l31);
                        if (kt == 4) ok = ok && (r <= l31);
                        sc[kt][i] = ok ? sc[kt][i] : -1e30f;
                        mx = fmaxf(mx, sc[kt][i]);
                    }
                {
                    float a = mx, bq = mx;
                    asm volatile("s_nop 1\n\tv_permlane32_swap_b32 %0, %1\n\ts_nop 1" : "+v"(a), "+v"(bq));
                    mx = fmaxf(fmaxf(a, bq), sink);
                }
                float lsum = 0.f;
#pragma unroll
                for (int kt = 0; kt < 5; ++kt)
#pragma unroll
                    for (int i = 0; i < 16; ++i) { const float pe = __expf(sc[kt][i] - mx); sc[kt][i] = pe; lsum += pe; }
                lsum = xor32_sum(lsum) + __expf(sink - mx);
                const float inv = 1.f / lsum;
                f32x16 oacc[2];
                oacc[0] = zero16(); oacc[1] = zero16();
#pragma unroll
                for (int kt = 0; kt < 5; ++kt)
#pragma unroll
                    for (int s2 = 0; s2 < 2; ++s2) {
                        uint4 pb;
                        pb.x = cvtpk(sc[kt][8 * s2 + 0], sc[kt][8 * s2 + 1]); pb.y = cvtpk(sc[kt][8 * s2 + 2], sc[kt][8 * s2 + 3]);
                        pb.z = cvtpk(sc[kt][8 * s2 + 4], sc[kt][8 * s2 + 5]); pb.w = cvtpk(sc[kt][8 * s2 + 6], sc[kt][8 * s2 + 7]);
                        const int kloc = 32 * qt + 32 * kt + 16 * s2 + 4 * hh;
#pragma unroll
                        for (int dt = 0; dt < 2; ++dt) {
                            const char* vp = Vt + (dt * 32 + l31) * VTS + kloc * 2;
                            const uint2 v0 = *(const uint2*)vp, v1 = *(const uint2*)(vp + 16);
                            const bf16x8 vf = __builtin_bit_cast(bf16x8, make_uint4(v0.x, v0.y, v1.x, v1.y));
                            oacc[dt] = __builtin_amdgcn_mfma_f32_32x32x16_bf16(vf, __builtin_bit_cast(bf16x8, pb), oacc[dt], 0, 0, 0);
                        }
                    }
                bf16_t* orow = mix + (size_t)(b * SEQ + tq) * DM + h * 64;
#pragma unroll
                for (int dt = 0; dt < 2; ++dt)
#pragma unroll
                    for (int q = 0; q < 4; ++q) {
                        uint2 o; o.x = cvtpk(oacc[dt][4 * q] * inv, oacc[dt][4 * q + 1] * inv); o.y = cvtpk(oacc[dt][4 * q + 2] * inv, oacc[dt][4 * q + 3] * inv);
                        *(uint2*)(orow + dt * 32 + 8 * q + 4 * hh) = o;
                    }
            }
        } else {
            const int v = u - N_ATT, prod = 2 - (v >> 7), mt = v & 31, nt = (v >> 5) & 3;
            const int row0 = mt * 256, col0 = nt * 256 + wave * 32, li = lane & 15, lg = lane >> 4;
            const int koff = prod == 0 ? 3072 : (prod == 1 ? 3136 : 3200), nk = prod == 2 ? 5 : 2;
            const float* W = prod == 0 ? p.wd_up : (prod == 1 ? p.wa_up : p.wg_up);
            const float* bp0 = W + (size_t)(8 * lg) * RW + col0 + li; const float* bp1 = bp0 + 16;
            const int srow = row0 + (tid >> 2), scol = koff + (tid & 3) * 8;
            auto aload = [&](int i, int kt) -> uint4 {
                const int tok = srow + 128 * i, c = scol + kt * 32;
                const uint4 zc = *(const uint4*)(z + (size_t)tok * INC + ZC_RW + c);
                uint4 zp = make_uint4(0u, 0u, 0u, 0u);
                if (tok & (SEQ - 1)) zp = *(const uint4*)(z + (size_t)(tok - 1) * INC + ZC_RW + c);
                const float4 m0 = *(const float4*)(p.mu + c), m1 = *(const float4*)(p.mu + c + 4);
                const float a[8] = {bflo(zc.x), bfhi(zc.x), bflo(zc.y), bfhi(zc.y), bflo(zc.z), bfhi(zc.z), bflo(zc.w), bfhi(zc.w)};
                const float q[8] = {bflo(zp.x), bfhi(zp.x), bflo(zp.y), bfhi(zp.y), bflo(zp.z), bfhi(zp.z), bflo(zp.w), bfhi(zp.w)};
                const float mm[8] = {m0.x, m0.y, m0.z, m0.w, m1.x, m1.y, m1.z, m1.w};
                float o[8];
#pragma unroll
                for (int e = 0; e < 8; ++e) {
                    const float zs = a[e] + (q[e] - a[e]) * mm[e];
                    o[e] = prod == 0 ? (1.f - 2.f / (1.f + __expf(2.f * zs))) : (prod == 1 ? zs : sigmoidf_(zs));
                }
                return make_uint4(cvtpk(o[0], o[1]), cvtpk(o[2], o[3]), cvtpk(o[4], o[5]), cvtpk(o[6], o[7]));
            };
            float* LWb = (float*)(p.ws + WS_LW); bf16_t* AVb = (bf16_t*)(p.ws + WS_AV); bf16_t* GVb = (bf16_t*)(p.ws + WS_GV);
            gemm_tile_f<1, 2>(smem, nk, RW, bp0, bp1, aload, [&](f32x4 (&acc)[16][2]) {
#pragma unroll
                for (int nf = 0; nf < 2; ++nf) {
                    const int col = col0 + nf * 16 + 4 * lg;
                    const float4 w0c = *(const float4*)(p.w0 + col), a0c = *(const float4*)(p.a0 + col);
                    const float wc[4] = {w0c.x, w0c.y, w0c.z, w0c.w}, ac[4] = {a0c.x, a0c.y, a0c.z, a0c.w};
#pragma unroll
                    for (int m = 0; m < 16; ++m) {
                        const size_t o = (size_t)(row0 + 16 * m + li) * RW + col;
                        if (prod == 0) {
                            float r[4];
#pragma unroll
                            for (int e = 0; e < 4; ++e) r[e] = -0.60653065971f * sigmoidf_(wc[e] + acc[m][nf][e]);
                            *(float4*)(LWb + o) = make_float4(r[0], r[1], r[2], r[3]);
                        } else if (prod == 1) {
                            uint2 ob; ob.x = cvtpk(sigmoidf_(ac[0] + acc[m][nf][0]), sigmoidf_(ac[1] + acc[m][nf][1])); ob.y = cvtpk(sigmoidf_(ac[2] + acc[m][nf][2]), sigmoidf_(ac[3] + acc[m][nf][3]));
                            *(uint2*)(AVb + o) = ob;
                        } else {
                            uint2 ob; ob.x = cvtpk(acc[m][nf][0], acc[m][nf][1]); ob.y = cvtpk(acc[m][nf][2], acc[m][nf][3]);
                            *(uint2*)(GVb + o) = ob;
                        }
                    }
                }
            });
        }
    }
}
DEVI void phase3(const Params& p, char* smem) {
    for (int v = blockIdx.x; v < 384; v += gridDim.x) p3_unit(p, smem, 256 + v);
}

DEVI void phase4(const Params& p, char* smem) {
    const int tid = threadIdx.x, lane = tid & 63, wave = tid >> 6;
    const float* const pAA = (const float*)(p.ws + WS_AA); const float* const pDE = (const float*)(p.ws + WS_DEC); const float* const pBB = (const float*)(p.ws + WS_BB);
    const float* const pK2 = (const float*)(p.ws + WS_K2); const float* const pR = (const float*)(p.ws + WS_R); const float* const pV = (const float*)(p.ws + WS_V);
    float* Y = (float*)(p.ws + WS_Y);
    constexpr int CH = 32;
    float* bufs = (float*)smem;
    for (int u = blockIdx.x; u < 32; u += gridDim.x) {
        const int b = u >> 4, h = u & 15;
        const int vr = lane >> 2, kq = lane & 3;
        float s[16];
#pragma unroll
        for (int j = 0; j < 16; ++j) s[j] = 0.f;
        __syncthreads();
        const int lst = tid >> 4, lc4 = tid & 15;
        const size_t goff = (size_t)(b * SEQ + lst) * RW + h * 64 + lc4 * 4;
        const int loff = lst * 64 + lc4 * 4;
        {
            *(float4*)(bufs + 0 * CH * 64 + loff) = *(const float4*)(pAA + goff); *(float4*)(bufs + 1 * CH * 64 + loff) = *(const float4*)(pDE + goff);
            *(float4*)(bufs + 2 * CH * 64 + loff) = *(const float4*)(pBB + goff); *(float4*)(bufs + 3 * CH * 64 + loff) = *(const float4*)(pK2 + goff);
            *(float4*)(bufs + 4 * CH * 64 + loff) = *(const float4*)(pR + goff); *(float4*)(bufs + 5 * CH * 64 + loff) = *(const float4*)(pV + goff);
        }
        __syncthreads();
        for (int c = 0; c < SEQ / CH; ++c) {
            float* cur = bufs + (c & 1) * (6 * CH * 64);
            float* nxt = bufs + ((c + 1) & 1) * (6 * CH * 64);
            float4 pre0, pre1, pre2, pre3, pre4, pre5;
            if (c + 1 < SEQ / CH) {
                const size_t g2 = goff + (size_t)(c + 1) * CH * RW;
                pre0 = *(const float4*)(pAA + g2); pre1 = *(const float4*)(pDE + g2); pre2 = *(const float4*)(pBB + g2);
                pre3 = *(const float4*)(pK2 + g2); pre4 = *(const float4*)(pR + g2); pre5 = *(const float4*)(pV + g2);
            }
            if (wave < 4) {
                for (int st = 0; st < CH; ++st) {
                    const float* aa = cur + (0 * CH + st) * 64 + kq * 16;
                    const float* de = cur + (1 * CH + st) * 64 + kq * 16;
                    const float* bb = cur + (2 * CH + st) * 64 + kq * 16;
                    const float* k2 = cur + (3 * CH + st) * 64 + kq * 16;
                    const float* rr = cur + (4 * CH + st) * 64 + kq * 16;
                    const float v = cur[(5 * CH + st) * 64 + wave * 16 + vr];
                    float sa = 0.f;
#pragma unroll
                    for (int j = 0; j < 16; ++j) sa += s[j] * aa[j];
                    sa += __shfl_xor(sa, 1, 64); sa += __shfl_xor(sa, 2, 64);
                    float y = 0.f;
#pragma unroll
                    for (int j = 0; j < 16; ++j) { s[j] = s[j] * de[j] + sa * bb[j] + v * k2[j]; y += s[j] * rr[j]; }
                    y += __shfl_xor(y, 1, 64); y += __shfl_xor(y, 2, 64);
                    if (kq == 0) Y[(size_t)(b * SEQ + c * CH + st) * RW + h * 64 + wave * 16 + vr] = y;
                }
            }
            if (c + 1 < SEQ / CH) {
                *(float4*)(nxt + 0 * CH * 64 + loff) = pre0; *(float4*)(nxt + 1 * CH * 64 + loff) = pre1; *(float4*)(nxt + 2 * CH * 64 + loff) = pre2;
                *(float4*)(nxt + 3 * CH * 64 + loff) = pre3; *(float4*)(nxt + 4 * CH * 64 + loff) = pre4; *(float4*)(nxt + 5 * CH * 64 + loff) = pre5;
            }
            __syncthreads();
        }
    }
}

DEVI void phase5(const Params& p, char* smem) {
    const int tid = threadIdx.x, lane = tid & 63, wave = tid >> 6;
    const float* Y = (const float*)(p.ws + WS_Y); const float* Vb = (const float*)(p.ws + WS_V); const float* Gb = (const float*)(p.ws + WS_G); const float* RKSb = (const float*)(p.ws + WS_RKS);
    bf16_t* mix = (bf16_t*)(p.ws + WS_MIX);
    for (int u = blockIdx.x; u < NTOK * 16 / 8; u += gridDim.x) {
        const int pi = u * 8 + wave, tok = pi >> 4, head = pi & 15, ch = head * 64 + lane;
        const float y = Y[(size_t)tok * RW + ch];
        const float mean = wave_sum(y) * (1.f / 64.f);
        const float d = y - mean;
        const float var = wave_sum(d * d) * (1.f / 64.f);
        const float yn = d * rsqrtf(var + 64e-5f) * p.ln_w[ch] + p.ln_b[ch];
        const float o = (yn + RKSb[tok * 16 + head] * Vb[(size_t)tok * RW + ch]) * Gb[(size_t)tok * RW + ch];
        mix[(size_t)tok * DM + 1024 + ch] = (bf16_t)(cvtpk(o, 0.f) & 0xffffu);
    }
}


constexpr int RA_AT = 0, RA_BT = 8192, RA_KT = 16384, RA_RT = 24576, RA_BPT = 32768, RA_KPT = 40960, RA_VT = 49152, RA_AAK = 57344, RA_ARB = 65536, RA_ARK = 73728,
              RA_AABP = 81920, RA_RHS = 98304, RA_WL = 131072, RA_SEG = 131328, RA_P1T = RA_BT, RA_P2T = RA_KT, RA_CUM = RA_AABP;

DEVI void phaseRA(const Params& p, char* smem) {
    const int tid = threadIdx.x, lane = tid & 63, wave = tid >> 6, l31 = lane & 31, hh = lane >> 5;
    const bf16_t* z = (const bf16_t*)(p.ws + WS_Z);
    float* cumb = (float*)(smem + RA_CUM); float* segs = (float*)(smem + RA_SEG); float* wl = (float*)(smem + RA_WL);
    float* rhs = (float*)(smem + RA_RHS); float* aabp = (float*)(smem + RA_AABP);
    uint4 n_cr, n_ck, n_cv, n_pr, n_pk, n_pv, n_au; float4 n_lw0, n_lw1;
    auto load_raw = [&](int unit_) {
        const int bh_ = unit_ >> 6, c_ = unit_ & 63, b_ = bh_ >> 4, h_ = bh_ & 15;
        const int tok = b_ * SEQ + c_ * 64 + (tid >> 3), ch0 = h_ * 64 + (tid & 7) * 8;
        const bf16_t* zr = z + (size_t)tok * INC + ZC_RW + ch0;
        const bool hasp = (tok & (SEQ - 1)) != 0;
        const uint4 zero4 = make_uint4(0u, 0u, 0u, 0u);
        n_cr = *(const uint4*)zr; n_ck = *(const uint4*)(zr + 1024); n_cv = *(const uint4*)(zr + 2048);
        n_pr = hasp ? *(const uint4*)(zr - INC) : zero4; n_pk = hasp ? *(const uint4*)(zr - INC + 1024) : zero4; n_pv = hasp ? *(const uint4*)(zr - INC + 2048) : zero4;
        n_au = *(const uint4*)((const bf16_t*)(p.ws + WS_AV) + (size_t)tok * RW + ch0);
        const float* lwp = (const float*)(p.ws + WS_LW) + (size_t)tok * RW + ch0;
        n_lw0 = *(const float4*)lwp; n_lw1 = *(const float4*)(lwp + 4);
    };
    if (((int)blockIdx.x >> 3) < 256) load_raw((((int)blockIdx.x & 7) + 8 * (((int)blockIdx.x >> 3) >> 6)) * 64 + (((int)blockIdx.x >> 3) & 63));
    const int ra_x = (int)blockIdx.x & 7, ra_slot = (int)blockIdx.x >> 3, ra_nslot = ((int)gridDim.x - ra_x + 7) >> 3;
    for (int uu = ra_slot; uu < 256; uu += ra_nslot) {
        const int bh = ra_x + 8 * (uu >> 6), c = uu & 63, b = bh >> 4, h = bh & 15;
        const int unit = bh * 64 + c;
        const int tokbase = b * SEQ + c * 64;
        __syncthreads();
        const int t = tid >> 3, c8 = tid & 7;
        float r_[8], k2[8], v_[8], aa[8], bb[8], lw[8];
        {
            const int tok = tokbase + t, ch0 = h * 64 + c8 * 8;
            const uint4 cr = n_cr, ck = n_ck, cv = n_cv, pr = n_pr, pk_ = n_pk, pv = n_pv, au = n_au;
            float fr[8], fk[8], fpr[8], fpk[8], fpv[8], mur[8], muk[8], muv[8], av[8], kkc[8], kac[8], rkc[8];
#define UNPK8(dst, u) { dst[0] = bflo(u.x); dst[1] = bfhi(u.x); dst[2] = bflo(u.y); dst[3] = bfhi(u.y); dst[4] = bflo(u.z); dst[5] = bfhi(u.z); dst[6] = bflo(u.w); dst[7] = bfhi(u.w); }
#define LDF8(dst, ptr) { const float4 q0_ = *(const float4*)(ptr), q1_ = *(const float4*)((ptr) + 4); dst[0] = q0_.x; dst[1] = q0_.y; dst[2] = q0_.z; dst[3] = q0_.w; dst[4] = q1_.x; dst[5] = q1_.y; dst[6] = q1_.z; dst[7] = q1_.w; }
            UNPK8(fr, cr) UNPK8(fk, ck) UNPK8(v_, cv) UNPK8(fpr, pr) UNPK8(fpk, pk_) UNPK8(fpv, pv) UNPK8(av, au)
            LDF8(mur, p.mu + ch0) LDF8(muk, p.mu + 1024 + ch0) LDF8(muv, p.mu + 2048 + ch0)
            LDF8(kkc, p.k_k + ch0) LDF8(kac, p.k_a + ch0) LDF8(rkc, p.r_k + ch0)
            lw[0] = n_lw0.x; lw[1] = n_lw0.y; lw[2] = n_lw0.z; lw[3] = n_lw0.w; lw[4] = n_lw1.x; lw[5] = n_lw1.y; lw[6] = n_lw1.z; lw[7] = n_lw1.w;
            float ssq = 0.f, rk = 0.f, kk[8];
#pragma unroll
            for (int i = 0; i < 8; ++i) {
                r_[i] = fr[i] + (fpr[i] - fr[i]) * mur[i];
                const float kx = fk[i] + (fpk[i] - fk[i]) * muk[i];
                v_[i] = v_[i] + (fpv[i] - v_[i]) * muv[i];
                kk[i] = kx * kkc[i]; ssq += kk[i] * kk[i];
                k2[i] = kx * (1.f + (av[i] - 1.f) * kac[i]);
                rk += r_[i] * k2[i] * rkc[i];
            }
            ssq += dpp_xor1(ssq); ssq += dpp_xor2(ssq); ssq += __shfl_xor(ssq, 4, 64);
            rk += dpp_xor1(rk); rk += dpp_xor2(rk); rk += __shfl_xor(rk, 4, 64);
            const float invn = 1.f / fmaxf(sqrtf(ssq), 1e-12f);
#pragma unroll
            for (int i = 0; i < 8; ++i) { const float kn = kk[i] * invn; aa[i] = -kn; bb[i] = kn * av[i]; }
            if (c8 == 0) ((float*)(p.ws + WS_RKS))[tok * 16 + h] = rk;
        }
#pragma unroll
        for (int i = 0; i < 8; ++i) cumb[t * 64 + c8 * 8 + i] = lw[i];
        __syncthreads();
        if (uu + ra_nslot < 256) { const int u2 = uu + ra_nslot; load_raw((ra_x + 8 * (u2 >> 6)) * 64 + (u2 & 63)); }
        {
            const int ch = tid & 63, seg = tid >> 6;
            float loc[8]; float run = 0.f;
#pragma unroll
            for (int j = 0; j < 8; ++j) { run += cumb[(seg * 8 + j) * 64 + ch]; loc[j] = run; }
            segs[seg * 64 + ch] = run;
            __syncthreads();
            float off = 0.f;
#pragma unroll
            for (int s2 = 0; s2 < 8; ++s2) off += (s2 < seg) ? segs[s2 * 64 + ch] : 0.f;
#pragma unroll
            for (int j = 0; j < 8; ++j) cumb[(seg * 8 + j) * 64 + ch] = off + loc[j];
        }
        __syncthreads();
        {
            unsigned pk[7][4];
            float atf[8];
#pragma unroll
            for (int i = 0; i < 8; i += 2) {
                float o[7][2];
#pragma unroll
                for (int e = 0; e < 2; ++e) {
                    const float cu = cumb[t * 64 + c8 * 8 + i + e], cl = cumb[63 * 64 + c8 * 8 + i + e];
                    const float e1 = __expf(cu), e2 = 1.f / e1, ex = __expf(cu - lw[i + e]), ew = __expf(cl - cu);
                    o[0][e] = aa[i + e] * ex; o[1][e] = bb[i + e] * e2; o[2][e] = k2[i + e] * e2; o[3][e] = r_[i + e] * e1;
                    o[4][e] = bb[i + e] * ew; o[5][e] = k2[i + e] * ew; o[6][e] = v_[i + e];
                    atf[i + e] = o[0][e];
                    if (t == 63) wl[c8 * 8 + i + e] = e1;
                }
#pragma unroll
                for (int m = 0; m < 7; ++m) pk[m][i >> 1] = cvtpk(o[m][0], o[m][1]);
            }
            const unsigned ro = m64_off(t, c8);
            *(uint4*)(smem + RA_AT + ro) = make_uint4(pk[0][0], pk[0][1], pk[0][2], pk[0][3]);
            *(uint4*)(smem + RA_BT + ro) = make_uint4(pk[1][0], pk[1][1], pk[1][2], pk[1][3]);
            *(uint4*)(smem + RA_KT + ro) = make_uint4(pk[2][0], pk[2][1], pk[2][2], pk[2][3]);
            *(uint4*)(smem + RA_RT + ro) = make_uint4(pk[3][0], pk[3][1], pk[3][2], pk[3][3]);
            *(float4*)(rhs + t * 128 + c8 * 8) = make_float4(atf[0], atf[1], atf[2], atf[3]);
            *(float4*)(rhs + t * 128 + c8 * 8 + 4) = make_float4(atf[4], atf[5], atf[6], atf[7]);
#pragma unroll
            for (int i = 0; i < 8; ++i) {
                const int ch = c8 * 8 + i;
                const unsigned to = m64_off(ch, t >> 3) + (t & 7) * 2;
                const unsigned w4 = pk[4][i >> 1], w5 = pk[5][i >> 1], w6 = pk[6][i >> 1];
                *(bf16_t*)(smem + RA_BPT + to) = (bf16_t)((i & 1) ? (w4 >> 16) : (w4 & 0xffffu));
                *(bf16_t*)(smem + RA_KPT + to) = (bf16_t)((i & 1) ? (w5 >> 16) : (w5 & 0xffffu));
                *(bf16_t*)(smem + RA_VT + to) = (bf16_t)((i & 1) ? (w6 >> 16) : (w6 & 0xffffu));
            }
        }
        __syncthreads();
        {
            const int pr = wave >> 1, sub = wave & 1;
            const char* X = smem + ((pr & 1) ? RA_KT : RA_BT);
            const char* Y = smem + ((pr & 2) ? RA_RT : RA_AT);
            const int incl = (pr & 2) ? 1 : 0;
            char* dst = smem + (pr == 1 ? RA_AAK : pr == 2 ? RA_ARB : RA_ARK);
#pragma unroll
            for (int tt = 0; tt < 2; ++tt) {
                const int i0 = sub ? (tt ? 32 : 0) : (tt ? 32 : 0);
                const int t0 = sub ? (tt ? 0 : 32) : (tt ? 32 : 0);
                const bool zero_tile = sub && tt;
                f32x16 acc = zero16();
                if (!zero_tile) mm_tile(acc, X, i0, Y, t0, l31, hh);
                const int tq = t0 + l31;
#pragma unroll
                for (int q = 0; q < 4; ++q) {
                    float vv[4];
#pragma unroll
                    for (int e = 0; e < 4; ++e) { const int ii = i0 + 8 * q + 4 * hh + e; vv[e] = (ii < tq + incl) ? acc[4 * q + e] : 0.f; }
                    if (pr == 0) {
                        if (!zero_tile) {
#pragma unroll
                            for (int e = 0; e < 4; ++e) aabp[tq * 64 + e * 16 + (i0 >> 2) + 2 * q + hh] = vv[e];
                        }
                    } else {
                        uint2 o; o.x = cvtpk(vv[0], vv[1]); o.y = cvtpk(vv[2], vv[3]);
                        *(uint2*)(dst + m64_off(tq, (i0 >> 3) + q) + 8 * hh) = o;
                    }
                }
            }
        }
        __syncthreads();
        f32x16 accA = zero16();
        const int w4 = wave & 3, ta = w4 & 1, tb2 = w4 >> 1;
        if (wave < 4) {
            f32x16 x2 = zero16();
            mm_tile(x2, smem + RA_VT, ta * 32, smem + RA_AAK, tb2 * 32, l31, hh);
            const int tq = tb2 * 32 + l31;
#pragma unroll
            for (int q = 0; q < 4; ++q) *(float4*)(rhs + tq * 128 + 64 + ta * 32 + 8 * q + 4 * hh) = make_float4(x2[4 * q], x2[4 * q + 1], x2[4 * q + 2], x2[4 * q + 3]);
            mm_tile(accA, smem + RA_VT, ta * 32, smem + RA_ARK, tb2 * 32, l31, hh);
        } else {
            mm_tile(accA, smem + RA_KPT, ta * 32, smem + RA_VT, tb2 * 32, l31, hh);
        }
        __syncthreads();
        {
            const int g = lane & 3, col = wave * 16 + (lane >> 2);
            float P[16];
#pragma unroll
            for (int q = 0; q < 16; ++q) P[q] = 0.f;
            float last[4];
            char* pt = smem + (col < 64 ? RA_P1T : RA_P2T);
            const int prow = col & 63;
            float4 acur[4]; float rcur = rhs[col];
#pragma unroll
            for (int q4 = 0; q4 < 4; ++q4) acur[q4] = make_float4(0.f, 0.f, 0.f, 0.f);
#pragma unroll
            for (int ts = 0; ts < 64; ++ts) {
                float4 anxt[4]; float rnxt = 0.f;
#pragma unroll
                for (int q4 = 0; q4 < 4; ++q4) anxt[q4] = make_float4(0.f, 0.f, 0.f, 0.f);
                if (ts + 1 < 64) {
                    const int nq4n = (((ts + 4) >> 2) + 3) >> 2;
#pragma unroll
                    for (int q4 = 0; q4 < nq4n; ++q4) anxt[q4] = *(const float4*)(aabp + (ts + 1) * 64 + g * 16 + q4 * 4);
                    rnxt = rhs[(ts + 1) * 128 + col];
                }
                float part = 0.f;
                const int nq4 = (((ts + 3) >> 2) + 3) >> 2;
#pragma unroll
                for (int q4 = 0; q4 < nq4; ++q4) {
                    const float4 a = acur[q4];
                    part += a.x * P[4 * q4] + a.y * P[4 * q4 + 1] + a.z * P[4 * q4 + 2] + a.w * P[4 * q4 + 3];
                }
                part += dpp_xor1(part); part += dpp_xor2(part);
                const float val = rcur + part;
#pragma unroll
                for (int q4 = 0; q4 < 4; ++q4) acur[q4] = anxt[q4];
                rcur = rnxt;
                if (g == (ts & 3)) P[ts >> 2] = val;
                last[ts & 3] = val;
                if ((ts & 3) == 3 && g == 0) {
                    uint2 o; o.x = cvtpk(last[0], last[1]); o.y = cvtpk(last[2], last[3]);
                    *(uint2*)(pt + m64_off(prow, ts >> 3) + ((ts >> 2) & 1) * 8) = o;
                }
            }
        }
        __syncthreads();
        if (wave < 4) {
            mm_tile(accA, smem + RA_P2T, ta * 32, smem + RA_ARB, tb2 * 32, l31, hh);
            float* q2 = (float*)(p.ws + WS_Q2) + ((size_t)unit * 4 + (ta * 2 + tb2)) * 1024;
#pragma unroll
            for (int i = 0; i < 16; ++i) q2[i * 64 + lane] = accA[i];
            f32x16 q1 = zero16();
            mm_tile(q1, smem + RA_P1T, ta * 32, smem + RA_ARB, tb2 * 32, l31, hh);
            const int tq = tb2 * 32 + l31;
            bf16_t* q1g = (bf16_t*)(p.ws + WS_Q1) + (size_t)unit * 4096 + tq * 64;
#pragma unroll
            for (int q = 0; q < 4; ++q) {
                const int k0 = ta * 32 + 8 * q + 4 * hh;
                const uint2 rr = *(const uint2*)(smem + RA_RT + m64_off(tq, k0 >> 3) + (k0 & 7) * 2);
                uint2 o; o.x = cvtpk(q1[4 * q] + bflo(rr.x), q1[4 * q + 1] + bfhi(rr.x)); o.y = cvtpk(q1[4 * q + 2] + bflo(rr.y), q1[4 * q + 3] + bfhi(rr.y));
                *(uint2*)(q1g + k0) = o;
            }
        } else {
            mm_tile(accA, smem + RA_BPT, ta * 32, smem + RA_P2T, tb2 * 32, l31, hh);
            unsigned* hb = (unsigned*)(p.ws + WS_HB) + ((size_t)unit * 4 + (ta * 2 + tb2)) * 512;
#pragma unroll
            for (int j = 0; j < 8; ++j) hb[j * 64 + lane] = cvtpk(accA[2 * j], accA[2 * j + 1]);
            f32x16 gg = zero16();
            mm_tile(gg, smem + RA_P1T, ta * 32, smem + RA_BPT, tb2 * 32, l31, hh);
            if (ta == tb2) {
#pragma unroll
                for (int i = 0; i < 16; ++i) { const int kk = (i & 3) + 8 * (i >> 2) + 4 * hh; if (kk == l31) gg[i] += wl[ta * 32 + kk]; }
            }
            unsigned* gb = (unsigned*)(p.ws + WS_GB) + ((size_t)unit * 4 + (ta * 2 + tb2)) * 512 + lane * 8;
            uint4 o0, o1;
            o0.x = cvtpk(gg[0], gg[1]); o0.y = cvtpk(gg[2], gg[3]); o0.z = cvtpk(gg[4], gg[5]); o0.w = cvtpk(gg[6], gg[7]);
            o1.x = cvtpk(gg[8], gg[9]); o1.y = cvtpk(gg[10], gg[11]); o1.z = cvtpk(gg[12], gg[13]); o1.w = cvtpk(gg[14], gg[15]);
            *(uint4*)(gb) = o0; *(uint4*)(gb + 4) = o1;
        }
    }
}

struct RbH { unsigned w[2][8]; };
DEVI void rb_load(const Params& p, int unit, int vh, int lane, uint4 (&g)[8], RbH& hq) {
    const unsigned* gb = (const unsigned*)(p.ws + WS_GB) + (size_t)unit * 2048 + lane * 8;
    const unsigned* hb = (const unsigned*)(p.ws + WS_HB) + (size_t)unit * 2048 + lane;
#pragma unroll
    for (int t4 = 0; t4 < 4; ++t4) { g[2 * t4] = *(const uint4*)(gb + t4 * 512); g[2 * t4 + 1] = *(const uint4*)(gb + t4 * 512 + 4); }
#pragma unroll
    for (int j = 0; j < 8; ++j) { hq.w[0][j] = hb[(0 * 2 + vh) * 512 + j * 64]; hq.w[1][j] = hb[(1 * 2 + vh) * 512 + j * 64]; }
}
DEVI void rb_store(const Params& p, int unit, int vh, int l31, int hh, const f32x16& X0, const f32x16& X1) {
    bf16_t* s0 = (bf16_t*)(p.ws + WS_S0) + (size_t)unit * 4096 + (vh * 32 + l31) * 64;
#pragma unroll
    for (int q = 0; q < 4; ++q) {
        uint2 o; o.x = cvtpk(X0[4 * q], X0[4 * q + 1]); o.y = cvtpk(X0[4 * q + 2], X0[4 * q + 3]);
        *(uint2*)(s0 + 8 * q + 4 * hh) = o;
        uint2 o2; o2.x = cvtpk(X1[4 * q], X1[4 * q + 1]); o2.y = cvtpk(X1[4 * q + 2], X1[4 * q + 3]);
        *(uint2*)(s0 + 32 + 8 * q + 4 * hh) = o2;
    }
}
#define BF8(u) __builtin_bit_cast(bf16x8, u)
DEVI void rb_step(f32x16& X0, f32x16& X1, const uint4 (&g)[8], const RbH& hq) {
    uint4 xa, xb, xc, xd;
    xa.x = cvtpk(X0[0], X0[1]); xa.y = cvtpk(X0[2], X0[3]); xa.z = cvtpk(X0[4], X0[5]); xa.w = cvtpk(X0[6], X0[7]);
    xb.x = cvtpk(X0[8], X0[9]); xb.y = cvtpk(X0[10], X0[11]); xb.z = cvtpk(X0[12], X0[13]); xb.w = cvtpk(X0[14], X0[15]);
    xc.x = cvtpk(X1[0], X1[1]); xc.y = cvtpk(X1[2], X1[3]); xc.z = cvtpk(X1[4], X1[5]); xc.w = cvtpk(X1[6], X1[7]);
    xd.x = cvtpk(X1[8], X1[9]); xd.y = cvtpk(X1[10], X1[11]); xd.z = cvtpk(X1[12], X1[13]); xd.w = cvtpk(X1[14], X1[15]);
    f32x16 N0, N1;
#pragma unroll
    for (int j = 0; j < 8; ++j) { N0[2 * j] = bflo(hq.w[0][j]); N0[2 * j + 1] = bfhi(hq.w[0][j]); N1[2 * j] = bflo(hq.w[1][j]); N1[2 * j + 1] = bfhi(hq.w[1][j]); }
    N0 = __builtin_amdgcn_mfma_f32_32x32x16_bf16(BF8(g[0]), BF8(xa), N0, 0, 0, 0);
    N1 = __builtin_amdgcn_mfma_f32_32x32x16_bf16(BF8(g[2]), BF8(xa), N1, 0, 0, 0);
    N0 = __builtin_amdgcn_mfma_f32_32x32x16_bf16(BF8(g[1]), BF8(xb), N0, 0, 0, 0);
    N1 = __builtin_amdgcn_mfma_f32_32x32x16_bf16(BF8(g[3]), BF8(xb), N1, 0, 0, 0);
    N0 = __builtin_amdgcn_mfma_f32_32x32x16_bf16(BF8(g[4]), BF8(xc), N0, 0, 0, 0);
    N1 = __builtin_amdgcn_mfma_f32_32x32x16_bf16(BF8(g[6]), BF8(xc), N1, 0, 0, 0);
    N0 = __builtin_amdgcn_mfma_f32_32x32x16_bf16(BF8(g[5]), BF8(xd), N0, 0, 0, 0);
    N1 = __builtin_amdgcn_mfma_f32_32x32x16_bf16(BF8(g[7]), BF8(xd), N1, 0, 0, 0);
    X0 = N0; X1 = N1;
}
DEVI void phaseRB_core(const Params& p, char* smem) {
    const int tid = threadIdx.x, lane = tid & 63, wave = tid >> 6, l31 = lane & 31, hh = lane >> 5;
    if (wave != 0) return;
    for (int wu = blockIdx.x; wu < 64; wu += gridDim.x) {
        const int bh = (wu & 7) | ((wu >> 4) << 3), vh = (wu >> 3) & 1;
        f32x16 X0 = zero16(), X1 = zero16();
        uint4 gA[8], gB[8], gC[8]; RbH hA, hB, hC;
        rb_load(p, bh * 64, vh, lane, gA, hA);
        rb_load(p, bh * 64 + 1, vh, lane, gB, hB);
        for (int c = 0; c < 63; c += 3) {
            rb_load(p, bh * 64 + (c + 2 < 64 ? c + 2 : 63), vh, lane, gC, hC);
            rb_store(p, bh * 64 + c, vh, l31, hh, X0, X1);
            rb_step(X0, X1, gA, hA);
            rb_load(p, bh * 64 + (c + 3 < 64 ? c + 3 : 63), vh, lane, gA, hA);
            rb_store(p, bh * 64 + c + 1, vh, l31, hh, X0, X1);
            rb_step(X0, X1, gB, hB);
            rb_load(p, bh * 64 + (c + 4 < 64 ? c + 4 : 63), vh, lane, gB, hB);
            rb_store(p, bh * 64 + c + 2, vh, l31, hh, X0, X1);
            rb_step(X0, X1, gC, hC);
        }
        rb_store(p, bh * 64 + 63, vh, l31, hh, X0, X1);
    }
}

DEVI void phaseRB(const Params& p, char* smem) {
    const bool split = gridDim.x >= 128;
    if (split && blockIdx.x < 64) { phaseRB_core(p, smem); return; }
    const int nw = split ? (int)gridDim.x - 64 : (int)gridDim.x, wi = split ? (int)blockIdx.x - 64 : (int)blockIdx.x;
    for (int u = wi; u < 256; u += nw) p3_unit(p, smem, u);
    if (!split) { __syncthreads(); phaseRB_core(p, smem); }
}

DEVI void phaseRC(const Params& p, char* smem) {
    const int tid = threadIdx.x, lane = tid & 63, wave = tid >> 6, l31 = lane & 31, hh = lane >> 5;
    const bf16_t* z = (const bf16_t*)(p.ws + WS_Z); const bf16_t* GVb = (const bf16_t*)(p.ws + WS_GV); const float* RKSb = (const float*)(p.ws + WS_RKS);
    bf16_t* mix = (bf16_t*)(p.ws + WS_MIX);
    for (int it0 = blockIdx.x; it0 < 512 + N_SPEC; it0 += gridDim.x) {
        if (it0 < N_SPEC) { spec_unit(p, smem, it0); continue; }
        const int it = it0 - N_SPEC;
        const int unit = it * 4 + (wave >> 1), tb = wave & 1;
        const int bh = unit >> 6, c = unit & 63, b = bh >> 4, h = bh & 15;
        const int tq = tb * 32 + l31, tok = b * SEQ + c * 64 + tq;
        const float* q2 = (const float*)(p.ws + WS_Q2) + (size_t)unit * 4096 + lane;
        f32x16 a0, a1;
#pragma unroll
        for (int i = 0; i < 16; ++i) { a0[i] = q2[(0 * 2 + tb) * 1024 + i * 64]; a1[i] = q2[(1 * 2 + tb) * 1024 + i * 64]; }
        const bf16_t* s0 = (const bf16_t*)(p.ws + WS_S0) + (size_t)unit * 4096;
        const bf16_t* q1 = (const bf16_t*)(p.ws + WS_Q1) + (size_t)unit * 4096 + tq * 64;
#pragma unroll
        for (int s4 = 0; s4 < 4; ++s4) {
            const bf16x8 fa0 = *(const bf16x8*)(s0 + (l31) * 64 + 16 * s4 + 8 * hh);
            const bf16x8 fa1 = *(const bf16x8*)(s0 + (32 + l31) * 64 + 16 * s4 + 8 * hh);
            const bf16x8 fb = *(const bf16x8*)(q1 + 16 * s4 + 8 * hh);
            a0 = __builtin_amdgcn_mfma_f32_32x32x16_bf16(fa0, fb, a0, 0, 0, 0);
            a1 = __builtin_amdgcn_mfma_f32_32x32x16_bf16(fa1, fb, a1, 0, 0, 0);
        }
        float sm = 0.f;
#pragma unroll
        for (int i = 0; i < 16; ++i) sm += a0[i] + a1[i];
        sm = xor32_sum(sm);
        const float mean = sm * (1.f / 64.f);
        float sq = 0.f;
#pragma unroll
        for (int i = 0; i < 16; ++i) { const float d0 = a0[i] - mean, d1 = a1[i] - mean; sq += d0 * d0 + d1 * d1; }
        sq = xor32_sum(sq);
        const float rstd = rsqrtf(sq * (1.f / 64.f) + 64e-5f);
        const float rk = RKSb[tok * 16 + h];
#pragma unroll
        for (int vb = 0; vb < 2; ++vb)
#pragma unroll
            for (int q = 0; q < 4; ++q) {
                const int ch = h * 64 + vb * 32 + 8 * q + 4 * hh;
                const int hc = ch;
                const uint2 zc2 = *(const uint2*)(z + (size_t)tok * INC + ZC_RW + 2048 + hc);
                uint2 zp2 = make_uint2(0u, 0u);
                if (tok & (SEQ - 1)) zp2 = *(const uint2*)(z + (size_t)(tok - 1) * INC + ZC_RW + 2048 + hc);
                const float4 muv = *(const float4*)(p.mu + 2048 + hc);
                const uint2 g2 = *(const uint2*)(GVb + (size_t)tok * RW + hc);
                float4 vv, gv;
                vv.x = bflo(zc2.x) + (bflo(zp2.x) - bflo(zc2.x)) * muv.x; vv.y = bfhi(zc2.x) + (bfhi(zp2.x) - bfhi(zc2.x)) * muv.y;
                vv.z = bflo(zc2.y) + (bflo(zp2.y) - bflo(zc2.y)) * muv.z; vv.w = bfhi(zc2.y) + (bfhi(zp2.y) - bfhi(zc2.y)) * muv.w;
                gv.x = bflo(g2.x); gv.y = bfhi(g2.x); gv.z = bflo(g2.y); gv.w = bfhi(g2.y);
                const float4 lnw = *(const float4*)(p.ln_w + ch), lnb = *(const float4*)(p.ln_b + ch);
                float y[4];
#pragma unroll
                for (int e = 0; e < 4; ++e) y[e] = ((vb ? a1[4 * q + e] : a0[4 * q + e]) - mean) * rstd;
                uint2 o;
                o.x = cvtpk((y[0] * lnw.x + lnb.x + rk * vv.x) * gv.x, (y[1] * lnw.y + lnb.y + rk * vv.y) * gv.y);
                o.y = cvtpk((y[2] * lnw.z + lnb.z + rk * vv.z) * gv.z, (y[3] * lnw.w + lnb.w + rk * vv.w) * gv.w);
                *(uint2*)(mix + (size_t)tok * DM + 1024 + ch) = o;
            }
    }
}

DEVI void phase6(const Params& p, char* smem) {
    pg8::Gemm g{(const pg8::bf16_t*)(p.ws + WS_MIX), (const pg8::bf16_t*)(p.ws + WS_WTO), NTOK, DM, DM};
    pg8::StaticOrder S; S.init(NTOK, DM, (int)gridDim.x, (int)blockIdx.x);
    pg8::EpiX1 E{(float*)(p.ws + WS_X1), p.x, (const float*)(p.ws + WS_MODF) + 2 * DM, DM, 12288, SEQ};
    pg8::gemm_phase<pg8::EpiX1, pg8::StaticOrder, true, true>((PG8_LAS unsigned char*)smem, g, S, E);
}

DEVI void phase7(const Params& p, char* smem) {
    float* part = (float*)smem;
    float* ssq = part + 8 * 32 * 80;
    float* rstd_s = ssq + 8 * 128;
    float* lg_ = rstd_s + 32;
    const float* x1 = (const float*)(p.ws + WS_X1);
    const uint4* wrf = (const uint4*)(p.ws + WS_WRF);
    const float* cb = (const float*)(p.ws + WS_CB);
    const float* as2 = (const float*)(p.ws + WS_AS2);
    bf16_t* h = (bf16_t*)(p.ws + WS_H);
    int* cnt = (int*)(p.ws + WS_CTL + CNT_OFF);
    int* list = (int*)(p.ws + WS_LIST); float* lw = (float*)(p.ws + WS_LWT);
    const int tid = threadIdx.x, lane = tid & 63, wave = tid >> 6, li = lane & 15, lg = lane >> 4;
    for (int u = blockIdx.x; u < NTOK / 32; u += gridDim.x) {
        const int tok0 = u * 32, b = tok0 >> 12;
        __syncthreads();
        f32x4 acc[2][5];
#pragma unroll
        for (int tg = 0; tg < 2; ++tg)
#pragma unroll
            for (int nf = 0; nf < 5; ++nf) acc[tg][nf] = f32x4{0.f, 0.f, 0.f, 0.f};
        float sq[2] = {0.f, 0.f};
        const float* xr = x1 + (size_t)(tok0 + li) * DM + wave * 256 + 8 * lg;
#pragma unroll 2
        for (int s4 = 0; s4 < 8; ++s4) {
            bf16x8 ah[2], al[2];
#pragma unroll
            for (int tg = 0; tg < 2; ++tg) {
                const float4 xa = *(const float4*)(xr + (size_t)tg * 16 * DM + s4 * 32), xb = *(const float4*)(xr + (size_t)tg * 16 * DM + s4 * 32 + 4);
                sq[tg] += xa.x * xa.x + xa.y * xa.y + xa.z * xa.z + xa.w * xa.w + xb.x * xb.x + xb.y * xb.y + xb.z * xb.z + xb.w * xb.w;
                uint4 hi, lo;
                hi.x = cvtpk(xa.x, xa.y); hi.y = cvtpk(xa.z, xa.w); hi.z = cvtpk(xb.x, xb.y); hi.w = cvtpk(xb.z, xb.w);
                lo.x = cvtpk(xa.x - bflo(hi.x), xa.y - bfhi(hi.x)); lo.y = cvtpk(xa.z - bflo(hi.y), xa.w - bfhi(hi.y));
                lo.z = cvtpk(xb.x - bflo(hi.z), xb.y - bfhi(hi.z)); lo.w = cvtpk(xb.z - bflo(hi.w), xb.w - bfhi(hi.w));
                ah[tg] = __builtin_bit_cast(bf16x8, hi); al[tg] = __builtin_bit_cast(bf16x8, lo);
            }
            const uint4* wf = wrf + ((size_t)(b * 64 + wave * 8 + s4) * 5) * 128 + lane;
#pragma unroll
            for (int nf = 0; nf < 5; ++nf) {
                const bf16x8 bh = __builtin_bit_cast(bf16x8, wf[nf * 128]), bl = __builtin_bit_cast(bf16x8, wf[nf * 128 + 64]);
#pragma unroll
                for (int tg = 0; tg < 2; ++tg) {
                    acc[tg][nf] = __builtin_amdgcn_mfma_f32_16x16x32_bf16(al[tg], bh, acc[tg][nf], 0, 0, 0);
                    acc[tg][nf] = __builtin_amdgcn_mfma_f32_16x16x32_bf16(ah[tg], bl, acc[tg][nf], 0, 0, 0);
                    acc[tg][nf] = __builtin_amdgcn_mfma_f32_16x16x32_bf16(ah[tg], bh, acc[tg][nf], 0, 0, 0);
                }
            }
        }
#pragma unroll
        for (int tg = 0; tg < 2; ++tg) {
#pragma unroll
            for (int nf = 0; nf < 5; ++nf)
#pragma unroll
                for (int r = 0; r < 4; ++r) part[(wave * 32 + 16 * tg + 4 * lg + r) * 80 + nf * 16 + li] = acc[tg][nf][r];
            ssq[(wave * 4 + lg) * 32 + 16 * tg + li] = sq[tg];
        }
        __syncthreads();
        if (tid < 32) {
            float t = 0.f;
#pragma unroll
            for (int q = 0; q < 32; ++q) t += ssq[q * 32 + tid];
            rstd_s[tid] = rsqrtf(t * (1.f / DM) + 1e-6f);
        }
        __syncthreads();
        for (int idx = tid; idx < 32 * 80; idx += 512) {
            const int tk = idx / 80, j = idx % 80;
            float t = 0.f;
#pragma unroll
            for (int w = 0; w < 8; ++w) t += part[(w * 32 + tk) * 80 + j];
            lg_[idx] = rstd_s[tk] * t + cb[b * 80 + j];
        }
        __syncthreads();
        if (tid < 32) {
            const int tok = tok0 + tid;
            const float* L = lg_ + tid * 80;
            int gi = 0; float gm = L[64];
            for (int j = 1; j < 8; ++j) if (L[64 + j] > gm) { gm = L[64 + j]; gi = j; }
            float den = 0.f;
            for (int j = 0; j < 8; ++j) den += expf(L[64 + j] - gm);
            const float ggate = 1.f / den;
            const float* E = L + gi * 8;
            int i1 = 0; float m1 = E[0];
            for (int j = 1; j < 8; ++j) if (E[j] > m1) { m1 = E[j]; i1 = j; }
            int i2 = -1; float m2 = -3.0e38f;
            for (int j = 0; j < 8; ++j) if (j != i1 && E[j] > m2) { m2 = E[j]; i2 = j; }
            const float e2 = expf(m2 - m1);
            const float p1 = 1.f / (1.f + e2), p2 = e2 / (1.f + e2);
            const int ex1 = gi * 8 + i1, ex2 = gi * 8 + i2;
            const int pos1 = atomicAdd(&cnt[ex1 * CNT_ST], 1); list[ex1 * LCAP + pos1] = tok * 2; lw[ex1 * LCAP + pos1] = ggate * p1;
            const int pos2 = atomicAdd(&cnt[ex2 * CNT_ST], 1); list[ex2 * LCAP + pos2] = tok * 2 + 1; lw[ex2 * LCAP + pos2] = ggate * p2;
        }
        {
            float4 av[8], sv[8];
#pragma unroll
            for (int i = 0; i < 8; ++i) { const int k = i * 256 + lane * 4; av[i] = *(const float4*)(as2 + b * DM + k); sv[i] = *(const float4*)(as2 + 2 * DM + b * DM + k); }
#pragma unroll
            for (int tp = 0; tp < 4; tp += 2) {
                float4 xv[2][8];
#pragma unroll
                for (int t2 = 0; t2 < 2; ++t2)
#pragma unroll
                    for (int i = 0; i < 8; ++i) xv[t2][i] = *(const float4*)(x1 + (size_t)(tok0 + wave * 4 + tp + t2) * DM + i * 256 + lane * 4);
#pragma unroll
                for (int t2 = 0; t2 < 2; ++t2) {
                    const int tk = wave * 4 + tp + t2, tok = tok0 + tk;
                    const float rs = rstd_s[tk];
#pragma unroll
                    for (int i = 0; i < 8; ++i) {
                        const int k = i * 256 + lane * 4;
                        uint2 o; o.x = cvtpk(xv[t2][i].x * rs * av[i].x + sv[i].x, xv[t2][i].y * rs * av[i].y + sv[i].y); o.y = cvtpk(xv[t2][i].z * rs * av[i].z + sv[i].z, xv[t2][i].w * rs * av[i].w + sv[i].w);
                        *(uint2*)(h + (size_t)tok * DM + k) = o;
                    }
                }
            }
        }
    }
}

struct MoeTab { int cnt[64]; int sb[65]; int ubx[9]; int np[8]; };
DEVI void moe_tables(const Params& p, MoeTab* tb, int slabs) {
    const int* cnt = (const int*)(p.ws + WS_CTL + CNT_OFF);
    const int tid = threadIdx.x, x = blockIdx.x & 7;
    __syncthreads();
    if (tid < 64) tb->cnt[tid] = cnt[tid * CNT_ST];
    __syncthreads();
    if (tid == 0) {
        int sb = 0;
        for (int e = 0; e < 64; ++e) { tb->sb[e] = sb; sb += tb->cnt[e]; }
        tb->sb[64] = sb;
        int ub = 0;
        for (int i = 0; i < 8; ++i) { const int np = (tb->cnt[x + 8 * i] + 255) >> 8; tb->np[i] = np; tb->ubx[i] = ub; ub += np * slabs; }
        tb->ubx[8] = ub;
    }
    __syncthreads();
}
struct MoeUnit { int e, s, ce, sbase, rbeg, rend; };
DEVI MoeUnit moe_unit(const MoeTab* tb, int u) {
    int i = 0;
    while (tb->ubx[i + 1] <= u) ++i;
    const int rem = u - tb->ubx[i], np = tb->np[i], ps = rem % np;
    MoeUnit m; m.e = (blockIdx.x & 7) + 8 * i; m.s = rem / np; m.ce = tb->cnt[m.e]; m.sbase = tb->sb[m.e];
    const int rp = (((m.ce + np - 1) / np) + 15) & ~15;
    m.rbeg = ps * rp; m.rend = m.rbeg + rp < m.ce ? m.rbeg + rp : m.ce;
    m.e = __builtin_amdgcn_readfirstlane(m.e); m.s = __builtin_amdgcn_readfirstlane(m.s); m.ce = __builtin_amdgcn_readfirstlane(m.ce);
    m.sbase = __builtin_amdgcn_readfirstlane(m.sbase); m.rbeg = __builtin_amdgcn_readfirstlane(m.rbeg); m.rend = __builtin_amdgcn_readfirstlane(m.rend);
    return m;
}

DEVI void phase8(const Params& p, char* smem) {
    MoeTab* tb = (MoeTab*)(smem + 32768);
    const bf16_t* h = (const bf16_t*)(p.ws + WS_H);
    bf16_t* hid = (bf16_t*)(p.ws + WS_HID);
    const int* list = (const int*)(p.ws + WS_LIST);
    moe_tables(p, tb, 4);
    const int total = __builtin_amdgcn_readfirstlane(tb->ubx[8]), nslot = ((int)gridDim.x - (int)(blockIdx.x & 7) + 7) >> 3;
    for (int u = blockIdx.x >> 3; u < total; u += nslot) {
        int tid = threadIdx.x;
        asm volatile("" : "+v"(tid));
        const int lane = tid & 63, wave = tid >> 6, li = lane & 15, lg = lane >> 4;
        const MoeUnit mu = moe_unit(tb, u);
        const int e = mu.e, s = mu.s;
        const int fcol = s * 128 + wave * 16;
        const gcp_t wb0 = uniform_ptr(p.w1 + (size_t)e * DM * FF), wb1 = uniform_ptr(p.w3 + (size_t)e * DM * FF);
        const unsigned boff = (unsigned)(((8 * lg) * FF + fcol + li) * 4);
        int r0 = mu.rbeg + (tid >> 2), r1 = r0 + 128; r0 = r0 < mu.rend ? r0 : mu.rend - 1; r1 = r1 < mu.rend ? r1 : mu.rend - 1;
        const unsigned aoff0 = (unsigned)(((list[e * LCAP + r0] >> 1) * DM + (tid & 3) * 8) * 2), aoff1 = (unsigned)(((list[e * LCAP + r1] >> 1) * DM + (tid & 3) * 8) * 2);
        __syncthreads();
        gemm_tile_s<2, DM / 32, FF, 0>(smem, wb0, wb1, boff, uniform_ptr(h), aoff0, aoff1, [&](f32x4 (&acc)[16][2]) {
            int t2 = threadIdx.x;
            asm volatile("" : "+v"(t2));
            const int lio = t2 & 15, cof = ((t2 >> 6) * 16 + 4 * ((t2 >> 4) & 3));
#pragma unroll
            for (int m = 0; m < 16; ++m) {
                const int r = mu.rbeg + 16 * m + lio;
                if (r < mu.rend) {
                    float hv[4];
#pragma unroll
                    for (int q = 0; q < 4; ++q) { const float a = acc[m][0][q]; hv[q] = a / (1.f + __expf(-a)) * acc[m][1][q]; }
                    uint2 o; o.x = cvtpk(hv[0], hv[1]); o.y = cvtpk(hv[2], hv[3]);
                    *(uint2*)(hid + (size_t)(mu.sbase + r) * FF + s * 128 + cof) = o;
                }
            }
        });
    }
}

DEVI void phase9(const Params& p, char* smem) {
    MoeTab* tb = (MoeTab*)(smem + 32768);
    const bf16_t* hid = (const bf16_t*)(p.ws + WS_HID);
    bf16_t* yb = (bf16_t*)(p.ws + WS_YB);
    const int* list = (const int*)(p.ws + WS_LIST); const float* lw = (const float*)(p.ws + WS_LWT);
    moe_tables(p, tb, 8);
    const int total = __builtin_amdgcn_readfirstlane(tb->ubx[8]), nslot = ((int)gridDim.x - (int)(blockIdx.x & 7) + 7) >> 3;
    for (int u = blockIdx.x >> 3; u < total; u += nslot) {
        int tid = threadIdx.x;
        asm volatile("" : "+v"(tid));
        const int lane = tid & 63, wave = tid >> 6, li = lane & 15, lg = lane >> 4;
        const MoeUnit mu = moe_unit(tb, u);
        const int e = mu.e, s = mu.s;
        const int col0 = s * 256 + wave * 32;
        const gcp_t wb0 = uniform_ptr(p.w2 + (size_t)e * FF * DM), wb1 = wb0 + 64;
        const unsigned boff = (unsigned)(((8 * lg) * DM + col0 + li) * 4);
        int r0 = mu.rbeg + (tid >> 2), r1 = r0 + 128; r0 = r0 < mu.rend ? r0 : mu.rend - 1; r1 = r1 < mu.rend ? r1 : mu.rend - 1;
        const unsigned aoff0 = (unsigned)(((mu.sbase + r0) * FF + (tid & 3) * 8) * 2), aoff1 = (unsigned)(((mu.sbase + r1) * FF + (tid & 3) * 8) * 2);
        __syncthreads();
        gemm_tile_s<2, FF / 32, DM, 64>(smem, wb0, wb1, boff, uniform_ptr(hid), aoff0, aoff1, [&](f32x4 (&acc)[16][2]) {
            int t2 = threadIdx.x;
            asm volatile("" : "+v"(t2));
            const int lio = t2 & 15, cof = ((t2 >> 6) * 32 + 4 * ((t2 >> 4) & 3));
#pragma unroll
            for (int m = 0; m < 16; ++m) {
                const int r = mu.rbeg + 16 * m + lio;
                if (r < mu.rend) {
                    const int a = list[e * LCAP + r]; const float wgt = lw[e * LCAP + r];
#pragma unroll
                    for (int nf = 0; nf < 2; ++nf) {
                        uint2 o; o.x = cvtpk(acc[m][nf][0] * wgt, acc[m][nf][1] * wgt); o.y = cvtpk(acc[m][nf][2] * wgt, acc[m][nf][3] * wgt);
                        *(uint2*)(yb + (size_t)a * DM + s * 256 + cof + nf * 16) = o;
                    }
                }
            }
        });
    }
}

DEVI void phase10(const Params& p, char* smem) {
    const float* modf = (const float*)(p.ws + WS_MODF);
    const float* x1 = (const float*)(p.ws + WS_X1);
    const bf16_t* yb = (const bf16_t*)(p.ws + WS_YB);
    const int tid = threadIdx.x, lane = tid & 63, wave = tid >> 6;
    for (int u = blockIdx.x; u < NTOK / 8; u += gridDim.x) {
        const int tok = u * 8 + wave, b = tok >> 12;
        float4 v[8]; float ss = 0.f;
#pragma unroll
        for (int i = 0; i < 8; ++i) {
            const int k = i * 256 + lane * 4;
            const float4 xv = *(const float4*)(x1 + (size_t)tok * DM + k);
            const float4 gt = *(const float4*)(modf + b * 12288 + 5 * DM + k);
            const uint2 ya = *(const uint2*)(yb + (size_t)(tok * 2) * DM + k), yc = *(const uint2*)(yb + (size_t)(tok * 2 + 1) * DM + k);
            v[i].x = xv.x + gt.x * (bflo(ya.x) + bflo(yc.x)); v[i].y = xv.y + gt.y * (bfhi(ya.x) + bfhi(yc.x));
            v[i].z = xv.z + gt.z * (bflo(ya.y) + bflo(yc.y)); v[i].w = xv.w + gt.w * (bfhi(ya.y) + bfhi(yc.y));
            ss += v[i].x * v[i].x + v[i].y * v[i].y + v[i].z * v[i].z + v[i].w * v[i].w;
        }
        ss = wave_sum(ss);
        const float rstd = rsqrtf(ss * (1.f / DM) + 1e-6f);
#pragma unroll
        for (int i = 0; i < 8; ++i) {
            const int k = i * 256 + lane * 4;
            const float4 g = *(const float4*)(p.final_g + k);
            float4 o; o.x = v[i].x * rstd * g.x; o.y = v[i].y * rstd * g.y; o.z = v[i].z * rstd * g.z; o.w = v[i].w * rstd * g.w;
            *(float4*)(p.out + (size_t)tok * DM + k) = o;
        }
    }
}

constexpr size_t WS_BAR = 4096;
constexpr int N_PHASES = 12;
#ifndef MK_N_LAUNCHES
#define MK_N_LAUNCHES 1
#endif

__global__ void __launch_bounds__(512) mega_kernel(Params p, int lo, int hi) {
    extern __shared__ __attribute__((aligned(16))) char smem[];
    volatile LAS unsigned* xb_words = (volatile LAS unsigned*)(smem + LDS_BYTES - 16);
    if (threadIdx.x == 0) { xb_words[0] = 0u; xb_words[1] = 0u; xb_words[2] = 0u; xb_words[3] = 0u; }
    __syncthreads();
    XcdBarrier bar;
    if (hi - lo > 1) bar = xcd_barrier_post((unsigned*)(p.ws + WS_BAR), xb_words);
#define IN(k) (lo <= (k) && (k) < hi)
    unsigned long long ts_a = 0ull, ts_b = 0ull;
#define STAMP(k) do { if (PROBE_TS >= 0 && blockIdx.x == 0) { if ((k) == PROBE_TS) ts_a = __builtin_amdgcn_s_memrealtime(); if ((k) == PROBE_TS + 1) ts_b = __builtin_amdgcn_s_memrealtime(); } } while (0)
#define SEAM(k) do { if (IN(k) && IN((k) + 1)) { xcd_barrier(bar); STAMP((k) + 1); } } while (0)
    STAMP(0);
#ifndef PROBE_MASK
#define PROBE_MASK 0
#endif
#define REP(k) (((PROBE_MASK >> (k)) & 1) ? 2 : 1)
    if (IN(0)) for (int rp = 0; rp < REP(0); ++rp) phase0(p, smem);
    SEAM(0);
    if (IN(1)) for (int rp = 0; rp < REP(1); ++rp) phase1(p, smem);
    SEAM(1);
    if (IN(2)) for (int rp = 0; rp < REP(2); ++rp) phase2(p, smem);
    SEAM(2);
    if (IN(3)) for (int rp = 0; rp < REP(3); ++rp) phase3(p, smem);
    SEAM(3);
    if (IN(4)) for (int rp = 0; rp < REP(4); ++rp) phaseRA(p, smem);
    SEAM(4);
    if (IN(5)) for (int rp = 0; rp < REP(5); ++rp) phaseRB(p, smem);
    SEAM(5);
    if (IN(6)) for (int rp = 0; rp < REP(6); ++rp) phaseRC(p, smem);
    SEAM(6);
    if (IN(7)) for (int rp = 0; rp < REP(7); ++rp) phase6(p, smem);
    SEAM(7);
    if (IN(8)) phase7(p, smem);
    SEAM(8);
    if (IN(9)) for (int rp = 0; rp < REP(9); ++rp) phase8(p, smem);
    SEAM(9);
    if (IN(10)) for (int rp = 0; rp < REP(10); ++rp) phase9(p, smem);
    SEAM(10);
    if (IN(11)) for (int rp = 0; rp < REP(11); ++rp) phase10(p, smem);
    STAMP(12);
    if (PROBE_TS >= 0 && blockIdx.x == 0) { const unsigned long long t0 = __builtin_amdgcn_s_memrealtime(), dt = 2ull * (ts_b - ts_a); while (__builtin_amdgcn_s_memrealtime() - t0 < dt) __builtin_amdgcn_s_sleep(8); }
#undef IN
#undef SEAM
}

extern "C" void kernel_launch(void* const* d_in, const int* in_sizes, int n_in, void* d_out, int out_size, void* d_ws, size_t ws_size, hipStream_t stream) {
    static int grid = 0;
    if (!grid) {
        int dev = 0, cus = 0, per_cu = 0;
        (void)hipGetDevice(&dev);
        (void)hipDeviceGetAttribute(&cus, hipDeviceAttributeMultiprocessorCount, dev);
        if (hipFuncSetAttribute((const void*)mega_kernel, hipFuncAttributeMaxDynamicSharedMemorySize, LDS_BYTES) != hipSuccess) { grid = -1; return; }
        if (hipOccupancyMaxActiveBlocksPerMultiprocessor(&per_cu, (const void*)mega_kernel, 512, LDS_BYTES) != hipSuccess || per_cu < 1) { grid = -1; return; }
        grid = cus;
        if (grid > 256) grid = 256;
    }
    if (grid < 0) return;
    Params p{};
    const float* const* in = (const float* const*)d_in;
    p.x = in[0]; p.c = in[1]; p.w_ada = in[2]; p.b_ada = in[3]; p.norm1_g = in[4]; p.w_in = in[5]; p.mu = in[6]; p.sinks = in[7]; p.w0 = in[8]; p.wd_up = in[9];
    p.a0 = in[10]; p.wa_up = in[11]; p.wg_up = in[12]; p.k_k = in[13]; p.k_a = in[14]; p.r_k = in[15]; p.ln_w = in[16]; p.ln_b = in[17]; p.w_o = in[18]; p.norm2_g = in[19];
    p.w_rg = in[20]; p.b_rg = in[21]; p.w_re = in[22]; p.b_re = in[23]; p.w1 = in[24]; p.w3 = in[25]; p.w2 = in[26]; p.final_g = in[27];
    p.out = (float*)d_out; p.ws = (unsigned char*)d_ws;
    (void)hipMemsetAsync((char*)d_ws + WS_CTL, 0, CTL_BYTES, stream);
#if MK_N_LAUNCHES == 1
    hipLaunchKernelGGL(mega_kernel, dim3(grid), dim3(512), LDS_BYTES, stream, p, 0, N_PHASES);
#else
    for (int k = 0; k < N_PHASES; ++k) hipLaunchKernelGGL(mega_kernel, dim3(grid), dim3(512), LDS_BYTES, stream, p, k, k + 1);
#endif
}
```

```cpp
#ifndef PROBE_TS
#define PROBE_TS -1
#endif
#include <hip/hip_runtime.h>
#include <stdint.h>

#define DEVI __device__ __forceinline__
typedef unsigned short bf16_t;
typedef short bf16x8 __attribute__((ext_vector_type(8)));
typedef float f32x4 __attribute__((ext_vector_type(4)));
typedef float f32x16 __attribute__((ext_vector_type(16)));
typedef float f32x2_t __attribute__((ext_vector_type(2)));
typedef __bf16 bf16x2_t __attribute__((ext_vector_type(2)));

constexpr int NTOK = 8192, DM = 2048, SEQ = 4096, INC = 4640, RW = 1024;
constexpr int ZC_K = 1024, ZC_V = 1152, ZC_RW = 1280;
constexpr int NEXP = 64, FF = 512, LCAP = 8192;
constexpr int NKS = 16;

constexpr size_t MiB = 1u << 20;
constexpr size_t WS_CTL = 0, CTL_BYTES = 98304;
constexpr int CNT_OFF = 32768, CNT_ST = 256;
constexpr size_t WS_PART = 1 * MiB;
constexpr size_t WS_MODF = 3 * MiB;
constexpr size_t WS_ROPE = 4 * MiB;
constexpr size_t WS_WRF = 5 * MiB;
constexpr size_t WS_CB = 7 * MiB;
constexpr size_t WS_AS2 = 7 * MiB + 4096;
constexpr size_t WS_H = 8 * MiB;
constexpr size_t WS_Z = 40 * MiB;
constexpr size_t WS_MIX = 116 * MiB;
constexpr size_t WS_X1 = 148 * MiB;
constexpr size_t WS_R = 212 * MiB, WS_DEC = 244 * MiB, WS_K2 = 276 * MiB, WS_V = 308 * MiB, WS_AA = 340 * MiB, WS_BB = 372 * MiB, WS_G = 404 * MiB, WS_Y = 436 * MiB;
constexpr size_t WS_LW = 212 * MiB;
constexpr size_t WS_AV = 244 * MiB;
constexpr size_t WS_GV = 260 * MiB;
constexpr size_t WS_RKS = 468 * MiB;
constexpr size_t WS_LIST = 469 * MiB;
constexpr size_t WS_LWT = 471 * MiB;
constexpr size_t WS_HID = 473 * MiB;
constexpr size_t WS_YB = 490 * MiB;

constexpr size_t WS_WTI = 672 * MiB;
constexpr size_t WS_WTO = 692 * MiB;
constexpr size_t WS_GB = 556 * MiB;
constexpr size_t WS_HB = 572 * MiB;
constexpr size_t WS_Q2 = 604 * MiB;
constexpr size_t WS_Q1 = 636 * MiB;
constexpr size_t WS_S0 = 652 * MiB;

constexpr int LDS_BYTES = 147456;

struct Params {
    const float *x, *c, *w_ada, *b_ada, *norm1_g, *w_in, *mu, *sinks, *w0, *wd_up, *a0, *wa_up, *wg_up, *k_k, *k_a, *r_k, *ln_w, *ln_b, *w_o, *norm2_g,
        *w_rg, *b_rg, *w_re, *b_re, *w1, *w3, *w2, *final_g;
    float* out;
    unsigned char* ws;
};

DEVI unsigned cvtpk_v(float lo, float hi) { unsigned r; asm volatile("v_cvt_pk_bf16_f32 %0, %1, %2" : "=v"(r) : "v"(lo), "v"(hi)); return r; }
DEVI unsigned cvtpk(float lo, float hi) { f32x2_t v = {lo, hi}; bf16x2_t b = __builtin_convertvector(v, bf16x2_t); return __builtin_bit_cast(unsigned, b); }
DEVI float bf2f(unsigned h) { return __builtin_bit_cast(float, h << 16); }
DEVI float bflo(unsigned u) { return __builtin_bit_cast(float, u << 16); }
DEVI float bfhi(unsigned u) { return __builtin_bit_cast(float, u & 0xffff0000u); }
DEVI float wave_sum(float v) {
#pragma unroll
    for (int o = 32; o > 0; o >>= 1) v += __shfl_xor(v, o, 64);
    return v;
}
DEVI float sigmoidf_(float x) { return 1.f / (1.f + __expf(-x)); }

#define XB_TMO      128
#define XB_XCNT(j)  (256  + 64 * (j))
#define XB_XSUB(j)  (1280 + 64 * (j))
#define XB_XGEN(j)  (2304 + 64 * (j))
#define XB_TOP      3328
#define XB_TOPGEN   3392
#define XCD_BAR_WORDS 3456
#define XB_SPIN_CAP (1u << 18)
#define LAS __attribute__((address_space(3)))

__device__ __forceinline__ unsigned xb_ld(unsigned* p)              { return __hip_atomic_load(p, __ATOMIC_RELAXED, __HIP_MEMORY_SCOPE_AGENT); }
__device__ __forceinline__ unsigned xb_add(unsigned* p, unsigned v) { return __hip_atomic_fetch_add(p, v, __ATOMIC_RELAXED, __HIP_MEMORY_SCOPE_AGENT); }
__device__ __forceinline__ unsigned xb_xcc_id() { return (unsigned)__builtin_amdgcn_s_getreg((3 << 11) | 20) & 0xFu; }
#define XB_SPIN(cond, bar) do { unsigned _sp = 0; while (cond) { __builtin_amdgcn_s_sleep(1); \
    if ((++_sp & 255u) == 0u) { if (xb_ld(&(bar)[XB_TMO])) break; if (_sp > XB_SPIN_CAP) { atomicAdd(&(bar)[XB_TMO], 1u); break; } } } } while (0)

struct XcdBarrier {
    unsigned* bar; unsigned x;
    volatile LAS unsigned* st;
};

__device__ __forceinline__ XcdBarrier xcd_barrier_post(unsigned* bar, volatile LAS unsigned* st) {
    XcdBarrier b; b.bar = bar; b.x = xb_xcc_id(); b.st = st;
    if (threadIdx.x == 0) (void)xb_add(&bar[XB_XCNT(b.x)], 1u);
    return b;
}
__device__ __forceinline__ void xcd_barrier_complete(unsigned* bar, unsigned x, unsigned& nloc, unsigned& nx) {
    const unsigned G = gridDim.x * gridDim.y * gridDim.z;
    unsigned sum, cnt, mine, sp = 0u;
    for (;;) {
        sum = 0u; cnt = 0u; mine = 0u;
#pragma unroll
        for (unsigned j = 0; j < 16; ++j) { const unsigned c = xb_ld(&bar[XB_XCNT(j)]); sum += c; cnt += (c > 0u) ? 1u : 0u; mine = (j == x) ? c : mine; }
        if (sum == G) break;
        __builtin_amdgcn_s_sleep(1);
        if ((++sp & 255u) == 0u) { if (xb_ld(&bar[XB_TMO])) break; if (sp > XB_SPIN_CAP) { atomicAdd(&bar[XB_TMO], 1u); break; } }
    }
    nloc = mine > 0u ? mine : 1u; nx = cnt > 0u ? cnt : 1u;
}

__device__ __forceinline__ void xcd_barrier(const XcdBarrier& b) {
    asm volatile("s_waitcnt vmcnt(0)" ::: "memory");
    __syncthreads();
    if (threadIdx.x == 0) {
        unsigned* bar = b.bar;
        __builtin_amdgcn_s_waitcnt(0);
        unsigned nloc = b.st[0], nx = b.st[1];
        if (nloc == 0u) { xcd_barrier_complete(bar, b.x, nloc, nx); b.st[0] = nloc; b.st[1] = nx; }
        const unsigned old = xb_add(&bar[XB_XSUB(b.x)], 1u);
        const unsigned gen = old / nloc;
        if (old + 1u == (gen + 1u) * nloc) {
            __builtin_amdgcn_fence(__ATOMIC_RELEASE, "agent");
            asm volatile("s_waitcnt vmcnt(0)" ::: "memory");
            const unsigned og = xb_add(&bar[XB_TOP], 1u);
            const unsigned tg = og / nx;
            if (og + 1u == (tg + 1u) * nx) xb_add(&bar[XB_TOPGEN], 1u);
            else XB_SPIN(xb_ld(&bar[XB_TOPGEN]) == tg, bar);
            __builtin_amdgcn_fence(__ATOMIC_ACQUIRE, "agent");
            xb_add(&bar[XB_XGEN(b.x)], 1u);
            asm volatile("s_waitcnt vmcnt(0)" ::: "memory");
        } else {
            XB_SPIN(xb_ld(&bar[XB_XGEN(b.x)]) == gen, bar);
            __builtin_amdgcn_fence(__ATOMIC_ACQUIRE, "agent");
            asm volatile("s_waitcnt vmcnt(0)" ::: "memory");
        }
    }
    __syncthreads();
}

template <int PF, int R, class ALoad, class Epi>
DEVI void gemm_tile_f(char* smem, int nk, long ldb, const float* bp0, const float* bp1, ALoad&& aload, Epi&& epi) {
    static_assert(R > PF && (R % 2) == 0, "ring");
    const int tid = threadIdx.x, lane = tid & 63, li = lane & 15, lg = lane >> 4;
    const int sr = tid >> 2, scn = tid & 3;
    const unsigned aw0 = sr * 64 + ((scn ^ ((0 - (sr >> 2)) & 3)) << 4), aw1 = aw0 + 128 * 64;
    const unsigned ar = li * 64 + ((lg ^ ((0 - (li >> 2)) & 3)) << 4);
    float breg[R][2][8];
    f32x4 acc[16][2];
#pragma unroll
    for (int m = 0; m < 16; ++m) { acc[m][0] = f32x4{0.f, 0.f, 0.f, 0.f}; acc[m][1] = f32x4{0.f, 0.f, 0.f, 0.f}; }
    uint4 areg0 = aload(0, 0), areg1 = aload(1, 0);
#pragma unroll
    for (int s = 0; s < PF; ++s) {
        if (s < nk) {
#pragma unroll
            for (int j = 0; j < 8; ++j) { breg[s][0][j] = bp0[(long)(s * 32 + j) * ldb]; breg[s][1][j] = bp1[(long)(s * 32 + j) * ldb]; }
        }
    }
    *(uint4*)(smem + aw0) = areg0; *(uint4*)(smem + aw1) = areg1;
    __syncthreads();
    for (int kt0 = 0; kt0 < nk; kt0 += R) {
#pragma unroll
        for (int u = 0; u < R; ++u) {
            const int kt = kt0 + u;
            if (kt < nk) {
                {
                    const int ka = kt + 1 < nk ? kt + 1 : nk - 1, kb = kt + PF < nk ? kt + PF : nk - 1;
                    areg0 = aload(0, ka); areg1 = aload(1, ka);
                    __builtin_amdgcn_sched_barrier(0);
                    const float* q0 = bp0 + (long)kb * 32 * ldb; const float* q1 = bp1 + (long)kb * 32 * ldb;
#pragma unroll
                    for (int j = 0; j < 8; ++j) { breg[(u + PF) % R][0][j] = q0[(long)j * ldb]; breg[(u + PF) % R][1][j] = q1[(long)j * ldb]; }
                }
                __builtin_amdgcn_sched_barrier(0);
                uint4 b0, b1;
                b0.x = cvtpk_v(breg[u][0][0], breg[u][0][1]); b0.y = cvtpk_v(breg[u][0][2], breg[u][0][3]); b0.z = cvtpk_v(breg[u][0][4], breg[u][0][5]); b0.w = cvtpk_v(breg[u][0][6], breg[u][0][7]);
                b1.x = cvtpk_v(breg[u][1][0], breg[u][1][1]); b1.y = cvtpk_v(breg[u][1][2], breg[u][1][3]); b1.z = cvtpk_v(breg[u][1][4], breg[u][1][5]); b1.w = cvtpk_v(breg[u][1][6], breg[u][1][7]);
                const bf16x8 bf0 = __builtin_bit_cast(bf16x8, b0), bf1 = __builtin_bit_cast(bf16x8, b1);
                const char* As = smem + (u & 1) * 16384 + ar;
#pragma unroll
                for (int mb = 0; mb < 16; mb += 4) {
                    bf16x8 af[4];
#pragma unroll
                    for (int m = 0; m < 4; ++m) af[m] = *(const bf16x8*)(As + (mb + m) * 1024);
                    __builtin_amdgcn_sched_barrier(0);
#pragma unroll
                    for (int m = 0; m < 4; ++m) {
                        acc[mb + m][0] = __builtin_amdgcn_mfma_f32_16x16x32_bf16(bf0, af[m], acc[mb + m][0], 0, 0, 0);
                        acc[mb + m][1] = __builtin_amdgcn_mfma_f32_16x16x32_bf16(bf1, af[m], acc[mb + m][1], 0, 0, 0);
                    }
                    __builtin_amdgcn_sched_barrier(0);
                }
                { char* Aw = smem + ((u + 1) & 1) * 16384; *(uint4*)(Aw + aw0) = areg0; *(uint4*)(Aw + aw1) = areg1; }
                __syncthreads();
            }
        }
    }
    epi(acc);
}
template <int N> struct IC { static constexpr int value = N; };
typedef const __attribute__((address_space(1))) char* gcp_t;
template <class T> DEVI gcp_t uniform_ptr(const T* p) {
    const unsigned long long v = (unsigned long long)p;
    const unsigned lo = __builtin_amdgcn_readfirstlane((unsigned)v), hi = __builtin_amdgcn_readfirstlane((unsigned)(v >> 32));
    return (gcp_t)(((unsigned long long)hi << 32) | lo);
}
DEVI float ldg_f(gcp_t sbase, unsigned voff) { return *(const __attribute__((address_space(1))) float*)(sbase + voff); }
typedef unsigned u32x4n_t __attribute__((ext_vector_type(4)));
DEVI uint4 ldg_q(gcp_t sbase, unsigned voff) { const u32x4n_t v = *(const __attribute__((address_space(1))) u32x4n_t*)(sbase + voff); return make_uint4(v.x, v.y, v.z, v.w); }
template <int AB, int NK, int LDB, int W1OFF, class Epi>
DEVI void gemm_tile_s(char* smem, gcp_t wb0, gcp_t wb1, unsigned boff, gcp_t ab, unsigned aoff0, unsigned aoff1, Epi&& epi) {
    constexpr long ldb = LDB;
    static_assert(NK >= 4, "K steps");
    int tid = threadIdx.x;
    asm volatile("" : "+v"(tid));
    const int lane = tid & 63, li = lane & 15, lg = lane >> 4;
    const int sr = tid >> 2, scn = tid & 3;
    const unsigned aw0 = sr * 64 + ((scn ^ ((0 - (sr >> 2)) & 3)) << 4), aw1 = aw0 + 128 * 64;
    const unsigned ar = li * 64 + ((lg ^ ((0 - (li >> 2)) & 3)) << 4);
    float breg[3][2][8];
    uint4 areg[2][2];
    f32x4 acc[16][2];
#pragma unroll
    for (int m = 0; m < 16; ++m) { acc[m][0] = f32x4{0.f, 0.f, 0.f, 0.f}; acc[m][1] = f32x4{0.f, 0.f, 0.f, 0.f}; }
    {
        const uint4 a0 = ldg_q(ab, aoff0), a1 = ldg_q(ab, aoff1);
        areg[1][0] = ldg_q(ab + 64, aoff0); areg[1][1] = ldg_q(ab + 64, aoff1);
#pragma unroll
        for (int s = 0; s < 2; ++s) {
#pragma unroll
            for (int j = 0; j < 8; ++j) {
                breg[s][0][j] = ldg_f(wb0 + (long)(s * 32 + j) * ldb * 4, boff);
                breg[s][1][j] = ldg_f(wb1 + (long)(s * 32 + j) * ldb * 4, boff);
            }
        }
        *(uint4*)(smem + aw0) = a0; *(uint4*)(smem + aw1) = a1;
    }
    __syncthreads();
    auto step = [&](auto uc, auto prec, auto wrc, const int kt) __attribute__((always_inline)) {
        constexpr int u = decltype(uc)::value;
        constexpr bool PRE = decltype(prec)::value != 0, WR = decltype(wrc)::value != 0;
        unsigned bo = boff;
        if constexpr (PRE) {
            unsigned ao0 = aoff0, ao1 = aoff1;
            asm volatile("" : "+v"(ao0), "+v"(ao1), "+v"(bo));
            { gcp_t sa = ab + (kt + 2) * 64; asm volatile("" : "+s"(sa)); areg[u & 1][0] = ldg_q(sa, ao0); areg[u & 1][1] = ldg_q(sa, ao1); }
        }
        __builtin_amdgcn_sched_barrier(0);
        uint4 b0, b1;
        b0.x = cvtpk_v(breg[u % 3][0][0], breg[u % 3][0][1]); b0.y = cvtpk_v(breg[u % 3][0][2], breg[u % 3][0][3]); b0.z = cvtpk_v(breg[u % 3][0][4], breg[u % 3][0][5]); b0.w = cvtpk_v(breg[u % 3][0][6], breg[u % 3][0][7]);
        b1.x = cvtpk_v(breg[u % 3][1][0], breg[u % 3][1][1]); b1.y = cvtpk_v(breg[u % 3][1][2], breg[u % 3][1][3]); b1.z = cvtpk_v(breg[u % 3][1][4], breg[u % 3][1][5]); b1.w = cvtpk_v(breg[u % 3][1][6], breg[u % 3][1][7]);
        const bf16x8 bf0 = __builtin_bit_cast(bf16x8, b0), bf1 = __builtin_bit_cast(bf16x8, b1);
        const char* As = smem + (u & 1) * 16384 + ar;
        constexpr int JS = (LDB * 4 <= 2048) ? 2 : 1;
        static_assert(AB == 2, "one weight row pair requested per batch of two A fragments");
#pragma unroll
        for (int mb = 0; mb < 16; mb += AB) {
            if constexpr (PRE) {
                constexpr int j = 0;
                const int jr = mb / 2;
                gcp_t s0 = wb0 + (long)((kt + 2) * 32 + (jr & ~(JS - 1))) * ldb * 4, s1 = wb1 + (long)((kt + 2) * 32 + (jr & ~(JS - 1))) * ldb * 4;
                if constexpr (W1OFF != 0) { asm volatile("" : "+s"(s0)); s1 = s0 + W1OFF; } else asm volatile("" : "+s"(s0), "+s"(s1));
                breg[(u + 2) % 3][0][jr] = ldg_f(s0 + (jr & (JS - 1)) * LDB * 4, bo);
                breg[(u + 2) % 3][1][jr] = ldg_f(s1 + (jr & (JS - 1)) * LDB * 4, bo);
                (void)j;
            }
            bf16x8 af[AB];
#pragma unroll
            for (int m = 0; m < AB; ++m) af[m] = *(const bf16x8*)(As + (mb + m) * 1024);
            __builtin_amdgcn_sched_barrier(0);
#pragma unroll
            for (int m = 0; m < AB; ++m) {
                acc[mb + m][0] = __builtin_amdgcn_mfma_f32_16x16x32_bf16(bf0, af[m], acc[mb + m][0], 0, 0, 0);
                acc[mb + m][1] = __builtin_amdgcn_mfma_f32_16x16x32_bf16(bf1, af[m], acc[mb + m][1], 0, 0, 0);
            }
            __builtin_amdgcn_sched_barrier(0);
        }
        if constexpr (WR) { char* Aw = smem + ((u + 1) & 1) * 16384; *(uint4*)(Aw + aw0) = areg[(u + 1) & 1][0]; *(uint4*)(Aw + aw1) = areg[(u + 1) & 1][1]; }
        __syncthreads();
    };
    constexpr int H = (NK - 2) % 6, G = (NK - 2 - H) / 6;
    static_assert(H == 2, "ring phase of the unrolled groups below assumes two head steps (NK = 16, 64, ...)");
    step(IC<0>{}, IC<1>{}, IC<1>{}, 0); step(IC<1>{}, IC<1>{}, IC<1>{}, 1);
    for (int g = 0; g < G; ++g) {
        const int kt0 = H + 6 * g;
        step(IC<2>{}, IC<1>{}, IC<1>{}, kt0); step(IC<3>{}, IC<1>{}, IC<1>{}, kt0 + 1); step(IC<4>{}, IC<1>{}, IC<1>{}, kt0 + 2);
        step(IC<5>{}, IC<1>{}, IC<1>{}, kt0 + 3); step(IC<0>{}, IC<1>{}, IC<1>{}, kt0 + 4); step(IC<1>{}, IC<1>{}, IC<1>{}, kt0 + 5);
    }
    step(IC<2>{}, IC<0>{}, IC<1>{}, NK - 2); step(IC<3>{}, IC<0>{}, IC<0>{}, NK - 1);
    epi(acc);
}
template <int PF, int R, class Epi>
DEVI void gemm_tile(char* smem, int nk, long ldb, const float* bp0, const float* bp1, const bf16_t* ap0, const bf16_t* ap1, Epi&& epi) {
    gemm_tile_f<PF, R>(smem, nk, ldb, bp0, bp1, [&](int i, int kt) { return *(const uint4*)((i ? ap1 : ap0) + kt * 32); }, epi);
}

namespace pg8 {
#define PG8_LAS __attribute__((address_space(3)))
typedef unsigned short bf16_t;
typedef short bf16x8 __attribute__((ext_vector_type(8)));
typedef float f32x4 __attribute__((ext_vector_type(4)));
typedef unsigned u32x4 __attribute__((ext_vector_type(4)));
constexpr int BM = 256, BK = 64, HALF = 128, HTB = HALF * BK * 2  , STAGE_BYTES = 8 * HTB, NXCD = 8, WGM = 8;

__host__ __device__ __forceinline__ int lds_byte(int r, int c) { const int st = (r >> 4) * 2 + (c >> 5), rr = r & 15, cc = c & 31, ob = rr * 64 + cc * 2; return st * 1024 + (ob ^ (((ob >> 9) & 1) << 5)); }
__host__ __device__ __forceinline__ void stage_rc(int b, int& R, int& C) { const int st = b / 1024, sb = b % 1024, swz = sb ^ (((sb >> 9) & 1) << 5); R = (st >> 1) * 16 + swz / 64; C = (st & 1) * 32 + (swz % 64) / 2; }
__host__ __device__ __forceinline__ int perm32(int rho) { const int n = rho >> 4, i = rho & 15; return 8 * (i >> 2) + 4 * n + (i & 3); }

struct Unit { int pm, pn; };
struct Gemm { const bf16_t* A; const bf16_t* Bt; int M, N, K; };

struct StaticOrder {
    int nM, nN, nwg, G, c;
    __host__ __device__ void init(int M, int N, int G_, int c_) { nM = M / BM; nN = N / BM; nwg = nM * nN; G = G_; c = c_; }
    __host__ __device__ bool next(int i, Unit& u) const {
        const long L = (long)i * G + c; if (L >= nwg) return false;
        int wgid = (int)L; { const int q = nwg / NXCD, r = nwg % NXCD, xcd = wgid % NXCD, off = wgid / NXCD; wgid = (xcd < r ? xcd * (q + 1) : r * (q + 1) + (xcd - r) * q) + off; }
        const int nig = WGM * nN, gid = wgid / nig, fm = gid * WGM, gsz = (nM - fm) < WGM ? (nM - fm) : WGM;
        u.pm = fm + ((wgid % nig) % gsz); u.pn = (wgid % nig) / gsz; return true;
    }
    __device__ __forceinline__ void a_ready(const Unit&) const {}
    __device__ __forceinline__ void done(const Unit&) const {}
};


__device__ __forceinline__ unsigned cvt_pk_bf16(float lo, float hi) { unsigned r; asm volatile("v_cvt_pk_bf16_f32 %0, %1, %2" : "=v"(r) : "v"(lo), "v"(hi)); return r; }
struct EpiZ {
    static constexpr bool PERM = true, AFTER_DRAIN = false;
    bf16_t* O; int ldc; int ncols;
    __device__ __forceinline__ void operator()(const f32x4 (&acc)[2][2][4][2], const Unit& u, int wr, int wc, int fr, int fq) const {
        const int row0 = u.pm * BM + wr * 64 + fr, col0 = u.pn * BM + wc * 32 + 8 * fq;
#pragma unroll
        for (int ai = 0; ai < 2; ++ai)
#pragma unroll
            for (int m = 0; m < 4; ++m) { bf16_t* rowp = O + (size_t)(row0 + ai * HALF + m * 16) * ldc;
#pragma unroll
                for (int bj = 0; bj < 2; ++bj) { const int col = col0 + bj * HALF;
                    if (col < ncols) { const f32x4 v0 = acc[ai][bj][m][0], v1 = acc[ai][bj][m][1];
                        u32x4 w; w.x = cvt_pk_bf16(v0[0], v0[1]); w.y = cvt_pk_bf16(v0[2], v0[3]); w.z = cvt_pk_bf16(v1[0], v1[1]); w.w = cvt_pk_bf16(v1[2], v1[3]);
                        *(u32x4*)(rowp + col) = w; } } }
    }
};
struct EpiX1 {
    static constexpr bool PERM = true, AFTER_DRAIN = false;
    float* O; const float* res; const float* gate; int ldc; int gate_stride; int rows_per_batch;
    __device__ __forceinline__ void operator()(const f32x4 (&acc)[2][2][4][2], const Unit& u, int wr, int wc, int fr, int fq) const {
        const int row0 = u.pm * BM + wr * 64 + fr, col0 = u.pn * BM + wc * 32 + 8 * fq;
        const float* gp = gate + (size_t)((u.pm * BM) / rows_per_batch) * gate_stride;
#pragma unroll
        for (int bj = 0; bj < 2; ++bj) { const int col = col0 + bj * HALF;
            const f32x4 g0 = *(const f32x4*)(gp + col), g1 = *(const f32x4*)(gp + col + 4);
#pragma unroll
            for (int ai = 0; ai < 2; ++ai) {
                f32x4 x0[4], x1[4];
#pragma unroll
                for (int m = 0; m < 4; ++m) { const size_t o = (size_t)(row0 + ai * HALF + m * 16) * ldc + col; x0[m] = *(const f32x4*)(res + o); x1[m] = *(const f32x4*)(res + o + 4); }
#pragma unroll
                for (int m = 0; m < 4; ++m) { const size_t o = (size_t)(row0 + ai * HALF + m * 16) * ldc + col;
                    *(f32x4*)(O + o) = x0[m] + g0 * acc[ai][bj][m][0]; *(f32x4*)(O + o + 4) = x1[m] + g1 * acc[ai][bj][m][1]; }
            } }
    }
};
template <class Epi, class Sched, bool ALIGN_EPI = false, bool SP2 = false>
__device__ __forceinline__ void gemm_phase(PG8_LAS unsigned char* lds, const Gemm g, const Sched& S, const Epi& E) {
    const int tid = threadIdx.x, wid = __builtin_amdgcn_readfirstlane(tid >> 6), lane = tid & 63, wr = wid >> 2, wc = wid & 3, fr = lane & 15, fq = lane >> 4;
    const int K = g.K, nt = K / BK;
    unsigned voffA[2], voffB[2];
#pragma unroll
    for (int i = 0; i < 2; ++i) { int R, C; stage_rc(tid * 16 + i * 8192, R, C); const int Rb = Epi::PERM ? ((R & ~31) + perm32(R & 31)) : R;
        voffA[i] = (unsigned)(R * K + C) * 2u; voffB[i] = (unsigned)(Rb * K + C) * 2u; }
    const size_t kstep = (size_t)(BK * 2);
    const size_t hstep = (size_t)HALF * K * 2;
    const size_t tstep = 2 * hstep;
    const unsigned ldsw = (unsigned)wid * 1024u;
    const int aoff = lds_byte(wr * 64 + fr, fq * 8), boff = lds_byte(wc * 32 + fr, fq * 8);
#define PG8_SA(b, h) (((b) * 2 + (h)) * HTB)
#define PG8_SB(b, h) ((4 + (b) * 2 + (h)) * HTB)
#define PG8_STAGE(bufoff, gbase, voff) do { _Pragma("unroll") for (int _i = 0; _i < 2; ++_i) \
        __builtin_amdgcn_global_load_lds((const unsigned*)((const char*)(gbase) + (voff)[_i]), (PG8_LAS unsigned*)(lds + (bufoff) + ldsw + _i * 8192), 16, 0, 0); } while (0)
#define PG8_LDA(dst, b, h) do { _Pragma("unroll") for (int m = 0; m < 4; ++m) _Pragma("unroll") for (int k = 0; k < 2; ++k) dst[m][k] = *(const PG8_LAS bf16x8*)(lds + PG8_SA(b, h) + aoff + m * 2048 + k * 1024); } while (0)
#define PG8_LDB(dst, b, h) do { _Pragma("unroll") for (int n = 0; n < 2; ++n) _Pragma("unroll") for (int k = 0; k < 2; ++k) dst[n][k] = *(const PG8_LAS bf16x8*)(lds + PG8_SB(b, h) + boff + n * 2048 + k * 1024); } while (0)
#define PG8_MMA(ai, bj, At, Bt) do { __builtin_amdgcn_s_setprio(1); _Pragma("unroll") for (int m = 0; m < 4; ++m) _Pragma("unroll") for (int n = 0; n < 2; ++n) _Pragma("unroll") for (int k = 0; k < 2; ++k) \
        acc[ai][bj][m][n] = __builtin_amdgcn_mfma_f32_16x16x32_bf16(Bt[n][k], At[m][k], acc[ai][bj][m][n], 0, 0, 0); __builtin_amdgcn_s_setprio(0); } while (0)
#define PG8_WAIT_V(n) asm volatile("s_waitcnt vmcnt(" #n ")" ::: "memory")
#define PG8_WAIT_L(n) asm volatile("s_waitcnt lgkmcnt(" #n ")" ::: "memory")
#define PG8_BAR __builtin_amdgcn_s_barrier()
#define PG8_SCHED __builtin_amdgcn_sched_barrier(0)
    Unit cur, nxt; int ui = 0;
    if (!S.next(0, cur)) return;
    f32x4 acc[2][2][4][2];
#pragma unroll
    for (int a = 0; a < 2; ++a)
#pragma unroll
        for (int b = 0; b < 2; ++b)
#pragma unroll
            for (int m = 0; m < 4; ++m)
#pragma unroll
                for (int n = 0; n < 2; ++n) acc[a][b][m][n] = (f32x4){0.f, 0.f, 0.f, 0.f};
    bf16x8 At[4][2], B0[2][2], B1[2][2];
    const char* cA = (const char*)g.A + (size_t)cur.pm * tstep; const char* cB = (const char*)g.Bt + (size_t)cur.pn * tstep;
    S.a_ready(cur);
    if constexpr (SP2) {
        PG8_STAGE(PG8_SB(0, 0), cB, voffB); PG8_STAGE(PG8_SB(0, 1), cB + hstep, voffB); PG8_STAGE(PG8_SA(0, 0), cA, voffA); PG8_STAGE(PG8_SA(0, 1), cA + hstep, voffA);
        if (wr == 1) PG8_BAR;
        PG8_WAIT_V(2); PG8_BAR;
        PG8_STAGE(PG8_SB(1, 0), cB + kstep, voffB); PG8_STAGE(PG8_SA(1, 0), cA + kstep, voffA); PG8_STAGE(PG8_SB(1, 1), cB + hstep + kstep, voffB);
        PG8_WAIT_V(6); PG8_BAR;
    } else {
        PG8_STAGE(PG8_SB(0, 0), cB, voffB); PG8_STAGE(PG8_SA(0, 0), cA, voffA); PG8_STAGE(PG8_SB(0, 1), cB + hstep, voffB); PG8_STAGE(PG8_SA(0, 1), cA + hstep, voffA);
        if (wr == 1) PG8_BAR;
        PG8_WAIT_V(4); PG8_BAR;
        PG8_STAGE(PG8_SB(1, 0), cB + kstep, voffB); PG8_STAGE(PG8_SA(1, 0), cA + kstep, voffA); PG8_STAGE(PG8_SB(1, 1), cB + hstep + kstep, voffB);
        PG8_WAIT_V(6); PG8_BAR;
    }
    for (;;) {
        const bool has_next = S.next(ui + 1, nxt);
        const char* nA = has_next ? (const char*)g.A + (size_t)nxt.pm * tstep : cA; const char* nB = has_next ? (const char*)g.Bt + (size_t)nxt.pn * tstep : cB;
        for (int t = 0; t < nt; t += 2) {
            const bool last = (t == nt - 2);
            const char* a1 = cA + (size_t)(t + 1) * kstep;
            const char* a2 = last ? nA : cA + (size_t)(t + 2) * kstep; const char* b2 = last ? nB : cB + (size_t)(t + 2) * kstep;
            const char* a3 = a2 + kstep; const char* b3 = b2 + kstep;
            if (last && has_next) S.a_ready(nxt);
            if constexpr (SP2) {
            PG8_LDB(B0, 0, 0); PG8_LDB(B1, 0, 1); PG8_SCHED; PG8_LDA(At, 0, 0); PG8_STAGE(PG8_SA(1, 1), a1 + hstep, voffA);
            PG8_WAIT_V(8); PG8_WAIT_L(0); PG8_BAR; PG8_MMA(0, 0, At, B0); PG8_MMA(0, 1, At, B1); PG8_BAR; PG8_SCHED;
            PG8_LDA(At, 0, 1); PG8_STAGE(PG8_SB(0, 0), b2, voffB); PG8_STAGE(PG8_SB(0, 1), b2 + hstep, voffB); PG8_STAGE(PG8_SA(0, 0), a2, voffA);
            PG8_WAIT_V(8); PG8_WAIT_L(0); PG8_BAR; PG8_MMA(1, 0, At, B0); PG8_MMA(1, 1, At, B1); PG8_BAR; PG8_SCHED;
            PG8_LDB(B0, 1, 0); PG8_LDB(B1, 1, 1); PG8_SCHED; PG8_LDA(At, 1, 0); PG8_STAGE(PG8_SA(0, 1), a2 + hstep, voffA);
            PG8_WAIT_V(8); PG8_WAIT_L(0); PG8_BAR; PG8_MMA(0, 0, At, B0); PG8_MMA(0, 1, At, B1); PG8_BAR; PG8_SCHED;
            PG8_LDA(At, 1, 1); PG8_STAGE(PG8_SB(1, 0), b3, voffB); PG8_STAGE(PG8_SB(1, 1), b3 + hstep, voffB); PG8_STAGE(PG8_SA(1, 0), a3, voffA);
            PG8_WAIT_V(8); PG8_WAIT_L(0); PG8_BAR; PG8_MMA(1, 0, At, B0); PG8_MMA(1, 1, At, B1); PG8_BAR; PG8_SCHED;
            } else {
            PG8_LDB(B0, 0, 0); PG8_SCHED; PG8_LDA(At, 0, 0); PG8_STAGE(PG8_SA(1, 1), a1 + hstep, voffA);
            PG8_WAIT_L(8); PG8_BAR; PG8_WAIT_L(0); PG8_MMA(0, 0, At, B0); PG8_BAR; PG8_SCHED;
            PG8_LDB(B1, 0, 1); PG8_STAGE(PG8_SB(0, 0), b2, voffB);
            PG8_BAR; PG8_WAIT_L(0); PG8_MMA(0, 1, At, B1); PG8_BAR;
            PG8_LDA(At, 0, 1); PG8_STAGE(PG8_SA(0, 0), a2, voffA);
            PG8_BAR; PG8_WAIT_L(0); PG8_MMA(1, 0, At, B0); PG8_BAR; PG8_SCHED;
            PG8_STAGE(PG8_SB(0, 1), b2 + hstep, voffB);
            PG8_WAIT_V(6); PG8_BAR; PG8_MMA(1, 1, At, B1); PG8_BAR;
            PG8_LDB(B0, 1, 0); PG8_SCHED; PG8_LDA(At, 1, 0); PG8_STAGE(PG8_SA(0, 1), a2 + hstep, voffA);
            PG8_WAIT_L(8); PG8_BAR; PG8_WAIT_L(0); PG8_MMA(0, 0, At, B0); PG8_BAR; PG8_SCHED;
            PG8_LDB(B1, 1, 1); PG8_STAGE(PG8_SB(1, 0), b3, voffB);
            PG8_BAR; PG8_WAIT_L(0); PG8_MMA(0, 1, At, B1); PG8_BAR;
            PG8_LDA(At, 1, 1); PG8_STAGE(PG8_SA(1, 0), a3, voffA);
            PG8_BAR; PG8_WAIT_L(0); PG8_MMA(1, 0, At, B0); PG8_BAR; PG8_SCHED;
            PG8_STAGE(PG8_SB(1, 1), b3 + hstep, voffB);
            PG8_WAIT_V(6); PG8_BAR; PG8_MMA(1, 1, At, B1); PG8_BAR;
            }
        }
        if constexpr (ALIGN_EPI) { if (wr == 0) PG8_BAR; }
        if constexpr (!Epi::AFTER_DRAIN) { E(acc, cur, wr, wc, fr, fq); S.done(cur); }
        if (!has_next) break;
#pragma unroll
        for (int a = 0; a < 2; ++a)
#pragma unroll
            for (int b = 0; b < 2; ++b)
#pragma unroll
                for (int m = 0; m < 4; ++m)
#pragma unroll
                    for (int n = 0; n < 2; ++n) acc[a][b][m][n] = (f32x4){0.f, 0.f, 0.f, 0.f};
        cur = nxt; cA = nA; cB = nB; ++ui;
        if constexpr (ALIGN_EPI) { if (wr == 1) PG8_BAR; }
    }
    PG8_WAIT_V(0);
    if constexpr (!ALIGN_EPI) { if (wr == 0) PG8_BAR; }
    PG8_BAR;
    if constexpr (Epi::AFTER_DRAIN) { E.fused(acc, cur, wr, wc, fr, fq, lds, wid, lane); S.done(cur); }
#undef PG8_SA
#undef PG8_SB
#undef PG8_STAGE
#undef PG8_LDA
#undef PG8_LDB
#undef PG8_MMA
#undef PG8_WAIT_V
#undef PG8_WAIT_L
#undef PG8_BAR
#undef PG8_SCHED
}
}

DEVI void ada_unit(const Params& p, char* smem, int cb, int ks) {
    float* sl = (float*)smem;
    float* part = (float*)(p.ws + WS_PART);
    const int tid = threadIdx.x;
    __syncthreads();
    if (tid < 256) { const int b = tid >> 7, kk = tid & 127; const float cv = p.c[b * DM + ks * 128 + kk]; sl[b * 128 + kk] = cv / (1.f + expf(-cv)); }
    __syncthreads();
    const int j = cb * 512 + tid;
    const float* w = p.w_ada + (size_t)(ks * 128) * 12288 + j;
    float a0 = 0.f, a1 = 0.f;
#pragma unroll 16
    for (int kk = 0; kk < 128; ++kk) { const float wv = w[(size_t)kk * 12288]; a0 += sl[kk] * wv; a1 += sl[128 + kk] * wv; }
    part[(ks * 2 + 0) * 12288 + j] = a0; part[(ks * 2 + 1) * 12288 + j] = a1;
}
DEVI void ada_unit_h(const Params& p, char* smem, int cb, int ks) {
    float* sl = (float*)smem;
    float* part = (float*)(p.ws + WS_PART);
    const int tid = threadIdx.x, hf = tid >> 8, t = tid & 255;
    __syncthreads();
    if (tid < 256) { const int b = tid >> 7, kk = tid & 127; const float cv = p.c[b * DM + ks * 128 + kk]; sl[b * 128 + kk] = cv / (1.f + expf(-cv)); }
    __syncthreads();
    const int j = cb * 256 + t;
    const float* w = p.w_ada + (size_t)(ks * 128 + hf * 64) * 12288 + j;
    const float* s0 = sl + hf * 64;
    float a0 = 0.f, a1 = 0.f;
#pragma unroll 16
    for (int kk = 0; kk < 64; ++kk) { const float wv = w[(size_t)kk * 12288]; a0 += s0[kk] * wv; a1 += s0[128 + kk] * wv; }
    if (hf) { sl[256 + t] = a0; sl[512 + t] = a1; }
    __syncthreads();
    if (!hf) { part[(ks * 2 + 0) * 12288 + j] = a0 + sl[256 + t]; part[(ks * 2 + 1) * 12288 + j] = a1 + sl[512 + t]; }
}
DEVI void transpose_item(const float* W, int N, bf16_t* WT, int r, char* smem) {
    const int lane = threadIdx.x & 63, wave = threadIdx.x >> 6;
    float* scr = (float*)(smem + 4096) + wave * (64 * 33);
    const int nblk = N / 32, kb = r / nblk, nb = r % nblk, k0 = 64 * kb, n0 = 32 * nb;
    {
        float4 t[8];
#pragma unroll
        for (int i = 0; i < 8; ++i) t[i] = *(const float4*)(W + (size_t)(k0 + (lane >> 3) + 8 * i) * N + n0 + 4 * (lane & 7));
#pragma unroll
        for (int i = 0; i < 8; ++i) { float* d = scr + ((lane >> 3) + 8 * i) * 33 + 4 * (lane & 7); d[0] = t[i].x; d[1] = t[i].y; d[2] = t[i].z; d[3] = t[i].w; }
    }
    const int c = lane & 7;
#pragma unroll
    for (int j = 0; j < 4; ++j) { const int n = (lane >> 3) + 8 * j; const float* sp = scr + (8 * c) * 33 + n;
        uint4 o; o.x = cvtpk(sp[0 * 33], sp[1 * 33]); o.y = cvtpk(sp[2 * 33], sp[3 * 33]); o.z = cvtpk(sp[4 * 33], sp[5 * 33]); o.w = cvtpk(sp[6 * 33], sp[7 * 33]);
        *(uint4*)(WT + (size_t)(n0 + n) * DM + k0 + 8 * c) = o; }
}
DEVI void phase0(const Params& p, char* smem) {
    float* rope = (float*)(p.ws + WS_ROPE);
    const int tid = threadIdx.x, lane = tid & 63, wave = tid >> 6;
    constexpr int N_ADA = 16 * NKS, N_ROPE = 256;
    for (int u = blockIdx.x; u < N_ADA + N_ROPE; u += gridDim.x) {
        if (u < N_ADA) {
            ada_unit_h(p, smem, u & 15, u >> 4);
        } else {
            const int idx = (u - N_ADA) * 512 + tid;
            const int t = idx >> 5, i = idx & 31;
            const double invf = exp(-(double)(2 * i) / 64.0 * 9.210340371976184);
            const double ang = (double)t * invf;
            rope[idx] = (float)cos(ang); rope[SEQ * 32 + idx] = (float)sin(ang);
        }
    }
    __syncthreads();
    {
        bf16_t* wti = (bf16_t*)(p.ws + WS_WTI);
        constexpr int I_IN = 32 * (INC / 32), I_Z = (4864 - INC) * DM / 8 / 64;
        for (int it = blockIdx.x * 8 + wave; it < I_IN + I_Z; it += gridDim.x * 8) {
            if (it >= I_IN) { const size_t o = (size_t)INC * DM + ((size_t)(it - I_IN) * 64 + lane) * 8; *(uint4*)(wti + o) = make_uint4(0u, 0u, 0u, 0u); continue; }
            transpose_item(p.w_in, INC, wti, it, smem);
        }
    }
}

DEVI float mod_from_part(const Params& p, int b, int j) {
    const float* part = (const float*)(p.ws + WS_PART);
    float s = p.b_ada[j];
#pragma unroll
    for (int ks = 0; ks < NKS; ++ks) s += part[(ks * 2 + b) * 12288 + j];
    return s;
}

constexpr int N_MODF = 48, N_WRF = 128, N_CB = 2, N_AS2 = 8, N_SPEC = N_WRF + N_CB + N_AS2 + N_MODF;
DEVI void spec_unit(const Params& p, char* smem, int v) {
    float* A1 = (float*)smem;
    const int tid = threadIdx.x, lane = tid & 63, wave = tid >> 6;
    if (v >= N_CB + N_WRF + N_AS2) {
        const int idx = (v - (N_CB + N_WRF + N_AS2)) * 512 + tid; const int b = idx / 12288, j = idx % 12288;
        ((float*)(p.ws + WS_MODF))[idx] = mod_from_part(p, b, j);
    } else {
            if (v < N_CB) {
                const int b = v;
                float* sh2 = A1 + 4 * DM;
                float* red = sh2 + DM;
                __syncthreads();
                for (int k = tid; k < DM; k += 512) sh2[k] = mod_from_part(p, b, 3 * DM + k);
                __syncthreads();
                float ae = 0.f, ag = 0.f;
#pragma unroll 16
                for (int kk = 0; kk < 256; ++kk) { const int k = wave * 256 + kk; const float sv = sh2[k]; ae += sv * p.w_re[k * 64 + lane]; ag += sv * p.w_rg[k * 8 + (lane & 7)]; }
                red[wave * 80 + lane] = ae; if (lane < 8) red[wave * 80 + 64 + lane] = ag;
                __syncthreads();
                if (tid < 80) {
                    float r = 0.f;
                    if (tid < 72) {
#pragma unroll
                        for (int w = 0; w < 8; ++w) r += red[w * 80 + tid];
                        r += (tid < 64 ? p.b_re[tid] : p.b_rg[tid - 64]);
                    }
                    ((float*)(p.ws + WS_CB))[b * 80 + tid] = r;
                }
            } else if (v < N_CB + N_WRF) {
                const int vv = v - N_CB, b = vv >> 6, ks = vv & 63, ln = tid & 63, e = tid >> 6;
                const int k = ks * 32 + 8 * (ln >> 4) + e;
                const float a2 = p.norm2_g[k] * (1.f + mod_from_part(p, b, 4 * DM + k));
                bf16_t* wrf = (bf16_t*)(p.ws + WS_WRF);
#pragma unroll
                for (int nf = 0; nf < 5; ++nf) {
                    const int j = nf * 16 + (ln & 15);
                    const float wv = j < 64 ? p.w_re[k * 64 + j] : (j < 72 ? p.w_rg[k * 8 + (j - 64)] : 0.f);
                    const float val = a2 * wv;
                    const unsigned hi = cvtpk(val, 0.f) & 0xffffu;
                    const unsigned lo = cvtpk(val - bf2f(hi), 0.f) & 0xffffu;
                    const size_t base = ((((size_t)(b * 64 + ks) * 5 + nf) * 2) * 64 + ln) * 8 + e;
                    wrf[base] = (bf16_t)hi; wrf[base + 512] = (bf16_t)lo;
                }
            } else {
                const int idx = (v - N_WRF - N_CB) * 512 + tid, b = idx >> 11, k = idx & 2047;
                float* as2 = (float*)(p.ws + WS_AS2);
                as2[idx] = p.norm2_g[k] * (1.f + mod_from_part(p, b, 4 * DM + k));
                as2[2 * DM + idx] = mod_from_part(p, b, 3 * DM + k);
            }
    }
}

DEVI void phase1(const Params& p, char* smem) {
    float* A1 = (float*)smem;
    float* S1 = A1 + 2 * DM;
    float* modf = (float*)(p.ws + WS_MODF);
    bf16_t* h = (bf16_t*)(p.ws + WS_H);
    const int tid = threadIdx.x, lane = tid & 63, wave = tid >> 6;
    constexpr int N_ROWS = NTOK / 8;
    const int upw = (N_ROWS + (int)gridDim.x - 1) / (int)gridDim.x, u_lo = (int)blockIdx.x * upw, u_hi = (u_lo + upw < N_ROWS) ? u_lo + upw : N_ROWS;
    const int b_lo = (u_lo * 8) >> 12, b_hi = u_hi > u_lo ? ((u_hi * 8 - 1) >> 12) : b_lo;
    for (int idx = tid; idx < 2 * DM; idx += 512) {
        const int b = idx >> 11, k = idx & 2047;
        if (b >= b_lo && b <= b_hi) {
            const float sh = mod_from_part(p, b, k), sc = mod_from_part(p, b, DM + k);
            A1[idx] = p.norm1_g[k] * (1.f + sc); S1[idx] = sh;
        }
    }
    __syncthreads();
    for (int u = u_lo; u < u_hi; ++u) {
        {
            const int row = u * 8 + wave, b = row >> 12;
            const float* xr = p.x + (size_t)row * DM;
            float4 v[8]; float ss = 0.f;
#pragma unroll
            for (int i = 0; i < 8; ++i) { v[i] = *(const float4*)(xr + i * 256 + lane * 4); ss += v[i].x * v[i].x + v[i].y * v[i].y + v[i].z * v[i].z + v[i].w * v[i].w; }
            ss = wave_sum(ss);
            const float rstd = rsqrtf(ss * (1.f / DM) + 1e-6f);
#pragma unroll
            for (int i = 0; i < 8; ++i) {
                const int k = i * 256 + lane * 4;
                const float4 a = *(const float4*)(A1 + b * DM + k), s = *(const float4*)(S1 + b * DM + k);
                uint2 o; o.x = cvtpk(v[i].x * rstd * a.x + s.x, v[i].y * rstd * a.y + s.y); o.y = cvtpk(v[i].z * rstd * a.z + s.z, v[i].w * rstd * a.w + s.w);
                *(uint2*)(h + (size_t)row * DM + k) = o;
            }
        }
    }
}

DEVI void phase2(const Params& p, char* smem) {
    pg8::Gemm g{(const pg8::bf16_t*)(p.ws + WS_H), (const pg8::bf16_t*)(p.ws + WS_WTI), NTOK, 4864, DM};
    pg8::StaticOrder S; S.init(NTOK, 4864, (int)gridDim.x, (int)blockIdx.x);
    pg8::EpiZ E{(pg8::bf16_t*)(p.ws + WS_Z), INC, INC};
    pg8::gemm_phase<pg8::EpiZ, pg8::StaticOrder, true, true>((PG8_LAS unsigned char*)smem, g, S, E);
    const int nthird = 608 - 2 * (int)gridDim.x;
    if (gridDim.x == 256 ? (int)blockIdx.x >= nthird : true) {
        const int nw = gridDim.x == 256 ? 256 - nthird : (int)gridDim.x, wi = gridDim.x == 256 ? (int)blockIdx.x - nthird : (int)blockIdx.x;
        __syncthreads();
        for (int u = wi; u < 512; u += nw) {
            if (u < 256) ada_unit(p, smem, 8 + (u & 15), u >> 4);
            else { __syncthreads(); transpose_item(p.w_o, DM, (bf16_t*)(p.ws + WS_WTO), (u - 256) * 8 + (int)(threadIdx.x >> 6), smem); }
        }
    }
}

DEVI float dpp_xor1(float x) { return __builtin_bit_cast(float, __builtin_amdgcn_update_dpp(0, __builtin_bit_cast(int, x), 0xB1, 0xF, 0xF, true)); }
DEVI float dpp_xor2(float x) { return __builtin_bit_cast(float, __builtin_amdgcn_update_dpp(0, __builtin_bit_cast(int, x), 0x4E, 0xF, 0xF, true)); }
DEVI float xor32_sum(float x) {
    float a = x, b = x;
    asm volatile("s_nop 1\n\tv_permlane32_swap_b32 %0, %1\n\ts_nop 1" : "+v"(a), "+v"(b));
    return a + b;
}
DEVI unsigned m64_off(int row, int chunk) { return row * 128 + ((chunk ^ ((row >> 1) & 7)) << 4); }
DEVI void mm_tile(f32x16& acc, const char* X, int xr0, const char* Y, int yr0, int l31, int hh) {
#pragma unroll
    for (int s4 = 0; s4 < 4; ++s4) {
        const bf16x8 a = *(const bf16x8*)(X + m64_off(xr0 + l31, 2 * s4 + hh));
        const bf16x8 b = *(const bf16x8*)(Y + m64_off(yr0 + l31, 2 * s4 + hh));
        acc = __builtin_amdgcn_mfma_f32_32x32x16_bf16(a, b, acc, 0, 0, 0);
    }
}
DEVI f32x16 zero16() { f32x16 z;
#pragma unroll
    for (int i = 0; i < 16; ++i) z[i] = 0.f;
    return z; }


DEVI float tokshift(const bf16_t* z, const float* mu, int tok, int c) {
    const float zc = bf2f(z[(size_t)tok * INC + ZC_RW + c]);
    const float zp = (tok & (SEQ - 1)) ? bf2f(z[(size_t)(tok - 1) * INC + ZC_RW + c]) : 0.f;
    return zc + (zp - zc) * mu[c];
}

DEVI void p3_unit(const Params& p, char* smem, int u) {
    const bf16_t* z = (const bf16_t*)(p.ws + WS_Z);
    bf16_t* mix = (bf16_t*)(p.ws + WS_MIX);
    const float* rope = (const float*)(p.ws + WS_ROPE);
    const int tid = threadIdx.x, lane = tid & 63, wave = tid >> 6;
    constexpr int N_ATT = 256;
    {
        __syncthreads();
        if (u < N_ATT) {
            constexpr int VTS = 392;
            char* Ks = smem;
            char* Vt = smem + 192 * 128;
            const int b = u >> 7, kvh = (u >> 6) & 1, qb = u & 63, t0 = qb * 64, kbase = t0 - 128;
            for (int idx = tid; idx < 192 * 4; idx += 512) {
                const int j = idx >> 2, c = idx & 3, t = kbase + j;
                uint4 o1 = make_uint4(0u, 0u, 0u, 0u), o2 = o1;
                if (t >= 0) {
                    const bf16_t* zr = z + (size_t)(b * SEQ + t) * INC + ZC_K + kvh * 64 + 8 * c;
                    const uint4 ka = *(const uint4*)zr, kb = *(const uint4*)(zr + 32);
                    const float4 c0 = *(const float4*)(rope + t * 32 + 8 * c), c1 = *(const float4*)(rope + t * 32 + 8 * c + 4);
                    const float4 s0 = *(const float4*)(rope + SEQ * 32 + t * 32 + 8 * c), s1 = *(const float4*)(rope + SEQ * 32 + t * 32 + 8 * c + 4);
                    const float a[8] = {bflo(ka.x), bfhi(ka.x), bflo(ka.y), bfhi(ka.y), bflo(ka.z), bfhi(ka.z), bflo(ka.w), bfhi(ka.w)};
                    const float bq[8] = {bflo(kb.x), bfhi(kb.x), bflo(kb.y), bfhi(kb.y), bflo(kb.z), bfhi(kb.z), bflo(kb.w), bfhi(kb.w)};
                    const float cs[8] = {c0.x, c0.y, c0.z, c0.w, c1.x, c1.y, c1.z, c1.w}, sn[8] = {s0.x, s0.y, s0.z, s0.w, s1.x, s1.y, s1.z, s1.w};
                    float r1[8], r2[8];
#pragma unroll
                    for (int e = 0; e < 8; ++e) { r1[e] = a[e] * cs[e] - bq[e] * sn[e]; r2[e] = bq[e] * cs[e] + a[e] * sn[e]; }
                    o1 = make_uint4(cvtpk(r1[0], r1[1]), cvtpk(r1[2], r1[3]), cvtpk(r1[4], r1[5]), cvtpk(r1[6], r1[7]));
                    o2 = make_uint4(cvtpk(r2[0], r2[1]), cvtpk(r2[2], r2[3]), cvtpk(r2[4], r2[5]), cvtpk(r2[6], r2[7]));
                }
                *(uint4*)(Ks + m64_off(j, c)) = o1; *(uint4*)(Ks + m64_off(j, c + 4)) = o2;
            }
            for (int idx = tid; idx < 192 * 8; idx += 512) {
                const int j = idx >> 3, c = idx & 7, t = kbase + j;
                uint4 vv = make_uint4(0u, 0u, 0u, 0u);
                if (t >= 0) vv = *(const uint4*)(z + (size_t)(b * SEQ + t) * INC + ZC_V + kvh * 64 + 8 * c);
                char* vp = Vt + (8 * c) * VTS + j * 2;
                *(bf16_t*)(vp + 0 * VTS) = (bf16_t)(vv.x & 0xffffu); *(bf16_t*)(vp + 1 * VTS) = (bf16_t)(vv.x >> 16);
                *(bf16_t*)(vp + 2 * VTS) = (bf16_t)(vv.y & 0xffffu); *(bf16_t*)(vp + 3 * VTS) = (bf16_t)(vv.y >> 16);
                *(bf16_t*)(vp + 4 * VTS) = (bf16_t)(vv.z & 0xffffu); *(bf16_t*)(vp + 5 * VTS) = (bf16_t)(vv.z >> 16);
                *(bf16_t*)(vp + 6 * VTS) = (bf16_t)(vv.w & 0xffffu); *(bf16_t*)(vp + 7 * VTS) = (bf16_t)(vv.w >> 16);
            }
            __syncthreads();
            const int h = kvh * 8 + wave, l31 = lane & 31, hh = lane >> 5;
            const float sink = p.sinks[h];
#pragma unroll 1
            for (int qt = 0; qt < 2; ++qt) {
                const int T0 = t0 + qt * 32, tq = T0 + l31;
                bf16x8 qf[4];
                {
                    const bf16_t* zr = z + (size_t)(b * SEQ + tq) * INC + h * 64 + 8 * hh;
                    uint4 raw[4];
#pragma unroll
                    for (int s4 = 0; s4 < 4; ++s4) raw[s4] = *(const uint4*)(zr + 16 * s4);
#pragma unroll
                    for (int s2 = 0; s2 < 2; ++s2) {
                        const int d0 = 16 * s2 + 8 * hh;
                        const float4 c0 = *(const float4*)(rope + tq * 32 + d0), c1 = *(const float4*)(rope + tq * 32 + d0 + 4);
                        const float4 s0 = *(const float4*)(rope + SEQ * 32 + tq * 32 + d0), s1 = *(const float4*)(rope + SEQ * 32 + tq * 32 + d0 + 4);
                        const uint4 ua = raw[s2], ub = raw[s2 + 2];
                        const float a[8] = {bflo(ua.x), bfhi(ua.x), bflo(ua.y), bfhi(ua.y), bflo(ua.z), bfhi(ua.z), bflo(ua.w), bfhi(ua.w)};
                        const float bq[8] = {bflo(ub.x), bfhi(ub.x), bflo(ub.y), bfhi(ub.y), bflo(ub.z), bfhi(ub.z), bflo(ub.w), bfhi(ub.w)};
                        const float cs[8] = {c0.x, c0.y, c0.z, c0.w, c1.x, c1.y, c1.z, c1.w}, sn[8] = {s0.x, s0.y, s0.z, s0.w, s1.x, s1.y, s1.z, s1.w};
                        float r1[8], r2[8];
#pragma unroll
                        for (int e = 0; e < 8; ++e) { r1[e] = (a[e] * cs[e] - bq[e] * sn[e]) * 0.125f; r2[e] = (bq[e] * cs[e] + a[e] * sn[e]) * 0.125f; }
                        qf[s2] = __builtin_bit_cast(bf16x8, make_uint4(cvtpk(r1[0], r1[1]), cvtpk(r1[2], r1[3]), cvtpk(r1[4], r1[5]), cvtpk(r1[6], r1[7])));
                        qf[s2 + 2] = __builtin_bit_cast(bf16x8, make_uint4(cvtpk(r2[0], r2[1]), cvtpk(r2[2], r2[3]), cvtpk(r2[4], r2[5]), cvtpk(r2[6], r2[7])));
                    }
                }
                f32x16 sc[5];
#pragma unroll
                for (int kt = 0; kt < 5; ++kt) {
                    sc[kt] = zero16();
                    const int krow = 32 * qt + 32 * kt + l31;
#pragma unroll
                    for (int s4 = 0; s4 < 4; ++s4) {
                        const bf16x8 kf = *(const bf16x8*)(Ks + m64_off(krow, 2 * s4 + hh));
                        sc[kt] = __builtin_amdgcn_mfma_f32_32x32x16_bf16(kf, qf[s4], sc[kt], 0, 0, 0);
                    }
                }
                float mx = -1e30f;
#pragma unroll
                for (int kt = 0; kt < 5; ++kt)
#pragma unroll
                    for (int i = 0; i < 16; ++i) {
                        const int r = (i & 3) + 8 * (i >> 2) + 4 * hh;
                        bool ok = (T0 - 128 + 32 * kt + r) >= 0;
                        if (kt == 0) ok = ok && (r > l31);
                        if (kt == 4) ok = ok && (r <= l31);
                        sc[kt][i] = ok ? sc[kt][i] : -1e30f;
                        mx = fmaxf(mx, sc[kt][i]);
                    }
                {
                    float a = mx, bq = mx;
                    asm volatile("s_nop 1\n\tv_permlane32_swap_b32 %0, %1\n\ts_nop 1" : "+v"(a), "+v"(bq));
                    mx = fmaxf(fmaxf(a, bq), sink);
                }
                float lsum = 0.f;
#pragma unroll
                for (int kt = 0; kt < 5; ++kt)
#pragma unroll
                    for (int i = 0; i < 16; ++i) { const float pe = __expf(sc[kt][i] - mx); sc[kt][i] = pe; lsum += pe; }
                lsum = xor32_sum(lsum) + __expf(sink - mx);
                const float inv = 1.f / lsum;
                f32x16 oacc[2];
                oacc[0] = zero16(); oacc[1] = zero16();
#pragma unroll
                for (int kt = 0; kt < 5; ++kt)
#pragma unroll
                    for (int s2 = 0; s2 < 2; ++s2) {
                        uint4 pb;
                        pb.x = cvtpk(sc[kt][8 * s2 + 0], sc[kt][8 * s2 + 1]); pb.y = cvtpk(sc[kt][8 * s2 + 2], sc[kt][8 * s2 + 3]);
                        pb.z = cvtpk(sc[kt][8 * s2 + 4], sc[kt][8 * s2 + 5]); pb.w = cvtpk(sc[kt][8 * s2 + 6], sc[kt][8 * s2 + 7]);
                        const int kloc = 32 * qt + 32 * kt + 16 * s2 + 4 * hh;
#pragma unroll
                        for (int dt = 0; dt < 2; ++dt) {
                            const char* vp = Vt + (dt * 32 + l31) * VTS + kloc * 2;
                            const uint2 v0 = *(const uint2*)vp, v1 = *(const uint2*)(vp + 16);
                            const bf16x8 vf = __builtin_bit_cast(bf16x8, make_uint4(v0.x, v0.y, v1.x, v1.y));
                            oacc[dt] = __builtin_amdgcn_mfma_f32_32x32x16_bf16(vf, __builtin_bit_cast(bf16x8, pb), oacc[dt], 0, 0, 0);
                        }
                    }
                bf16_t* orow = mix + (size_t)(b * SEQ + tq) * DM + h * 64;
#pragma unroll
                for (int dt = 0; dt < 2; ++dt)
#pragma unroll
                    for (int q = 0; q < 4; ++q) {
                        uint2 o; o.x = cvtpk(oacc[dt][4 * q] * inv, oacc[dt][4 * q + 1] * inv); o.y = cvtpk(oacc[dt][4 * q + 2] * inv, oacc[dt][4 * q + 3] * inv);
                        *(uint2*)(orow + dt * 32 + 8 * q + 4 * hh) = o;
                    }
            }
        } else {
            const int v = u - N_ATT, prod = 2 - (v >> 7), mt = v & 31, nt = (v >> 5) & 3;
            const int row0 = mt * 256, col0 = nt * 256 + wave * 32, li = lane & 15, lg = lane >> 4;
            const int koff = prod == 0 ? 3072 : (prod == 1 ? 3136 : 3200), nk = prod == 2 ? 5 : 2;
            const float* W = prod == 0 ? p.wd_up : (prod == 1 ? p.wa_up : p.wg_up);
            const float* bp0 = W + (size_t)(8 * lg) * RW + col0 + li; const float* bp1 = bp0 + 16;
            const int srow = row0 + (tid >> 2), scol = koff + (tid & 3) * 8;
            auto aload = [&](int i, int kt) -> uint4 {
                const int tok = srow + 128 * i, c = scol + kt * 32;
                const uint4 zc = *(const uint4*)(z + (size_t)tok * INC + ZC_RW + c);
                uint4 zp = make_uint4(0u, 0u, 0u, 0u);
                if (tok & (SEQ - 1)) zp = *(const uint4*)(z + (size_t)(tok - 1) * INC + ZC_RW + c);
                const float4 m0 = *(const float4*)(p.mu + c), m1 = *(const float4*)(p.mu + c + 4);
                const float a[8] = {bflo(zc.x), bfhi(zc.x), bflo(zc.y), bfhi(zc.y), bflo(zc.z), bfhi(zc.z), bflo(zc.w), bfhi(zc.w)};
                const float q[8] = {bflo(zp.x), bfhi(zp.x), bflo(zp.y), bfhi(zp.y), bflo(zp.z), bfhi(zp.z), bflo(zp.w), bfhi(zp.w)};
                const float mm[8] = {m0.x, m0.y, m0.z, m0.w, m1.x, m1.y, m1.z, m1.w};
                float o[8];
#pragma unroll
                for (int e = 0; e < 8; ++e) {
                    const float zs = a[e] + (q[e] - a[e]) * mm[e];
                    o[e] = prod == 0 ? (1.f - 2.f / (1.f + __expf(2.f * zs))) : (prod == 1 ? zs : sigmoidf_(zs));
                }
                return make_uint4(cvtpk(o[0], o[1]), cvtpk(o[2], o[3]), cvtpk(o[4], o[5]), cvtpk(o[6], o[7]));
            };
            float* LWb = (float*)(p.ws + WS_LW); bf16_t* AVb = (bf16_t*)(p.ws + WS_AV); bf16_t* GVb = (bf16_t*)(p.ws + WS_GV);
            gemm_tile_f<1, 2>(smem, nk, RW, bp0, bp1, aload, [&](f32x4 (&acc)[16][2]) {
#pragma unroll
                for (int nf = 0; nf < 2; ++nf) {
                    const int col = col0 + nf * 16 + 4 * lg;
                    const float4 w0c = *(const float4*)(p.w0 + col), a0c = *(const float4*)(p.a0 + col);
                    const float wc[4] = {w0c.x, w0c.y, w0c.z, w0c.w}, ac[4] = {a0c.x, a0c.y, a0c.z, a0c.w};
#pragma unroll
                    for (int m = 0; m < 16; ++m) {
                        const size_t o = (size_t)(row0 + 16 * m + li) * RW + col;
                        if (prod == 0) {
                            float r[4];
#pragma unroll
                            for (int e = 0; e < 4; ++e) r[e] = -0.60653065971f * sigmoidf_(wc[e] + acc[m][nf][e]);
                            *(float4*)(LWb + o) = make_float4(r[0], r[1], r[2], r[3]);
                        } else if (prod == 1) {
                            uint2 ob; ob.x = cvtpk(sigmoidf_(ac[0] + acc[m][nf][0]), sigmoidf_(ac[1] + acc[m][nf][1])); ob.y = cvtpk(sigmoidf_(ac[2] + acc[m][nf][2]), sigmoidf_(ac[3] + acc[m][nf][3]));
                            *(uint2*)(AVb + o) = ob;
                        } else {
                            uint2 ob; ob.x = cvtpk(acc[m][nf][0], acc[m][nf][1]); ob.y = cvtpk(acc[m][nf][2], acc[m][nf][3]);
                            *(uint2*)(GVb + o) = ob;
                        }
                    }
                }
            });
        }
    }
}
DEVI void phase3(const Params& p, char* smem) {
    for (int v = blockIdx.x; v < 384; v += gridDim.x) p3_unit(p, smem, 256 + v);
}

DEVI void phase4(const Params& p, char* smem) {
    const int tid = threadIdx.x, lane = tid & 63, wave = tid >> 6;
    const float* const pAA = (const float*)(p.ws + WS_AA); const float* const pDE = (const float*)(p.ws + WS_DEC); const float* const pBB = (const float*)(p.ws + WS_BB);
    const float* const pK2 = (const float*)(p.ws + WS_K2); const float* const pR = (const float*)(p.ws + WS_R); const float* const pV = (const float*)(p.ws + WS_V);
    float* Y = (float*)(p.ws + WS_Y);
    constexpr int CH = 32;
    float* bufs = (float*)smem;
    for (int u = blockIdx.x; u < 32; u += gridDim.x) {
        const int b = u >> 4, h = u & 15;
        const int vr = lane >> 2, kq = lane & 3;
        float s[16];
#pragma unroll
        for (int j = 0; j < 16; ++j) s[j] = 0.f;
        __syncthreads();
        const int lst = tid >> 4, lc4 = tid & 15;
        const size_t goff = (size_t)(b * SEQ + lst) * RW + h * 64 + lc4 * 4;
        const int loff = lst * 64 + lc4 * 4;
        {
            *(float4*)(bufs + 0 * CH * 64 + loff) = *(const float4*)(pAA + goff); *(float4*)(bufs + 1 * CH * 64 + loff) = *(const float4*)(pDE + goff);
            *(float4*)(bufs + 2 * CH * 64 + loff) = *(const float4*)(pBB + goff); *(float4*)(bufs + 3 * CH * 64 + loff) = *(const float4*)(pK2 + goff);
            *(float4*)(bufs + 4 * CH * 64 + loff) = *(const float4*)(pR + goff); *(float4*)(bufs + 5 * CH * 64 + loff) = *(const float4*)(pV + goff);
        }
        __syncthreads();
        for (int c = 0; c < SEQ / CH; ++c) {
            float* cur = bufs + (c & 1) * (6 * CH * 64);
            float* nxt = bufs + ((c + 1) & 1) * (6 * CH * 64);
            float4 pre0, pre1, pre2, pre3, pre4, pre5;
            if (c + 1 < SEQ / CH) {
                const size_t g2 = goff + (size_t)(c + 1) * CH * RW;
                pre0 = *(const float4*)(pAA + g2); pre1 = *(const float4*)(pDE + g2); pre2 = *(const float4*)(pBB + g2);
                pre3 = *(const float4*)(pK2 + g2); pre4 = *(const float4*)(pR + g2); pre5 = *(const float4*)(pV + g2);
            }
            if (wave < 4) {
                for (int st = 0; st < CH; ++st) {
                    const float* aa = cur + (0 * CH + st) * 64 + kq * 16;
                    const float* de = cur + (1 * CH + st) * 64 + kq * 16;
                    const float* bb = cur + (2 * CH + st) * 64 + kq * 16;
                    const float* k2 = cur + (3 * CH + st) * 64 + kq * 16;
                    const float* rr = cur + (4 * CH + st) * 64 + kq * 16;
                    const float v = cur[(5 * CH + st) * 64 + wave * 16 + vr];
                    float sa = 0.f;
#pragma unroll
                    for (int j = 0; j < 16; ++j) sa += s[j] * aa[j];
                    sa += __shfl_xor(sa, 1, 64); sa += __shfl_xor(sa, 2, 64);
                    float y = 0.f;
#pragma unroll
                    for (int j = 0; j < 16; ++j) { s[j] = s[j] * de[j] + sa * bb[j] + v * k2[j]; y += s[j] * rr[j]; }
                    y += __shfl_xor(y, 1, 64); y += __shfl_xor(y, 2, 64);
                    if (kq == 0) Y[(size_t)(b * SEQ + c * CH + st) * RW + h * 64 + wave * 16 + vr] = y;
                }
            }
            if (c + 1 < SEQ / CH) {
                *(float4*)(nxt + 0 * CH * 64 + loff) = pre0; *(float4*)(nxt + 1 * CH * 64 + loff) = pre1; *(float4*)(nxt + 2 * CH * 64 + loff) = pre2;
                *(float4*)(nxt + 3 * CH * 64 + loff) = pre3; *(float4*)(nxt + 4 * CH * 64 + loff) = pre4; *(float4*)(nxt + 5 * CH * 64 + loff) = pre5;
            }
            __syncthreads();
        }
    }
}

DEVI void phase5(const Params& p, char* smem) {
    const int tid = threadIdx.x, lane = tid & 63, wave = tid >> 6;
    const float* Y = (const float*)(p.ws + WS_Y); const float* Vb = (const float*)(p.ws + WS_V); const float* Gb = (const float*)(p.ws + WS_G); const float* RKSb = (const float*)(p.ws + WS_RKS);
    bf16_t* mix = (bf16_t*)(p.ws + WS_MIX);
    for (int u = blockIdx.x; u < NTOK * 16 / 8; u += gridDim.x) {
        const int pi = u * 8 + wave, tok = pi >> 4, head = pi & 15, ch = head * 64 + lane;
        const float y = Y[(size_t)tok * RW + ch];
        const float mean = wave_sum(y) * (1.f / 64.f);
        const float d = y - mean;
        const float var = wave_sum(d * d) * (1.f / 64.f);
        const float yn = d * rsqrtf(var + 64e-5f) * p.ln_w[ch] + p.ln_b[ch];
        const float o = (yn + RKSb[tok * 16 + head] * Vb[(size_t)tok * RW + ch]) * Gb[(size_t)tok * RW + ch];
        mix[(size_t)tok * DM + 1024 + ch] = (bf16_t)(cvtpk(o, 0.f) & 0xffffu);
    }
}


constexpr int RA_AT = 0, RA_BT = 8192, RA_KT = 16384, RA_RT = 24576, RA_BPT = 32768, RA_KPT = 40960, RA_VT = 49152, RA_AAK = 57344, RA_ARB = 65536, RA_ARK = 73728,
              RA_AABP = 81920, RA_RHS = 98304, RA_WL = 131072, RA_SEG = 131328, RA_P1T = RA_BT, RA_P2T = RA_KT, RA_CUM = RA_AABP;

DEVI void phaseRA(const Params& p, char* smem) {
    const int tid = threadIdx.x, lane = tid & 63, wave = tid >> 6, l31 = lane & 31, hh = lane >> 5;
    const bf16_t* z = (const bf16_t*)(p.ws + WS_Z);
    float* cumb = (float*)(smem + RA_CUM); float* segs = (float*)(smem + RA_SEG); float* wl = (float*)(smem + RA_WL);
    float* rhs = (float*)(smem + RA_RHS); float* aabp = (float*)(smem + RA_AABP);
    uint4 n_cr, n_ck, n_cv, n_pr, n_pk, n_pv, n_au; float4 n_lw0, n_lw1;
    auto load_raw = [&](int unit_) {
        const int bh_ = unit_ >> 6, c_ = unit_ & 63, b_ = bh_ >> 4, h_ = bh_ & 15;
        const int tok = b_ * SEQ + c_ * 64 + (tid >> 3), ch0 = h_ * 64 + (tid & 7) * 8;
        const bf16_t* zr = z + (size_t)tok * INC + ZC_RW + ch0;
        const bool hasp = (tok & (SEQ - 1)) != 0;
        const uint4 zero4 = make_uint4(0u, 0u, 0u, 0u);
        n_cr = *(const uint4*)zr; n_ck = *(const uint4*)(zr + 1024); n_cv = *(const uint4*)(zr + 2048);
        n_pr = hasp ? *(const uint4*)(zr - INC) : zero4; n_pk = hasp ? *(const uint4*)(zr - INC + 1024) : zero4; n_pv = hasp ? *(const uint4*)(zr - INC + 2048) : zero4;
        n_au = *(const uint4*)((const bf16_t*)(p.ws + WS_AV) + (size_t)tok * RW + ch0);
        const float* lwp = (const float*)(p.ws + WS_LW) + (size_t)tok * RW + ch0;
        n_lw0 = *(const float4*)lwp; n_lw1 = *(const float4*)(lwp + 4);
    };
    if (((int)blockIdx.x >> 3) < 256) load_raw((((int)blockIdx.x & 7) + 8 * (((int)blockIdx.x >> 3) >> 6)) * 64 + (((int)blockIdx.x >> 3) & 63));
    const int ra_x = (int)blockIdx.x & 7, ra_slot = (int)blockIdx.x >> 3, ra_nslot = ((int)gridDim.x - ra_x + 7) >> 3;
    for (int uu = ra_slot; uu < 256; uu += ra_nslot) {
        const int bh = ra_x + 8 * (uu >> 6), c = uu & 63, b = bh >> 4, h = bh & 15;
        const int unit = bh * 64 + c;
        const int tokbase = b * SEQ + c * 64;
        __syncthreads();
        const int t = tid >> 3, c8 = tid & 7;
        float r_[8], k2[8], v_[8], aa[8], bb[8], lw[8];
        {
            const int tok = tokbase + t, ch0 = h * 64 + c8 * 8;
            const uint4 cr = n_cr, ck = n_ck, cv = n_cv, pr = n_pr, pk_ = n_pk, pv = n_pv, au = n_au;
            float fr[8], fk[8], fpr[8], fpk[8], fpv[8], mur[8], muk[8], muv[8], av[8], kkc[8], kac[8], rkc[8];
#define UNPK8(dst, u) { dst[0] = bflo(u.x); dst[1] = bfhi(u.x); dst[2] = bflo(u.y); dst[3] = bfhi(u.y); dst[4] = bflo(u.z); dst[5] = bfhi(u.z); dst[6] = bflo(u.w); dst[7] = bfhi(u.w); }
#define LDF8(dst, ptr) { const float4 q0_ = *(const float4*)(ptr), q1_ = *(const float4*)((ptr) + 4); dst[0] = q0_.x; dst[1] = q0_.y; dst[2] = q0_.z; dst[3] = q0_.w; dst[4] = q1_.x; dst[5] = q1_.y; dst[6] = q1_.z; dst[7] = q1_.w; }
            UNPK8(fr, cr) UNPK8(fk, ck) UNPK8(v_, cv) UNPK8(fpr, pr) UNPK8(fpk, pk_) UNPK8(fpv, pv) UNPK8(av, au)
            LDF8(mur, p.mu + ch0) LDF8(muk, p.mu + 1024 + ch0) LDF8(muv, p.mu + 2048 + ch0)
            LDF8(kkc, p.k_k + ch0) LDF8(kac, p.k_a + ch0) LDF8(rkc, p.r_k + ch0)
            lw[0] = n_lw0.x; lw[1] = n_lw0.y; lw[2] = n_lw0.z; lw[3] = n_lw0.w; lw[4] = n_lw1.x; lw[5] = n_lw1.y; lw[6] = n_lw1.z; lw[7] = n_lw1.w;
            float ssq = 0.f, rk = 0.f, kk[8];
#pragma unroll
            for (int i = 0; i < 8; ++i) {
                r_[i] = fr[i] + (fpr[i] - fr[i]) * mur[i];
                const float kx = fk[i] + (fpk[i] - fk[i]) * muk[i];
                v_[i] = v_[i] + (fpv[i] - v_[i]) * muv[i];
                kk[i] = kx * kkc[i]; ssq += kk[i] * kk[i];
                k2[i] = kx * (1.f + (av[i] - 1.f) * kac[i]);
                rk += r_[i] * k2[i] * rkc[i];
            }
            ssq += dpp_xor1(ssq); ssq += dpp_xor2(ssq); ssq += __shfl_xor(ssq, 4, 64);
            rk += dpp_xor1(rk); rk += dpp_xor2(rk); rk += __shfl_xor(rk, 4, 64);
            const float invn = 1.f / fmaxf(sqrtf(ssq), 1e-12f);
#pragma unroll
            for (int i = 0; i < 8; ++i) { const float kn = kk[i] * invn; aa[i] = -kn; bb[i] = kn * av[i]; }
            if (c8 == 0) ((float*)(p.ws + WS_RKS))[tok * 16 + h] = rk;
        }
#pragma unroll
        for (int i = 0; i < 8; ++i) cumb[t * 64 + c8 * 8 + i] = lw[i];
        __syncthreads();
        if (uu + ra_nslot < 256) { const int u2 = uu + ra_nslot; load_raw((ra_x + 8 * (u2 >> 6)) * 64 + (u2 & 63)); }
        {
            const int ch = tid & 63, seg = tid >> 6;
            float loc[8]; float run = 0.f;
#pragma unroll
            for (int j = 0; j < 8; ++j) { run += cumb[(seg * 8 + j) * 64 + ch]; loc[j] = run; }
            segs[seg * 64 + ch] = run;
            __syncthreads();
            float off = 0.f;
#pragma unroll
            for (int s2 = 0; s2 < 8; ++s2) off += (s2 < seg) ? segs[s2 * 64 + ch] : 0.f;
#pragma unroll
            for (int j = 0; j < 8; ++j) cumb[(seg * 8 + j) * 64 + ch] = off + loc[j];
        }
        __syncthreads();
        {
            unsigned pk[7][4];
            float atf[8];
#pragma unroll
            for (int i = 0; i < 8; i += 2) {
                float o[7][2];
#pragma unroll
                for (int e = 0; e < 2; ++e) {
                    const float cu = cumb[t * 64 + c8 * 8 + i + e], cl = cumb[63 * 64 + c8 * 8 + i + e];
                    const float e1 = __expf(cu), e2 = 1.f / e1, ex = __expf(cu - lw[i + e]), ew = __expf(cl - cu);
                    o[0][e] = aa[i + e] * ex; o[1][e] = bb[i + e] * e2; o[2][e] = k2[i + e] * e2; o[3][e] = r_[i + e] * e1;
                    o[4][e] = bb[i + e] * ew; o[5][e] = k2[i + e] * ew; o[6][e] = v_[i + e];
                    atf[i + e] = o[0][e];
                    if (t == 63) wl[c8 * 8 + i + e] = e1;
                }
#pragma unroll
                for (int m = 0; m < 7; ++m) pk[m][i >> 1] = cvtpk(o[m][0], o[m][1]);
            }
            const unsigned ro = m64_off(t, c8);
            *(uint4*)(smem + RA_AT + ro) = make_uint4(pk[0][0], pk[0][1], pk[0][2], pk[0][3]);
            *(uint4*)(smem + RA_BT + ro) = make_uint4(pk[1][0], pk[1][1], pk[1][2], pk[1][3]);
            *(uint4*)(smem + RA_KT + ro) = make_uint4(pk[2][0], pk[2][1], pk[2][2], pk[2][3]);
            *(uint4*)(smem + RA_RT + ro) = make_uint4(pk[3][0], pk[3][1], pk[3][2], pk[3][3]);
            *(float4*)(rhs + t * 128 + c8 * 8) = make_float4(atf[0], atf[1], atf[2], atf[3]);
            *(float4*)(rhs + t * 128 + c8 * 8 + 4) = make_float4(atf[4], atf[5], atf[6], atf[7]);
#pragma unroll
            for (int i = 0; i < 8; ++i) {
                const int ch = c8 * 8 + i;
                const unsigned to = m64_off(ch, t >> 3) + (t & 7) * 2;
                const unsigned w4 = pk[4][i >> 1], w5 = pk[5][i >> 1], w6 = pk[6][i >> 1];
                *(bf16_t*)(smem + RA_BPT + to) = (bf16_t)((i & 1) ? (w4 >> 16) : (w4 & 0xffffu));
                *(bf16_t*)(smem + RA_KPT + to) = (bf16_t)((i & 1) ? (w5 >> 16) : (w5 & 0xffffu));
                *(bf16_t*)(smem + RA_VT + to) = (bf16_t)((i & 1) ? (w6 >> 16) : (w6 & 0xffffu));
            }
        }
        __syncthreads();
        {
            const int pr = wave >> 1, sub = wave & 1;
            const char* X = smem + ((pr & 1) ? RA_KT : RA_BT);
            const char* Y = smem + ((pr & 2) ? RA_RT : RA_AT);
            const int incl = (pr & 2) ? 1 : 0;
            char* dst = smem + (pr == 1 ? RA_AAK : pr == 2 ? RA_ARB : RA_ARK);
#pragma unroll
            for (int tt = 0; tt < 2; ++tt) {
                const int i0 = sub ? (tt ? 32 : 0) : (tt ? 32 : 0);
                const int t0 = sub ? (tt ? 0 : 32) : (tt ? 32 : 0);
                const bool zero_tile = sub && tt;
                f32x16 acc = zero16();
                if (!zero_tile) mm_tile(acc, X, i0, Y, t0, l31, hh);
                const int tq = t0 + l31;
#pragma unroll
                for (int q = 0; q < 4; ++q) {
                    float vv[4];
#pragma unroll
                    for (int e = 0; e < 4; ++e) { const int ii = i0 + 8 * q + 4 * hh + e; vv[e] = (ii < tq + incl) ? acc[4 * q + e] : 0.f; }
                    if (pr == 0) {
                        if (!zero_tile) {
#pragma unroll
                            for (int e = 0; e < 4; ++e) aabp[tq * 64 + e * 16 + (i0 >> 2) + 2 * q + hh] = vv[e];
                        }
                    } else {
                        uint2 o; o.x = cvtpk(vv[0], vv[1]); o.y = cvtpk(vv[2], vv[3]);
                        *(uint2*)(dst + m64_off(tq, (i0 >> 3) + q) + 8 * hh) = o;
                    }
                }
            }
        }
        __syncthreads();
        f32x16 accA = zero16();
        const int w4 = wave & 3, ta = w4 & 1, tb2 = w4 >> 1;
        if (wave < 4) {
            f32x16 x2 = zero16();
            mm_tile(x2, smem + RA_VT, ta * 32, smem + RA_AAK, tb2 * 32, l31, hh);
            const int tq = tb2 * 32 + l31;
#pragma unroll
            for (int q = 0; q < 4; ++q) *(float4*)(rhs + tq * 128 + 64 + ta * 32 + 8 * q + 4 * hh) = make_float4(x2[4 * q], x2[4 * q + 1], x2[4 * q + 2], x2[4 * q + 3]);
            mm_tile(accA, smem + RA_VT, ta * 32, smem + RA_ARK, tb2 * 32, l31, hh);
        } else {
            mm_tile(accA, smem + RA_KPT, ta * 32, smem + RA_VT, tb2 * 32, l31, hh);
        }
        __syncthreads();
        {
            const int g = lane & 3, col = wave * 16 + (lane >> 2);
            float P[16];
#pragma unroll
            for (int q = 0; q < 16; ++q) P[q] = 0.f;
            float last[4];
            char* pt = smem + (col < 64 ? RA_P1T : RA_P2T);
            const int prow = col & 63;
            float4 acur[4]; float rcur = rhs[col];
#pragma unroll
            for (int q4 = 0; q4 < 4; ++q4) acur[q4] = make_float4(0.f, 0.f, 0.f, 0.f);
#pragma unroll
            for (int ts = 0; ts < 64; ++ts) {
                float4 anxt[4]; float rnxt = 0.f;
#pragma unroll
                for (int q4 = 0; q4 < 4; ++q4) anxt[q4] = make_float4(0.f, 0.f, 0.f, 0.f);
                if (ts + 1 < 64) {
                    const int nq4n = (((ts + 4) >> 2) + 3) >> 2;
#pragma unroll
                    for (int q4 = 0; q4 < nq4n; ++q4) anxt[q4] = *(const float4*)(aabp + (ts + 1) * 64 + g * 16 + q4 * 4);
                    rnxt = rhs[(ts + 1) * 128 + col];
                }
                float part = 0.f;
                const int nq4 = (((ts + 3) >> 2) + 3) >> 2;
#pragma unroll
                for (int q4 = 0; q4 < nq4; ++q4) {
                    const float4 a = acur[q4];
                    part += a.x * P[4 * q4] + a.y * P[4 * q4 + 1] + a.z * P[4 * q4 + 2] + a.w * P[4 * q4 + 3];
                }
                part += dpp_xor1(part); part += dpp_xor2(part);
                const float val = rcur + part;
#pragma unroll
                for (int q4 = 0; q4 < 4; ++q4) acur[q4] = anxt[q4];
                rcur = rnxt;
                if (g == (ts & 3)) P[ts >> 2] = val;
                last[ts & 3] = val;
                if ((ts & 3) == 3 && g == 0) {
                    uint2 o; o.x = cvtpk(last[0], last[1]); o.y = cvtpk(last[2], last[3]);
                    *(uint2*)(pt + m64_off(prow, ts >> 3) + ((ts >> 2) & 1) * 8) = o;
                }
            }
        }
        __syncthreads();
        if (wave < 4) {
            mm_tile(accA, smem + RA_P2T, ta * 32, smem + RA_ARB, tb2 * 32, l31, hh);
            float* q2 = (float*)(p.ws + WS_Q2) + ((size_t)unit * 4 + (ta * 2 + tb2)) * 1024;
#pragma unroll
            for (int i = 0; i < 16; ++i) q2[i * 64 + lane] = accA[i];
            f32x16 q1 = zero16();
            mm_tile(q1, smem + RA_P1T, ta * 32, smem + RA_ARB, tb2 * 32, l31, hh);
            const int tq = tb2 * 32 + l31;
            bf16_t* q1g = (bf16_t*)(p.ws + WS_Q1) + (size_t)unit * 4096 + tq * 64;
#pragma unroll
            for (int q = 0; q < 4; ++q) {
                const int k0 = ta * 32 + 8 * q + 4 * hh;
                const uint2 rr = *(const uint2*)(smem + RA_RT + m64_off(tq, k0 >> 3) + (k0 & 7) * 2);
                uint2 o; o.x = cvtpk(q1[4 * q] + bflo(rr.x), q1[4 * q + 1] + bfhi(rr.x)); o.y = cvtpk(q1[4 * q + 2] + bflo(rr.y), q1[4 * q + 3] + bfhi(rr.y));
                *(uint2*)(q1g + k0) = o;
            }
        } else {
            mm_tile(accA, smem + RA_BPT, ta * 32, smem + RA_P2T, tb2 * 32, l31, hh);
            unsigned* hb = (unsigned*)(p.ws + WS_HB) + ((size_t)unit * 4 + (ta * 2 + tb2)) * 512;
#pragma unroll
            for (int j = 0; j < 8; ++j) hb[j * 64 + lane] = cvtpk(accA[2 * j], accA[2 * j + 1]);
            f32x16 gg = zero16();
            mm_tile(gg, smem + RA_P1T, ta * 32, smem + RA_BPT, tb2 * 32, l31, hh);
            if (ta == tb2) {
#pragma unroll
                for (int i = 0; i < 16; ++i) { const int kk = (i & 3) + 8 * (i >> 2) + 4 * hh; if (kk == l31) gg[i] += wl[ta * 32 + kk]; }
            }
            unsigned* gb = (unsigned*)(p.ws + WS_GB) + ((size_t)unit * 4 + (ta * 2 + tb2)) * 512 + lane * 8;
            uint4 o0, o1;
            o0.x = cvtpk(gg[0], gg[1]); o0.y = cvtpk(gg[2], gg[3]); o0.z = cvtpk(gg[4], gg[5]); o0.w = cvtpk(gg[6], gg[7]);
            o1.x = cvtpk(gg[8], gg[9]); o1.y = cvtpk(gg[10], gg[11]); o1.z = cvtpk(gg[12], gg[13]); o1.w = cvtpk(gg[14], gg[15]);
            *(uint4*)(gb) = o0; *(uint4*)(gb + 4) = o1;
        }
    }
}

struct RbH { unsigned w[2][8]; };
DEVI void rb_load(const Params& p, int unit, int vh, int lane, uint4 (&g)[8], RbH& hq) {
    const unsigned* gb = (const unsigned*)(p.ws + WS_GB) + (size_t)unit * 2048 + lane * 8;
    const unsigned* hb = (const unsigned*)(p.ws + WS_HB) + (size_t)unit * 2048 + lane;
#pragma unroll
    for (int t4 = 0; t4 < 4; ++t4) { g[2 * t4] = *(const uint4*)(gb + t4 * 512); g[2 * t4 + 1] = *(const uint4*)(gb + t4 * 512 + 4); }
#pragma unroll
    for (int j = 0; j < 8; ++j) { hq.w[0][j] = hb[(0 * 2 + vh) * 512 + j * 64]; hq.w[1][j] = hb[(1 * 2 + vh) * 512 + j * 64]; }
}
DEVI void rb_store(const Params& p, int unit, int vh, int l31, int hh, const f32x16& X0, const f32x16& X1) {
    bf16_t* s0 = (bf16_t*)(p.ws + WS_S0) + (size_t)unit * 4096 + (vh * 32 + l31) * 64;
#pragma unroll
    for (int q = 0; q < 4; ++q) {
        uint2 o; o.x = cvtpk(X0[4 * q], X0[4 * q + 1]); o.y = cvtpk(X0[4 * q + 2], X0[4 * q + 3]);
        *(uint2*)(s0 + 8 * q + 4 * hh) = o;
        uint2 o2; o2.x = cvtpk(X1[4 * q], X1[4 * q + 1]); o2.y = cvtpk(X1[4 * q + 2], X1[4 * q + 3]);
        *(uint2*)(s0 + 32 + 8 * q + 4 * hh) = o2;
    }
}
#define BF8(u) __builtin_bit_cast(bf16x8, u)
DEVI void rb_step(f32x16& X0, f32x16& X1, const uint4 (&g)[8], const RbH& hq) {
    uint4 xa, xb, xc, xd;
    xa.x = cvtpk(X0[0], X0[1]); xa.y = cvtpk(X0[2], X0[3]); xa.z = cvtpk(X0[4], X0[5]); xa.w = cvtpk(X0[6], X0[7]);
    xb.x = cvtpk(X0[8], X0[9]); xb.y = cvtpk(X0[10], X0[11]); xb.z = cvtpk(X0[12], X0[13]); xb.w = cvtpk(X0[14], X0[15]);
    xc.x = cvtpk(X1[0], X1[1]); xc.y = cvtpk(X1[2], X1[3]); xc.z = cvtpk(X1[4], X1[5]); xc.w = cvtpk(X1[6], X1[7]);
    xd.x = cvtpk(X1[8], X1[9]); xd.y = cvtpk(X1[10], X1[11]); xd.z = cvtpk(X1[12], X1[13]); xd.w = cvtpk(X1[14], X1[15]);
    f32x16 N0, N1;
#pragma unroll
    for (int j = 0; j < 8; ++j) { N0[2 * j] = bflo(hq.w[0][j]); N0[2 * j + 1] = bfhi(hq.w[0][j]); N1[2 * j] = bflo(hq.w[1][j]); N1[2 * j + 1] = bfhi(hq.w[1][j]); }
    N0 = __builtin_amdgcn_mfma_f32_32x32x16_bf16(BF8(g[0]), BF8(xa), N0, 0, 0, 0);
    N1 = __builtin_amdgcn_mfma_f32_32x32x16_bf16(BF8(g[2]), BF8(xa), N1, 0, 0, 0);
    N0 = __builtin_amdgcn_mfma_f32_32x32x16_bf16(BF8(g[1]), BF8(xb), N0, 0, 0, 0);
    N1 = __builtin_amdgcn_mfma_f32_32x32x16_bf16(BF8(g[3]), BF8(xb), N1, 0, 0, 0);
    N0 = __builtin_amdgcn_mfma_f32_32x32x16_bf16(BF8(g[4]), BF8(xc), N0, 0, 0, 0);
    N1 = __builtin_amdgcn_mfma_f32_32x32x16_bf16(BF8(g[6]), BF8(xc), N1, 0, 0, 0);
    N0 = __builtin_amdgcn_mfma_f32_32x32x16_bf16(BF8(g[5]), BF8(xd), N0, 0, 0, 0);
    N1 = __builtin_amdgcn_mfma_f32_32x32x16_bf16(BF8(g[7]), BF8(xd), N1, 0, 0, 0);
    X0 = N0; X1 = N1;
}
DEVI void phaseRB_core(const Params& p, char* smem) {
    const int tid = threadIdx.x, lane = tid & 63, wave = tid >> 6, l31 = lane & 31, hh = lane >> 5;
    if (wave != 0) return;
    for (int wu = blockIdx.x; wu < 64; wu += gridDim.x) {
        const int bh = (wu & 7) | ((wu >> 4) << 3), vh = (wu >> 3) & 1;
        f32x16 X0 = zero16(), X1 = zero16();
        uint4 gA[8], gB[8], gC[8]; RbH hA, hB, hC;
        rb_load(p, bh * 64, vh, lane, gA, hA);
        rb_load(p, bh * 64 + 1, vh, lane, gB, hB);
        for (int c = 0; c < 63; c += 3) {
            rb_load(p, bh * 64 + (c + 2 < 64 ? c + 2 : 63), vh, lane, gC, hC);
            rb_store(p, bh * 64 + c, vh, l31, hh, X0, X1);
            rb_step(X0, X1, gA, hA);
            rb_load(p, bh * 64 + (c + 3 < 64 ? c + 3 : 63), vh, lane, gA, hA);
            rb_store(p, bh * 64 + c + 1, vh, l31, hh, X0, X1);
            rb_step(X0, X1, gB, hB);
            rb_load(p, bh * 64 + (c + 4 < 64 ? c + 4 : 63), vh, lane, gB, hB);
            rb_store(p, bh * 64 + c + 2, vh, l31, hh, X0, X1);
            rb_step(X0, X1, gC, hC);
        }
        rb_store(p, bh * 64 + 63, vh, l31, hh, X0, X1);
    }
}

DEVI void phaseRB(const Params& p, char* smem) {
    const bool split = gridDim.x >= 128;
    if (split && blockIdx.x < 64) { phaseRB_core(p, smem); return; }
    const int nw = split ? (int)gridDim.x - 64 : (int)gridDim.x, wi = split ? (int)blockIdx.x - 64 : (int)blockIdx.x;
    for (int u = wi; u < 256; u += nw) p3_unit(p, smem, u);
    if (!split) { __syncthreads(); phaseRB_core(p, smem); }
}

DEVI void phaseRC(const Params& p, char* smem) {
    const int tid = threadIdx.x, lane = tid & 63, wave = tid >> 6, l31 = lane & 31, hh = lane >> 5;
    const bf16_t* z = (const bf16_t*)(p.ws + WS_Z); const bf16_t* GVb = (const bf16_t*)(p.ws + WS_GV); const float* RKSb = (const float*)(p.ws + WS_RKS);
    bf16_t* mix = (bf16_t*)(p.ws + WS_MIX);
    for (int it0 = blockIdx.x; it0 < 512 + N_SPEC; it0 += gridDim.x) {
        if (it0 < N_SPEC) { spec_unit(p, smem, it0); continue; }
        const int it = it0 - N_SPEC;
        const int unit = it * 4 + (wave >> 1), tb = wave & 1;
        const int bh = unit >> 6, c = unit & 63, b = bh >> 4, h = bh & 15;
        const int tq = tb * 32 + l31, tok = b * SEQ + c * 64 + tq;
        const float* q2 = (const float*)(p.ws + WS_Q2) + (size_t)unit * 4096 + lane;
        f32x16 a0, a1;
#pragma unroll
        for (int i = 0; i < 16; ++i) { a0[i] = q2[(0 * 2 + tb) * 1024 + i * 64]; a1[i] = q2[(1 * 2 + tb) * 1024 + i * 64]; }
        const bf16_t* s0 = (const bf16_t*)(p.ws + WS_S0) + (size_t)unit * 4096;
        const bf16_t* q1 = (const bf16_t*)(p.ws + WS_Q1) + (size_t)unit * 4096 + tq * 64;
#pragma unroll
        for (int s4 = 0; s4 < 4; ++s4) {
            const bf16x8 fa0 = *(const bf16x8*)(s0 + (l31) * 64 + 16 * s4 + 8 * hh);
            const bf16x8 fa1 = *(const bf16x8*)(s0 + (32 + l31) * 64 + 16 * s4 + 8 * hh);
            const bf16x8 fb = *(const bf16x8*)(q1 + 16 * s4 + 8 * hh);
            a0 = __builtin_amdgcn_mfma_f32_32x32x16_bf16(fa0, fb, a0, 0, 0, 0);
            a1 = __builtin_amdgcn_mfma_f32_32x32x16_bf16(fa1, fb, a1, 0, 0, 0);
        }
        float sm = 0.f;
#pragma unroll
        for (int i = 0; i < 16; ++i) sm += a0[i] + a1[i];
        sm = xor32_sum(sm);
        const float mean = sm * (1.f / 64.f);
        float sq = 0.f;
#pragma unroll
        for (int i = 0; i < 16; ++i) { const float d0 = a0[i] - mean, d1 = a1[i] - mean; sq += d0 * d0 + d1 * d1; }
        sq = xor32_sum(sq);
        const float rstd = rsqrtf(sq * (1.f / 64.f) + 64e-5f);
        const float rk = RKSb[tok * 16 + h];
#pragma unroll
        for (int vb = 0; vb < 2; ++vb) {
            uint2 zc_[4], zp_[4], gv_[4]; float4 mu_[4], lw_[4], lb_[4];
#pragma unroll
            for (int q = 0; q < 4; ++q) {
                const int ch = h * 64 + vb * 32 + 8 * q + 4 * hh;
                zc_[q] = *(const uint2*)(z + (size_t)tok * INC + ZC_RW + 2048 + ch);
                zp_[q] = make_uint2(0u, 0u);
                if (tok & (SEQ - 1)) zp_[q] = *(const uint2*)(z + (size_t)(tok - 1) * INC + ZC_RW + 2048 + ch);
                gv_[q] = *(const uint2*)(GVb + (size_t)tok * RW + ch);
                mu_[q] = *(const float4*)(p.mu + 2048 + ch); lw_[q] = *(const float4*)(p.ln_w + ch); lb_[q] = *(const float4*)(p.ln_b + ch);
            }
#pragma unroll
            for (int q = 0; q < 4; ++q) {
                const int ch = h * 64 + vb * 32 + 8 * q + 4 * hh;
                const uint2 zc2 = zc_[q], zp2 = zp_[q], g2 = gv_[q];
                const float4 muv = mu_[q], lnw = lw_[q], lnb = lb_[q];
                float4 vv, gv;
                vv.x = bflo(zc2.x) + (bflo(zp2.x) - bflo(zc2.x)) * muv.x; vv.y = bfhi(zc2.x) + (bfhi(zp2.x) - bfhi(zc2.x)) * muv.y;
                vv.z = bflo(zc2.y) + (bflo(zp2.y) - bflo(zc2.y)) * muv.z; vv.w = bfhi(zc2.y) + (bfhi(zp2.y) - bfhi(zc2.y)) * muv.w;
                gv.x = bflo(g2.x); gv.y = bfhi(g2.x); gv.z = bflo(g2.y); gv.w = bfhi(g2.y);
                float y[4];
#pragma unroll
                for (int e = 0; e < 4; ++e) y[e] = ((vb ? a1[4 * q + e] : a0[4 * q + e]) - mean) * rstd;
                uint2 o;
                o.x = cvtpk((y[0] * lnw.x + lnb.x + rk * vv.x) * gv.x, (y[1] * lnw.y + lnb.y + rk * vv.y) * gv.y);
                o.y = cvtpk((y[2] * lnw.z + lnb.z + rk * vv.z) * gv.z, (y[3] * lnw.w + lnb.w + rk * vv.w) * gv.w);
                *(uint2*)(mix + (size_t)tok * DM + 1024 + ch) = o;
            }
        }
    }
}

DEVI void phase6(const Params& p, char* smem) {
    pg8::Gemm g{(const pg8::bf16_t*)(p.ws + WS_MIX), (const pg8::bf16_t*)(p.ws + WS_WTO), NTOK, DM, DM};
    pg8::StaticOrder S; S.init(NTOK, DM, (int)gridDim.x, (int)blockIdx.x);
    pg8::EpiX1 E{(float*)(p.ws + WS_X1), p.x, (const float*)(p.ws + WS_MODF) + 2 * DM, DM, 12288, SEQ};
    pg8::gemm_phase<pg8::EpiX1, pg8::StaticOrder, true, true>((PG8_LAS unsigned char*)smem, g, S, E);
}

DEVI void phase7(const Params& p, char* smem) {
    float* part = (float*)smem;
    float* ssq = part + 8 * 32 * 80;
    float* rstd_s = ssq + 8 * 128;
    float* lg_ = rstd_s + 32;
    const float* x1 = (const float*)(p.ws + WS_X1);
    const uint4* wrf = (const uint4*)(p.ws + WS_WRF);
    const float* cb = (const float*)(p.ws + WS_CB);
    const float* as2 = (const float*)(p.ws + WS_AS2);
    bf16_t* h = (bf16_t*)(p.ws + WS_H);
    int* cnt = (int*)(p.ws + WS_CTL + CNT_OFF);
    int* list = (int*)(p.ws + WS_LIST); float* lw = (float*)(p.ws + WS_LWT);
    const int tid = threadIdx.x, lane = tid & 63, wave = tid >> 6, li = lane & 15, lg = lane >> 4;
    for (int u = blockIdx.x; u < NTOK / 32; u += gridDim.x) {
        const int tok0 = u * 32, b = tok0 >> 12;
        __syncthreads();
        f32x4 acc[2][5];
#pragma unroll
        for (int tg = 0; tg < 2; ++tg)
#pragma unroll
            for (int nf = 0; nf < 5; ++nf) acc[tg][nf] = f32x4{0.f, 0.f, 0.f, 0.f};
        float sq[2] = {0.f, 0.f};
        const float* xr = x1 + (size_t)(tok0 + li) * DM + wave * 256 + 8 * lg;
#pragma unroll 2
        for (int s4 = 0; s4 < 8; ++s4) {
            bf16x8 ah[2], al[2];
#pragma unroll
            for (int tg = 0; tg < 2; ++tg) {
                const float4 xa = *(const float4*)(xr + (size_t)tg * 16 * DM + s4 * 32), xb = *(const float4*)(xr + (size_t)tg * 16 * DM + s4 * 32 + 4);
                sq[tg] += xa.x * xa.x + xa.y * xa.y + xa.z * xa.z + xa.w * xa.w + xb.x * xb.x + xb.y * xb.y + xb.z * xb.z + xb.w * xb.w;
                uint4 hi, lo;
                hi.x = cvtpk(xa.x, xa.y); hi.y = cvtpk(xa.z, xa.w); hi.z = cvtpk(xb.x, xb.y); hi.w = cvtpk(xb.z, xb.w);
                lo.x = cvtpk(xa.x - bflo(hi.x), xa.y - bfhi(hi.x)); lo.y = cvtpk(xa.z - bflo(hi.y), xa.w - bfhi(hi.y));
                lo.z = cvtpk(xb.x - bflo(hi.z), xb.y - bfhi(hi.z)); lo.w = cvtpk(xb.z - bflo(hi.w), xb.w - bfhi(hi.w));
                ah[tg] = __builtin_bit_cast(bf16x8, hi); al[tg] = __builtin_bit_cast(bf16x8, lo);
            }
            const uint4* wf = wrf + ((size_t)(b * 64 + wave * 8 + s4) * 5) * 128 + lane;
#pragma unroll
            for (int nf = 0; nf < 5; ++nf) {
                const bf16x8 bh = __builtin_bit_cast(bf16x8, wf[nf * 128]), bl = __builtin_bit_cast(bf16x8, wf[nf * 128 + 64]);
#pragma unroll
                for (int tg = 0; tg < 2; ++tg) {
                    acc[tg][nf] = __builtin_amdgcn_mfma_f32_16x16x32_bf16(al[tg], bh, acc[tg][nf], 0, 0, 0);
                    acc[tg][nf] = __builtin_amdgcn_mfma_f32_16x16x32_bf16(ah[tg], bl, acc[tg][nf], 0, 0, 0);
                    acc[tg][nf] = __builtin_amdgcn_mfma_f32_16x16x32_bf16(ah[tg], bh, acc[tg][nf], 0, 0, 0);
                }
            }
        }
#pragma unroll
        for (int tg = 0; tg < 2; ++tg) {
#pragma unroll
            for (int nf = 0; nf < 5; ++nf)
#pragma unroll
                for (int r = 0; r < 4; ++r) part[(wave * 32 + 16 * tg + 4 * lg + r) * 80 + nf * 16 + li] = acc[tg][nf][r];
            ssq[(wave * 4 + lg) * 32 + 16 * tg + li] = sq[tg];
        }
        __syncthreads();
        if (tid < 32) {
            float t = 0.f;
#pragma unroll
            for (int q = 0; q < 32; ++q) t += ssq[q * 32 + tid];
            rstd_s[tid] = rsqrtf(t * (1.f / DM) + 1e-6f);
        }
        __syncthreads();
        for (int idx = tid; idx < 32 * 80; idx += 512) {
            const int tk = idx / 80, j = idx % 80;
            float t = 0.f;
#pragma unroll
            for (int w = 0; w < 8; ++w) t += part[(w * 32 + tk) * 80 + j];
            lg_[idx] = rstd_s[tk] * t + cb[b * 80 + j];
        }
        __syncthreads();
        if (tid < 32) {
            const int tok = tok0 + tid;
            const float* L = lg_ + tid * 80;
            int gi = 0; float gm = L[64];
            for (int j = 1; j < 8; ++j) if (L[64 + j] > gm) { gm = L[64 + j]; gi = j; }
            float den = 0.f;
            for (int j = 0; j < 8; ++j) den += expf(L[64 + j] - gm);
            const float ggate = 1.f / den;
            const float* E = L + gi * 8;
            int i1 = 0; float m1 = E[0];
            for (int j = 1; j < 8; ++j) if (E[j] > m1) { m1 = E[j]; i1 = j; }
            int i2 = -1; float m2 = -3.0e38f;
            for (int j = 0; j < 8; ++j) if (j != i1 && E[j] > m2) { m2 = E[j]; i2 = j; }
            const float e2 = expf(m2 - m1);
            const float p1 = 1.f / (1.f + e2), p2 = e2 / (1.f + e2);
            const int ex1 = gi * 8 + i1, ex2 = gi * 8 + i2;
            const int pos1 = atomicAdd(&cnt[ex1 * CNT_ST], 1); list[ex1 * LCAP + pos1] = tok * 2; lw[ex1 * LCAP + pos1] = ggate * p1;
            const int pos2 = atomicAdd(&cnt[ex2 * CNT_ST], 1); list[ex2 * LCAP + pos2] = tok * 2 + 1; lw[ex2 * LCAP + pos2] = ggate * p2;
        }
        {
            float4 av[8], sv[8];
#pragma unroll
            for (int i = 0; i < 8; ++i) { const int k = i * 256 + lane * 4; av[i] = *(const float4*)(as2 + b * DM + k); sv[i] = *(const float4*)(as2 + 2 * DM + b * DM + k); }
#pragma unroll
            for (int tp = 0; tp < 4; tp += 2) {
                float4 xv[2][8];
#pragma unroll
                for (int t2 = 0; t2 < 2; ++t2)
#pragma unroll
                    for (int i = 0; i < 8; ++i) xv[t2][i] = *(const float4*)(x1 + (size_t)(tok0 + wave * 4 + tp + t2) * DM + i * 256 + lane * 4);
#pragma unroll
                for (int t2 = 0; t2 < 2; ++t2) {
                    const int tk = wave * 4 + tp + t2, tok = tok0 + tk;
                    const float rs = rstd_s[tk];
#pragma unroll
                    for (int i = 0; i < 8; ++i) {
                        const int k = i * 256 + lane * 4;
                        uint2 o; o.x = cvtpk(xv[t2][i].x * rs * av[i].x + sv[i].x, xv[t2][i].y * rs * av[i].y + sv[i].y); o.y = cvtpk(xv[t2][i].z * rs * av[i].z + sv[i].z, xv[t2][i].w * rs * av[i].w + sv[i].w);
                        *(uint2*)(h + (size_t)tok * DM + k) = o;
                    }
                }
            }
        }
    }
}

struct MoeTab { int cnt[64]; int sb[65]; int ubx[9]; int np[8]; };
DEVI void moe_tables(const Params& p, MoeTab* tb, int slabs) {
    const int* cnt = (const int*)(p.ws + WS_CTL + CNT_OFF);
    const int tid = threadIdx.x, x = blockIdx.x & 7;
    __syncthreads();
    if (tid < 64) tb->cnt[tid] = cnt[tid * CNT_ST];
    __syncthreads();
    if (tid == 0) {
        int sb = 0;
        for (int e = 0; e < 64; ++e) { tb->sb[e] = sb; sb += tb->cnt[e]; }
        tb->sb[64] = sb;
        int ub = 0;
        for (int i = 0; i < 8; ++i) { const int np = (tb->cnt[x + 8 * i] + 255) >> 8; tb->np[i] = np; tb->ubx[i] = ub; ub += np * slabs; }
        tb->ubx[8] = ub;
    }
    __syncthreads();
}
struct MoeUnit { int e, s, ce, sbase, rbeg, rend; };
DEVI MoeUnit moe_unit(const MoeTab* tb, int u) {
    int i = 0;
    while (tb->ubx[i + 1] <= u) ++i;
    const int rem = u - tb->ubx[i], np = tb->np[i], ps = rem % np;
    MoeUnit m; m.e = (blockIdx.x & 7) + 8 * i; m.s = rem / np; m.ce = tb->cnt[m.e]; m.sbase = tb->sb[m.e];
    const int rp = (((m.ce + np - 1) / np) + 15) & ~15;
    m.rbeg = ps * rp; m.rend = m.rbeg + rp < m.ce ? m.rbeg + rp : m.ce;
    m.e = __builtin_amdgcn_readfirstlane(m.e); m.s = __builtin_amdgcn_readfirstlane(m.s); m.ce = __builtin_amdgcn_readfirstlane(m.ce);
    m.sbase = __builtin_amdgcn_readfirstlane(m.sbase); m.rbeg = __builtin_amdgcn_readfirstlane(m.rbeg); m.rend = __builtin_amdgcn_readfirstlane(m.rend);
    return m;
}

DEVI void phase8(const Params& p, char* smem) {
    MoeTab* tb = (MoeTab*)(smem + 32768);
    const bf16_t* h = (const bf16_t*)(p.ws + WS_H);
    bf16_t* hid = (bf16_t*)(p.ws + WS_HID);
    const int* list = (const int*)(p.ws + WS_LIST);
    moe_tables(p, tb, 4);
    const int total = __builtin_amdgcn_readfirstlane(tb->ubx[8]), nslot = ((int)gridDim.x - (int)(blockIdx.x & 7) + 7) >> 3;
    for (int u = blockIdx.x >> 3; u < total; u += nslot) {
        int tid = threadIdx.x;
        asm volatile("" : "+v"(tid));
        const int lane = tid & 63, wave = tid >> 6, li = lane & 15, lg = lane >> 4;
        const MoeUnit mu = moe_unit(tb, u);
        const int e = mu.e, s = mu.s;
        const int fcol = s * 128 + wave * 16;
        const gcp_t wb0 = uniform_ptr(p.w1 + (size_t)e * DM * FF), wb1 = uniform_ptr(p.w3 + (size_t)e * DM * FF);
        const unsigned boff = (unsigned)(((8 * lg) * FF + fcol + li) * 4);
        int r0 = mu.rbeg + (tid >> 2), r1 = r0 + 128; r0 = r0 < mu.rend ? r0 : mu.rend - 1; r1 = r1 < mu.rend ? r1 : mu.rend - 1;
        const unsigned aoff0 = (unsigned)(((list[e * LCAP + r0] >> 1) * DM + (tid & 3) * 8) * 2), aoff1 = (unsigned)(((list[e * LCAP + r1] >> 1) * DM + (tid & 3) * 8) * 2);
        __syncthreads();
        gemm_tile_s<2, DM / 32, FF, 0>(smem, wb0, wb1, boff, uniform_ptr(h), aoff0, aoff1, [&](f32x4 (&acc)[16][2]) {
            int t2 = threadIdx.x;
            asm volatile("" : "+v"(t2));
            const int lio = t2 & 15, cof = ((t2 >> 6) * 16 + 4 * ((t2 >> 4) & 3));
#pragma unroll
            for (int m = 0; m < 16; ++m) {
                const int r = mu.rbeg + 16 * m + lio;
                if (r < mu.rend) {
                    float hv[4];
#pragma unroll
                    for (int q = 0; q < 4; ++q) { const float a = acc[m][0][q]; hv[q] = a / (1.f + __expf(-a)) * acc[m][1][q]; }
                    uint2 o; o.x = cvtpk(hv[0], hv[1]); o.y = cvtpk(hv[2], hv[3]);
                    *(uint2*)(hid + (size_t)(mu.sbase + r) * FF + s * 128 + cof) = o;
                }
            }
        });
    }
}

DEVI void phase9(const Params& p, char* smem) {
    MoeTab* tb = (MoeTab*)(smem + 32768);
    const bf16_t* hid = (const bf16_t*)(p.ws + WS_HID);
    bf16_t* yb = (bf16_t*)(p.ws + WS_YB);
    const int* list = (const int*)(p.ws + WS_LIST); const float* lw = (const float*)(p.ws + WS_LWT);
    moe_tables(p, tb, 8);
    const int total = __builtin_amdgcn_readfirstlane(tb->ubx[8]), nslot = ((int)gridDim.x - (int)(blockIdx.x & 7) + 7) >> 3;
    for (int u = blockIdx.x >> 3; u < total; u += nslot) {
        int tid = threadIdx.x;
        asm volatile("" : "+v"(tid));
        const int lane = tid & 63, wave = tid >> 6, li = lane & 15, lg = lane >> 4;
        const MoeUnit mu = moe_unit(tb, u);
        const int e = mu.e, s = mu.s;
        const int col0 = s * 256 + wave * 32;
        const gcp_t wb0 = uniform_ptr(p.w2 + (size_t)e * FF * DM), wb1 = wb0 + 64;
        const unsigned boff = (unsigned)(((8 * lg) * DM + col0 + li) * 4);
        int r0 = mu.rbeg + (tid >> 2), r1 = r0 + 128; r0 = r0 < mu.rend ? r0 : mu.rend - 1; r1 = r1 < mu.rend ? r1 : mu.rend - 1;
        const unsigned aoff0 = (unsigned)(((mu.sbase + r0) * FF + (tid & 3) * 8) * 2), aoff1 = (unsigned)(((mu.sbase + r1) * FF + (tid & 3) * 8) * 2);
        __syncthreads();
        gemm_tile_s<2, FF / 32, DM, 64>(smem, wb0, wb1, boff, uniform_ptr(hid), aoff0, aoff1, [&](f32x4 (&acc)[16][2]) {
            int t2 = threadIdx.x;
            asm volatile("" : "+v"(t2));
            const int lio = t2 & 15, cof = ((t2 >> 6) * 32 + 4 * ((t2 >> 4) & 3));
#pragma unroll
            for (int m = 0; m < 16; ++m) {
                const int r = mu.rbeg + 16 * m + lio;
                if (r < mu.rend) {
                    const int a = list[e * LCAP + r]; const float wgt = lw[e * LCAP + r];
#pragma unroll
                    for (int nf = 0; nf < 2; ++nf) {
                        uint2 o; o.x = cvtpk(acc[m][nf][0] * wgt, acc[m][nf][1] * wgt); o.y = cvtpk(acc[m][nf][2] * wgt, acc[m][nf][3] * wgt);
                        *(uint2*)(yb + (size_t)a * DM + s * 256 + cof + nf * 16) = o;
                    }
                }
            }
        });
    }
}

DEVI void phase10(const Params& p, char* smem) {
    const float* modf = (const float*)(p.ws + WS_MODF);
    const float* x1 = (const float*)(p.ws + WS_X1);
    const bf16_t* yb = (const bf16_t*)(p.ws + WS_YB);
    const int tid = threadIdx.x, lane = tid & 63, wave = tid >> 6;
    for (int u = blockIdx.x; u < NTOK / 8; u += gridDim.x) {
        const int tok = u * 8 + wave, b = tok >> 12;
        float4 v[8]; float ss = 0.f;
#pragma unroll
        for (int i = 0; i < 8; ++i) {
            const int k = i * 256 + lane * 4;
            const float4 xv = *(const float4*)(x1 + (size_t)tok * DM + k);
            const float4 gt = *(const float4*)(modf + b * 12288 + 5 * DM + k);
            const uint2 ya = *(const uint2*)(yb + (size_t)(tok * 2) * DM + k), yc = *(const uint2*)(yb + (size_t)(tok * 2 + 1) * DM + k);
            v[i].x = xv.x + gt.x * (bflo(ya.x) + bflo(yc.x)); v[i].y = xv.y + gt.y * (bfhi(ya.x) + bfhi(yc.x));
            v[i].z = xv.z + gt.z * (bflo(ya.y) + bflo(yc.y)); v[i].w = xv.w + gt.w * (bfhi(ya.y) + bfhi(yc.y));
            ss += v[i].x * v[i].x + v[i].y * v[i].y + v[i].z * v[i].z + v[i].w * v[i].w;
        }
        ss = wave_sum(ss);
        const float rstd = rsqrtf(ss * (1.f / DM) + 1e-6f);
#pragma unroll
        for (int i = 0; i < 8; ++i) {
            const int k = i * 256 + lane * 4;
            const float4 g = *(const float4*)(p.final_g + k);
            float4 o; o.x = v[i].x * rstd * g.x; o.y = v[i].y * rstd * g.y; o.z = v[i].z * rstd * g.z; o.w = v[i].w * rstd * g.w;
            *(float4*)(p.out + (size_t)tok * DM + k) = o;
        }
    }
}

constexpr size_t WS_BAR = 4096;
constexpr int N_PHASES = 12;
#ifndef MK_N_LAUNCHES
#define MK_N_LAUNCHES 1
#endif

__global__ void __launch_bounds__(512) mega_kernel(Params p, int lo, int hi) {
    extern __shared__ __attribute__((aligned(16))) char smem[];
    volatile LAS unsigned* xb_words = (volatile LAS unsigned*)(smem + LDS_BYTES - 16);
    if (threadIdx.x == 0) { xb_words[0] = 0u; xb_words[1] = 0u; xb_words[2] = 0u; xb_words[3] = 0u; }
    __syncthreads();
    XcdBarrier bar;
    if (hi - lo > 1) bar = xcd_barrier_post((unsigned*)(p.ws + WS_BAR), xb_words);
#define IN(k) (lo <= (k) && (k) < hi)
    unsigned long long ts_a = 0ull, ts_b = 0ull;
#define STAMP(k) do { if (PROBE_TS >= 0 && blockIdx.x == 0) { if ((k) == PROBE_TS) ts_a = __builtin_amdgcn_s_memrealtime(); if ((k) == PROBE_TS + 1) ts_b = __builtin_amdgcn_s_memrealtime(); } } while (0)
#define SEAM(k) do { if (IN(k) && IN((k) + 1)) { xcd_barrier(bar); STAMP((k) + 1); } } while (0)
    STAMP(0);
#ifndef PROBE_MASK
#define PROBE_MASK 0
#endif
#define REP(k) (((PROBE_MASK >> (k)) & 1) ? 2 : 1)
    if (IN(0)) for (int rp = 0; rp < REP(0); ++rp) phase0(p, smem);
    SEAM(0);
    if (IN(1)) for (int rp = 0; rp < REP(1); ++rp) phase1(p, smem);
    SEAM(1);
    if (IN(2)) for (int rp = 0; rp < REP(2); ++rp) phase2(p, smem);
    SEAM(2);
    if (IN(3)) for (int rp = 0; rp < REP(3); ++rp) phase3(p, smem);
    SEAM(3);
    if (IN(4)) for (int rp = 0; rp < REP(4); ++rp) phaseRA(p, smem);
    SEAM(4);
    if (IN(5)) for (int rp = 0; rp < REP(5); ++rp) phaseRB(p, smem);
    SEAM(5);
    if (IN(6)) for (int rp = 0; rp < REP(6); ++rp) phaseRC(p, smem);
    SEAM(6);
    if (IN(7)) for (int rp = 0; rp < REP(7); ++rp) phase6(p, smem);
    SEAM(7);
    if (IN(8)) phase7(p, smem);
    SEAM(8);
    if (IN(9)) for (int rp = 0; rp < REP(9); ++rp) phase8(p, smem);
    SEAM(9);
    if (IN(10)) for (int rp = 0; rp < REP(10); ++rp) phase9(p, smem);
    SEAM(10);
    if (IN(11)) for (int rp = 0; rp < REP(11); ++rp) phase10(p, smem);
    STAMP(12);
    if (PROBE_TS >= 0 && blockIdx.x == 0) { const unsigned long long t0 = __builtin_amdgcn_s_memrealtime(), dt = 2ull * (ts_b - ts_a); while (__builtin_amdgcn_s_memrealtime() - t0 < dt) __builtin_amdgcn_s_sleep(8); }
#undef IN
#undef SEAM
}

extern "C" void kernel_launch(void* const* d_in, const int* in_sizes, int n_in, void* d_out, int out_size, void* d_ws, size_t ws_size, hipStream_t stream) {
    static int grid = 0;
    if (!grid) {
        int dev = 0, cus = 0, per_cu = 0;
        (void)hipGetDevice(&dev);
        (void)hipDeviceGetAttribute(&cus, hipDeviceAttributeMultiprocessorCount, dev);
        if (hipFuncSetAttribute((const void*)mega_kernel, hipFuncAttributeMaxDynamicSharedMemorySize, LDS_BYTES) != hipSuccess) { grid = -1; return; }
        if (hipOccupancyMaxActiveBlocksPerMultiprocessor(&per_cu, (const void*)mega_kernel, 512, LDS_BYTES) != hipSuccess || per_cu < 1) { grid = -1; return; }
        grid = cus;
        if (grid > 256) grid = 256;
    }
    if (grid < 0) return;
    Params p{};
    const float* const* in = (const float* const*)d_in;
    p.x = in[0]; p.c = in[1]; p.w_ada = in[2]; p.b_ada = in[3]; p.norm1_g = in[4]; p.w_in = in[5]; p.mu = in[6]; p.sinks = in[7]; p.w0 = in[8]; p.wd_up = in[9];
    p.a0 = in[10]; p.wa_up = in[11]; p.wg_up = in[12]; p.k_k = in[13]; p.k_a = in[14]; p.r_k = in[15]; p.ln_w = in[16]; p.ln_b = in[17]; p.w_o = in[18]; p.norm2_g = in[19];
    p.w_rg = in[20]; p.b_rg = in[21]; p.w_re = in[22]; p.b_re = in[23]; p.w1 = in[24]; p.w3 = in[25]; p.w2 = in[26]; p.final_g = in[27];
    p.out = (float*)d_out; p.ws = (unsigned char*)d_ws;
    (void)hipMemsetAsync((char*)d_ws + WS_CTL, 0, CTL_BYTES, stream);
#if MK_N_LAUNCHES == 1
    hipLaunchKernelGGL(mega_kernel, dim3(grid), dim3(512), LDS_BYTES, stream, p, 0, N_PHASES);
#else
    for (int k = 0; k < N_PHASES; ++k) hipLaunchKernelGGL(mega_kernel, dim3(grid), dim3(512), LDS_BYTES, stream, p, k, k + 1);
#endif
}
```
